# Optimizing an MI355X kernel written in HIP

```python
import math
import jax, jax.numpy as jnp
from jax import lax
import numpy as np

D_MODEL = 1024
BATCH = 32
SEQ = 256
DEPTH = 4
DEC_BATCH = 8
DEC_SEQ = 2048
PAST_LEN = 512

GRID_W = 64
MLA_HEADS = 6
MLA_NOPE = 64
MLA_ROPE = 32
MLA_DV = 64
MLA_KV_RANK = 128
DIFF_HEADS = 6
DIFF_DH = 32
DIFF_DV = 2 * DIFF_DH
FOURIER_GROUPS = 4
FOURIER_GROUP_W = 64
FOURIER_WIDTH = FOURIER_GROUPS * FOURIER_GROUP_W
MIX_WIDTH = MLA_HEADS * MLA_DV + DIFF_HEADS * DIFF_DV + FOURIER_WIDTH
D_FF = 2816
CONV_W = 3
ROPE_BASE = 10000.0
Q_BLOCK = 128
EPS = 1e-6
MLA_SCALE = (MLA_NOPE + MLA_ROPE) ** -0.5
DIFF_SCALE = DIFF_DH ** -0.5
_MLA_Q_END = MLA_HEADS * (MLA_NOPE + MLA_ROPE)
_CKV_END = _MLA_Q_END + MLA_KV_RANK
_KROPE_END = _CKV_END + MLA_ROPE
_DQ_END = _KROPE_END + DIFF_HEADS * 2 * DIFF_DH
_DK_END = _DQ_END + DIFF_HEADS * 2 * DIFF_DH
_DV_END = _DK_END + DIFF_HEADS * DIFF_DV
IN_COLS = _DV_END + FOURIER_WIDTH
IN_SPLITS = (_MLA_Q_END, _CKV_END, _KROPE_END, _DQ_END, _DK_END, _DV_END)

kernel_name = "hybrid_mla_diffattn_fnet_prefix_dit_step"


def _rmsnorm(x, g):
    xf = x.astype(jnp.float32)
    y = xf * lax.rsqrt(jnp.mean(xf * xf, axis=-1, keepdims=True) + EPS)
    return (y * g.astype(jnp.float32)).astype(x.dtype)


def _modulation(cond, w_ada_l, b_ada_l):
    mod = jax.nn.silu(cond) @ w_ada_l + b_ada_l
    mod = mod.reshape(cond.shape[:-1] + (1, 6, D_MODEL))
    return tuple(mod[..., i, :] for i in range(6))


def _modulate(x, g, shift, scale):
    return _rmsnorm(x, g) * (1.0 + scale) + shift


def _axial_rope_tables(n, dim):
    rows = n // GRID_W
    row = jnp.broadcast_to(jnp.arange(rows)[:, None], (rows, GRID_W)).reshape(-1).astype(jnp.float32)
    col = jnp.broadcast_to(jnp.arange(GRID_W)[None, :], (rows, GRID_W)).reshape(-1).astype(jnp.float32)
    quarter = dim // 4
    inv = ROPE_BASE ** (-jnp.arange(quarter, dtype=jnp.float32) / quarter)
    ang_r = row[:, None] * inv
    ang_c = col[:, None] * inv
    return (jnp.cos(ang_r), jnp.sin(ang_r), jnp.cos(ang_c), jnp.sin(ang_c))


def _rotate(x, cos, sin):
    x1, x2 = jnp.split(x, 2, axis=-1)
    return jnp.concatenate([x1 * cos - x2 * sin, x2 * cos + x1 * sin], axis=-1)


def _apply_axial_rope(x, tables):
    mid = [1] * (x.ndim - 3)
    cos_r, sin_r, cos_c, sin_c = (t.reshape(t.shape[0], *mid, t.shape[1]).astype(x.dtype) for t in tables)
    xr, xc = jnp.split(x, 2, axis=-1)
    return jnp.concatenate([_rotate(xr, cos_r, sin_r), _rotate(xc, cos_c, sin_c)], axis=-1)


def _map_query_blocks(fn, qs):
    B, N = qs[0].shape[:2]
    nb = N // Q_BLOCK
    blocks = tuple(q.reshape(B, nb, Q_BLOCK, *q.shape[2:]).swapaxes(0, 1) for q in qs)
    out = lax.map(lambda b: fn(*b), blocks)
    return out.swapaxes(0, 1).reshape(B, N, *out.shape[3:])


def _joint_scores(qb, ks, scale):
    s = jnp.concatenate([jnp.einsum('bqhd,bkhd->bhqk', q, k) for q, k in zip(qb, ks)], axis=-1)
    return s.astype(jnp.float32) * scale


def _joint_attention(qs, ks, v, scale):
    def block(*qb):
        p = jax.nn.softmax(_joint_scores(qb, ks, scale), axis=-1)
        return jnp.einsum('bhqk,bkhd->bqhd', p.astype(v.dtype), v)
    return _map_query_blocks(block, tuple(qs))


def _diff_joint_attention(q1s, k1s, q2s, k2s, v, lam, scale):
    n = len(k1s)
    def block(*qb):
        p1 = jax.nn.softmax(_joint_scores(qb[:n], k1s, scale), axis=-1)
        p2 = jax.nn.softmax(_joint_scores(qb[n:], k2s, scale), axis=-1)
        a = p1 - lam * p2
        return jnp.einsum('bhqk,bkhd->bqhd', a.astype(v.dtype), v)
    return _map_query_blocks(block, tuple(q1s) + tuple(q2s))


def _project(h, w_in_l, g_kv_l):
    B, N = h.shape[:2]
    p = h @ w_in_l
    q_m, ckv, krope, q_d, k_d, v_d, u_f = jnp.split(p, IN_SPLITS, axis=-1)
    return (q_m.reshape(B, N, MLA_HEADS, MLA_NOPE + MLA_ROPE),
            _rmsnorm(ckv, g_kv_l),
            krope,
            q_d.reshape(B, N, DIFF_HEADS, 2 * DIFF_DH),
            k_d.reshape(B, N, DIFF_HEADS, 2 * DIFF_DH),
            v_d.reshape(B, N, DIFF_HEADS, DIFF_DV),
            u_f)


def _mla_kv(ckv, krope, w_uk_l, w_uv_l):
    B, L = ckv.shape[:2]
    k_nope = (ckv @ w_uk_l).reshape(B, L, MLA_HEADS, MLA_NOPE)
    v = (ckv @ w_uv_l).reshape(B, L, MLA_HEADS, MLA_DV)
    k_rope = jnp.broadcast_to(krope[:, :, None, :], (B, L, MLA_HEADS, MLA_ROPE))
    return jnp.concatenate([k_nope, k_rope], axis=-1), v


def _fourier_mix(u):
    B, N = u.shape[:2]
    uf = u.reshape(B, N, FOURIER_GROUPS, FOURIER_GROUP_W).astype(jnp.float32)
    y = jnp.fft.fft2(uf, axes=(1, 3), norm="ortho").real
    return y.reshape(B, N, FOURIER_WIDTH).astype(u.dtype)


def _merge(o_m, o_d, u_f, g_sub_l, lam_init, w_out_l):
    B, N = o_m.shape[:2]
    o_d = _rmsnorm(o_d, g_sub_l) * (1.0 - lam_init)
    o = jnp.concatenate([o_m.reshape(B, N, -1), o_d.reshape(B, N, -1), _fourier_mix(u_f)], axis=-1)
    return o @ w_out_l


def _conv_ffn(h, w_up_l, w_conv_l, w_down_l):
    N = h.shape[1]
    u = h @ w_up_l
    pad = CONV_W // 2
    up = jnp.pad(u, ((0, 0), (pad, pad), (0, 0)))
    u = sum(up[:, j:j + N] * w_conv_l[j] for j in range(CONV_W))
    gate, val = jnp.split(u, 2, axis=-1)
    return (jax.nn.silu(gate) * val) @ w_down_l


def _context_mixer(h, lw, lam, lam_init):
    q_m, ckv, krope, q_d, k_d, v_d, u_f = _project(h, lw['w_in'], lw['g_kv'])
    k_m, v_m = _mla_kv(ckv, krope, lw['w_uk'], lw['w_uv'])
    o_m = _joint_attention((q_m,), (k_m,), v_m, MLA_SCALE)
    o_d = _diff_joint_attention((q_d[..., :DIFF_DH],), (k_d[..., :DIFF_DH],),
                                (q_d[..., DIFF_DH:],), (k_d[..., DIFF_DH:],), v_d, lam, DIFF_SCALE)
    o = _merge(o_m, o_d, u_f, lw['g_sub'], lam_init, lw['w_out'])
    return o, ckv, krope, k_d, v_d


def _latent_mixer(h, ckv_c, krope_c, kd_c, vd_c, lw, lam, lam_init, rope_m, rope_d):
    q_m, ckv, krope, q_d, k_d, v_d, u_f = _project(h, lw['w_in'], lw['g_kv'])
    q_nope, q_rope = jnp.split(q_m, [MLA_NOPE], axis=-1)
    q_lat = jnp.concatenate([q_nope, _apply_axial_rope(q_rope, rope_m)], axis=-1)
    k_lat, v_lat = _mla_kv(ckv, _apply_axial_rope(krope, rope_m), lw['w_uk'], lw['w_uv'])
    k_ctx, v_ctx = _mla_kv(ckv_c, krope_c, lw['w_uk'], lw['w_uv'])
    o_m = _joint_attention((q_lat, q_m), (k_lat, k_ctx),
                           jnp.concatenate([v_lat, v_ctx], axis=1), MLA_SCALE)
    B, N = q_d.shape[:2]
    q_rot = _apply_axial_rope(q_d.reshape(B, N, DIFF_HEADS, 2, DIFF_DH), rope_d).reshape(q_d.shape)
    k_rot = _apply_axial_rope(k_d.reshape(B, N, DIFF_HEADS, 2, DIFF_DH), rope_d).reshape(k_d.shape)
    o_d = _diff_joint_attention(
        (q_rot[..., :DIFF_DH], q_d[..., :DIFF_DH]), (k_rot[..., :DIFF_DH], kd_c[..., :DIFF_DH]),
        (q_rot[..., DIFF_DH:], q_d[..., DIFF_DH:]), (k_rot[..., DIFF_DH:], kd_c[..., DIFF_DH:]),
        jnp.concatenate([v_d, vd_c], axis=1), lam, DIFF_SCALE)
    return _merge(o_m, o_d, u_f, lw['g_sub'], lam_init, lw['w_out'])


def setup_inputs(seed: int = 0) -> dict:
    key = jax.random.key(seed)
    ks = jax.random.split(key, 26)
    f32 = jnp.float32

    def nrm(k, shape, scale=1.0):
        return jax.random.normal(k, shape, f32) * scale

    return {
        "x_prompt": nrm(ks[0], (BATCH, SEQ, D_MODEL)),
        "x_sample": nrm(ks[1], (DEC_BATCH, DEC_SEQ, D_MODEL)),
        "c": nrm(ks[2], (DEC_BATCH, D_MODEL)),
        "cache_mla_ckv": nrm(ks[3], (DEC_BATCH, DEPTH, PAST_LEN, MLA_KV_RANK)),
        "cache_mla_krope": nrm(ks[4], (DEC_BATCH, DEPTH, PAST_LEN, MLA_ROPE)),
        "cache_diff_k": nrm(ks[5], (DEC_BATCH, DEPTH, PAST_LEN, DIFF_HEADS, 2 * DIFF_DH)),
        "cache_diff_v": nrm(ks[6], (DEC_BATCH, DEPTH, PAST_LEN, DIFF_HEADS, DIFF_DV)),
        "c_ctx": nrm(ks[7], (D_MODEL,)),
        "w_ada": nrm(ks[8], (DEPTH, D_MODEL, 6 * D_MODEL), 0.5 * D_MODEL ** -0.5),
        "b_ada": nrm(ks[9], (DEPTH, 6 * D_MODEL), 0.01),
        "g_mix_norm": 1.0 + nrm(ks[10], (DEPTH, D_MODEL), 0.02),
        "g_ffn_norm": 1.0 + nrm(ks[11], (DEPTH, D_MODEL), 0.02),
        "w_in": nrm(ks[12], (DEPTH, D_MODEL, IN_COLS), D_MODEL ** -0.5),
        "g_kv_norm": 1.0 + nrm(ks[13], (DEPTH, MLA_KV_RANK), 0.02),
        "w_uk": nrm(ks[14], (DEPTH, MLA_KV_RANK, MLA_HEADS * MLA_NOPE), MLA_KV_RANK ** -0.5),
        "w_uv": nrm(ks[15], (DEPTH, MLA_KV_RANK, MLA_HEADS * MLA_DV), MLA_KV_RANK ** -0.5),
        "lam_q1": nrm(ks[16], (DEPTH, DIFF_DH), 0.1),
        "lam_k1": nrm(ks[17], (DEPTH, DIFF_DH), 0.1),
        "lam_q2": nrm(ks[18], (DEPTH, DIFF_DH), 0.1),
        "lam_k2": nrm(ks[19], (DEPTH, DIFF_DH), 0.1),
        "g_diff_subln": 1.0 + nrm(ks[20], (DEPTH, DIFF_DV), 0.02),
        "w_out": nrm(ks[21], (DEPTH, MIX_WIDTH, D_MODEL), MIX_WIDTH ** -0.5),
        "w_up": nrm(ks[22], (DEPTH, D_MODEL, 2 * D_FF), D_MODEL ** -0.5),
        "w_conv": nrm(ks[23], (DEPTH, CONV_W, 2 * D_FF), CONV_W ** -0.5),
        "w_down": nrm(ks[24], (DEPTH, D_FF, D_MODEL), D_FF ** -0.5),
        "g_final": 1.0 + nrm(ks[25], (D_MODEL,), 0.02),
    }


def reference(x_prompt, x_sample, c, cache_mla_ckv, cache_mla_krope, cache_diff_k, cache_diff_v,
              c_ctx, w_ada, b_ada, g_mix_norm, g_ffn_norm, w_in, g_kv_norm, w_uk, w_uv,
              lam_q1, lam_k1, lam_q2, lam_k2, g_diff_subln, w_out, w_up, w_conv, w_down, g_final):
    n_lat = x_sample.shape[1]
    rope_m = _axial_rope_tables(n_lat, MLA_ROPE)
    rope_d = _axial_rope_tables(n_lat, DIFF_DH)
    x_c = x_prompt
    x_l = x_sample
    ckv_list, krope_list, dk_list, dv_list = [], [], [], []
    for l in range(DEPTH):
        lw = {'w_in': w_in[l], 'g_kv': g_kv_norm[l], 'w_uk': w_uk[l], 'w_uv': w_uv[l],
              'g_sub': g_diff_subln[l], 'w_out': w_out[l]}
        lam_init = 0.8 - 0.6 * math.exp(-0.3 * l)
        lam = (jnp.exp(jnp.sum(lam_q1[l].astype(jnp.float32) * lam_k1[l].astype(jnp.float32)))
               - jnp.exp(jnp.sum(lam_q2[l].astype(jnp.float32) * lam_k2[l].astype(jnp.float32)))
               + lam_init)

        sa, ca, ga, sf, cf, gf = _modulation(c_ctx, w_ada[l], b_ada[l])
        h = _modulate(x_c, g_mix_norm[l], sa, ca)
        o, ckv, krope, k_d, v_d = _context_mixer(h, lw, lam, lam_init)
        x_c = x_c + ga * o
        h = _modulate(x_c, g_ffn_norm[l], sf, cf)
        x_c = x_c + gf * _conv_ffn(h, w_up[l], w_conv[l], w_down[l])
        ckv_list.append(ckv)
        krope_list.append(krope)
        dk_list.append(k_d)
        dv_list.append(v_d)

        sa, ca, ga, sf, cf, gf = _modulation(c, w_ada[l], b_ada[l])
        h = _modulate(x_l, g_mix_norm[l], sa, ca)
        o = _latent_mixer(h, cache_mla_ckv[:, l], cache_mla_krope[:, l], cache_diff_k[:, l],
                          cache_diff_v[:, l], lw, lam, lam_init, rope_m, rope_d)
        x_l = x_l + ga * o
        h = _modulate(x_l, g_ffn_norm[l], sf, cf)
        x_l = x_l + gf * _conv_ffn(h, w_up[l], w_conv[l], w_down[l])

    y_prompt = _rmsnorm(x_c, g_final)
    y_sample = _rmsnorm(x_l, g_final)
    new_mla_ckv = jnp.stack(ckv_list, axis=1)
    new_mla_krope = jnp.stack(krope_list, axis=1)
    new_diff_k = jnp.stack(dk_list, axis=1)
    new_diff_v = jnp.stack(dv_list, axis=1)
    return (y_prompt, y_sample, new_mla_ckv, new_mla_krope, new_diff_k, new_diff_v)
```

```cpp
#include <hip/hip_runtime.h>
#include <hip/hip_cooperative_groups.h>
#include <cstdio>
#include <cstdint>
namespace cg = cooperative_groups;
namespace pg8 {
#define PG8_LAS __attribute__((address_space(3)))
typedef unsigned short bf16_t;
typedef short bf16x8 __attribute__((ext_vector_type(8)));
typedef float f32x4 __attribute__((ext_vector_type(4)));
typedef unsigned u32x4 __attribute__((ext_vector_type(4)));
constexpr int BM = 256, BK = 64, HALF = 128, HTB = HALF * BK * 2  , STAGE_BYTES = 8 * HTB, NXCD = 8, WGM = 8;

__host__ __device__ __forceinline__ int lds_byte(int r, int c) { const int st = (r >> 4) * 2 + (c >> 5), rr = r & 15, cc = c & 31, ob = rr * 64 + cc * 2; return st * 1024 + (ob ^ (((ob >> 9) & 1) << 5)); }
__host__ __device__ __forceinline__ void stage_rc(int b, int& R, int& C) { const int st = b / 1024, sb = b % 1024, swz = sb ^ (((sb >> 9) & 1) << 5); R = (st >> 1) * 16 + swz / 64; C = (st & 1) * 32 + (swz % 64) / 2; }
__host__ __device__ __forceinline__ int perm32(int rho) { const int n = rho >> 4, i = rho & 15; return 8 * (i >> 2) + 4 * n + (i & 3); }

struct Unit { int pm, pn; };
struct Gemm { const bf16_t* A; const bf16_t* Bt; int M, N, K; };

struct StaticOrder {
    int nM, nN, nwg, G, c;
    __host__ __device__ void init(int M, int N, int G_, int c_) { nM = M / BM; nN = N / BM; nwg = nM * nN; G = G_; c = c_; }
    __host__ __device__ bool next(int i, Unit& u) const {
        const long L = (long)i * G + c; if (L >= nwg) return false;
        int wgid = (int)L; { const int q = nwg / NXCD, r = nwg % NXCD, xcd = wgid % NXCD, off = wgid / NXCD; wgid = (xcd < r ? xcd * (q + 1) : r * (q + 1) + (xcd - r) * q) + off; }
        const int nig = WGM * nN, gid = wgid / nig, fm = gid * WGM, gsz = (nM - fm) < WGM ? (nM - fm) : WGM;
        u.pm = fm + ((wgid % nig) % gsz); u.pn = (wgid % nig) / gsz; return true;
    }
    __device__ __forceinline__ void a_ready(const Unit&) const {}
    __device__ __forceinline__ void done(const Unit&) const {}
};

__device__ __forceinline__ unsigned cvt_pk_bf16(float lo, float hi) { unsigned r; asm volatile("v_cvt_pk_bf16_f32 %0, %1, %2" : "=v"(r) : "v"(lo), "v"(hi)); return r; }
typedef float f32x2 __attribute__((ext_vector_type(2)));
__device__ __forceinline__ f32x2 gelu_pk(f32x2 v) {
    const f32x2 av = __builtin_elementwise_abs(v), d = av * 0.2316418882f + 1.0f;
    f32x2 t; t.x = __builtin_amdgcn_rcpf(d.x); t.y = __builtin_amdgcn_rcpf(d.y);
    f32x2 q = t * 0.5307027145f + (-0.7265760135f); q = q * t + 0.7107068705f; q = q * t + (-0.142248368f); q = q * t + 0.127414796f; q = q * t;
    const f32x2 s = (v * v) * (-0.72134752044f);
    f32x2 e; e.x = __builtin_amdgcn_exp2f(s.x); e.y = __builtin_amdgcn_exp2f(s.y);
    const f32x2 m = v * (q * e), r = v - m;
    f32x2 o; o.x = v.x < 0.f ? m.x : r.x; o.y = v.y < 0.f ? m.y : r.y; return o;
}

template <int ACT  > struct EpiBf16 {
    static constexpr bool PERM = true, AFTER_DRAIN = false; static_assert(ACT == 0 || ACT == 1, "EpiBf16: ACT is 0 (none) or 1 (gelu_pk)");
    bf16_t* O; int ldc; const float* bias; int split_cols; size_t split_stride; float scale0;
    __device__ __forceinline__ void operator()(const f32x4 (&acc)[2][2][4][2], const Unit& u, int wr, int wc, int fr, int fq) const {
        const int row0 = u.pm * BM + wr * 64 + fr; int colt = u.pn * BM; bf16_t* base = O;
        float sc = 1.f; if (split_cols) { const int t = colt / split_cols; base += (size_t)t * split_stride; colt -= t * split_cols; if (t == 0) sc = scale0; }
        const int col0 = colt + wc * 32 + 8 * fq, bcol0 = u.pn * BM + wc * 32 + 8 * fq;
        f32x4 bv[2][2];
#pragma unroll
        for (int bj = 0; bj < 2; ++bj)
#pragma unroll
            for (int n = 0; n < 2; ++n) bv[bj][n] = bias ? *(const f32x4*)(bias + bcol0 + bj * HALF + 4 * n) : (f32x4){0.f, 0.f, 0.f, 0.f};
#pragma unroll
        for (int ai = 0; ai < 2; ++ai)
#pragma unroll
            for (int m = 0; m < 4; ++m) { bf16_t* rowp = base + (size_t)(row0 + ai * HALF + m * 16) * ldc + col0;
#pragma unroll
                for (int bj = 0; bj < 2; ++bj) { f32x4 v0 = acc[ai][bj][m][0] + bv[bj][0], v1 = acc[ai][bj][m][1] + bv[bj][1];
                    if (ACT == 1) { f32x2 a = gelu_pk((f32x2){v0[0], v0[1]}), b = gelu_pk((f32x2){v0[2], v0[3]}), c = gelu_pk((f32x2){v1[0], v1[1]}), d = gelu_pk((f32x2){v1[2], v1[3]});
                        v0 = (f32x4){a.x, a.y, b.x, b.y}; v1 = (f32x4){c.x, c.y, d.x, d.y}; }
                    v0 = v0 * sc; v1 = v1 * sc; u32x4 w; w.x = cvt_pk_bf16(v0[0], v0[1]); w.y = cvt_pk_bf16(v0[2], v0[3]); w.z = cvt_pk_bf16(v1[0], v1[1]); w.w = cvt_pk_bf16(v1[2], v1[3]);
                    *(u32x4*)(rowp + bj * HALF) = w; } }
    }
};

struct PanelStats {
    unsigned* xbuf;
    unsigned* cnt;
    unsigned* tmo;
    int ntn; float eps;
    unsigned code;
    __device__ __forceinline__ bool run(const f32x4 (&v)[2][2][4][2], const Unit& u, int wr, int wc, int fr, int fq, PG8_LAS unsigned char* lds, int wid, int lane) const {
        typedef float f32x2v __attribute__((ext_vector_type(2)));
        PG8_LAS f32x2v* P = (PG8_LAS f32x2v*)lds;
        PG8_LAS f32x2v* S = (PG8_LAS f32x2v*)(lds + 8192);
        PG8_LAS unsigned* flag = (PG8_LAS unsigned*)(lds + 8192 + 2048);
#pragma unroll
        for (int ai = 0; ai < 2; ++ai)
#pragma unroll
            for (int m = 0; m < 4; ++m) {
                float s = 0.f;
#pragma unroll
                for (int bj = 0; bj < 2; ++bj)
#pragma unroll
                    for (int n = 0; n < 2; ++n) { const f32x4 x = v[ai][bj][m][n]; s += (x[0] + x[1]) + (x[2] + x[3]); }
                s += __shfl_xor(s, 16); s += __shfl_xor(s, 32);
                const float mw = s * (1.0f / 64.0f); float q = 0.f;
#pragma unroll
                for (int bj = 0; bj < 2; ++bj)
#pragma unroll
                    for (int n = 0; n < 2; ++n) { const f32x4 d = v[ai][bj][m][n] - mw; q += (d[0] * d[0] + d[1] * d[1]) + (d[2] * d[2] + d[3] * d[3]); }
                q += __shfl_xor(q, 16); q += __shfl_xor(q, 32);
                if (fq == 0) P[(ai * HALF + wr * 64 + m * 16 + fr) * 4 + wc] = (f32x2v){mw, q};
            }
        asm volatile("s_waitcnt lgkmcnt(0)" ::: "memory"); __builtin_amdgcn_s_barrier(); asm volatile("" ::: "memory");
#if defined(BROKEN_EXCHANGE_NO_WAIT)
#warning BROKEN CONTROL BUILD: the row-statistics exchange does not wait; results are wrong by design
        if (blockIdx.x >= 64) { const long long t0_ = clock64(); while (clock64() - t0_ < 60000) __builtin_amdgcn_s_sleep(8); }
#endif
        const int row = wid * 32 + (lane & 31);
        if (lane < 32) {
            const f32x2v a = P[row * 4 + 0], b = P[row * 4 + 1], c = P[row * 4 + 2], d = P[row * 4 + 3];
            const float mt = (a.x + b.x + c.x + d.x) * 0.25f;
            const float da = a.x - mt, db = b.x - mt, dc = c.x - mt, dd = d.x - mt;
            const float m2 = (a.y + b.y) + (c.y + d.y) + 64.0f * ((da * da + db * db) + (dc * dc + dd * dd));
            unsigned long long* slot = (unsigned long long*)xbuf + ((size_t)(u.pm * BM + row) * 4 + u.pn);
            __hip_atomic_store(slot, ((unsigned long long)__float_as_uint(m2) << 32) | __float_as_uint(mt), __ATOMIC_RELAXED, __HIP_MEMORY_SCOPE_AGENT);
        }
        asm volatile("s_waitcnt vmcnt(0)" ::: "memory");
        if (lane == 0) __hip_atomic_fetch_add(cnt + 64 * u.pm, 1u, __ATOMIC_RELAXED, __HIP_MEMORY_SCOPE_AGENT);
        if (wid == 0) {
            bool dead = false; const unsigned long long t0 = __builtin_amdgcn_s_memrealtime(); const unsigned want = 8u * (unsigned)ntn;
            for (;;) {
#if defined(BROKEN_EXCHANGE_NO_WAIT)
                break;
#endif
                if ((unsigned)__builtin_amdgcn_readfirstlane(__hip_atomic_load(cnt + 64 * u.pm, __ATOMIC_RELAXED, __HIP_MEMORY_SCOPE_AGENT)) >= want) break;
                if (__builtin_amdgcn_s_memrealtime() - t0 > 2000000ull) {
                    if (lane == 0) { unsigned expect = 0u; __hip_atomic_compare_exchange_strong(tmo + 1, &expect, code | (unsigned)(u.pm & 0xff), __ATOMIC_RELAXED, __ATOMIC_RELAXED, __HIP_MEMORY_SCOPE_AGENT);
                                     __hip_atomic_store(tmo, 1u, __ATOMIC_RELAXED, __HIP_MEMORY_SCOPE_AGENT); }
                    dead = true; break; }
                __builtin_amdgcn_s_sleep(2);
            }
            __builtin_amdgcn_fence(__ATOMIC_ACQUIRE, "agent");
            if (lane == 0) flag[0] = dead ? 1u : 0u;
        }
        asm volatile("s_waitcnt vmcnt(0) lgkmcnt(0)" ::: "memory"); __builtin_amdgcn_s_barrier(); asm volatile("" ::: "memory");
        const bool bad = flag[0] != 0u;
        if (lane < 32) {
            const unsigned long long* slot = (const unsigned long long*)xbuf + (size_t)(u.pm * BM + row) * 4; float mt[4], m2[4]; float ms = 0.f;
#pragma unroll
            for (int t = 0; t < 4; ++t) { if (t < ntn) { const unsigned long long w = __hip_atomic_load(slot + t, __ATOMIC_RELAXED, __HIP_MEMORY_SCOPE_AGENT); mt[t] = __uint_as_float((unsigned)w); m2[t] = __uint_as_float((unsigned)(w >> 32)); } else { mt[t] = 0.f; m2[t] = 0.f; } ms += mt[t]; }
            const float mean = ms / (float)ntn; float q = 0.f;
#pragma unroll
            for (int t = 0; t < 4; ++t) if (t < ntn) { const float dm = mt[t] - mean; q += m2[t] + 256.0f * dm * dm; }
            S[row] = (f32x2v){mean, 1.0f / sqrtf(q / (256.0f * (float)ntn) + eps)};
        }
        asm volatile("s_waitcnt lgkmcnt(0)" ::: "memory"); __builtin_amdgcn_s_barrier(); asm volatile("" ::: "memory");
        return bad;
    }
};
struct EpiLnRes {
    static constexpr bool PERM = false, AFTER_DRAIN = true;
    const float* base; float* out; int ldc; const float* bias; PanelStats st; unsigned poison;
    __device__ __forceinline__ void fused(f32x4 (&acc)[2][2][4][2], const Unit& u, int wr, int wc, int fr, int fq, PG8_LAS unsigned char* lds, int wid, int lane) const {
        typedef float f32x2v __attribute__((ext_vector_type(2)));
        const PG8_LAS f32x2v* S = (const PG8_LAS f32x2v*)(lds + 8192);
        const int col0 = u.pn * BM + wc * 32 + 4 * fq;
#pragma unroll
        for (int bj = 0; bj < 2; ++bj)
#pragma unroll
            for (int n = 0; n < 2; ++n) { const f32x4 bv = bias ? *(const f32x4*)(bias + col0 + bj * HALF + n * 16) : (f32x4){0.f, 0.f, 0.f, 0.f};
#pragma unroll
                for (int ai = 0; ai < 2; ++ai)
#pragma unroll
                    for (int m = 0; m < 4; ++m) acc[ai][bj][m][n] += bv; }
        f32x4 pre[4][2][2];
#pragma unroll
        for (int m = 0; m < 4; ++m) { const size_t off = (size_t)(u.pm * BM + wr * 64 + m * 16 + fr) * ldc + col0;
#pragma unroll
            for (int bj = 0; bj < 2; ++bj)
#pragma unroll
                for (int n = 0; n < 2; ++n) pre[m][bj][n] = *(const f32x4*)(base + off + bj * HALF + n * 16); }
        const bool bad = st.run(acc, u, wr, wc, fr, fq, lds, wid, lane) || poison != 0u;
        const float qnan = __builtin_nanf("");
#pragma unroll
        for (int ai = 0; ai < 2; ++ai)
#pragma unroll
            for (int m = 0; m < 4; ++m) { const int r = ai * HALF + wr * 64 + m * 16 + fr; const f32x2v sr = S[r]; const size_t off = (size_t)(u.pm * BM + r) * ldc + col0;
#pragma unroll
                for (int bj = 0; bj < 2; ++bj)
#pragma unroll
                    for (int n = 0; n < 2; ++n) { const f32x4 bs = ai == 0 ? pre[m][bj][n] : *(const f32x4*)(base + off + bj * HALF + n * 16); f32x4 o = bs + (acc[ai][bj][m][n] - sr.x) * sr.y;
                        if (bad) o = (f32x4){qnan, qnan, qnan, qnan}; *(f32x4*)(out + off + bj * HALF + n * 16) = o; }
                if (m & 1) asm volatile("" ::: "memory"); }
    }
};
struct EpiLnResLn {
    static constexpr bool PERM = false, AFTER_DRAIN = true;
    const float* base; float* out; bf16_t* xn; int ldc; const float* bias; PanelStats st1, st2; unsigned poison;
    __device__ __forceinline__ void fused(f32x4 (&acc)[2][2][4][2], const Unit& u, int wr, int wc, int fr, int fq, PG8_LAS unsigned char* lds, int wid, int lane) const {
        typedef float f32x2v __attribute__((ext_vector_type(2))); typedef unsigned u32x2v __attribute__((ext_vector_type(2)));
        const PG8_LAS f32x2v* S = (const PG8_LAS f32x2v*)(lds + 8192);
        const int col0 = u.pn * BM + wc * 32 + 4 * fq;
#pragma unroll
        for (int bj = 0; bj < 2; ++bj)
#pragma unroll
            for (int n = 0; n < 2; ++n) { const f32x4 bv = bias ? *(const f32x4*)(bias + col0 + bj * HALF + n * 16) : (f32x4){0.f, 0.f, 0.f, 0.f};
#pragma unroll
                for (int ai = 0; ai < 2; ++ai)
#pragma unroll
                    for (int m = 0; m < 4; ++m) acc[ai][bj][m][n] += bv; }
        bool bad = st1.run(acc, u, wr, wc, fr, fq, lds, wid, lane) || poison != 0u;
        const float qnan = __builtin_nanf("");
#pragma unroll
        for (int ai = 0; ai < 2; ++ai)
#pragma unroll
            for (int m = 0; m < 4; ++m) { const int r = ai * HALF + wr * 64 + m * 16 + fr; const f32x2v sr = S[r]; const size_t off = (size_t)(u.pm * BM + r) * ldc + col0;
#pragma unroll
                for (int bj = 0; bj < 2; ++bj)
#pragma unroll
                    for (int n = 0; n < 2; ++n) { const f32x4 bs = *(const f32x4*)(base + off + bj * HALF + n * 16); acc[ai][bj][m][n] = bs + (acc[ai][bj][m][n] - sr.x) * sr.y; }
                asm volatile("" : "+v"(acc[ai][0][m][0]), "+v"(acc[ai][0][m][1]), "+v"(acc[ai][1][m][0]), "+v"(acc[ai][1][m][1]));
                if (m & 1) asm volatile("" ::: "memory"); }
        const bool bad1 = bad;
        bad = st2.run(acc, u, wr, wc, fr, fq, lds, wid, lane) || bad;
#pragma unroll
        for (int ai = 0; ai < 2; ++ai)
#pragma unroll
            for (int m = 0; m < 4; ++m) { const int r = ai * HALF + wr * 64 + m * 16 + fr; const f32x2v sr = S[r]; const size_t off = (size_t)(u.pm * BM + r) * ldc + col0;
#pragma unroll
                for (int bj = 0; bj < 2; ++bj)
#pragma unroll
                    for (int n = 0; n < 2; ++n) { const f32x4 x1 = acc[ai][bj][m][n]; *(f32x4*)(out + off + bj * HALF + n * 16) = bad1 ? (f32x4){qnan, qnan, qnan, qnan} : x1;
                        const f32x4 o = (x1 - sr.x) * sr.y; u32x2v w; w.x = cvt_pk_bf16(o[0], o[1]); w.y = cvt_pk_bf16(o[2], o[3]);
                        if (bad) { w.x = 0x7fc07fc0u; w.y = 0x7fc07fc0u; } *(u32x2v*)(xn + off + bj * HALF + n * 16) = w; }
                asm volatile("" ::: "memory"); }
    }
};

template <class Epi, class Sched, bool ALIGN_EPI = false, bool SP2 = false>
__device__ __forceinline__ void gemm_phase(PG8_LAS unsigned char* lds, const Gemm g, const Sched& S, const Epi& E) {
    int tid = threadIdx.x; asm volatile("" : "+v"(tid));
    const int wid = __builtin_amdgcn_readfirstlane(tid >> 6), lane = tid & 63, wr = wid >> 2, wc = wid & 3, fr = lane & 15, fq = lane >> 4;
    const int K = g.K, nt = K / BK;
    unsigned voffA[2], voffB[2];
#pragma unroll
    for (int i = 0; i < 2; ++i) { int R, C; stage_rc(tid * 16 + i * 8192, R, C); const int Rb = Epi::PERM ? ((R & ~31) + perm32(R & 31)) : R;
        voffA[i] = (unsigned)(R * K + C) * 2u; voffB[i] = (unsigned)(Rb * K + C) * 2u; }
    const size_t kstep = (size_t)(BK * 2);
    const size_t hstep = (size_t)HALF * K * 2;
    const size_t tstep = 2 * hstep;
    const unsigned ldsw = (unsigned)wid * 1024u;
    const int aoff = lds_byte(wr * 64 + fr, fq * 8), boff = lds_byte(wc * 32 + fr, fq * 8);
#define PG8_SA(b, h) (((b) * 2 + (h)) * HTB)
#define PG8_SB(b, h) ((4 + (b) * 2 + (h)) * HTB)
#define PG8_STAGE(bufoff, gbase, voff) do { _Pragma("unroll") for (int _i = 0; _i < 2; ++_i) \
        __builtin_amdgcn_global_load_lds((const unsigned*)((const char*)(gbase) + (voff)[_i]), (PG8_LAS unsigned*)(lds + (bufoff) + ldsw + _i * 8192), 16, 0, 0); } while (0)
#define PG8_LDA(dst, b, h) do { _Pragma("unroll") for (int m = 0; m < 4; ++m) _Pragma("unroll") for (int k = 0; k < 2; ++k) dst[m][k] = *(const PG8_LAS bf16x8*)(lds + PG8_SA(b, h) + aoff + m * 2048 + k * 1024); } while (0)
#define PG8_LDB(dst, b, h) do { _Pragma("unroll") for (int n = 0; n < 2; ++n) _Pragma("unroll") for (int k = 0; k < 2; ++k) dst[n][k] = *(const PG8_LAS bf16x8*)(lds + PG8_SB(b, h) + boff + n * 2048 + k * 1024); } while (0)
#define PG8_MMA(ai, bj, At, Bt) do { __builtin_amdgcn_s_setprio(1); _Pragma("unroll") for (int m = 0; m < 4; ++m) _Pragma("unroll") for (int n = 0; n < 2; ++n) _Pragma("unroll") for (int k = 0; k < 2; ++k) \
        acc[ai][bj][m][n] = __builtin_amdgcn_mfma_f32_16x16x32_bf16(Bt[n][k], At[m][k], acc[ai][bj][m][n], 0, 0, 0); __builtin_amdgcn_s_setprio(0); } while (0)
#define PG8_WAIT_V(n) asm volatile("s_waitcnt vmcnt(" #n ")" ::: "memory")
#define PG8_WAIT_L(n) asm volatile("s_waitcnt lgkmcnt(" #n ")" ::: "memory")
#define PG8_BAR __builtin_amdgcn_s_barrier()
#define PG8_SCHED __builtin_amdgcn_sched_barrier(0)
    Unit cur, nxt; int ui = 0;
    if (!S.next(0, cur)) return;
    f32x4 acc[2][2][4][2];
#pragma unroll
    for (int a = 0; a < 2; ++a)
#pragma unroll
        for (int b = 0; b < 2; ++b)
#pragma unroll
            for (int m = 0; m < 4; ++m)
#pragma unroll
                for (int n = 0; n < 2; ++n) acc[a][b][m][n] = (f32x4){0.f, 0.f, 0.f, 0.f};
    bf16x8 At[4][2], B0[2][2], B1[2][2];
    const char* cA = (const char*)g.A + (size_t)cur.pm * tstep; const char* cB = (const char*)g.Bt + (size_t)cur.pn * tstep;
    S.a_ready(cur);
    if constexpr (SP2) {
        PG8_STAGE(PG8_SB(0, 0), cB, voffB); PG8_STAGE(PG8_SB(0, 1), cB + hstep, voffB); PG8_STAGE(PG8_SA(0, 0), cA, voffA); PG8_STAGE(PG8_SA(0, 1), cA + hstep, voffA);
        if (wr == 1) PG8_BAR;
        PG8_WAIT_V(2); PG8_BAR;
        PG8_STAGE(PG8_SB(1, 0), cB + kstep, voffB); PG8_STAGE(PG8_SA(1, 0), cA + kstep, voffA); PG8_STAGE(PG8_SB(1, 1), cB + hstep + kstep, voffB);
        PG8_WAIT_V(6); PG8_BAR;
    } else {
        PG8_STAGE(PG8_SB(0, 0), cB, voffB); PG8_STAGE(PG8_SA(0, 0), cA, voffA); PG8_STAGE(PG8_SB(0, 1), cB + hstep, voffB); PG8_STAGE(PG8_SA(0, 1), cA + hstep, voffA);
        if (wr == 1) PG8_BAR;
        PG8_WAIT_V(4); PG8_BAR;
        PG8_STAGE(PG8_SB(1, 0), cB + kstep, voffB); PG8_STAGE(PG8_SA(1, 0), cA + kstep, voffA); PG8_STAGE(PG8_SB(1, 1), cB + hstep + kstep, voffB);
        PG8_WAIT_V(6); PG8_BAR;
    }
    for (;;) {
        const bool has_next = S.next(ui + 1, nxt);
        const char* nA = has_next ? (const char*)g.A + (size_t)nxt.pm * tstep : cA; const char* nB = has_next ? (const char*)g.Bt + (size_t)nxt.pn * tstep : cB;
        for (int t = 0; t < nt; t += 2) {
            const bool last = (t == nt - 2);
            const char* a1 = cA + (size_t)(t + 1) * kstep;
            const char* a2 = last ? nA : cA + (size_t)(t + 2) * kstep; const char* b2 = last ? nB : cB + (size_t)(t + 2) * kstep;
            const char* a3 = a2 + kstep; const char* b3 = b2 + kstep;
            if (last && has_next) S.a_ready(nxt);
            if constexpr (SP2) {
            PG8_LDB(B0, 0, 0); PG8_LDB(B1, 0, 1); PG8_SCHED; PG8_LDA(At, 0, 0); PG8_STAGE(PG8_SA(1, 1), a1 + hstep, voffA);
            PG8_WAIT_V(8); PG8_WAIT_L(0); PG8_BAR; PG8_MMA(0, 0, At, B0); PG8_MMA(0, 1, At, B1); PG8_BAR; PG8_SCHED;
            PG8_LDA(At, 0, 1); PG8_STAGE(PG8_SB(0, 0), b2, voffB); PG8_STAGE(PG8_SB(0, 1), b2 + hstep, voffB); PG8_STAGE(PG8_SA(0, 0), a2, voffA);
            PG8_WAIT_V(8); PG8_WAIT_L(0); PG8_BAR; PG8_MMA(1, 0, At, B0); PG8_MMA(1, 1, At, B1); PG8_BAR; PG8_SCHED;
            PG8_LDB(B0, 1, 0); PG8_LDB(B1, 1, 1); PG8_SCHED; PG8_LDA(At, 1, 0); PG8_STAGE(PG8_SA(0, 1), a2 + hstep, voffA);
            PG8_WAIT_V(8); PG8_WAIT_L(0); PG8_BAR; PG8_MMA(0, 0, At, B0); PG8_MMA(0, 1, At, B1); PG8_BAR; PG8_SCHED;
            PG8_LDA(At, 1, 1); PG8_STAGE(PG8_SB(1, 0), b3, voffB); PG8_STAGE(PG8_SB(1, 1), b3 + hstep, voffB); PG8_STAGE(PG8_SA(1, 0), a3, voffA);
            PG8_WAIT_V(8); PG8_WAIT_L(0); PG8_BAR; PG8_MMA(1, 0, At, B0); PG8_MMA(1, 1, At, B1); PG8_BAR; PG8_SCHED;
            } else {
            PG8_LDB(B0, 0, 0); PG8_SCHED; PG8_LDA(At, 0, 0); PG8_STAGE(PG8_SA(1, 1), a1 + hstep, voffA);
            PG8_WAIT_L(8); PG8_BAR; PG8_WAIT_L(0); PG8_MMA(0, 0, At, B0); PG8_BAR; PG8_SCHED;
            PG8_LDB(B1, 0, 1); PG8_STAGE(PG8_SB(0, 0), b2, voffB);
            PG8_BAR; PG8_WAIT_L(0); PG8_MMA(0, 1, At, B1); PG8_BAR;
            PG8_LDA(At, 0, 1); PG8_STAGE(PG8_SA(0, 0), a2, voffA);
            PG8_BAR; PG8_WAIT_L(0); PG8_MMA(1, 0, At, B0); PG8_BAR; PG8_SCHED;
            PG8_STAGE(PG8_SB(0, 1), b2 + hstep, voffB);
            PG8_WAIT_V(6); PG8_BAR; PG8_MMA(1, 1, At, B1); PG8_BAR;
            PG8_LDB(B0, 1, 0); PG8_SCHED; PG8_LDA(At, 1, 0); PG8_STAGE(PG8_SA(0, 1), a2 + hstep, voffA);
            PG8_WAIT_L(8); PG8_BAR; PG8_WAIT_L(0); PG8_MMA(0, 0, At, B0); PG8_BAR; PG8_SCHED;
            PG8_LDB(B1, 1, 1); PG8_STAGE(PG8_SB(1, 0), b3, voffB);
            PG8_BAR; PG8_WAIT_L(0); PG8_MMA(0, 1, At, B1); PG8_BAR;
            PG8_LDA(At, 1, 1); PG8_STAGE(PG8_SA(1, 0), a3, voffA);
            PG8_BAR; PG8_WAIT_L(0); PG8_MMA(1, 0, At, B0); PG8_BAR; PG8_SCHED;
            PG8_STAGE(PG8_SB(1, 1), b3 + hstep, voffB);
            PG8_WAIT_V(6); PG8_BAR; PG8_MMA(1, 1, At, B1); PG8_BAR;
            }
        }
        if constexpr (ALIGN_EPI) { if (wr == 0) PG8_BAR; }
        if constexpr (!Epi::AFTER_DRAIN) { E(acc, cur, wr, wc, fr, fq); S.done(cur); }
        if (!has_next) break;
#pragma unroll
        for (int a = 0; a < 2; ++a)
#pragma unroll
            for (int b = 0; b < 2; ++b)
#pragma unroll
                for (int m = 0; m < 4; ++m)
#pragma unroll
                    for (int n = 0; n < 2; ++n) acc[a][b][m][n] = (f32x4){0.f, 0.f, 0.f, 0.f};
        cur = nxt; cA = nA; cB = nB; ++ui;
        if constexpr (ALIGN_EPI) { if (wr == 1) PG8_BAR; }
    }
    PG8_WAIT_V(0);
    if constexpr (!ALIGN_EPI) { if (wr == 0) PG8_BAR; }
    PG8_BAR;
    if constexpr (Epi::AFTER_DRAIN) { E.fused(acc, cur, wr, wc, fr, fq, lds, wid, lane); S.done(cur); }
#undef PG8_SA
#undef PG8_SB
#undef PG8_STAGE
#undef PG8_LDA
#undef PG8_LDB
#undef PG8_MMA
#undef PG8_WAIT_V
#undef PG8_WAIT_L
#undef PG8_BAR
#undef PG8_SCHED
}
}

#define DEV __device__ __forceinline__
#define LAS __attribute__((address_space(3)))
typedef unsigned short bf16_t;
typedef short bf16x8 __attribute__((ext_vector_type(8)));
typedef short s16x4 __attribute__((ext_vector_type(4)));
typedef float f32x4 __attribute__((ext_vector_type(4)));
typedef float f32x2 __attribute__((ext_vector_type(2)));
typedef float f32x16 __attribute__((ext_vector_type(16)));
typedef unsigned u32x4 __attribute__((ext_vector_type(4)));
typedef unsigned u32x2 __attribute__((ext_vector_type(2)));
typedef __bf16 bf16x2_t __attribute__((ext_vector_type(2)));

constexpr int DM = 1024, NCTX = 8192, NLAT = 16384, MTOT = 24576;
constexpr int INP = 2304, INC = 2144, DFF = 2816, UPC = 5632;
constexpr int NLAYER = 4;
constexpr float EPS = 1e-6f;
constexpr size_t MiB = 1u << 20;
constexpr size_t WS_CTL = 0;
constexpr size_t WS_MOD = 1 * MiB;
constexpr size_t WS_BIN = 2 * MiB;
constexpr size_t WS_BUP = 3 * MiB;
constexpr size_t WS_SSQ = 4 * MiB;
constexpr size_t WS_WIN = 5 * MiB;
constexpr size_t WS_WUKV = WS_WIN + 4718592;
constexpr size_t WS_WOUT = 10 * MiB;
constexpr size_t WS_WUP = 12 * MiB;
constexpr size_t WS_WDN = 23 * MiB;
constexpr size_t WS_TLAT = 29 * MiB;
constexpr size_t WS_TCTX = 45 * MiB;
constexpr size_t WS_CS64 = WS_TCTX + 512 * 1024;
constexpr size_t WS_XS = 46 * MiB;
constexpr size_t WS_R = 94 * MiB;
constexpr size_t WS_P = WS_R;
constexpr size_t WS_OB = WS_P + 108 * MiB;
constexpr size_t WS_KML = WS_OB + 48 * MiB;
constexpr size_t WS_KMC = WS_KML + 23592960;
constexpr size_t WS_VML = WS_KMC + 9 * MiB;
constexpr size_t WS_VMC = WS_VML + 15 * MiB;
constexpr size_t WS_KDL = WS_VMC + 6 * MiB;
constexpr size_t WS_KDC = WS_KDL + 15 * MiB;
constexpr size_t WS_VDL = WS_KDC + 6 * MiB;
constexpr size_t WS_VDC = WS_VDL + 15 * MiB;
constexpr size_t WS_QMR = WS_VDC + 6 * MiB;
constexpr size_t WS_QDR = WS_QMR + 18 * MiB;
constexpr size_t WS_FBL = WS_QDR + 12 * MiB;
constexpr size_t WS_FBC = WS_FBL + 16 * MiB;
constexpr size_t WS_END = WS_FBC + 8 * MiB;
constexpr size_t WS_U = WS_R;
constexpr size_t WS_ACT = WS_R + 176 * MiB;
static_assert(WS_ACT + 88 * MiB <= WS_END, "overlay fits");
constexpr size_t OUT_CKV = 25165824, OUT_KROPE = OUT_CKV + 4194304, OUT_DK = OUT_KROPE + 1048576, OUT_DV = OUT_DK + 12582912;
constexpr int LDS_BYTES = 147456;
constexpr int RING_BYTES = 131072;
constexpr int LDS_MISC = RING_BYTES;

struct Args { const float* in[26]; float* out; unsigned char* ws; int ph_lo, ph_hi; };
enum { I_XP = 0, I_XS, I_C, I_CCKV, I_CKROPE, I_CDK, I_CDV, I_CCTX, I_WADA, I_BADA, I_GMIX, I_GFFN, I_WIN, I_GKV, I_WUK, I_WUV,
       I_LQ1, I_LK1, I_LQ2, I_LK2, I_GSUB, I_WOUT, I_WUP, I_WCONV, I_WDOWN, I_GFINAL };

DEV float bf2f(unsigned b) { return __uint_as_float(b << 16); }
DEV unsigned pk2(float lo, float hi) { f32x2 v = {lo, hi}; bf16x2_t b = __builtin_convertvector(v, bf16x2_t); return __builtin_bit_cast(unsigned, b); }
DEV bf16_t f2bf(float f) { return (bf16_t)(pk2(f, 0.f) & 0xffffu); }
DEV float wave_sum(float v) {
#pragma unroll
    for (int o = 1; o < 64; o <<= 1) v += __shfl_xor(v, o);
    return v;
}
DEV f32x4 mfma16(bf16x8 a, bf16x8 b, f32x4 c) { return __builtin_amdgcn_mfma_f32_16x16x32_bf16(a, b, c, 0, 0, 0); }
DEV f32x16 mfma32(bf16x8 a, bf16x8 b, f32x16 c) { return __builtin_amdgcn_mfma_f32_32x32x16_bf16(a, b, c, 0, 0, 0); }
DEV int row_b9(int row0) { return row0 < NCTX ? 0 : 1 + ((row0 - NCTX) >> 11); }

struct EpiA {
    static constexpr bool PERM = true, AFTER_DRAIN = false;
    bf16_t* O; int ldc; const float* ssq; const float* bias; int ldb; int row_off;
    DEV void operator()(const f32x4 (&acc)[2][2][4][2], const pg8::Unit& u, int wr, int wc, int fr, int fq) const {
        const int lrow0 = u.pm * 256, b9 = row_b9(row_off + lrow0);
        const int col0 = u.pn * 256 + wc * 32 + 8 * fq;
        f32x4 bv[2][2];
#pragma unroll
        for (int bj = 0; bj < 2; ++bj)
#pragma unroll
            for (int n = 0; n < 2; ++n) bv[bj][n] = *(const f32x4*)(bias + (size_t)b9 * ldb + col0 + bj * 128 + 4 * n);
#pragma unroll
        for (int ai = 0; ai < 2; ++ai)
#pragma unroll
            for (int m = 0; m < 4; ++m) {
                const int lr = lrow0 + ai * 128 + wr * 64 + m * 16 + fr;
                const float rs = rsqrtf(ssq[row_off + lr] * (1.0f / 1024.0f) + EPS);
                bf16_t* rowp = O + (size_t)lr * ldc + col0;
#pragma unroll
                for (int bj = 0; bj < 2; ++bj) {
                    const f32x4 v0 = acc[ai][bj][m][0] * rs + bv[bj][0], v1 = acc[ai][bj][m][1] * rs + bv[bj][1];
                    u32x4 w; w.x = pk2(v0[0], v0[1]); w.y = pk2(v0[2], v0[3]); w.z = pk2(v1[0], v1[1]); w.w = pk2(v1[2], v1[3]);
                    *(u32x4*)(rowp + bj * 128) = w;
                }
            }
    }
};
struct EpiRes {
    static constexpr bool PERM = false, AFTER_DRAIN = false;
    const float* xold_c; const float* xold_l;
    float* X;
    const float* gate;
    const float* g; const float* scale;
    bf16_t* XS; float* ssq; int row_off;
    DEV void operator()(const f32x4 (&acc)[2][2][4][2], const pg8::Unit& u, int wr, int wc, int fr, int fq) const {
        const int row0 = row_off + u.pm * 256, b9 = row_b9(row0);
        const int col0 = u.pn * 256 + wc * 32 + 4 * fq;
        f32x4 gv[2][2], gs[2][2];
#pragma unroll
        for (int bj = 0; bj < 2; ++bj)
#pragma unroll
            for (int n = 0; n < 2; ++n) {
                const int c = col0 + bj * 128 + n * 16;
                gv[bj][n] = *(const f32x4*)(gate + (size_t)b9 * 6144 + c);
                if (g) { const f32x4 gg = *(const f32x4*)(g + c), sc = *(const f32x4*)(scale + (size_t)b9 * 6144 + c); gs[bj][n] = gg * (sc + 1.0f); }
                else gs[bj][n] = (f32x4){0.f, 0.f, 0.f, 0.f};
            }
        const float* xo = (row0 < NCTX) ? xold_c : (xold_l - (size_t)NCTX * DM);
#pragma unroll
        for (int ai = 0; ai < 2; ++ai)
#pragma unroll
            for (int m = 0; m < 4; ++m) {
                const int r = row0 + ai * 128 + wr * 64 + m * 16 + fr;
                float ss = 0.f;
#pragma unroll
                for (int bj = 0; bj < 2; ++bj)
#pragma unroll
                    for (int n = 0; n < 2; ++n) {
                        const size_t off = (size_t)r * DM + col0 + bj * 128 + n * 16;
                        const f32x4 xv = *(const f32x4*)(xo + off);
                        const f32x4 xn = xv + gv[bj][n] * acc[ai][bj][m][n];
                        *(f32x4*)(X + off) = xn;
                        ss += (xn[0] * xn[0] + xn[1] * xn[1]) + (xn[2] * xn[2] + xn[3] * xn[3]);
                        if (g) { const f32x4 y = xn * gs[bj][n]; u32x2 w; w.x = pk2(y[0], y[1]); w.y = pk2(y[2], y[3]); *(u32x2*)(XS + off) = w; }
                    }
                ss += __shfl_xor(ss, 16); ss += __shfl_xor(ss, 32);
                if (fq == 0) unsafeAtomicAdd(ssq + r, ss);
            }
    }
};
struct EpiF {
    static constexpr bool PERM = true, AFTER_DRAIN = false;
    bf16_t* OB; int rowbase; int nseq;
    DEV void operator()(const f32x4 (&acc)[2][2][4][2], const pg8::Unit& u, int wr, int wc, int fr, int fq) const {
        const int col0 = 768 + wc * 32 + 8 * fq;
#pragma unroll
        for (int ai = 0; ai < 2; ++ai)
#pragma unroll
            for (int m = 0; m < 4; ++m) {
                const int np = u.pm * 256 + ai * 128 + wr * 64 + m * 16 + fr;
                bf16_t* rowp = OB + (size_t)(rowbase + u.pn * nseq + np) * DM + col0;
#pragma unroll
                for (int bj = 0; bj < 2; ++bj) {
                    const f32x4 v0 = acc[ai][bj][m][0], v1 = acc[ai][bj][m][1];
                    u32x4 w; w.x = pk2(v0[0], v0[1]); w.y = pk2(v0[2], v0[3]); w.z = pk2(v1[0], v1[1]); w.w = pk2(v1[2], v1[3]);
                    *(u32x4*)(rowp + bj * 128) = w;
                }
            }
    }
};

DEV void transpose_item(const float* W, int K, int N, bf16_t* WT, int row_off, LAS float* scr, int item, int lane) {
    const int nblk = N / 32, kb = item / nblk, nb = item % nblk, k0 = 64 * kb, n0 = 32 * nb;
#pragma unroll 8
    for (int i = 0; i < 32; ++i) { const int kk = 2 * i + (lane >> 5); scr[kk * 33 + (lane & 31)] = W[(size_t)(k0 + kk) * N + n0 + (lane & 31)]; }
    asm volatile("s_waitcnt lgkmcnt(0)" ::: "memory");
    const int c = lane & 7;
#pragma unroll
    for (int j = 0; j < 4; ++j) { const int n = (lane >> 3) + 8 * j; const LAS float* s = scr + (8 * c) * 33 + n;
        u32x4 o; o.x = pk2(s[0 * 33], s[1 * 33]); o.y = pk2(s[2 * 33], s[3 * 33]); o.z = pk2(s[4 * 33], s[5 * 33]); o.w = pk2(s[6 * 33], s[7 * 33]);
        *(u32x4*)(WT + (size_t)(row_off + n0 + n) * K + k0 + 8 * c) = o; }
    asm volatile("s_waitcnt lgkmcnt(0)" ::: "memory");
}
DEV void convert_weights(const Args& a, LAS unsigned char* lds, int l, int mask, int gw, int NGW, int wave, int lane) {
    LAS float* scr = (LAS float*)(lds + wave * 16384);
    unsigned char* ws = a.ws;
    const int n_in = (mask & 1) ? 16 * 67 : 0, n_uk = (mask & 2) ? 2 * 12 : 0, n_out = (mask & 4) ? 16 * 32 : 0, n_up = (mask & 8) ? 16 * 176 : 0, n_dn = (mask & 16) ? 44 * 32 : 0;
    const int total = n_in + 2 * n_uk + n_out + n_up + n_dn;
    for (int it = gw; it < total; it += NGW) {
        int r = it;
        if (r < n_in) { transpose_item(a.in[I_WIN] + (size_t)l * DM * INC, DM, INC, (bf16_t*)(ws + WS_WIN), 0, scr, r, lane); continue; } r -= n_in;
        if (r < n_uk) { transpose_item(a.in[I_WUK] + (size_t)l * 128 * 384, 128, 384, (bf16_t*)(ws + WS_WUKV), 0, scr, r, lane); continue; } r -= n_uk;
        if (r < n_uk) { transpose_item(a.in[I_WUV] + (size_t)l * 128 * 384, 128, 384, (bf16_t*)(ws + WS_WUKV), 384, scr, r, lane); continue; } r -= n_uk;
        if (r < n_out) { transpose_item(a.in[I_WOUT] + (size_t)l * DM * DM, DM, DM, (bf16_t*)(ws + WS_WOUT), 0, scr, r, lane); continue; } r -= n_out;
        if (r < n_up) { transpose_item(a.in[I_WUP] + (size_t)l * DM * UPC, DM, UPC, (bf16_t*)(ws + WS_WUP), 0, scr, r, lane); continue; } r -= n_up;
        transpose_item(a.in[I_WDOWN] + (size_t)l * DFF * DM, DFF, DM, (bf16_t*)(ws + WS_WDN), 0, scr, r, lane);
    }
}
DEV void gemv9_item(LAS float* vec, LAS float* red, const float* W, int N, int ldw, const float* bias, float* out, int ldo, int n0, int tid) {
    const int w = tid >> 6, lane = tid & 63; const int n = n0 + lane; const bool valid = n < N;
    float acc0 = 0.f, acc1 = 0.f, acc2 = 0.f, acc3 = 0.f, acc4 = 0.f, acc5 = 0.f, acc6 = 0.f, acc7 = 0.f, acc8 = 0.f;
    const float* wp = W + (size_t)(128 * w) * ldw + (valid ? n : 0);
    const LAS float* vp = vec + 128 * w;
#pragma unroll 4
    for (int k = 0; k < 128; ++k) {
        const float wv = valid ? wp[(size_t)k * ldw] : 0.f;
        acc0 += vp[k] * wv; acc1 += vp[1024 + k] * wv; acc2 += vp[2048 + k] * wv; acc3 += vp[3072 + k] * wv; acc4 += vp[4096 + k] * wv;
        acc5 += vp[5120 + k] * wv; acc6 += vp[6144 + k] * wv; acc7 += vp[7168 + k] * wv; acc8 += vp[8192 + k] * wv;
    }
    LAS float* rp = red + (w * 9) * 64 + lane;
    rp[0] = acc0; rp[64] = acc1; rp[128] = acc2; rp[192] = acc3; rp[256] = acc4; rp[320] = acc5; rp[384] = acc6; rp[448] = acc7; rp[512] = acc8;
    __syncthreads();
    for (int idx = tid; idx < 576; idx += 512) {
        const int v = idx >> 6, ln = idx & 63; float s = 0.f;
#pragma unroll
        for (int ww = 0; ww < 8; ++ww) s += red[(ww * 9 + v) * 64 + ln];
        const int nn = n0 + ln;
        out[(size_t)v * ldo + nn] = s + ((bias && nn < N) ? bias[nn] : 0.f);
    }
    __syncthreads();
}

constexpr int B_AROW = 272, B_VROW = 772, B_UROW = 528;
constexpr int B_LDS_A = 0, B_LDS_V = 64 * B_AROW, B_LDS_U = B_LDS_V + 64 * B_VROW, B_LDS_TAB = B_LDS_U + 64 * B_UROW;
static_assert(B_LDS_TAB + 4096 <= RING_BYTES, "phase B LDS");

DEV float rope1(float x, int dd, int t, const LAS f32x2* tab) {
    const float xp = __shfl_xor(x, 8);
    const int pos = (dd < 16) ? (t >> 6) : (t & 63);
    const f32x2 cs = tab[pos * 8 + (dd & 7)];
    return (dd & 8) ? (x * cs.x + xp * cs.y) : (x * cs.x - xp * cs.y);
}

DEV void phase_b(const Args& a, LAS unsigned char* lds, int l, int tid) {
    unsigned char* ws = a.ws;
    const int wave = __builtin_amdgcn_readfirstlane(tid >> 6), lane = tid & 63, fr = lane & 15, fq = lane >> 4;
    const bf16_t* P = (const bf16_t*)(ws + WS_P);
    const bf16_t* WUKV = (const bf16_t*)(ws + WS_WUKV);
    const bf16_t* CS64 = (const bf16_t*)(ws + WS_CS64);
    LAS f32x2* tab = (LAS f32x2*)(lds + B_LDS_TAB);
    {
        const int pos = tid >> 3, f = tid & 7;
        const float inv = __builtin_amdgcn_exp2f(-(float)f * (13.287712379549449f / 8.0f));
        const float ang = (float)pos * inv;
        tab[tid] = (f32x2){cosf(ang), sinf(ang)};
    }
    __syncthreads();
    const float* gkv = a.in[I_GKV] + l * 128;
    const float g0 = gkv[2 * lane], g1 = gkv[2 * lane + 1];
    for (int blk = blockIdx.x; blk < 448; blk += gridDim.x) {
        int kind, r0 = 0, bidx, t0;
        if (blk < 128) { kind = 0; r0 = blk * 64; bidx = r0 >> 8; t0 = r0 & 255; }
        else if (blk < 384) { kind = 1; r0 = NCTX + (blk - 128) * 64; bidx = (r0 - NCTX) >> 11; t0 = (r0 - NCTX) & 2047; }
        else { kind = 2; const int cb = blk - 384; bidx = cb >> 3; t0 = 2048 + 64 * (cb & 7); }
        bf16_t* KM; bf16_t* KD; bf16_t* VMt; bf16_t* VDt; int vt_ld;
        if (kind == 0) { KM = (bf16_t*)(ws + WS_KMC) + (size_t)(bidx * 256 + t0) * 576; KD = (bf16_t*)(ws + WS_KDC) + (size_t)(bidx * 256 + t0) * 384;
                         VMt = (bf16_t*)(ws + WS_VMC) + (size_t)bidx * 6 * 64 * 256 + t0; VDt = (bf16_t*)(ws + WS_VDC) + (size_t)bidx * 6 * 64 * 256 + t0; vt_ld = 256; }
        else { KM = (bf16_t*)(ws + WS_KML) + (size_t)(bidx * 2560 + t0) * 576; KD = (bf16_t*)(ws + WS_KDL) + (size_t)(bidx * 2560 + t0) * 384;
               VMt = (bf16_t*)(ws + WS_VML) + (size_t)bidx * 6 * 64 * 2560 + t0; VDt = (bf16_t*)(ws + WS_VDL) + (size_t)bidx * 6 * 64 * 2560 + t0; vt_ld = 2560; }
        for (int i = 0; i < 8; ++i) {
            const int rr = wave * 8 + i;
            if (kind == 2) {
                const int j = (t0 - 2048) + rr;
                const size_t crow = ((size_t)(bidx * 4 + l)) * 512 + j;
                const f32x2 cv = *(const f32x2*)(a.in[I_CCKV] + crow * 128 + 2 * lane);
                *(LAS unsigned*)(lds + B_LDS_A + rr * B_AROW + lane * 4) = pk2(cv.x, cv.y);
                const float kr = a.in[I_CKROPE][crow * 32 + (lane & 31)];
                const bf16_t krb = f2bf(kr);
                { const int hb = (lane >> 5) * 3;
#pragma unroll
                  for (int h = 0; h < 3; ++h) KM[(size_t)rr * 576 + (hb + h) * 96 + 64 + (lane & 31)] = krb; }
#pragma unroll
                for (int q = 0; q < 6; ++q) {
                    KD[(size_t)rr * 384 + 64 * q + lane] = f2bf(a.in[I_CDK][crow * 384 + 64 * q + lane]);
                    *(LAS bf16_t*)(lds + B_LDS_V + rr * B_VROW + (64 * q + lane) * 2) = f2bf(a.in[I_CDV][crow * 384 + 64 * q + lane]);
                }
            } else {
                const int r = r0 + rr, t = t0 + rr;
                const bf16_t* prow = P + (size_t)r * INP;
                const unsigned cv = *(const unsigned*)(prow + 576 + 2 * lane);
                float ca = bf2f(cv & 0xffffu), cb = bf2f(cv >> 16);
                const float ss = wave_sum(ca * ca + cb * cb);
                const float rs = rsqrtf(ss * (1.0f / 128.0f) + EPS);
                ca *= rs * g0; cb *= rs * g1;
                *(LAS unsigned*)(lds + B_LDS_A + rr * B_AROW + lane * 4) = pk2(ca, cb);
                const size_t orow = ((size_t)(bidx * 4 + l)) * 256 + t;
                if (kind == 0) *(f32x2*)(a.out + OUT_CKV + orow * 128 + 2 * lane) = (f32x2){ca, cb};
                {
                    float x = bf2f(prow[704 + (lane & 31)]);
                    if (kind == 1) x = rope1(x, lane & 31, t, tab);
                    else if (lane < 32) a.out[OUT_KROPE + orow * 32 + lane] = x;
                    const bf16_t xb = f2bf(x); const int hb = (lane >> 5) * 3;
#pragma unroll
                    for (int h = 0; h < 3; ++h) KM[(size_t)rr * 576 + (hb + h) * 96 + 64 + (lane & 31)] = xb;
                }
#pragma unroll
                for (int q = 0; q < 6; ++q) {
                    float x = bf2f(prow[1120 + 64 * q + lane]);
                    if (kind == 1) x = rope1(x, lane & 31, t, tab);
                    else a.out[OUT_DK + orow * 384 + 64 * q + lane] = x;
                    KD[(size_t)rr * 384 + 64 * q + lane] = f2bf(x);
                    const bf16_t vraw = prow[1504 + 64 * q + lane];
                    *(LAS bf16_t*)(lds + B_LDS_V + rr * B_VROW + (64 * q + lane) * 2) = vraw;
                    if (kind == 0) a.out[OUT_DV + orow * 384 + 64 * q + lane] = bf2f(vraw);
                }
#pragma unroll
                for (int q = 0; q < 4; ++q) *(LAS bf16_t*)(lds + B_LDS_U + rr * B_UROW + (64 * q + lane) * 2) = prow[1888 + 64 * q + lane];
                if (kind == 1) {
                    const int lr = r - NCTX;
                    bf16_t* qm = (bf16_t*)(ws + WS_QMR) + (size_t)lr * 576; bf16_t* qd = (bf16_t*)(ws + WS_QDR) + (size_t)lr * 384;
#pragma unroll
                    for (int q = 0; q < 6; ++q) qm[96 * q + lane] = prow[96 * q + lane];
#pragma unroll
                    for (int q = 0; q < 3; ++q) { const int head = 2 * q + (lane >> 5), dd = lane & 31;
                        const float x = rope1(bf2f(prow[96 * head + 64 + dd]), dd, t, tab); qm[96 * head + 64 + dd] = f2bf(x); }
#pragma unroll
                    for (int q = 0; q < 6; ++q) { const float x = rope1(bf2f(prow[736 + 64 * q + lane]), lane & 31, t, tab); qd[64 * q + lane] = f2bf(x); }
                }
            }
        }
        __syncthreads();
#pragma unroll 1
        for (int nt = 0; nt < 6; ++nt) {
            const int c0 = 96 * wave + 16 * nt;
            bf16x8 bw[4];
#pragma unroll
            for (int kk = 0; kk < 4; ++kk) bw[kk] = *(const bf16x8*)(WUKV + (size_t)(c0 + fr) * 128 + 32 * kk + 8 * fq);
#pragma unroll
            for (int mt = 0; mt < 4; ++mt) {
                f32x4 acc = {0.f, 0.f, 0.f, 0.f};
#pragma unroll
                for (int kk = 0; kk < 4; ++kk) {
                    const bf16x8 af = *(const LAS bf16x8*)(lds + B_LDS_A + (16 * mt + fr) * B_AROW + (32 * kk + 8 * fq) * 2);
                    acc = (wave < 4) ? mfma16(bw[kk], af, acc) : mfma16(af, bw[kk], acc);
                }
                u32x2 w; w.x = pk2(acc[0], acc[1]); w.y = pk2(acc[2], acc[3]);
                if (wave < 4) { const int h = c0 >> 6, d = (c0 & 63) + 4 * fq; *(u32x2*)(KM + (size_t)(16 * mt + fr) * 576 + h * 96 + d) = w; }
                else { const int col = c0 - 384 + fr, h = col >> 6, dv = col & 63; *(u32x2*)(VMt + (size_t)(h * 64 + dv) * vt_ld + 16 * mt + 4 * fq) = w; }
            }
        }
        if (kind != 2) {
            const int g = wave >> 1, nseq = (kind == 0) ? 256 : 2048, ldk = 2 * nseq;
            bf16_t* FB = (kind == 0) ? (bf16_t*)(ws + WS_FBC) : (bf16_t*)(ws + WS_FBL);
#pragma unroll 1
            for (int nt = 0; nt < 4; ++nt) {
                const int cc0 = 16 * ((wave & 1) * 4 + nt);
                bf16x8 bw[2];
#pragma unroll
                for (int kk = 0; kk < 2; ++kk) bw[kk] = *(const bf16x8*)(CS64 + (size_t)(cc0 + fr) * 64 + 32 * kk + 8 * fq);
                const int cc = cc0 + fr, cp = cc & 63, koff = (cc >= 64) ? nseq : 0;
                bf16_t* dst = FB + (size_t)(bidx * 256 + g * 64 + cp) * ldk + koff + (t0 & (nseq - 1));
#pragma unroll
                for (int mt = 0; mt < 4; ++mt) {
                    f32x4 acc = {0.f, 0.f, 0.f, 0.f};
#pragma unroll
                    for (int kk = 0; kk < 2; ++kk) {
                        const bf16x8 af = *(const LAS bf16x8*)(lds + B_LDS_U + (16 * mt + fr) * B_UROW + (64 * g + 32 * kk + 8 * fq) * 2);
                        acc = mfma16(af, bw[kk], acc);
                    }
                    u32x2 w; w.x = pk2(acc[0], acc[1]); w.y = pk2(acc[2], acc[3]);
                    *(u32x2*)(dst + 16 * mt + 4 * fq) = w;
                }
            }
        }
#pragma unroll 4
        for (int q = 0; q < 48; ++q) {
            const int cr = 48 * wave + q;
            const bf16_t v = *(const LAS bf16_t*)(lds + B_LDS_V + lane * B_VROW + cr * 2);
            VDt[(size_t)cr * vt_ld + lane] = v;
        }
        __syncthreads();
    }
}

constexpr int AT_VROW = 136;
template <bool DIFF> struct AttnCfg {
    static constexpr int ND = DIFF ? 4 : 6;
    static constexpr int NM = DIFF ? 2 : 1;
    static constexpr int NDM = DIFF ? 2 : 6;
    static constexpr int KROW = DIFF ? 144 : 208;
    static constexpr int KT = 64 * KROW;
    static constexpr int CPR = 2 * ND;
    static constexpr int NKC = 64 * CPR;
};
constexpr int AT_LDS_K = 0, AT_LDS_V = 2 * 64 * 208, AT_LDS_SCR = AT_LDS_V + 2 * 64 * AT_VROW;
static_assert(AT_LDS_SCR + 2048 <= RING_BYTES, "attention LDS");

template <bool DIFF>
DEV void attn_unit(LAS unsigned char* lds, const bf16_t* Qa, int qa_ld, const bf16_t* Qb, int qb_ld, const bf16_t* Kp, int k_ld,
                   const bf16_t* Vt, int vt_ld, int nt_main, int nt_total, bf16_t* Oout, float cscale, float lam, const float* gsub, float subscale, int tid) {
    typedef AttnCfg<DIFF> C;
    const int wave = __builtin_amdgcn_readfirstlane(tid >> 6), lane = tid & 63, l31 = lane & 31, hi = lane >> 5;
    LAS float* scr = (LAS float*)(lds + AT_LDS_SCR) + wave * 64;
    const int kkey0 = tid / C::CPR, kpart0 = tid % C::CPR;
    const int kc1 = tid + 512; const bool has1 = kc1 < C::NKC; const int kkey1 = kc1 / C::CPR, kpart1 = kc1 % C::CPR;
    const int vdv = tid >> 3, vpart = tid & 7;
    const bf16_t* kg0 = Kp + (size_t)kkey0 * k_ld + kpart0 * 8;
    const bf16_t* kg1 = Kp + (size_t)kkey1 * k_ld + kpart1 * 8;
    const bf16_t* vg = Vt + (size_t)vdv * vt_ld + vpart * 8;
    const int kl0 = kkey0 * C::KROW + kpart0 * 16, kl1 = kkey1 * C::KROW + kpart1 * 16, vl = vdv * AT_VROW + vpart * 16;
    u32x4 kr0, kr1 = {0, 0, 0, 0}, vr;
    bf16x8 qf[C::ND];
    { const bf16_t* qp = Qa + (size_t)(32 * wave + l31) * qa_ld + 8 * hi;
#pragma unroll
      for (int d = 0; d < C::ND; ++d) qf[d] = *(const bf16x8*)(qp + 16 * d); }
    kr0 = *(const u32x4*)kg0; if (has1) kr1 = *(const u32x4*)kg1; vr = *(const u32x4*)vg;
    *(LAS u32x4*)(lds + AT_LDS_K + kl0) = kr0; if (has1) *(LAS u32x4*)(lds + AT_LDS_K + kl1) = kr1;
    *(LAS u32x2*)(lds + AT_LDS_V + vl) = (u32x2){vr.x, vr.y}; *(LAS u32x2*)(lds + AT_LDS_V + vl + 8) = (u32x2){vr.z, vr.w};
    __syncthreads();
    f32x16 O[C::NM][2];
    float mref[C::NM], lsum[C::NM];
#pragma unroll
    for (int mp = 0; mp < C::NM; ++mp) { mref[mp] = 0.f; lsum[mp] = 0.f;
#pragma unroll
        for (int r = 0; r < 16; ++r) { O[mp][0][r] = 0.f; O[mp][1][r] = 0.f; } }
#pragma unroll 1
    for (int t = 0; t < nt_total; ++t) {
        const int cur = t & 1;
        const bool more = (t + 1) < nt_total;
        if (more) {
            const size_t ko = (size_t)(t + 1) * 64 * k_ld;
            kr0 = *(const u32x4*)(kg0 + ko); if (has1) kr1 = *(const u32x4*)(kg1 + ko);
            vr = *(const u32x4*)(vg + (t + 1) * 64);
        }
        if (t == nt_main) {
            const bf16_t* qp = Qb + (size_t)(32 * wave + l31) * qb_ld + 8 * hi;
#pragma unroll
            for (int d = 0; d < C::ND; ++d) qf[d] = *(const bf16x8*)(qp + 16 * d);
        }
        const LAS unsigned char* Kb = lds + AT_LDS_K + cur * C::KT;
        const LAS unsigned char* Vb = lds + AT_LDS_V + cur * (64 * AT_VROW);
#pragma unroll
        for (int mp = 0; mp < C::NM; ++mp) {
            f32x16 s0, s1;
#pragma unroll
            for (int r = 0; r < 16; ++r) { s0[r] = 0.f; s1[r] = 0.f; }
#pragma unroll
            for (int dd = 0; dd < C::NDM; ++dd) {
                const int d0 = mp * C::NDM + dd;
                const bf16x8 a0 = *(const LAS bf16x8*)(Kb + l31 * C::KROW + d0 * 32 + hi * 16);
                const bf16x8 a1 = *(const LAS bf16x8*)(Kb + (32 + l31) * C::KROW + d0 * 32 + hi * 16);
                s0 = mfma32(a0, qf[d0], s0); s1 = mfma32(a1, qf[d0], s1);
            }
            float mx = fmaxf(s0[0], s1[0]);
#pragma unroll
            for (int r = 1; r < 16; ++r) mx = fmaxf(mx, fmaxf(s0[r], s1[r]));
            mx = fmaxf(mx, __shfl_xor(mx, 32));
            const float rm = mx * cscale;
            if (t == 0) mref[mp] = rm;
            else if (__any(rm > mref[mp] + 8.0f)) {
                const float mnew = fmaxf(mref[mp], rm);
                const float alpha = __builtin_amdgcn_exp2f(mref[mp] - mnew);
                lsum[mp] *= alpha; mref[mp] = mnew;
                if (hi == 0) scr[l31] = alpha;
                asm volatile("s_waitcnt lgkmcnt(0)" ::: "memory");
#pragma unroll
                for (int g4 = 0; g4 < 4; ++g4) { const f32x4 a4 = *(const LAS f32x4*)(scr + 8 * g4 + 4 * hi);
#pragma unroll
                    for (int j = 0; j < 4; ++j) { O[mp][0][4 * g4 + j] *= a4[j]; O[mp][1][4 * g4 + j] *= a4[j]; } }
                asm volatile("s_waitcnt lgkmcnt(0)" ::: "memory");
            }
            const float nm = -mref[mp];
            float ls = 0.f;
#pragma unroll
            for (int r = 0; r < 16; ++r) { s0[r] = __builtin_amdgcn_exp2f(fmaf(s0[r], cscale, nm)); s1[r] = __builtin_amdgcn_exp2f(fmaf(s1[r], cscale, nm)); ls += s0[r] + s1[r]; }
            lsum[mp] += ls;
            bf16x8 pa[4];
#pragma unroll
            for (int j = 0; j < 4; ++j) {
                u32x4 w;
                if (j < 2) { w.x = pk2(s0[8 * j], s0[8 * j + 1]); w.y = pk2(s0[8 * j + 2], s0[8 * j + 3]); w.z = pk2(s0[8 * j + 4], s0[8 * j + 5]); w.w = pk2(s0[8 * j + 6], s0[8 * j + 7]); }
                else { const int jj = j - 2; w.x = pk2(s1[8 * jj], s1[8 * jj + 1]); w.y = pk2(s1[8 * jj + 2], s1[8 * jj + 3]); w.z = pk2(s1[8 * jj + 4], s1[8 * jj + 5]); w.w = pk2(s1[8 * jj + 6], s1[8 * jj + 7]); }
                pa[j] = __builtin_bit_cast(bf16x8, w);
            }
#pragma unroll
            for (int j = 0; j < 4; ++j)
#pragma unroll
                for (int db = 0; db < 2; ++db) {
                    const LAS unsigned char* vp = Vb + (32 * db + l31) * AT_VROW + (32 * (j >> 1) + 16 * (j & 1) + 4 * hi) * 2;
                    const s16x4 lo = *(const LAS s16x4*)vp, hh = *(const LAS s16x4*)(vp + 16);
                    const bf16x8 vb = {lo[0], lo[1], lo[2], lo[3], hh[0], hh[1], hh[2], hh[3]};
                    O[mp][db] = mfma32(pa[j], vb, O[mp][db]);
                }
        }
        if (more) {
            const int nb = cur ^ 1;
            *(LAS u32x4*)(lds + AT_LDS_K + nb * C::KT + kl0) = kr0; if (has1) *(LAS u32x4*)(lds + AT_LDS_K + nb * C::KT + kl1) = kr1;
            *(LAS u32x2*)(lds + AT_LDS_V + nb * (64 * AT_VROW) + vl) = (u32x2){vr.x, vr.y}; *(LAS u32x2*)(lds + AT_LDS_V + nb * (64 * AT_VROW) + vl + 8) = (u32x2){vr.z, vr.w};
        }
        __syncthreads();
    }
    float inv[C::NM][16];
#pragma unroll
    for (int mp = 0; mp < C::NM; ++mp) {
        float lt = lsum[mp]; lt += __shfl_xor(lt, 32);
        if (hi == 0) scr[l31] = 1.0f / lt;
        asm volatile("s_waitcnt lgkmcnt(0)" ::: "memory");
#pragma unroll
        for (int g4 = 0; g4 < 4; ++g4) { const f32x4 a4 = *(const LAS f32x4*)(scr + 8 * g4 + 4 * hi);
#pragma unroll
            for (int j = 0; j < 4; ++j) inv[mp][4 * g4 + j] = a4[j]; }
        asm volatile("s_waitcnt lgkmcnt(0)" ::: "memory");
    }
    bf16_t* ow = Oout + (size_t)(32 * wave) * DM;
    if constexpr (!DIFF) {
#pragma unroll
        for (int r = 0; r < 16; ++r) { const int q = (r & 3) + 8 * (r >> 2) + 4 * hi;
#pragma unroll
            for (int db = 0; db < 2; ++db) ow[(size_t)q * DM + 32 * db + l31] = f2bf(O[0][db][r] * inv[0][r]); }
    } else {
        const float gs0 = gsub[l31] * subscale, gs1 = gsub[32 + l31] * subscale;
#pragma unroll
        for (int r = 0; r < 16; ++r) { const int q = (r & 3) + 8 * (r >> 2) + 4 * hi;
            const float o0 = O[0][0][r] * inv[0][r] - lam * (O[1][0][r] * inv[1][r]);
            const float o1 = O[0][1][r] * inv[0][r] - lam * (O[1][1][r] * inv[1][r]);
            float ss = o0 * o0 + o1 * o1;
#pragma unroll
            for (int o = 1; o < 32; o <<= 1) ss += __shfl_xor(ss, o);
            const float rs = rsqrtf(ss * (1.0f / 64.0f) + EPS);
            ow[(size_t)q * DM + l31] = f2bf(o0 * rs * gs0); ow[(size_t)q * DM + 32 + l31] = f2bf(o1 * rs * gs1); }
    }
}

DEV void load8(const bf16_t* p, float (&v)[8]) {
    const u32x4 w = *(const u32x4*)p;
    v[0] = bf2f(w.x & 0xffffu); v[1] = bf2f(w.x >> 16); v[2] = bf2f(w.y & 0xffffu); v[3] = bf2f(w.y >> 16);
    v[4] = bf2f(w.z & 0xffffu); v[5] = bf2f(w.z >> 16); v[6] = bf2f(w.w & 0xffffu); v[7] = bf2f(w.w >> 16);
}
DEV void phase_f(const Args& a, int l, int nrows, int seqlen, int tid) {
    const bf16_t* U = (const bf16_t*)(a.ws + WS_U);
    bf16_t* ACT = (bf16_t*)(a.ws + WS_ACT);
    const float* wc = a.in[I_WCONV] + (size_t)l * 3 * UPC;
    const int nitems = (nrows / 8) * 352;
    for (int it = blockIdx.x * 512 + tid; it < nitems; it += gridDim.x * 512) {
        const int rb = it / 352, j8 = it - rb * 352, r0 = rb * 8, c0 = j8 * 8;
        float wg[3][8], wv[3][8];
#pragma unroll
        for (int k = 0; k < 3; ++k) {
            const f32x4 g0 = *(const f32x4*)(wc + k * UPC + c0), g1 = *(const f32x4*)(wc + k * UPC + c0 + 4);
            const f32x4 v0 = *(const f32x4*)(wc + k * UPC + DFF + c0), v1 = *(const f32x4*)(wc + k * UPC + DFF + c0 + 4);
#pragma unroll
            for (int j = 0; j < 4; ++j) { wg[k][j] = g0[j]; wg[k][4 + j] = g1[j]; wv[k][j] = v0[j]; wv[k][4 + j] = v1[j]; }
        }
        float pg[8], pv[8], cg_[8], cv[8], ng[8], nv[8];
        const bool hasp = (r0 % seqlen) != 0, hasn = ((r0 + 8) % seqlen) != 0;
        if (hasp) { load8(U + (size_t)(r0 - 1) * UPC + c0, pg); load8(U + (size_t)(r0 - 1) * UPC + DFF + c0, pv); }
        else {
#pragma unroll
            for (int j = 0; j < 8; ++j) { pg[j] = 0.f; pv[j] = 0.f; } }
        load8(U + (size_t)r0 * UPC + c0, cg_); load8(U + (size_t)r0 * UPC + DFF + c0, cv);
#pragma unroll
        for (int i = 0; i < 8; ++i) {
            const int r = r0 + i;
            if (i < 7 || hasn) { load8(U + (size_t)(r + 1) * UPC + c0, ng); load8(U + (size_t)(r + 1) * UPC + DFF + c0, nv); }
            else {
#pragma unroll
                for (int j = 0; j < 8; ++j) { ng[j] = 0.f; nv[j] = 0.f; } }
            float o[8];
#pragma unroll
            for (int j = 0; j < 8; ++j) {
                const float gt = wg[0][j] * pg[j] + wg[1][j] * cg_[j] + wg[2][j] * ng[j];
                const float vl = wv[0][j] * pv[j] + wv[1][j] * cv[j] + wv[2][j] * nv[j];
                const float sg = gt * __builtin_amdgcn_rcpf(1.0f + __expf(-gt));
                o[j] = sg * vl;
            }
            u32x4 w; w.x = pk2(o[0], o[1]); w.y = pk2(o[2], o[3]); w.z = pk2(o[4], o[5]); w.w = pk2(o[6], o[7]);
            *(u32x4*)(ACT + (size_t)r * DFF + c0) = w;
#pragma unroll
            for (int j = 0; j < 8; ++j) { pg[j] = cg_[j]; pv[j] = cv[j]; cg_[j] = ng[j]; cv[j] = nv[j]; }
        }
    }
}

struct ShiftOrder {
    pg8::StaticOrder S;
    __device__ void init(int M, int N, int G, int c) { S.init(M, N, G, c); }
    __device__ bool next(int i, pg8::Unit& u) const { return S.next(i, u); }
    DEV void a_ready(const pg8::Unit&) const {}
    DEV void done(const pg8::Unit&) const {}
};

__global__ void __launch_bounds__(512, 2) mega_fwd(Args a) {
    extern __shared__ __attribute__((aligned(16))) unsigned char lds_raw[];
    LAS unsigned char* lds = (LAS unsigned char*)lds_raw;
    cg::grid_group grid = cg::this_grid();
    const int G = gridDim.x, bid = blockIdx.x;
#define PH_LOCALS \
    unsigned char* ws = a.ws; asm volatile("" : "+s"(ws)); \
    int tid = threadIdx.x; asm volatile("" : "+v"(tid)); \
    const int lane = tid & 63, wave = __builtin_amdgcn_readfirstlane(tid >> 6); \
    const int gw = bid * 8 + wave, NGW = G * 8, gt = bid * 512 + tid, NGT = G * 512; \
    float* MOD = (float*)(ws + WS_MOD); float* BIN = (float*)(ws + WS_BIN); float* BUP = (float*)(ws + WS_BUP); float* SSQ = (float*)(ws + WS_SSQ); \
    bf16_t* XS = (bf16_t*)(ws + WS_XS); bf16_t* Pb = (bf16_t*)(ws + WS_P); bf16_t* OB = (bf16_t*)(ws + WS_OB); \
    unsigned* CTL = (unsigned*)(ws + WS_CTL); \
    (void)lane; (void)wave; (void)gw; (void)NGW; (void)gt; (void)NGT; (void)MOD; (void)BIN; (void)BUP; (void)SSQ; (void)XS; (void)Pb; (void)OB; (void)CTL;
    const bool one = (a.ph_hi - a.ph_lo) > 1;
    int ph = 0;
#define PH_BEGIN if (ph >= a.ph_lo && ph < a.ph_hi) { PH_LOCALS
#define PH_END   if (one && ph + 1 < a.ph_hi) grid.sync(); } ++ph;

    PH_BEGIN
#ifndef SKIP_P0
    {
        LAS float* vec = (LAS float*)lds; LAS float* red = (LAS float*)(lds + 36864);
        for (int i = tid; i < 9216; i += 512) { const int v = i >> 10, k = i & 1023; const float x = (v == 0) ? a.in[I_CCTX][k] : a.in[I_C][(v - 1) * 1024 + k]; vec[i] = x / (1.0f + __expf(-x)); }
        __syncthreads();
        for (int it = bid; it < 4 * 96; it += G) { const int l = it / 96, nb = it % 96;
            gemv9_item(vec, red, a.in[I_WADA] + (size_t)l * DM * 6144, 6144, 6144, a.in[I_BADA] + l * 6144, MOD + (size_t)l * 9 * 6144, 6144, nb * 64, tid); }
        __syncthreads();
        convert_weights(a, lds, 0, 31, gw, NGW, wave, lane);
        for (int i = gt; i < 9 * MTOT; i += NGT) SSQ[i] = 0.f;
        for (int i = gt; i < 1024; i += NGT) CTL[i] = 0u;
        { unsigned* padp = (unsigned*)(ws + WS_WIN + (size_t)INC * DM * 2); for (int i = gt; i < (INP - INC) * DM / 2; i += NGT) padp[i] = 0u; }
        { bf16_t* T = (bf16_t*)(ws + WS_TLAT);
          for (int i = gt; i < 2048 * 4096; i += NGT) { const int np = i >> 12, k = i & 4095, n = k & 2047; const int m = (np * n) & 2047; const float x = (float)m * (1.0f / 1024.0f);
              const float v = (k < 2048) ? cospif(x) : -sinpif(x); T[i] = f2bf(v * 0.02209708691207961f); } }
        { bf16_t* T = (bf16_t*)(ws + WS_TCTX);
          for (int i = gt; i < 256 * 512; i += NGT) { const int np = i >> 9, k = i & 511, n = k & 255; const int m = (np * n) & 255; const float x = (float)m * (1.0f / 128.0f);
              const float v = (k < 256) ? cospif(x) : -sinpif(x); T[i] = f2bf(v * 0.0625f); } }
        { bf16_t* T = (bf16_t*)(ws + WS_CS64);
          for (int i = gt; i < 128 * 64; i += NGT) { const int cc = i >> 6, c = i & 63, cp = cc & 63; const int m = (cp * c) & 63; const float x = (float)m * (1.0f / 32.0f);
              const float v = (cc < 64) ? cospif(x) : sinpif(x); T[i] = f2bf(v * 0.125f); } }
    }
#endif
    PH_END
    PH_BEGIN
#ifndef SKIP_P1
    {
        LAS float* vec = (LAS float*)lds; LAS float* red = (LAS float*)(lds + 36864);
        for (int it = bid; it < 4 * 124; it += G) { const int l = it / 124, j = it % 124; const bool up = j >= 36; const int chunk = up ? 3 : 0;
            for (int i = tid; i < 9216; i += 512) { const int v = i >> 10, k = i & 1023; vec[i] = MOD[((size_t)l * 9 + v) * 6144 + chunk * 1024 + k]; }
            __syncthreads();
            if (!up) gemv9_item(vec, red, a.in[I_WIN] + (size_t)l * DM * INC, INC, INC, nullptr, BIN + (size_t)l * 9 * INP, INP, j * 64, tid);
            else gemv9_item(vec, red, a.in[I_WUP] + (size_t)l * DM * UPC, UPC, UPC, nullptr, BUP + (size_t)l * 9 * UPC, UPC, (j - 36) * 64, tid);
        }
        for (int r = gw; r < MTOT; r += NGW) {
            const float* xr = (r < NCTX) ? a.in[I_XP] + (size_t)r * DM : a.in[I_XS] + (size_t)(r - NCTX) * DM;
            const int b9 = row_b9(r);
            const float* sc = MOD + (size_t)b9 * 6144 + 1024; const float* gm = a.in[I_GMIX];
            float ss = 0.f;
#pragma unroll
            for (int j = 0; j < 4; ++j) { const int c = 4 * lane + 256 * j; const f32x4 x = *(const f32x4*)(xr + c); const f32x4 g = *(const f32x4*)(gm + c), s = *(const f32x4*)(sc + c);
                ss += (x[0] * x[0] + x[1] * x[1]) + (x[2] * x[2] + x[3] * x[3]); const f32x4 y = x * g * (s + 1.0f);
                u32x2 w; w.x = pk2(y[0], y[1]); w.y = pk2(y[2], y[3]); *(u32x2*)(XS + (size_t)r * DM + c) = w; }
            ss = wave_sum(ss);
            if (lane == 0) SSQ[r] = ss;
        }
    }
#endif
    PH_END

#pragma unroll 1
    for (int l = 0; l < NLAYER; ++l) {
        PH_BEGIN
#ifndef SKIP_A
        {
            pg8::Gemm g{XS, (const bf16_t*)(ws + WS_WIN), MTOT, INP, DM}; pg8::StaticOrder S; S.init(MTOT, INP, G, bid);
            EpiA E{Pb, INP, SSQ + (size_t)(2 * l) * MTOT, BIN + (size_t)l * 9 * INP, INP, 0};
            pg8::gemm_phase<EpiA, pg8::StaticOrder, true, true>(lds, g, S, E);
        }
#endif
        PH_END
        PH_BEGIN
#ifndef SKIP_B
        {
            if (l > 0) convert_weights(a, lds, l, 16, gw, NGW, wave, lane);
            __syncthreads();
            phase_b(a, lds, l, tid);
        }
#endif
        PH_END
        PH_BEGIN
#ifndef SKIP_C
        {
#pragma unroll 1
            for (int f = 0; f < 2; ++f) {
                pg8::Gemm g = (f == 0) ? pg8::Gemm{(const bf16_t*)(ws + WS_TLAT), (const bf16_t*)(ws + WS_FBL), 2048, 2048, 4096}
                                       : pg8::Gemm{(const bf16_t*)(ws + WS_TCTX), (const bf16_t*)(ws + WS_FBC), 256, 8192, 512};
                pg8::StaticOrder S; S.init(g.M, g.N, G, (f == 0) ? bid : (bid + G - 64) % G);
                EpiF E{OB, (f == 0) ? NCTX : 0, (f == 0) ? 2048 : 256};
                pg8::gemm_phase<EpiF, pg8::StaticOrder, true, true>(lds, g, S, E);
            }
            int tid2 = threadIdx.x; asm volatile("" : "+v"(tid2));
            unsigned char* ws2 = a.ws; asm volatile("" : "+s"(ws2));
            float lam, lam_init;
            { const float p1 = ((tid2 & 63) < 32) ? a.in[I_LQ1][l * 32 + (tid2 & 63)] * a.in[I_LK1][l * 32 + (tid2 & 63)] : 0.f, p2 = ((tid2 & 63) < 32) ? a.in[I_LQ2][l * 32 + (tid2 & 63)] * a.in[I_LK2][l * 32 + (tid2 & 63)] : 0.f;
              lam_init = 0.8f - 0.6f * expf(-0.3f * (float)l); lam = expf(wave_sum(p1)) - expf(wave_sum(p2)) + lam_init; }
            const float cm = 0.10206207261596575f * 1.4426950408889634f, cd = 0.17677669529663687f * 1.4426950408889634f;
            LAS int* qslot = (LAS int*)(lds + LDS_MISC);
            unsigned* qctr = (unsigned*)(ws2 + WS_CTL) + 64 * (1 + l);
            for (;;) {
                __syncthreads();
                if (tid2 == 0) *qslot = (int)atomicAdd(qctr, 1u);
                __syncthreads();
                const int idx = *qslot;
                if (idx >= 1152) break;
                const bool lat = idx < 768;
                const bool diff = lat ? (idx < 384) : (idx < 960);
                int q0, vt_ld, nt_main, nt_total, qa_ld; size_t qa_off, k_off, vt_off; size_t qa_base, k_base, vt_base;
                int h;
                if (lat) { const int j = diff ? idx : idx - 384; const int bh = j >> 3, qb = j & 7, b = bh / 6; h = bh % 6;
                    const int lr0 = b * 2048 + qb * 256; q0 = NCTX + lr0; vt_ld = 2560; nt_main = 32; nt_total = 40;
                    qa_base = diff ? WS_QDR : WS_QMR; qa_ld = diff ? 384 : 576; qa_off = (size_t)lr0 * qa_ld + (diff ? 64 : 96) * h;
                    k_base = diff ? WS_KDL : WS_KML; k_off = (size_t)b * 2560 * (diff ? 384 : 576) + (diff ? 64 : 96) * h;
                    vt_base = diff ? WS_VDL : WS_VML; vt_off = (size_t)(b * 6 + h) * 64 * 2560; }
                else { const int j = diff ? idx - 768 : idx - 960; const int i = j / 6; h = j % 6; q0 = i * 256; vt_ld = 256; nt_main = 4; nt_total = 4;
                    qa_base = WS_P; qa_ld = INP; qa_off = (size_t)q0 * INP + (diff ? 736 + 64 * h : 96 * h);
                    k_base = diff ? WS_KDC : WS_KMC; k_off = (size_t)q0 * (diff ? 384 : 576) + (diff ? 64 : 96) * h;
                    vt_base = diff ? WS_VDC : WS_VMC; vt_off = (size_t)(i * 6 + h) * 64 * 256; }
                const bf16_t* Qa = (const bf16_t*)(ws2 + qa_base) + qa_off;
                const bf16_t* Qb = (const bf16_t*)(ws2 + WS_P) + (size_t)q0 * INP + (diff ? 736 + 64 * h : 96 * h);
                const bf16_t* Kp = (const bf16_t*)(ws2 + k_base) + k_off;
                const bf16_t* Vt = (const bf16_t*)(ws2 + vt_base) + vt_off;
                bf16_t* Oo = (bf16_t*)(ws2 + WS_OB) + (size_t)q0 * DM + (diff ? 384 : 0) + 64 * h;
                if (diff) attn_unit<true>(lds, Qa, qa_ld, Qb, INP, Kp, 384, Vt, vt_ld, nt_main, nt_total, Oo, cd, lam, a.in[I_GSUB] + l * 64, 1.0f - lam_init, tid2);
                else attn_unit<false>(lds, Qa, qa_ld, Qb, INP, Kp, 576, Vt, vt_ld, nt_main, nt_total, Oo, cm, 0.f, nullptr, 0.f, tid2);
            }
        }
#endif
        PH_END
        PH_BEGIN
#ifndef SKIP_D
        {
            pg8::Gemm g{OB, (const bf16_t*)(ws + WS_WOUT), MTOT, DM, DM}; pg8::StaticOrder S; S.init(MTOT, DM, G, bid);
            EpiRes E{(l == 0) ? a.in[I_XP] : a.out, (l == 0) ? a.in[I_XS] : a.out + (size_t)NCTX * DM, a.out, (MOD + (size_t)l * 9 * 6144) + 2 * 1024,
                     a.in[I_GFFN] + l * DM, (MOD + (size_t)l * 9 * 6144) + 4 * 1024, XS, SSQ + (size_t)(2 * l + 1) * MTOT, 0};
            pg8::gemm_phase<EpiRes, pg8::StaticOrder, true, true>(lds, g, S, E);
        }
#endif
        PH_END
#pragma unroll 1
        for (int ch = 0; ch < 2; ++ch) {
            const int row0 = (ch == 0) ? NCTX : 0, Mc = (ch == 0) ? NLAT : NCTX, seqlen = (ch == 0) ? 2048 : 256;
            PH_BEGIN
#ifndef SKIP_E
            {
                if (ch == 1 && l + 1 < NLAYER) { convert_weights(a, lds, l + 1, 7, gw, NGW, wave, lane); __syncthreads(); }
                pg8::Gemm g{XS + (size_t)row0 * DM, (const bf16_t*)(ws + WS_WUP), Mc, UPC, DM}; pg8::StaticOrder S; S.init(Mc, UPC, G, bid);
                EpiA E{(bf16_t*)(ws + WS_U), UPC, SSQ + (size_t)(2 * l + 1) * MTOT, BUP + (size_t)l * 9 * UPC, UPC, row0};
                pg8::gemm_phase<EpiA, pg8::StaticOrder, true, true>(lds, g, S, E);
            }
#endif
            PH_END
            PH_BEGIN
#ifndef SKIP_F
            { phase_f(a, l, Mc, seqlen, tid); }
#endif
            PH_END
            PH_BEGIN
#ifndef SKIP_G
            {
                if (ch == 1 && l + 1 < NLAYER) { convert_weights(a, lds, l + 1, 8, gw, NGW, wave, lane); __syncthreads(); }
                const bool nxt = (l + 1 < NLAYER);
                pg8::Gemm g{(const bf16_t*)(ws + WS_ACT), (const bf16_t*)(ws + WS_WDN), Mc, DM, DFF}; pg8::StaticOrder S; S.init(Mc, DM, G, bid);
                EpiRes E{a.out, a.out + (size_t)NCTX * DM, a.out, (MOD + (size_t)l * 9 * 6144) + 5 * 1024,
                         nxt ? a.in[I_GMIX] + (l + 1) * DM : nullptr, (MOD + (size_t)l * 9 * 6144) + 9 * 6144 + 1 * 1024, XS, SSQ + (size_t)(nxt ? 2 * l + 2 : 8) * MTOT, row0};
                pg8::gemm_phase<EpiRes, pg8::StaticOrder, true, true>(lds, g, S, E);
            }
#endif
            PH_END
        }
    }
    PH_BEGIN
#ifndef SKIP_FIN
    {
        const float* gf = a.in[I_GFINAL];
        for (int r = gw; r < MTOT; r += NGW) {
            float* xr = a.out + (size_t)r * DM;
            f32x4 x[4]; float ss = 0.f;
#pragma unroll
            for (int j = 0; j < 4; ++j) { x[j] = *(const f32x4*)(xr + 4 * lane + 256 * j); ss += (x[j][0] * x[j][0] + x[j][1] * x[j][1]) + (x[j][2] * x[j][2] + x[j][3] * x[j][3]); }
            ss = wave_sum(ss);
            const float rs = rsqrtf(ss * (1.0f / 1024.0f) + EPS);
#pragma unroll
            for (int j = 0; j < 4; ++j) { const f32x4 g = *(const f32x4*)(gf + 4 * lane + 256 * j); *(f32x4*)(xr + 4 * lane + 256 * j) = x[j] * rs * g; }
        }
    }
#endif
    PH_END
#undef PH_BEGIN
#undef PH_END
}
constexpr int N_PHASES = 2 + NLAYER * 10 + 1;

#ifndef MK_ONE_LAUNCH
#define MK_ONE_LAUNCH 1
#endif
extern "C" void kernel_launch(void* const* d_in, const int* in_sizes, int n_in, void* d_out, int out_size, void* d_ws, size_t ws_size, hipStream_t stream) {
    static int grid = 0;
    if (grid == 0) {
        if (n_in != 26 || ws_size < WS_END) { fprintf(stderr, "kernel_launch: unexpected inputs (n_in %d, ws %zu < %zu)\n", n_in, ws_size, (size_t)WS_END); grid = -1; return; }
        int dev = 0, cus = 0, per_cu = 0;
        hipGetDevice(&dev); hipDeviceGetAttribute(&cus, hipDeviceAttributeMultiprocessorCount, dev);
        if (hipFuncSetAttribute((const void*)mega_fwd, hipFuncAttributeMaxDynamicSharedMemorySize, LDS_BYTES) != hipSuccess) { fprintf(stderr, "kernel_launch: hipFuncSetAttribute failed\n"); grid = -1; return; }
        if (hipOccupancyMaxActiveBlocksPerMultiprocessor(&per_cu, (const void*)mega_fwd, 512, LDS_BYTES) != hipSuccess || per_cu < 1) { fprintf(stderr, "kernel_launch: occupancy query gave %d\n", per_cu); per_cu = 1; }
        (void)hipGetLastError();
        grid = cus * 1;
    }
    if (grid < 0) return;
    Args a{};
    for (int i = 0; i < 26; ++i) a.in[i] = (const float*)d_in[i];
    a.out = (float*)d_out; a.ws = (unsigned char*)d_ws;
#if MK_ONE_LAUNCH
    a.ph_lo = 0; a.ph_hi = N_PHASES;
    void* args[] = {&a};
    hipError_t e = hipLaunchCooperativeKernel((const void*)mega_fwd, dim3(grid), dim3(512), args, LDS_BYTES, stream);
    if (e != hipSuccess) fprintf(stderr, "cooperative launch failed: %s (grid %d)\n", hipGetErrorString(e), grid);
#else
    for (int p = 0; p < N_PHASES; ++p) { a.ph_lo = p; a.ph_hi = p + 1; hipLaunchKernelGGL(mega_fwd, dim3(grid), dim3(512), LDS_BYTES, stream, a); }
#endif
}
```

```cpp
#include <hip/hip_runtime.h>
#include <hip/hip_cooperative_groups.h>
#include <cstdio>
#include <cstdint>
namespace cg = cooperative_groups;
namespace pg8 {
#define PG8_LAS __attribute__((address_space(3)))
typedef unsigned short bf16_t;
typedef short bf16x8 __attribute__((ext_vector_type(8)));
typedef float f32x4 __attribute__((ext_vector_type(4)));
typedef unsigned u32x4 __attribute__((ext_vector_type(4)));
constexpr int BM = 256, BK = 64, HALF = 128, HTB = HALF * BK * 2  , STAGE_BYTES = 8 * HTB, NXCD = 8, WGM = 8;

__host__ __device__ __forceinline__ int lds_byte(int r, int c) { const int st = (r >> 4) * 2 + (c >> 5), rr = r & 15, cc = c & 31, ob = rr * 64 + cc * 2; return st * 1024 + (ob ^ (((ob >> 9) & 1) << 5)); }
__host__ __device__ __forceinline__ void stage_rc(int b, int& R, int& C) { const int st = b / 1024, sb = b % 1024, swz = sb ^ (((sb >> 9) & 1) << 5); R = (st >> 1) * 16 + swz / 64; C = (st & 1) * 32 + (swz % 64) / 2; }
__host__ __device__ __forceinline__ int perm32(int rho) { const int n = rho >> 4, i = rho & 15; return 8 * (i >> 2) + 4 * n + (i & 3); }

struct Unit { int pm, pn; };
struct Gemm { const bf16_t* A; const bf16_t* Bt; int M, N, K; };

struct StaticOrder {
    int nM, nN, nwg, G, c;
    __host__ __device__ void init(int M, int N, int G_, int c_) { nM = M / BM; nN = N / BM; nwg = nM * nN; G = G_; c = c_; }
    __host__ __device__ bool next(int i, Unit& u) const {
        const long L = (long)i * G + c; if (L >= nwg) return false;
        int wgid = (int)L; { const int q = nwg / NXCD, r = nwg % NXCD, xcd = wgid % NXCD, off = wgid / NXCD; wgid = (xcd < r ? xcd * (q + 1) : r * (q + 1) + (xcd - r) * q) + off; }
        const int nig = WGM * nN, gid = wgid / nig, fm = gid * WGM, gsz = (nM - fm) < WGM ? (nM - fm) : WGM;
        u.pm = fm + ((wgid % nig) % gsz); u.pn = (wgid % nig) / gsz; return true;
    }
    __device__ __forceinline__ void a_ready(const Unit&) const {}
    __device__ __forceinline__ void done(const Unit&) const {}
};

__device__ __forceinline__ unsigned cvt_pk_bf16(float lo, float hi) { unsigned r; asm volatile("v_cvt_pk_bf16_f32 %0, %1, %2" : "=v"(r) : "v"(lo), "v"(hi)); return r; }
typedef float f32x2 __attribute__((ext_vector_type(2)));
__device__ __forceinline__ f32x2 gelu_pk(f32x2 v) {
    const f32x2 av = __builtin_elementwise_abs(v), d = av * 0.2316418882f + 1.0f;
    f32x2 t; t.x = __builtin_amdgcn_rcpf(d.x); t.y = __builtin_amdgcn_rcpf(d.y);
    f32x2 q = t * 0.5307027145f + (-0.7265760135f); q = q * t + 0.7107068705f; q = q * t + (-0.142248368f); q = q * t + 0.127414796f; q = q * t;
    const f32x2 s = (v * v) * (-0.72134752044f);
    f32x2 e; e.x = __builtin_amdgcn_exp2f(s.x); e.y = __builtin_amdgcn_exp2f(s.y);
    const f32x2 m = v * (q * e), r = v - m;
    f32x2 o; o.x = v.x < 0.f ? m.x : r.x; o.y = v.y < 0.f ? m.y : r.y; return o;
}

template <int ACT  > struct EpiBf16 {
    static constexpr bool PERM = true, AFTER_DRAIN = false; static_assert(ACT == 0 || ACT == 1, "EpiBf16: ACT is 0 (none) or 1 (gelu_pk)");
    bf16_t* O; int ldc; const float* bias; int split_cols; size_t split_stride; float scale0;
    __device__ __forceinline__ void operator()(const f32x4 (&acc)[2][2][4][2], const Unit& u, int wr, int wc, int fr, int fq) const {
        const int row0 = u.pm * BM + wr * 64 + fr; int colt = u.pn * BM; bf16_t* base = O;
        float sc = 1.f; if (split_cols) { const int t = colt / split_cols; base += (size_t)t * split_stride; colt -= t * split_cols; if (t == 0) sc = scale0; }
        const int col0 = colt + wc * 32 + 8 * fq, bcol0 = u.pn * BM + wc * 32 + 8 * fq;
        f32x4 bv[2][2];
#pragma unroll
        for (int bj = 0; bj < 2; ++bj)
#pragma unroll
            for (int n = 0; n < 2; ++n) bv[bj][n] = bias ? *(const f32x4*)(bias + bcol0 + bj * HALF + 4 * n) : (f32x4){0.f, 0.f, 0.f, 0.f};
#pragma unroll
        for (int ai = 0; ai < 2; ++ai)
#pragma unroll
            for (int m = 0; m < 4; ++m) { bf16_t* rowp = base + (size_t)(row0 + ai * HALF + m * 16) * ldc + col0;
#pragma unroll
                for (int bj = 0; bj < 2; ++bj) { f32x4 v0 = acc[ai][bj][m][0] + bv[bj][0], v1 = acc[ai][bj][m][1] + bv[bj][1];
                    if (ACT == 1) { f32x2 a = gelu_pk((f32x2){v0[0], v0[1]}), b = gelu_pk((f32x2){v0[2], v0[3]}), c = gelu_pk((f32x2){v1[0], v1[1]}), d = gelu_pk((f32x2){v1[2], v1[3]});
                        v0 = (f32x4){a.x, a.y, b.x, b.y}; v1 = (f32x4){c.x, c.y, d.x, d.y}; }
                    v0 = v0 * sc; v1 = v1 * sc; u32x4 w; w.x = cvt_pk_bf16(v0[0], v0[1]); w.y = cvt_pk_bf16(v0[2], v0[3]); w.z = cvt_pk_bf16(v1[0], v1[1]); w.w = cvt_pk_bf16(v1[2], v1[3]);
                    *(u32x4*)(rowp + bj * HALF) = w; } }
    }
};

struct PanelStats {
    unsigned* xbuf;
    unsigned* cnt;
    unsigned* tmo;
    int ntn; float eps;
    unsigned code;
    __device__ __forceinline__ bool run(const f32x4 (&v)[2][2][4][2], const Unit& u, int wr, int wc, int fr, int fq, PG8_LAS unsigned char* lds, int wid, int lane) const {
        typedef float f32x2v __attribute__((ext_vector_type(2)));
        PG8_LAS f32x2v* P = (PG8_LAS f32x2v*)lds;
        PG8_LAS f32x2v* S = (PG8_LAS f32x2v*)(lds + 8192);
        PG8_LAS unsigned* flag = (PG8_LAS unsigned*)(lds + 8192 + 2048);
#pragma unroll
        for (int ai = 0; ai < 2; ++ai)
#pragma unroll
            for (int m = 0; m < 4; ++m) {
                float s = 0.f;
#pragma unroll
                for (int bj = 0; bj < 2; ++bj)
#pragma unroll
                    for (int n = 0; n < 2; ++n) { const f32x4 x = v[ai][bj][m][n]; s += (x[0] + x[1]) + (x[2] + x[3]); }
                s += __shfl_xor(s, 16); s += __shfl_xor(s, 32);
                const float mw = s * (1.0f / 64.0f); float q = 0.f;
#pragma unroll
                for (int bj = 0; bj < 2; ++bj)
#pragma unroll
                    for (int n = 0; n < 2; ++n) { const f32x4 d = v[ai][bj][m][n] - mw; q += (d[0] * d[0] + d[1] * d[1]) + (d[2] * d[2] + d[3] * d[3]); }
                q += __shfl_xor(q, 16); q += __shfl_xor(q, 32);
                if (fq == 0) P[(ai * HALF + wr * 64 + m * 16 + fr) * 4 + wc] = (f32x2v){mw, q};
            }
        asm volatile("s_waitcnt lgkmcnt(0)" ::: "memory"); __builtin_amdgcn_s_barrier(); asm volatile("" ::: "memory");
#if defined(BROKEN_EXCHANGE_NO_WAIT)
#warning BROKEN CONTROL BUILD: the row-statistics exchange does not wait; results are wrong by design
        if (blockIdx.x >= 64) { const long long t0_ = clock64(); while (clock64() - t0_ < 60000) __builtin_amdgcn_s_sleep(8); }
#endif
        const int row = wid * 32 + (lane & 31);
        if (lane < 32) {
            const f32x2v a = P[row * 4 + 0], b = P[row * 4 + 1], c = P[row * 4 + 2], d = P[row * 4 + 3];
            const float mt = (a.x + b.x + c.x + d.x) * 0.25f;
            const float da = a.x - mt, db = b.x - mt, dc = c.x - mt, dd = d.x - mt;
            const float m2 = (a.y + b.y) + (c.y + d.y) + 64.0f * ((da * da + db * db) + (dc * dc + dd * dd));
            unsigned long long* slot = (unsigned long long*)xbuf + ((size_t)(u.pm * BM + row) * 4 + u.pn);
            __hip_atomic_store(slot, ((unsigned long long)__float_as_uint(m2) << 32) | __float_as_uint(mt), __ATOMIC_RELAXED, __HIP_MEMORY_SCOPE_AGENT);
        }
        asm volatile("s_waitcnt vmcnt(0)" ::: "memory");
        if (lane == 0) __hip_atomic_fetch_add(cnt + 64 * u.pm, 1u, __ATOMIC_RELAXED, __HIP_MEMORY_SCOPE_AGENT);
        if (wid == 0) {
            bool dead = false; const unsigned long long t0 = __builtin_amdgcn_s_memrealtime(); const unsigned want = 8u * (unsigned)ntn;
            for (;;) {
#if defined(BROKEN_EXCHANGE_NO_WAIT)
                break;
#endif
                if ((unsigned)__builtin_amdgcn_readfirstlane(__hip_atomic_load(cnt + 64 * u.pm, __ATOMIC_RELAXED, __HIP_MEMORY_SCOPE_AGENT)) >= want) break;
                if (__builtin_amdgcn_s_memrealtime() - t0 > 2000000ull) {
                    if (lane == 0) { unsigned expect = 0u; __hip_atomic_compare_exchange_strong(tmo + 1, &expect, code | (unsigned)(u.pm & 0xff), __ATOMIC_RELAXED, __ATOMIC_RELAXED, __HIP_MEMORY_SCOPE_AGENT);
                                     __hip_atomic_store(tmo, 1u, __ATOMIC_RELAXED, __HIP_MEMORY_SCOPE_AGENT); }
                    dead = true; break; }
                __builtin_amdgcn_s_sleep(2);
            }
            __builtin_amdgcn_fence(__ATOMIC_ACQUIRE, "agent");
            if (lane == 0) flag[0] = dead ? 1u : 0u;
        }
        asm volatile("s_waitcnt vmcnt(0) lgkmcnt(0)" ::: "memory"); __builtin_amdgcn_s_barrier(); asm volatile("" ::: "memory");
        const bool bad = flag[0] != 0u;
        if (lane < 32) {
            const unsigned long long* slot = (const unsigned long long*)xbuf + (size_t)(u.pm * BM + row) * 4; float mt[4], m2[4]; float ms = 0.f;
#pragma unroll
            for (int t = 0; t < 4; ++t) { if (t < ntn) { const unsigned long long w = __hip_atomic_load(slot + t, __ATOMIC_RELAXED, __HIP_MEMORY_SCOPE_AGENT); mt[t] = __uint_as_float((unsigned)w); m2[t] = __uint_as_float((unsigned)(w >> 32)); } else { mt[t] = 0.f; m2[t] = 0.f; } ms += mt[t]; }
            const float mean = ms / (float)ntn; float q = 0.f;
#pragma unroll
            for (int t = 0; t < 4; ++t) if (t < ntn) { const float dm = mt[t] - mean; q += m2[t] + 256.0f * dm * dm; }
            S[row] = (f32x2v){mean, 1.0f / sqrtf(q / (256.0f * (float)ntn) + eps)};
        }
        asm volatile("s_waitcnt lgkmcnt(0)" ::: "memory"); __builtin_amdgcn_s_barrier(); asm volatile("" ::: "memory");
        return bad;
    }
};
struct EpiLnRes {
    static constexpr bool PERM = false, AFTER_DRAIN = true;
    const float* base; float* out; int ldc; const float* bias; PanelStats st; unsigned poison;
    __device__ __forceinline__ void fused(f32x4 (&acc)[2][2][4][2], const Unit& u, int wr, int wc, int fr, int fq, PG8_LAS unsigned char* lds, int wid, int lane) const {
        typedef float f32x2v __attribute__((ext_vector_type(2)));
        const PG8_LAS f32x2v* S = (const PG8_LAS f32x2v*)(lds + 8192);
        const int col0 = u.pn * BM + wc * 32 + 4 * fq;
#pragma unroll
        for (int bj = 0; bj < 2; ++bj)
#pragma unroll
            for (int n = 0; n < 2; ++n) { const f32x4 bv = bias ? *(const f32x4*)(bias + col0 + bj * HALF + n * 16) : (f32x4){0.f, 0.f, 0.f, 0.f};
#pragma unroll
                for (int ai = 0; ai < 2; ++ai)
#pragma unroll
                    for (int m = 0; m < 4; ++m) acc[ai][bj][m][n] += bv; }
        f32x4 pre[4][2][2];
#pragma unroll
        for (int m = 0; m < 4; ++m) { const size_t off = (size_t)(u.pm * BM + wr * 64 + m * 16 + fr) * ldc + col0;
#pragma unroll
            for (int bj = 0; bj < 2; ++bj)
#pragma unroll
                for (int n = 0; n < 2; ++n) pre[m][bj][n] = *(const f32x4*)(base + off + bj * HALF + n * 16); }
        const bool bad = st.run(acc, u, wr, wc, fr, fq, lds, wid, lane) || poison != 0u;
        const float qnan = __builtin_nanf("");
#pragma unroll
        for (int ai = 0; ai < 2; ++ai)
#pragma unroll
            for (int m = 0; m < 4; ++m) { const int r = ai * HALF + wr * 64 + m * 16 + fr; const f32x2v sr = S[r]; const size_t off = (size_t)(u.pm * BM + r) * ldc + col0;
#pragma unroll
                for (int bj = 0; bj < 2; ++bj)
#pragma unroll
                    for (int n = 0; n < 2; ++n) { const f32x4 bs = ai == 0 ? pre[m][bj][n] : *(const f32x4*)(base + off + bj * HALF + n * 16); f32x4 o = bs + (acc[ai][bj][m][n] - sr.x) * sr.y;
                        if (bad) o = (f32x4){qnan, qnan, qnan, qnan}; *(f32x4*)(out + off + bj * HALF + n * 16) = o; }
                if (m & 1) asm volatile("" ::: "memory"); }
    }
};
struct EpiLnResLn {
    static constexpr bool PERM = false, AFTER_DRAIN = true;
    const float* base; float* out; bf16_t* xn; int ldc; const float* bias; PanelStats st1, st2; unsigned poison;
    __device__ __forceinline__ void fused(f32x4 (&acc)[2][2][4][2], const Unit& u, int wr, int wc, int fr, int fq, PG8_LAS unsigned char* lds, int wid, int lane) const {
        typedef float f32x2v __attribute__((ext_vector_type(2))); typedef unsigned u32x2v __attribute__((ext_vector_type(2)));
        const PG8_LAS f32x2v* S = (const PG8_LAS f32x2v*)(lds + 8192);
        const int col0 = u.pn * BM + wc * 32 + 4 * fq;
#pragma unroll
        for (int bj = 0; bj < 2; ++bj)
#pragma unroll
            for (int n = 0; n < 2; ++n) { const f32x4 bv = bias ? *(const f32x4*)(bias + col0 + bj * HALF + n * 16) : (f32x4){0.f, 0.f, 0.f, 0.f};
#pragma unroll
                for (int ai = 0; ai < 2; ++ai)
#pragma unroll
                    for (int m = 0; m < 4; ++m) acc[ai][bj][m][n] += bv; }
        bool bad = st1.run(acc, u, wr, wc, fr, fq, lds, wid, lane) || poison != 0u;
        const float qnan = __builtin_nanf("");
#pragma unroll
        for (int ai = 0; ai < 2; ++ai)
#pragma unroll
            for (int m = 0; m < 4; ++m) { const int r = ai * HALF + wr * 64 + m * 16 + fr; const f32x2v sr = S[r]; const size_t off = (size_t)(u.pm * BM + r) * ldc + col0;
#pragma unroll
                for (int bj = 0; bj < 2; ++bj)
#pragma unroll
                    for (int n = 0; n < 2; ++n) { const f32x4 bs = *(const f32x4*)(base + off + bj * HALF + n * 16); acc[ai][bj][m][n] = bs + (acc[ai][bj][m][n] - sr.x) * sr.y; }
                asm volatile("" : "+v"(acc[ai][0][m][0]), "+v"(acc[ai][0][m][1]), "+v"(acc[ai][1][m][0]), "+v"(acc[ai][1][m][1]));
                if (m & 1) asm volatile("" ::: "memory"); }
        const bool bad1 = bad;
        bad = st2.run(acc, u, wr, wc, fr, fq, lds, wid, lane) || bad;
#pragma unroll
        for (int ai = 0; ai < 2; ++ai)
#pragma unroll
            for (int m = 0; m < 4; ++m) { const int r = ai * HALF + wr * 64 + m * 16 + fr; const f32x2v sr = S[r]; const size_t off = (size_t)(u.pm * BM + r) * ldc + col0;
#pragma unroll
                for (int bj = 0; bj < 2; ++bj)
#pragma unroll
                    for (int n = 0; n < 2; ++n) { const f32x4 x1 = acc[ai][bj][m][n]; *(f32x4*)(out + off + bj * HALF + n * 16) = bad1 ? (f32x4){qnan, qnan, qnan, qnan} : x1;
                        const f32x4 o = (x1 - sr.x) * sr.y; u32x2v w; w.x = cvt_pk_bf16(o[0], o[1]); w.y = cvt_pk_bf16(o[2], o[3]);
                        if (bad) { w.x = 0x7fc07fc0u; w.y = 0x7fc07fc0u; } *(u32x2v*)(xn + off + bj * HALF + n * 16) = w; }
                asm volatile("" ::: "memory"); }
    }
};

template <class Epi, class Sched, bool ALIGN_EPI = false, bool SP2 = false>
__device__ __forceinline__ void gemm_phase(PG8_LAS unsigned char* lds, const Gemm g, const Sched& S, const Epi& E) {
    int tid = threadIdx.x; asm volatile("" : "+v"(tid));
    const int wid = __builtin_amdgcn_readfirstlane(tid >> 6), lane = tid & 63, wr = wid >> 2, wc = wid & 3, fr = lane & 15, fq = lane >> 4;
    const int K = g.K, nt = K / BK;
    unsigned voffA[2], voffB[2];
#pragma unroll
    for (int i = 0; i < 2; ++i) { int R, C; stage_rc(tid * 16 + i * 8192, R, C); const int Rb = Epi::PERM ? ((R & ~31) + perm32(R & 31)) : R;
        voffA[i] = (unsigned)(R * K + C) * 2u; voffB[i] = (unsigned)(Rb * K + C) * 2u; }
    const size_t kstep = (size_t)(BK * 2);
    const size_t hstep = (size_t)HALF * K * 2;
    const size_t tstep = 2 * hstep;
    const unsigned ldsw = (unsigned)wid * 1024u;
    const int aoff = lds_byte(wr * 64 + fr, fq * 8), boff = lds_byte(wc * 32 + fr, fq * 8);
#define PG8_SA(b, h) (((b) * 2 + (h)) * HTB)
#define PG8_SB(b, h) ((4 + (b) * 2 + (h)) * HTB)
#define PG8_STAGE(bufoff, gbase, voff) do { _Pragma("unroll") for (int _i = 0; _i < 2; ++_i) \
        __builtin_amdgcn_global_load_lds((const unsigned*)((const char*)(gbase) + (voff)[_i]), (PG8_LAS unsigned*)(lds + (bufoff) + ldsw + _i * 8192), 16, 0, 0); } while (0)
#define PG8_LDA(dst, b, h) do { _Pragma("unroll") for (int m = 0; m < 4; ++m) _Pragma("unroll") for (int k = 0; k < 2; ++k) dst[m][k] = *(const PG8_LAS bf16x8*)(lds + PG8_SA(b, h) + aoff + m * 2048 + k * 1024); } while (0)
#define PG8_LDB(dst, b, h) do { _Pragma("unroll") for (int n = 0; n < 2; ++n) _Pragma("unroll") for (int k = 0; k < 2; ++k) dst[n][k] = *(const PG8_LAS bf16x8*)(lds + PG8_SB(b, h) + boff + n * 2048 + k * 1024); } while (0)
#define PG8_MMA(ai, bj, At, Bt) do { __builtin_amdgcn_s_setprio(1); _Pragma("unroll") for (int m = 0; m < 4; ++m) _Pragma("unroll") for (int n = 0; n < 2; ++n) _Pragma("unroll") for (int k = 0; k < 2; ++k) \
        acc[ai][bj][m][n] = __builtin_amdgcn_mfma_f32_16x16x32_bf16(Bt[n][k], At[m][k], acc[ai][bj][m][n], 0, 0, 0); __builtin_amdgcn_s_setprio(0); } while (0)
#define PG8_WAIT_V(n) asm volatile("s_waitcnt vmcnt(" #n ")" ::: "memory")
#define PG8_WAIT_L(n) asm volatile("s_waitcnt lgkmcnt(" #n ")" ::: "memory")
#define PG8_BAR __builtin_amdgcn_s_barrier()
#define PG8_SCHED __builtin_amdgcn_sched_barrier(0)
    Unit cur, nxt; int ui = 0;
    if (!S.next(0, cur)) return;
    f32x4 acc[2][2][4][2];
#pragma unroll
    for (int a = 0; a < 2; ++a)
#pragma unroll
        for (int b = 0; b < 2; ++b)
#pragma unroll
            for (int m = 0; m < 4; ++m)
#pragma unroll
                for (int n = 0; n < 2; ++n) acc[a][b][m][n] = (f32x4){0.f, 0.f, 0.f, 0.f};
    bf16x8 At[4][2], B0[2][2], B1[2][2];
    const char* cA = (const char*)g.A + (size_t)cur.pm * tstep; const char* cB = (const char*)g.Bt + (size_t)cur.pn * tstep;
    S.a_ready(cur);
    if constexpr (SP2) {
        PG8_STAGE(PG8_SB(0, 0), cB, voffB); PG8_STAGE(PG8_SB(0, 1), cB + hstep, voffB); PG8_STAGE(PG8_SA(0, 0), cA, voffA); PG8_STAGE(PG8_SA(0, 1), cA + hstep, voffA);
        if (wr == 1) PG8_BAR;
        PG8_WAIT_V(2); PG8_BAR;
        PG8_STAGE(PG8_SB(1, 0), cB + kstep, voffB); PG8_STAGE(PG8_SA(1, 0), cA + kstep, voffA); PG8_STAGE(PG8_SB(1, 1), cB + hstep + kstep, voffB);
        PG8_WAIT_V(6); PG8_BAR;
    } else {
        PG8_STAGE(PG8_SB(0, 0), cB, voffB); PG8_STAGE(PG8_SA(0, 0), cA, voffA); PG8_STAGE(PG8_SB(0, 1), cB + hstep, voffB); PG8_STAGE(PG8_SA(0, 1), cA + hstep, voffA);
        if (wr == 1) PG8_BAR;
        PG8_WAIT_V(4); PG8_BAR;
        PG8_STAGE(PG8_SB(1, 0), cB + kstep, voffB); PG8_STAGE(PG8_SA(1, 0), cA + kstep, voffA); PG8_STAGE(PG8_SB(1, 1), cB + hstep + kstep, voffB);
        PG8_WAIT_V(6); PG8_BAR;
    }
    for (;;) {
        const bool has_next = S.next(ui + 1, nxt);
        const char* nA = has_next ? (const char*)g.A + (size_t)nxt.pm * tstep : cA; const char* nB = has_next ? (const char*)g.Bt + (size_t)nxt.pn * tstep : cB;
        for (int t = 0; t < nt; t += 2) {
            const bool last = (t == nt - 2);
            const char* a1 = cA + (size_t)(t + 1) * kstep;
            const char* a2 = last ? nA : cA + (size_t)(t + 2) * kstep; const char* b2 = last ? nB : cB + (size_t)(t + 2) * kstep;
            const char* a3 = a2 + kstep; const char* b3 = b2 + kstep;
            if (last && has_next) S.a_ready(nxt);
            if constexpr (SP2) {
            PG8_LDB(B0, 0, 0); PG8_LDB(B1, 0, 1); PG8_SCHED; PG8_LDA(At, 0, 0); PG8_STAGE(PG8_SA(1, 1), a1 + hstep, voffA);
            PG8_WAIT_V(8); PG8_WAIT_L(0); PG8_BAR; PG8_MMA(0, 0, At, B0); PG8_MMA(0, 1, At, B1); PG8_BAR; PG8_SCHED;
            PG8_LDA(At, 0, 1); PG8_STAGE(PG8_SB(0, 0), b2, voffB); PG8_STAGE(PG8_SB(0, 1), b2 + hstep, voffB); PG8_STAGE(PG8_SA(0, 0), a2, voffA);
            PG8_WAIT_V(8); PG8_WAIT_L(0); PG8_BAR; PG8_MMA(1, 0, At, B0); PG8_MMA(1, 1, At, B1); PG8_BAR; PG8_SCHED;
            PG8_LDB(B0, 1, 0); PG8_LDB(B1, 1, 1); PG8_SCHED; PG8_LDA(At, 1, 0); PG8_STAGE(PG8_SA(0, 1), a2 + hstep, voffA);
            PG8_WAIT_V(8); PG8_WAIT_L(0); PG8_BAR; PG8_MMA(0, 0, At, B0); PG8_MMA(0, 1, At, B1); PG8_BAR; PG8_SCHED;
            PG8_LDA(At, 1, 1); PG8_STAGE(PG8_SB(1, 0), b3, voffB); PG8_STAGE(PG8_SB(1, 1), b3 + hstep, voffB); PG8_STAGE(PG8_SA(1, 0), a3, voffA);
            PG8_WAIT_V(8); PG8_WAIT_L(0); PG8_BAR; PG8_MMA(1, 0, At, B0); PG8_MMA(1, 1, At, B1); PG8_BAR; PG8_SCHED;
            } else {
            PG8_LDB(B0, 0, 0); PG8_SCHED; PG8_LDA(At, 0, 0); PG8_STAGE(PG8_SA(1, 1), a1 + hstep, voffA);
            PG8_WAIT_L(8); PG8_BAR; PG8_WAIT_L(0); PG8_MMA(0, 0, At, B0); PG8_BAR; PG8_SCHED;
            PG8_LDB(B1, 0, 1); PG8_STAGE(PG8_SB(0, 0), b2, voffB);
            PG8_BAR; PG8_WAIT_L(0); PG8_MMA(0, 1, At, B1); PG8_BAR;
            PG8_LDA(At, 0, 1); PG8_STAGE(PG8_SA(0, 0), a2, voffA);
            PG8_BAR; PG8_WAIT_L(0); PG8_MMA(1, 0, At, B0); PG8_BAR; PG8_SCHED;
            PG8_STAGE(PG8_SB(0, 1), b2 + hstep, voffB);
            PG8_WAIT_V(6); PG8_BAR; PG8_MMA(1, 1, At, B1); PG8_BAR;
            PG8_LDB(B0, 1, 0); PG8_SCHED; PG8_LDA(At, 1, 0); PG8_STAGE(PG8_SA(0, 1), a2 + hstep, voffA);
            PG8_WAIT_L(8); PG8_BAR; PG8_WAIT_L(0); PG8_MMA(0, 0, At, B0); PG8_BAR; PG8_SCHED;
            PG8_LDB(B1, 1, 1); PG8_STAGE(PG8_SB(1, 0), b3, voffB);
            PG8_BAR; PG8_WAIT_L(0); PG8_MMA(0, 1, At, B1); PG8_BAR;
            PG8_LDA(At, 1, 1); PG8_STAGE(PG8_SA(1, 0), a3, voffA);
            PG8_BAR; PG8_WAIT_L(0); PG8_MMA(1, 0, At, B0); PG8_BAR; PG8_SCHED;
            PG8_STAGE(PG8_SB(1, 1), b3 + hstep, voffB);
            PG8_WAIT_V(6); PG8_BAR; PG8_MMA(1, 1, At, B1); PG8_BAR;
            }
        }
        if constexpr (ALIGN_EPI) { if (wr == 0) PG8_BAR; }
        if constexpr (!Epi::AFTER_DRAIN) { E(acc, cur, wr, wc, fr, fq); S.done(cur); }
        if (!has_next) break;
#pragma unroll
        for (int a = 0; a < 2; ++a)
#pragma unroll
            for (int b = 0; b < 2; ++b)
#pragma unroll
                for (int m = 0; m < 4; ++m)
#pragma unroll
                    for (int n = 0; n < 2; ++n) acc[a][b][m][n] = (f32x4){0.f, 0.f, 0.f, 0.f};
        cur = nxt; cA = nA; cB = nB; ++ui;
        if constexpr (ALIGN_EPI) { if (wr == 1) PG8_BAR; }
    }
    PG8_WAIT_V(0);
    if constexpr (!ALIGN_EPI) { if (wr == 0) PG8_BAR; }
    PG8_BAR;
    if constexpr (Epi::AFTER_DRAIN) { E.fused(acc, cur, wr, wc, fr, fq, lds, wid, lane); S.done(cur); }
#undef PG8_SA
#undef PG8_SB
#undef PG8_STAGE
#undef PG8_LDA
#undef PG8_LDB
#undef PG8_MMA
#undef PG8_WAIT_V
#undef PG8_WAIT_L
#undef PG8_BAR
#undef PG8_SCHED
}
}

#define DEV __device__ __forceinline__
#define LAS __attribute__((address_space(3)))
typedef unsigned short bf16_t;
typedef short bf16x8 __attribute__((ext_vector_type(8)));
typedef short s16x4 __attribute__((ext_vector_type(4)));
typedef float f32x4 __attribute__((ext_vector_type(4)));
typedef float f32x2 __attribute__((ext_vector_type(2)));
typedef float f32x16 __attribute__((ext_vector_type(16)));
typedef unsigned u32x4 __attribute__((ext_vector_type(4)));
typedef unsigned u32x2 __attribute__((ext_vector_type(2)));
typedef __bf16 bf16x2_t __attribute__((ext_vector_type(2)));

constexpr int DM = 1024, NCTX = 8192, NLAT = 16384, MTOT = 24576;
constexpr int INP = 2304, INC = 2144, DFF = 2816, UPC = 5632;
constexpr int NLAYER = 4;
constexpr float EPS = 1e-6f;
constexpr size_t MiB = 1u << 20;
constexpr size_t WS_CTL = 0;
constexpr size_t WS_MOD = 1 * MiB;
constexpr size_t WS_BIN = 2 * MiB;
constexpr size_t WS_BUP = 3 * MiB;
constexpr size_t WS_SSQ = 4 * MiB;
constexpr size_t WS_WIN = 5 * MiB;
constexpr size_t WS_WUKV = WS_WIN + 4718592;
constexpr size_t WS_WOUT = 10 * MiB;
constexpr size_t WS_WUP = 12 * MiB;
constexpr size_t WS_WDN = 23 * MiB;
constexpr size_t WS_TLAT = 29 * MiB;
constexpr size_t WS_TCTX = 45 * MiB;
constexpr size_t WS_CS64 = WS_TCTX + 512 * 1024;
constexpr size_t WS_XS = 46 * MiB;
constexpr size_t WS_R = 94 * MiB;
constexpr size_t WS_P = WS_R;
constexpr size_t WS_OB = WS_P + 108 * MiB;
constexpr size_t WS_KML = WS_OB + 48 * MiB;
constexpr size_t WS_KMC = WS_KML + 23592960;
constexpr size_t WS_VML = WS_KMC + 9 * MiB;
constexpr size_t WS_VMC = WS_VML + 15 * MiB;
constexpr size_t WS_KDL = WS_VMC + 6 * MiB;
constexpr size_t WS_KDC = WS_KDL + 15 * MiB;
constexpr size_t WS_VDL = WS_KDC + 6 * MiB;
constexpr size_t WS_VDC = WS_VDL + 15 * MiB;
constexpr size_t WS_QMR = WS_VDC + 6 * MiB;
constexpr size_t WS_QDR = WS_QMR + 18 * MiB;
constexpr size_t WS_FBL = WS_QDR + 12 * MiB;
constexpr size_t WS_FBC = WS_FBL + 16 * MiB;
constexpr size_t WS_END = WS_FBC + 8 * MiB;
constexpr size_t WS_U = WS_R;
constexpr size_t WS_ACT = WS_R + 176 * MiB;
static_assert(WS_ACT + 88 * MiB <= WS_END, "overlay fits");
constexpr size_t OUT_CKV = 25165824, OUT_KROPE = OUT_CKV + 4194304, OUT_DK = OUT_KROPE + 1048576, OUT_DV = OUT_DK + 12582912;
constexpr int LDS_BYTES = 147456;
constexpr int RING_BYTES = 131072;
constexpr int LDS_MISC = RING_BYTES;

struct Args { const float* in[26]; float* out; unsigned char* ws; int ph_lo, ph_hi; };
enum { I_XP = 0, I_XS, I_C, I_CCKV, I_CKROPE, I_CDK, I_CDV, I_CCTX, I_WADA, I_BADA, I_GMIX, I_GFFN, I_WIN, I_GKV, I_WUK, I_WUV,
       I_LQ1, I_LK1, I_LQ2, I_LK2, I_GSUB, I_WOUT, I_WUP, I_WCONV, I_WDOWN, I_GFINAL };

DEV float bf2f(unsigned b) { return __uint_as_float(b << 16); }
DEV unsigned pk2(float lo, float hi) { f32x2 v = {lo, hi}; bf16x2_t b = __builtin_convertvector(v, bf16x2_t); return __builtin_bit_cast(unsigned, b); }
DEV bf16_t f2bf(float f) { return (bf16_t)(pk2(f, 0.f) & 0xffffu); }
DEV float wave_sum(float v) {
#pragma unroll
    for (int o = 1; o < 64; o <<= 1) v += __shfl_xor(v, o);
    return v;
}
DEV f32x4 mfma16(bf16x8 a, bf16x8 b, f32x4 c) { return __builtin_amdgcn_mfma_f32_16x16x32_bf16(a, b, c, 0, 0, 0); }
DEV f32x16 mfma32(bf16x8 a, bf16x8 b, f32x16 c) { return __builtin_amdgcn_mfma_f32_32x32x16_bf16(a, b, c, 0, 0, 0); }
DEV int row_b9(int row0) { return row0 < NCTX ? 0 : 1 + ((row0 - NCTX) >> 11); }

struct EpiA {
    static constexpr bool PERM = true, AFTER_DRAIN = false;
    bf16_t* O; int ldc; const float* ssq; const float* bias; int ldb; int row_off;
    DEV void operator()(const f32x4 (&acc)[2][2][4][2], const pg8::Unit& u, int wr, int wc, int fr, int fq) const {
        const int lrow0 = u.pm * 256, b9 = row_b9(row_off + lrow0);
        const int col0 = u.pn * 256 + wc * 32 + 8 * fq;
        f32x4 bv[2][2];
#pragma unroll
        for (int bj = 0; bj < 2; ++bj)
#pragma unroll
            for (int n = 0; n < 2; ++n) bv[bj][n] = *(const f32x4*)(bias + (size_t)b9 * ldb + col0 + bj * 128 + 4 * n);
#pragma unroll
        for (int ai = 0; ai < 2; ++ai)
#pragma unroll
            for (int m = 0; m < 4; ++m) {
                const int lr = lrow0 + ai * 128 + wr * 64 + m * 16 + fr;
                const float rs = rsqrtf(ssq[row_off + lr] * (1.0f / 1024.0f) + EPS);
                bf16_t* rowp = O + (size_t)lr * ldc + col0;
#pragma unroll
                for (int bj = 0; bj < 2; ++bj) {
                    const f32x4 v0 = acc[ai][bj][m][0] * rs + bv[bj][0], v1 = acc[ai][bj][m][1] * rs + bv[bj][1];
                    u32x4 w; w.x = pk2(v0[0], v0[1]); w.y = pk2(v0[2], v0[3]); w.z = pk2(v1[0], v1[1]); w.w = pk2(v1[2], v1[3]);
                    *(u32x4*)(rowp + bj * 128) = w;
                }
            }
    }
};
struct EpiRes {
    static constexpr bool PERM = false, AFTER_DRAIN = false;
    const float* xold_c; const float* xold_l;
    float* X;
    const float* gate;
    const float* g; const float* scale;
    bf16_t* XS; float* ssq; int row_off;
    DEV void operator()(const f32x4 (&acc)[2][2][4][2], const pg8::Unit& u, int wr, int wc, int fr, int fq) const {
        const int row0 = row_off + u.pm * 256, b9 = row_b9(row0);
        const int col0 = u.pn * 256 + wc * 32 + 4 * fq;
        f32x4 gv[2][2], gs[2][2];
#pragma unroll
        for (int bj = 0; bj < 2; ++bj)
#pragma unroll
            for (int n = 0; n < 2; ++n) {
                const int c = col0 + bj * 128 + n * 16;
                gv[bj][n] = *(const f32x4*)(gate + (size_t)b9 * 6144 + c);
                if (g) { const f32x4 gg = *(const f32x4*)(g + c), sc = *(const f32x4*)(scale + (size_t)b9 * 6144 + c); gs[bj][n] = gg * (sc + 1.0f); }
                else gs[bj][n] = (f32x4){0.f, 0.f, 0.f, 0.f};
            }
        const float* xo = (row0 < NCTX) ? xold_c : (xold_l - (size_t)NCTX * DM);
#pragma unroll
        for (int ai = 0; ai < 2; ++ai)
#pragma unroll
            for (int m = 0; m < 4; ++m) {
                const int r = row0 + ai * 128 + wr * 64 + m * 16 + fr;
                float ss = 0.f;
#pragma unroll
                for (int bj = 0; bj < 2; ++bj)
#pragma unroll
                    for (int n = 0; n < 2; ++n) {
                        const size_t off = (size_t)r * DM + col0 + bj * 128 + n * 16;
                        const f32x4 xv = *(const f32x4*)(xo + off);
                        const f32x4 xn = xv + gv[bj][n] * acc[ai][bj][m][n];
                        *(f32x4*)(X + off) = xn;
                        ss += (xn[0] * xn[0] + xn[1] * xn[1]) + (xn[2] * xn[2] + xn[3] * xn[3]);
                        if (g) { const f32x4 y = xn * gs[bj][n]; u32x2 w; w.x = pk2(y[0], y[1]); w.y = pk2(y[2], y[3]); *(u32x2*)(XS + off) = w; }
                    }
                ss += __shfl_xor(ss, 16); ss += __shfl_xor(ss, 32);
                if (fq == 0) unsafeAtomicAdd(ssq + r, ss);
            }
    }
};
struct EpiF {
    static constexpr bool PERM = true, AFTER_DRAIN = false;
    bf16_t* OB; int rowbase; int nseq;
    DEV void operator()(const f32x4 (&acc)[2][2][4][2], const pg8::Unit& u, int wr, int wc, int fr, int fq) const {
        const int col0 = 768 + wc * 32 + 8 * fq;
#pragma unroll
        for (int ai = 0; ai < 2; ++ai)
#pragma unroll
            for (int m = 0; m < 4; ++m) {
                const int np = u.pm * 256 + ai * 128 + wr * 64 + m * 16 + fr;
                bf16_t* rowp = OB + (size_t)(rowbase + u.pn * nseq + np) * DM + col0;
#pragma unroll
                for (int bj = 0; bj < 2; ++bj) {
                    const f32x4 v0 = acc[ai][bj][m][0], v1 = acc[ai][bj][m][1];
                    u32x4 w; w.x = pk2(v0[0], v0[1]); w.y = pk2(v0[2], v0[3]); w.z = pk2(v1[0], v1[1]); w.w = pk2(v1[2], v1[3]);
                    *(u32x4*)(rowp + bj * 128) = w;
                }
            }
    }
};

DEV void transpose_item(const float* W, int K, int N, bf16_t* WT, int row_off, LAS float* scr, int item, int lane) {
    const int nblk = N / 32, kb = item / nblk, nb = item % nblk, k0 = 64 * kb, n0 = 32 * nb;
#pragma unroll 8
    for (int i = 0; i < 32; ++i) { const int kk = 2 * i + (lane >> 5); scr[kk * 33 + (lane & 31)] = W[(size_t)(k0 + kk) * N + n0 + (lane & 31)]; }
    asm volatile("s_waitcnt lgkmcnt(0)" ::: "memory");
    const int c = lane & 7;
#pragma unroll
    for (int j = 0; j < 4; ++j) { const int n = (lane >> 3) + 8 * j; const LAS float* s = scr + (8 * c) * 33 + n;
        u32x4 o; o.x = pk2(s[0 * 33], s[1 * 33]); o.y = pk2(s[2 * 33], s[3 * 33]); o.z = pk2(s[4 * 33], s[5 * 33]); o.w = pk2(s[6 * 33], s[7 * 33]);
        *(u32x4*)(WT + (size_t)(row_off + n0 + n) * K + k0 + 8 * c) = o; }
    asm volatile("s_waitcnt lgkmcnt(0)" ::: "memory");
}
DEV void convert_weights(const Args& a, LAS unsigned char* lds, int l, int mask, int gw, int NGW, int wave, int lane) {
    LAS float* scr = (LAS float*)(lds + wave * 16384);
    unsigned char* ws = a.ws;
    const int n_in = (mask & 1) ? 16 * 67 : 0, n_uk = (mask & 2) ? 2 * 12 : 0, n_out = (mask & 4) ? 16 * 32 : 0, n_up = (mask & 8) ? 16 * 176 : 0, n_dn = (mask & 16) ? 44 * 32 : 0;
    const int total = n_in + 2 * n_uk + n_out + n_up + n_dn;
    for (int it = gw; it < total; it += NGW) {
        int r = it;
        if (r < n_in) { transpose_item(a.in[I_WIN] + (size_t)l * DM * INC, DM, INC, (bf16_t*)(ws + WS_WIN), 0, scr, r, lane); continue; } r -= n_in;
        if (r < n_uk) { transpose_item(a.in[I_WUK] + (size_t)l * 128 * 384, 128, 384, (bf16_t*)(ws + WS_WUKV), 0, scr, r, lane); continue; } r -= n_uk;
        if (r < n_uk) { transpose_item(a.in[I_WUV] + (size_t)l * 128 * 384, 128, 384, (bf16_t*)(ws + WS_WUKV), 384, scr, r, lane); continue; } r -= n_uk;
        if (r < n_out) { transpose_item(a.in[I_WOUT] + (size_t)l * DM * DM, DM, DM, (bf16_t*)(ws + WS_WOUT), 0, scr, r, lane); continue; } r -= n_out;
        if (r < n_up) { transpose_item(a.in[I_WUP] + (size_t)l * DM * UPC, DM, UPC, (bf16_t*)(ws + WS_WUP), 0, scr, r, lane); continue; } r -= n_up;
        transpose_item(a.in[I_WDOWN] + (size_t)l * DFF * DM, DFF, DM, (bf16_t*)(ws + WS_WDN), 0, scr, r, lane);
    }
}
DEV void gemv9_item(LAS float* vec, LAS float* red, const float* W, int N, int ldw, const float* bias, float* out, int ldo, int n0, int tid) {
    const int w = tid >> 6, lane = tid & 63; const int n = n0 + lane; const bool valid = n < N;
    float acc0 = 0.f, acc1 = 0.f, acc2 = 0.f, acc3 = 0.f, acc4 = 0.f, acc5 = 0.f, acc6 = 0.f, acc7 = 0.f, acc8 = 0.f;
    const float* wp = W + (size_t)(128 * w) * ldw + (valid ? n : 0);
    const LAS float* vp = vec + 128 * w;
#pragma unroll 4
    for (int k = 0; k < 128; ++k) {
        const float wv = valid ? wp[(size_t)k * ldw] : 0.f;
        acc0 += vp[k] * wv; acc1 += vp[1024 + k] * wv; acc2 += vp[2048 + k] * wv; acc3 += vp[3072 + k] * wv; acc4 += vp[4096 + k] * wv;
        acc5 += vp[5120 + k] * wv; acc6 += vp[6144 + k] * wv; acc7 += vp[7168 + k] * wv; acc8 += vp[8192 + k] * wv;
    }
    LAS float* rp = red + (w * 9) * 64 + lane;
    rp[0] = acc0; rp[64] = acc1; rp[128] = acc2; rp[192] = acc3; rp[256] = acc4; rp[320] = acc5; rp[384] = acc6; rp[448] = acc7; rp[512] = acc8;
    __syncthreads();
    for (int idx = tid; idx < 576; idx += 512) {
        const int v = idx >> 6, ln = idx & 63; float s = 0.f;
#pragma unroll
        for (int ww = 0; ww < 8; ++ww) s += red[(ww * 9 + v) * 64 + ln];
        const int nn = n0 + ln;
        out[(size_t)v * ldo + nn] = s + ((bias && nn < N) ? bias[nn] : 0.f);
    }
    __syncthreads();
}
#define XB_TMO      128
#define XB_XCNT(j)  (256  + 64 * (j))
#define XB_XSUB(j)  (1280 + 64 * (j))
#define XB_XGEN(j)  (2304 + 64 * (j))
#define XB_TOP      3328
#define XB_TOPGEN   3392
#define XCD_BAR_WORDS 3456
#define XB_SPIN_CAP (1u << 18)

__device__ __forceinline__ unsigned xb_ld(unsigned* p)              { return __hip_atomic_load(p, __ATOMIC_RELAXED, __HIP_MEMORY_SCOPE_AGENT); }
__device__ __forceinline__ unsigned xb_add(unsigned* p, unsigned v) { return __hip_atomic_fetch_add(p, v, __ATOMIC_RELAXED, __HIP_MEMORY_SCOPE_AGENT); }
__device__ __forceinline__ unsigned xb_xcc_id() { return (unsigned)__builtin_amdgcn_s_getreg((3 << 11) | 20) & 0xFu; }
#define XB_SPIN(cond, bar) do { unsigned _sp = 0; while (cond) { __builtin_amdgcn_s_sleep(1); \
    if ((++_sp & 255u) == 0u) { if (xb_ld(&(bar)[XB_TMO])) break; if (_sp > XB_SPIN_CAP) { atomicAdd(&(bar)[XB_TMO], 1u); break; } } } } while (0)

struct XcdBarrier {
    unsigned* bar; unsigned x;
    volatile LAS unsigned* st;
};

__device__ __forceinline__ XcdBarrier xcd_barrier_post(unsigned* bar, volatile LAS unsigned* st) {
    XcdBarrier b; b.bar = bar; b.x = xb_xcc_id(); b.st = st;
    if (threadIdx.x == 0) (void)xb_add(&bar[XB_XCNT(b.x)], 1u);
    return b;
}
__device__ __forceinline__ void xcd_barrier_complete(unsigned* bar, unsigned x, unsigned& nloc, unsigned& nx) {
    const unsigned G = gridDim.x * gridDim.y * gridDim.z;
    unsigned sum, cnt, mine, sp = 0u;
    for (;;) {
        sum = 0u; cnt = 0u; mine = 0u;
#pragma unroll
        for (unsigned j = 0; j < 16; ++j) { const unsigned c = xb_ld(&bar[XB_XCNT(j)]); sum += c; cnt += (c > 0u) ? 1u : 0u; mine = (j == x) ? c : mine; }
        if (sum == G) break;
        __builtin_amdgcn_s_sleep(1);
        if ((++sp & 255u) == 0u) { if (xb_ld(&bar[XB_TMO])) break; if (sp > XB_SPIN_CAP) { atomicAdd(&bar[XB_TMO], 1u); break; } }
    }
    nloc = mine > 0u ? mine : 1u; nx = cnt > 0u ? cnt : 1u;
}

__device__ __forceinline__ void xcd_barrier(const XcdBarrier& b) {
    asm volatile("s_waitcnt vmcnt(0)" ::: "memory");
    __syncthreads();
    if (threadIdx.x == 0) {
        unsigned* bar = b.bar;
        __builtin_amdgcn_s_waitcnt(0);
        unsigned nloc = b.st[0], nx = b.st[1];
        if (nloc == 0u) { xcd_barrier_complete(bar, b.x, nloc, nx); b.st[0] = nloc; b.st[1] = nx; }
        const unsigned old = xb_add(&bar[XB_XSUB(b.x)], 1u);
        const unsigned gen = old / nloc;
        if (old + 1u == (gen + 1u) * nloc) {
            __builtin_amdgcn_fence(__ATOMIC_RELEASE, "agent");
            asm volatile("s_waitcnt vmcnt(0)" ::: "memory");
            const unsigned og = xb_add(&bar[XB_TOP], 1u);
            const unsigned tg = og / nx;
            if (og + 1u == (tg + 1u) * nx) xb_add(&bar[XB_TOPGEN], 1u);
            else XB_SPIN(xb_ld(&bar[XB_TOPGEN]) == tg, bar);
            __builtin_amdgcn_fence(__ATOMIC_ACQUIRE, "agent");
            xb_add(&bar[XB_XGEN(b.x)], 1u);
            asm volatile("s_waitcnt vmcnt(0)" ::: "memory");
        } else {
            XB_SPIN(xb_ld(&bar[XB_XGEN(b.x)]) == gen, bar);
            __builtin_amdgcn_fence(__ATOMIC_ACQUIRE, "agent");
            asm volatile("s_waitcnt vmcnt(0)" ::: "memory");
        }
    }
    __syncthreads();
}

constexpr int B_AROW = 272, B_VROW = 772, B_UROW = 528;
constexpr int B_LDS_A = 0, B_LDS_V = 64 * B_AROW, B_LDS_U = B_LDS_V + 64 * B_VROW, B_LDS_TAB = B_LDS_U + 64 * B_UROW;
static_assert(B_LDS_TAB + 4096 <= RING_BYTES, "phase B LDS");

DEV float rope1(float x, int dd, int t, const LAS f32x2* tab) {
    const float xp = __shfl_xor(x, 8);
    const int pos = (dd < 16) ? (t >> 6) : (t & 63);
    const f32x2 cs = tab[pos * 8 + (dd & 7)];
    return (dd & 8) ? (x * cs.x + xp * cs.y) : (x * cs.x - xp * cs.y);
}

DEV void phase_b(const Args& a, LAS unsigned char* lds, int l, int tid) {
    unsigned char* ws = a.ws;
    const int wave = __builtin_amdgcn_readfirstlane(tid >> 6), lane = tid & 63, fr = lane & 15, fq = lane >> 4;
    const bf16_t* P = (const bf16_t*)(ws + WS_P);
    const bf16_t* WUKV = (const bf16_t*)(ws + WS_WUKV);
    const bf16_t* CS64 = (const bf16_t*)(ws + WS_CS64);
    LAS f32x2* tab = (LAS f32x2*)(lds + B_LDS_TAB);
    {
        const int pos = tid >> 3, f = tid & 7;
        const float inv = __builtin_amdgcn_exp2f(-(float)f * (13.287712379549449f / 8.0f));
        const float ang = (float)pos * inv;
        tab[tid] = (f32x2){cosf(ang), sinf(ang)};
    }
    __syncthreads();
    const float* gkv = a.in[I_GKV] + l * 128;
    const float g0 = gkv[2 * lane], g1 = gkv[2 * lane + 1];
    for (int blk = blockIdx.x; blk < 448; blk += gridDim.x) {
        int kind, r0 = 0, bidx, t0;
        if (blk < 128) { kind = 0; r0 = blk * 64; bidx = r0 >> 8; t0 = r0 & 255; }
        else if (blk < 384) { kind = 1; r0 = NCTX + (blk - 128) * 64; bidx = (r0 - NCTX) >> 11; t0 = (r0 - NCTX) & 2047; }
        else { kind = 2; const int cb = blk - 384; bidx = cb >> 3; t0 = 2048 + 64 * (cb & 7); }
        bf16_t* KM; bf16_t* KD; bf16_t* VMt; bf16_t* VDt; int vt_ld;
        if (kind == 0) { KM = (bf16_t*)(ws + WS_KMC) + (size_t)(bidx * 256 + t0) * 576; KD = (bf16_t*)(ws + WS_KDC) + (size_t)(bidx * 256 + t0) * 384;
                         VMt = (bf16_t*)(ws + WS_VMC) + (size_t)bidx * 6 * 64 * 256 + t0; VDt = (bf16_t*)(ws + WS_VDC) + (size_t)bidx * 6 * 64 * 256 + t0; vt_ld = 256; }
        else { KM = (bf16_t*)(ws + WS_KML) + (size_t)(bidx * 2560 + t0) * 576; KD = (bf16_t*)(ws + WS_KDL) + (size_t)(bidx * 2560 + t0) * 384;
               VMt = (bf16_t*)(ws + WS_VML) + (size_t)bidx * 6 * 64 * 2560 + t0; VDt = (bf16_t*)(ws + WS_VDL) + (size_t)bidx * 6 * 64 * 2560 + t0; vt_ld = 2560; }
        for (int i = 0; i < 8; ++i) {
            const int rr = wave * 8 + i;
            if (kind == 2) {
                const int j = (t0 - 2048) + rr;
                const size_t crow = ((size_t)(bidx * 4 + l)) * 512 + j;
                const f32x2 cv = *(const f32x2*)(a.in[I_CCKV] + crow * 128 + 2 * lane);
                *(LAS unsigned*)(lds + B_LDS_A + rr * B_AROW + lane * 4) = pk2(cv.x, cv.y);
                const float kr = a.in[I_CKROPE][crow * 32 + (lane & 31)];
                const bf16_t krb = f2bf(kr);
                { const int hb = (lane >> 5) * 3;
#pragma unroll
                  for (int h = 0; h < 3; ++h) KM[(size_t)rr * 576 + (hb + h) * 96 + 64 + (lane & 31)] = krb; }
#pragma unroll
                for (int q = 0; q < 6; ++q) {
                    KD[(size_t)rr * 384 + 64 * q + lane] = f2bf(a.in[I_CDK][crow * 384 + 64 * q + lane]);
                    *(LAS bf16_t*)(lds + B_LDS_V + rr * B_VROW + (64 * q + lane) * 2) = f2bf(a.in[I_CDV][crow * 384 + 64 * q + lane]);
                }
            } else {
                const int r = r0 + rr, t = t0 + rr;
                const bf16_t* prow = P + (size_t)r * INP;
                const unsigned cv = *(const unsigned*)(prow + 576 + 2 * lane);
                float ca = bf2f(cv & 0xffffu), cb = bf2f(cv >> 16);
                const float ss = wave_sum(ca * ca + cb * cb);
                const float rs = rsqrtf(ss * (1.0f / 128.0f) + EPS);
                ca *= rs * g0; cb *= rs * g1;
                *(LAS unsigned*)(lds + B_LDS_A + rr * B_AROW + lane * 4) = pk2(ca, cb);
                const size_t orow = ((size_t)(bidx * 4 + l)) * 256 + t;
                if (kind == 0) *(f32x2*)(a.out + OUT_CKV + orow * 128 + 2 * lane) = (f32x2){ca, cb};
                {
                    float x = bf2f(prow[704 + (lane & 31)]);
                    if (kind == 1) x = rope1(x, lane & 31, t, tab);
                    else if (lane < 32) a.out[OUT_KROPE + orow * 32 + lane] = x;
                    const bf16_t xb = f2bf(x); const int hb = (lane >> 5) * 3;
#pragma unroll
                    for (int h = 0; h < 3; ++h) KM[(size_t)rr * 576 + (hb + h) * 96 + 64 + (lane & 31)] = xb;
                }
#pragma unroll
                for (int q = 0; q < 6; ++q) {
                    float x = bf2f(prow[1120 + 64 * q + lane]);
                    if (kind == 1) x = rope1(x, lane & 31, t, tab);
                    else a.out[OUT_DK + orow * 384 + 64 * q + lane] = x;
                    KD[(size_t)rr * 384 + 64 * q + lane] = f2bf(x);
                    const bf16_t vraw = prow[1504 + 64 * q + lane];
                    *(LAS bf16_t*)(lds + B_LDS_V + rr * B_VROW + (64 * q + lane) * 2) = vraw;
                    if (kind == 0) a.out[OUT_DV + orow * 384 + 64 * q + lane] = bf2f(vraw);
                }
#pragma unroll
                for (int q = 0; q < 4; ++q) *(LAS bf16_t*)(lds + B_LDS_U + rr * B_UROW + (64 * q + lane) * 2) = prow[1888 + 64 * q + lane];
                if (kind == 1) {
                    const int lr = r - NCTX;
                    bf16_t* qm = (bf16_t*)(ws + WS_QMR) + (size_t)lr * 576; bf16_t* qd = (bf16_t*)(ws + WS_QDR) + (size_t)lr * 384;
#pragma unroll
                    for (int q = 0; q < 6; ++q) qm[96 * q + lane] = prow[96 * q + lane];
#pragma unroll
                    for (int q = 0; q < 3; ++q) { const int head = 2 * q + (lane >> 5), dd = lane & 31;
                        const float x = rope1(bf2f(prow[96 * head + 64 + dd]), dd, t, tab); qm[96 * head + 64 + dd] = f2bf(x); }
#pragma unroll
                    for (int q = 0; q < 6; ++q) { const float x = rope1(bf2f(prow[736 + 64 * q + lane]), lane & 31, t, tab); qd[64 * q + lane] = f2bf(x); }
                }
            }
        }
        __syncthreads();
#pragma unroll 1
        for (int nt = 0; nt < 6; ++nt) {
            const int c0 = 96 * wave + 16 * nt;
            bf16x8 bw[4];
#pragma unroll
            for (int kk = 0; kk < 4; ++kk) bw[kk] = *(const bf16x8*)(WUKV + (size_t)(c0 + fr) * 128 + 32 * kk + 8 * fq);
#pragma unroll
            for (int mt = 0; mt < 4; ++mt) {
                f32x4 acc = {0.f, 0.f, 0.f, 0.f};
#pragma unroll
                for (int kk = 0; kk < 4; ++kk) {
                    const bf16x8 af = *(const LAS bf16x8*)(lds + B_LDS_A + (16 * mt + fr) * B_AROW + (32 * kk + 8 * fq) * 2);
                    acc = (wave < 4) ? mfma16(bw[kk], af, acc) : mfma16(af, bw[kk], acc);
                }
                u32x2 w; w.x = pk2(acc[0], acc[1]); w.y = pk2(acc[2], acc[3]);
                if (wave < 4) { const int h = c0 >> 6, d = (c0 & 63) + 4 * fq; *(u32x2*)(KM + (size_t)(16 * mt + fr) * 576 + h * 96 + d) = w; }
                else { const int col = c0 - 384 + fr, h = col >> 6, dv = col & 63; *(u32x2*)(VMt + (size_t)(h * 64 + dv) * vt_ld + 16 * mt + 4 * fq) = w; }
            }
        }
        if (kind != 2) {
            const int g = wave >> 1, nseq = (kind == 0) ? 256 : 2048, ldk = 2 * nseq;
            bf16_t* FB = (kind == 0) ? (bf16_t*)(ws + WS_FBC) : (bf16_t*)(ws + WS_FBL);
#pragma unroll 1
            for (int nt = 0; nt < 4; ++nt) {
                const int cc0 = 16 * ((wave & 1) * 4 + nt);
                bf16x8 bw[2];
#pragma unroll
                for (int kk = 0; kk < 2; ++kk) bw[kk] = *(const bf16x8*)(CS64 + (size_t)(cc0 + fr) * 64 + 32 * kk + 8 * fq);
                const int cc = cc0 + fr, cp = cc & 63, koff = (cc >= 64) ? nseq : 0;
                bf16_t* dst = FB + (size_t)(bidx * 256 + g * 64 + cp) * ldk + koff + (t0 & (nseq - 1));
#pragma unroll
                for (int mt = 0; mt < 4; ++mt) {
                    f32x4 acc = {0.f, 0.f, 0.f, 0.f};
#pragma unroll
                    for (int kk = 0; kk < 2; ++kk) {
                        const bf16x8 af = *(const LAS bf16x8*)(lds + B_LDS_U + (16 * mt + fr) * B_UROW + (64 * g + 32 * kk + 8 * fq) * 2);
                        acc = mfma16(af, bw[kk], acc);
                    }
                    u32x2 w; w.x = pk2(acc[0], acc[1]); w.y = pk2(acc[2], acc[3]);
                    *(u32x2*)(dst + 16 * mt + 4 * fq) = w;
                }
            }
        }
#pragma unroll 4
        for (int q = 0; q < 48; ++q) {
            const int cr = 48 * wave + q;
            const bf16_t v = *(const LAS bf16_t*)(lds + B_LDS_V + lane * B_VROW + cr * 2);
            VDt[(size_t)cr * vt_ld + lane] = v;
        }
        __syncthreads();
    }
}

constexpr int AT_VROW = 136;
template <bool DIFF> struct AttnCfg {
    static constexpr int ND = DIFF ? 4 : 6;
    static constexpr int NM = DIFF ? 2 : 1;
    static constexpr int NDM = DIFF ? 2 : 6;
    static constexpr int KROW = DIFF ? 144 : 208;
    static constexpr int KT = 64 * KROW;
    static constexpr int CPR = 2 * ND;
    static constexpr int NKC = 64 * CPR;
};
constexpr int AT_LDS_K = 0, AT_LDS_V = 2 * 64 * 208, AT_LDS_SCR = AT_LDS_V + 2 * 64 * AT_VROW;
static_assert(AT_LDS_SCR + 2048 <= RING_BYTES, "attention LDS");

template <bool DIFF>
DEV void attn_unit(LAS unsigned char* lds, const bf16_t* Qa, int qa_ld, const bf16_t* Qb, int qb_ld, const bf16_t* Kp, int k_ld,
                   const bf16_t* Vt, int vt_ld, int nt_main, int nt_total, bf16_t* Oout, float cscale, float lam, const float* gsub, float subscale, int tid) {
    typedef AttnCfg<DIFF> C;
    const int wave = __builtin_amdgcn_readfirstlane(tid >> 6), lane = tid & 63, l31 = lane & 31, hi = lane >> 5;
    LAS float* scr = (LAS float*)(lds + AT_LDS_SCR) + wave * 64;
    const int kkey0 = tid / C::CPR, kpart0 = tid % C::CPR;
    const int kc1 = tid + 512; const bool has1 = kc1 < C::NKC; const int kkey1 = kc1 / C::CPR, kpart1 = kc1 % C::CPR;
    const int vdv = tid >> 3, vpart = tid & 7;
    const bf16_t* kg0 = Kp + (size_t)kkey0 * k_ld + kpart0 * 8;
    const bf16_t* kg1 = Kp + (size_t)kkey1 * k_ld + kpart1 * 8;
    const bf16_t* vg = Vt + (size_t)vdv * vt_ld + vpart * 8;
    const int kl0 = kkey0 * C::KROW + kpart0 * 16, kl1 = kkey1 * C::KROW + kpart1 * 16, vl = vdv * AT_VROW + vpart * 16;
    u32x4 kr0, kr1 = {0, 0, 0, 0}, vr;
    bf16x8 qf[C::ND];
    { const bf16_t* qp = Qa + (size_t)(32 * wave + l31) * qa_ld + 8 * hi;
#pragma unroll
      for (int d = 0; d < C::ND; ++d) qf[d] = *(const bf16x8*)(qp + 16 * d); }
    kr0 = *(const u32x4*)kg0; if (has1) kr1 = *(const u32x4*)kg1; vr = *(const u32x4*)vg;
    *(LAS u32x4*)(lds + AT_LDS_K + kl0) = kr0; if (has1) *(LAS u32x4*)(lds + AT_LDS_K + kl1) = kr1;
    *(LAS u32x2*)(lds + AT_LDS_V + vl) = (u32x2){vr.x, vr.y}; *(LAS u32x2*)(lds + AT_LDS_V + vl + 8) = (u32x2){vr.z, vr.w};
    __syncthreads();
    f32x16 O[C::NM][2];
    float mref[C::NM], lsum[C::NM];
#pragma unroll
    for (int mp = 0; mp < C::NM; ++mp) { mref[mp] = 0.f; lsum[mp] = 0.f;
#pragma unroll
        for (int r = 0; r < 16; ++r) { O[mp][0][r] = 0.f; O[mp][1][r] = 0.f; } }
#pragma unroll 1
    for (int t = 0; t < nt_total; ++t) {
        const int cur = t & 1;
        const bool more = (t + 1) < nt_total;
        if (more) {
            const size_t ko = (size_t)(t + 1) * 64 * k_ld;
            kr0 = *(const u32x4*)(kg0 + ko); if (has1) kr1 = *(const u32x4*)(kg1 + ko);
            vr = *(const u32x4*)(vg + (t + 1) * 64);
        }
        if (t == nt_main) {
            const bf16_t* qp = Qb + (size_t)(32 * wave + l31) * qb_ld + 8 * hi;
#pragma unroll
            for (int d = 0; d < C::ND; ++d) qf[d] = *(const bf16x8*)(qp + 16 * d);
        }
        const LAS unsigned char* Kb = lds + AT_LDS_K + cur * C::KT;
        const LAS unsigned char* Vb = lds + AT_LDS_V + cur * (64 * AT_VROW);
#pragma unroll
        for (int mp = 0; mp < C::NM; ++mp) {
            f32x16 s0, s1;
#pragma unroll
            for (int r = 0; r < 16; ++r) { s0[r] = 0.f; s1[r] = 0.f; }
#pragma unroll
            for (int dd = 0; dd < C::NDM; ++dd) {
                const int d0 = mp * C::NDM + dd;
                const bf16x8 a0 = *(const LAS bf16x8*)(Kb + l31 * C::KROW + d0 * 32 + hi * 16);
                const bf16x8 a1 = *(const LAS bf16x8*)(Kb + (32 + l31) * C::KROW + d0 * 32 + hi * 16);
                s0 = mfma32(a0, qf[d0], s0); s1 = mfma32(a1, qf[d0], s1);
            }
            float mx = fmaxf(s0[0], s1[0]);
#pragma unroll
            for (int r = 1; r < 16; ++r) mx = fmaxf(mx, fmaxf(s0[r], s1[r]));
            mx = fmaxf(mx, __shfl_xor(mx, 32));
            const float rm = mx * cscale;
            if (t == 0) mref[mp] = rm;
            else if (__any(rm > mref[mp] + 8.0f)) {
                const float mnew = fmaxf(mref[mp], rm);
                const float alpha = __builtin_amdgcn_exp2f(mref[mp] - mnew);
                lsum[mp] *= alpha; mref[mp] = mnew;
                if (hi == 0) scr[l31] = alpha;
                asm volatile("s_waitcnt lgkmcnt(0)" ::: "memory");
#pragma unroll
                for (int g4 = 0; g4 < 4; ++g4) { const f32x4 a4 = *(const LAS f32x4*)(scr + 8 * g4 + 4 * hi);
#pragma unroll
                    for (int j = 0; j < 4; ++j) { O[mp][0][4 * g4 + j] *= a4[j]; O[mp][1][4 * g4 + j] *= a4[j]; } }
                asm volatile("s_waitcnt lgkmcnt(0)" ::: "memory");
            }
            const float nm = -mref[mp];
            float ls = 0.f;
#pragma unroll
            for (int r = 0; r < 16; ++r) { s0[r] = __builtin_amdgcn_exp2f(fmaf(s0[r], cscale, nm)); s1[r] = __builtin_amdgcn_exp2f(fmaf(s1[r], cscale, nm)); ls += s0[r] + s1[r]; }
            lsum[mp] += ls;
            bf16x8 pa[4];
#pragma unroll
            for (int j = 0; j < 4; ++j) {
                u32x4 w;
                if (j < 2) { w.x = pk2(s0[8 * j], s0[8 * j + 1]); w.y = pk2(s0[8 * j + 2], s0[8 * j + 3]); w.z = pk2(s0[8 * j + 4], s0[8 * j + 5]); w.w = pk2(s0[8 * j + 6], s0[8 * j + 7]); }
                else { const int jj = j - 2; w.x = pk2(s1[8 * jj], s1[8 * jj + 1]); w.y = pk2(s1[8 * jj + 2], s1[8 * jj + 3]); w.z = pk2(s1[8 * jj + 4], s1[8 * jj + 5]); w.w = pk2(s1[8 * jj + 6], s1[8 * jj + 7]); }
                pa[j] = __builtin_bit_cast(bf16x8, w);
            }
#pragma unroll
            for (int j = 0; j < 4; ++j)
#pragma unroll
                for (int db = 0; db < 2; ++db) {
                    const LAS unsigned char* vp = Vb + (32 * db + l31) * AT_VROW + (32 * (j >> 1) + 16 * (j & 1) + 4 * hi) * 2;
                    const s16x4 lo = *(const LAS s16x4*)vp, hh = *(const LAS s16x4*)(vp + 16);
                    const bf16x8 vb = {lo[0], lo[1], lo[2], lo[3], hh[0], hh[1], hh[2], hh[3]};
                    O[mp][db] = mfma32(pa[j], vb, O[mp][db]);
                }
        }
        if (more) {
            const int nb = cur ^ 1;
            *(LAS u32x4*)(lds + AT_LDS_K + nb * C::KT + kl0) = kr0; if (has1) *(LAS u32x4*)(lds + AT_LDS_K + nb * C::KT + kl1) = kr1;
            *(LAS u32x2*)(lds + AT_LDS_V + nb * (64 * AT_VROW) + vl) = (u32x2){vr.x, vr.y}; *(LAS u32x2*)(lds + AT_LDS_V + nb * (64 * AT_VROW) + vl + 8) = (u32x2){vr.z, vr.w};
        }
        __syncthreads();
    }
    float inv[C::NM][16];
#pragma unroll
    for (int mp = 0; mp < C::NM; ++mp) {
        float lt = lsum[mp]; lt += __shfl_xor(lt, 32);
        if (hi == 0) scr[l31] = 1.0f / lt;
        asm volatile("s_waitcnt lgkmcnt(0)" ::: "memory");
#pragma unroll
        for (int g4 = 0; g4 < 4; ++g4) { const f32x4 a4 = *(const LAS f32x4*)(scr + 8 * g4 + 4 * hi);
#pragma unroll
            for (int j = 0; j < 4; ++j) inv[mp][4 * g4 + j] = a4[j]; }
        asm volatile("s_waitcnt lgkmcnt(0)" ::: "memory");
    }
    bf16_t* ow = Oout + (size_t)(32 * wave) * DM;
    if constexpr (!DIFF) {
#pragma unroll
        for (int r = 0; r < 16; ++r) { const int q = (r & 3) + 8 * (r >> 2) + 4 * hi;
#pragma unroll
            for (int db = 0; db < 2; ++db) ow[(size_t)q * DM + 32 * db + l31] = f2bf(O[0][db][r] * inv[0][r]); }
    } else {
        const float gs0 = gsub[l31] * subscale, gs1 = gsub[32 + l31] * subscale;
#pragma unroll
        for (int r = 0; r < 16; ++r) { const int q = (r & 3) + 8 * (r >> 2) + 4 * hi;
            const float o0 = O[0][0][r] * inv[0][r] - lam * (O[1][0][r] * inv[1][r]);
            const float o1 = O[0][1][r] * inv[0][r] - lam * (O[1][1][r] * inv[1][r]);
            float ss = o0 * o0 + o1 * o1;
#pragma unroll
            for (int o = 1; o < 32; o <<= 1) ss += __shfl_xor(ss, o);
            const float rs = rsqrtf(ss * (1.0f / 64.0f) + EPS);
            ow[(size_t)q * DM + l31] = f2bf(o0 * rs * gs0); ow[(size_t)q * DM + 32 + l31] = f2bf(o1 * rs * gs1); }
    }
}

DEV void load8(const bf16_t* p, float (&v)[8]) {
    const u32x4 w = *(const u32x4*)p;
    v[0] = bf2f(w.x & 0xffffu); v[1] = bf2f(w.x >> 16); v[2] = bf2f(w.y & 0xffffu); v[3] = bf2f(w.y >> 16);
    v[4] = bf2f(w.z & 0xffffu); v[5] = bf2f(w.z >> 16); v[6] = bf2f(w.w & 0xffffu); v[7] = bf2f(w.w >> 16);
}
DEV void phase_f(const Args& a, int l, int nrows, int seqlen, int tid) {
    const bf16_t* U = (const bf16_t*)(a.ws + WS_U);
    bf16_t* ACT = (bf16_t*)(a.ws + WS_ACT);
    const float* wc = a.in[I_WCONV] + (size_t)l * 3 * UPC;
    const int nitems = (nrows / 8) * 352;
    for (int it = blockIdx.x * 512 + tid; it < nitems; it += gridDim.x * 512) {
        const int rb = it / 352, j8 = it - rb * 352, r0 = rb * 8, c0 = j8 * 8;
        float wg[3][8], wv[3][8];
#pragma unroll
        for (int k = 0; k < 3; ++k) {
            const f32x4 g0 = *(const f32x4*)(wc + k * UPC + c0), g1 = *(const f32x4*)(wc + k * UPC + c0 + 4);
            const f32x4 v0 = *(const f32x4*)(wc + k * UPC + DFF + c0), v1 = *(const f32x4*)(wc + k * UPC + DFF + c0 + 4);
#pragma unroll
            for (int j = 0; j < 4; ++j) { wg[k][j] = g0[j]; wg[k][4 + j] = g1[j]; wv[k][j] = v0[j]; wv[k][4 + j] = v1[j]; }
        }
        float pg[8], pv[8], cg_[8], cv[8], ng[8], nv[8];
        const bool hasp = (r0 % seqlen) != 0, hasn = ((r0 + 8) % seqlen) != 0;
        if (hasp) { load8(U + (size_t)(r0 - 1) * UPC + c0, pg); load8(U + (size_t)(r0 - 1) * UPC + DFF + c0, pv); }
        else {
#pragma unroll
            for (int j = 0; j < 8; ++j) { pg[j] = 0.f; pv[j] = 0.f; } }
        load8(U + (size_t)r0 * UPC + c0, cg_); load8(U + (size_t)r0 * UPC + DFF + c0, cv);
#pragma unroll
        for (int i = 0; i < 8; ++i) {
            const int r = r0 + i;
            if (i < 7 || hasn) { load8(U + (size_t)(r + 1) * UPC + c0, ng); load8(U + (size_t)(r + 1) * UPC + DFF + c0, nv); }
            else {
#pragma unroll
                for (int j = 0; j < 8; ++j) { ng[j] = 0.f; nv[j] = 0.f; } }
            float o[8];
#pragma unroll
            for (int j = 0; j < 8; ++j) {
                const float gt = wg[0][j] * pg[j] + wg[1][j] * cg_[j] + wg[2][j] * ng[j];
                const float vl = wv[0][j] * pv[j] + wv[1][j] * cv[j] + wv[2][j] * nv[j];
                const float sg = gt * __builtin_amdgcn_rcpf(1.0f + __expf(-gt));
                o[j] = sg * vl;
            }
            u32x4 w; w.x = pk2(o[0], o[1]); w.y = pk2(o[2], o[3]); w.z = pk2(o[4], o[5]); w.w = pk2(o[6], o[7]);
            *(u32x4*)(ACT + (size_t)r * DFF + c0) = w;
#pragma unroll
            for (int j = 0; j < 8; ++j) { pg[j] = cg_[j]; pv[j] = cv[j]; cg_[j] = ng[j]; cv[j] = nv[j]; }
        }
    }
}

struct ShiftOrder {
    pg8::StaticOrder S;
    __device__ void init(int M, int N, int G, int c) { S.init(M, N, G, c); }
    __device__ bool next(int i, pg8::Unit& u) const { return S.next(i, u); }
    DEV void a_ready(const pg8::Unit&) const {}
    DEV void done(const pg8::Unit&) const {}
};

#ifndef NREP_SYNC
#define NREP_SYNC 1
#endif
#ifndef NREP_P
#define NREP_P 1
#endif
#ifndef NREP_A
#define NREP_A 1
#endif
#ifndef NREP_B
#define NREP_B 1
#endif
#ifndef NREP_C
#define NREP_C 1
#endif
#ifndef NREP_E
#define NREP_E 1
#endif
#ifndef NREP_F
#define NREP_F 1
#endif
__global__ void __launch_bounds__(512, 2) mega_fwd(Args a) {
    extern __shared__ __attribute__((aligned(16))) unsigned char lds_raw[];
    LAS unsigned char* lds = (LAS unsigned char*)lds_raw;
    cg::grid_group grid = cg::this_grid();
    const int G = gridDim.x, bid = blockIdx.x;
#define PH_LOCALS \
    unsigned char* ws = a.ws; asm volatile("" : "+s"(ws)); \
    int tid = threadIdx.x; asm volatile("" : "+v"(tid)); \
    const int lane = tid & 63, wave = __builtin_amdgcn_readfirstlane(tid >> 6); \
    const int gw = bid * 8 + wave, NGW = G * 8, gt = bid * 512 + tid, NGT = G * 512; \
    float* MOD = (float*)(ws + WS_MOD); float* BIN = (float*)(ws + WS_BIN); float* BUP = (float*)(ws + WS_BUP); float* SSQ = (float*)(ws + WS_SSQ); \
    bf16_t* XS = (bf16_t*)(ws + WS_XS); bf16_t* Pb = (bf16_t*)(ws + WS_P); bf16_t* OB = (bf16_t*)(ws + WS_OB); \
    unsigned* CTL = (unsigned*)(ws + WS_CTL); \
    (void)lane; (void)wave; (void)gw; (void)NGW; (void)gt; (void)NGT; (void)MOD; (void)BIN; (void)BUP; (void)SSQ; (void)XS; (void)Pb; (void)OB; (void)CTL;
    const bool one = (a.ph_hi - a.ph_lo) > 1;
    if (threadIdx.x < 16) ((LAS unsigned*)(lds + LDS_MISC))[threadIdx.x] = 0u;
    __syncthreads();
    XcdBarrier xbar; xbar.bar = (unsigned*)(a.ws + WS_CTL) + 16384; xbar.x = 0; xbar.st = nullptr;
    if (one) xbar = xcd_barrier_post((unsigned*)(a.ws + WS_CTL) + 16384, (volatile LAS unsigned*)(lds + LDS_MISC + 32));
    int ph = 0;
#define PH_BEGIN if (ph >= a.ph_lo && ph < a.ph_hi) { PH_LOCALS
#define PH_END   if (one && ph + 1 < a.ph_hi) { if (ph == 0) grid.sync(); else { for (int rs_ = 0; rs_ < NREP_SYNC; ++rs_) xcd_barrier(xbar); } } } ++ph;

    PH_BEGIN
#ifndef SKIP_P0
    for (int rep = 0; rep < NREP_P; ++rep) {
        LAS float* vec = (LAS float*)lds; LAS float* red = (LAS float*)(lds + 36864);
        for (int i = tid; i < 9216; i += 512) { const int v = i >> 10, k = i & 1023; const float x = (v == 0) ? a.in[I_CCTX][k] : a.in[I_C][(v - 1) * 1024 + k]; vec[i] = x / (1.0f + __expf(-x)); }
        __syncthreads();
        for (int it = bid; it < 4 * 96; it += G) { const int l = it / 96, nb = it % 96;
            gemv9_item(vec, red, a.in[I_WADA] + (size_t)l * DM * 6144, 6144, 6144, a.in[I_BADA] + l * 6144, MOD + (size_t)l * 9 * 6144, 6144, nb * 64, tid); }
        __syncthreads();
        convert_weights(a, lds, 0, 31, gw, NGW, wave, lane);
        for (int i = gt; i < 9 * MTOT; i += NGT) SSQ[i] = 0.f;
        for (int i = gt; i < 1024; i += NGT) CTL[i] = 0u;
        { unsigned* padp = (unsigned*)(ws + WS_WIN + (size_t)INC * DM * 2); for (int i = gt; i < (INP - INC) * DM / 2; i += NGT) padp[i] = 0u; }
        { bf16_t* T = (bf16_t*)(ws + WS_TLAT);
          for (int i = gt; i < 2048 * 4096; i += NGT) { const int np = i >> 12, k = i & 4095, n = k & 2047; const int m = (np * n) & 2047; const float x = (float)m * (1.0f / 1024.0f);
              const float v = (k < 2048) ? cospif(x) : -sinpif(x); T[i] = f2bf(v * 0.02209708691207961f); } }
        { bf16_t* T = (bf16_t*)(ws + WS_TCTX);
          for (int i = gt; i < 256 * 512; i += NGT) { const int np = i >> 9, k = i & 511, n = k & 255; const int m = (np * n) & 255; const float x = (float)m * (1.0f / 128.0f);
              const float v = (k < 256) ? cospif(x) : -sinpif(x); T[i] = f2bf(v * 0.0625f); } }
        { bf16_t* T = (bf16_t*)(ws + WS_CS64);
          for (int i = gt; i < 128 * 64; i += NGT) { const int cc = i >> 6, c = i & 63, cp = cc & 63; const int m = (cp * c) & 63; const float x = (float)m * (1.0f / 32.0f);
              const float v = (cc < 64) ? cospif(x) : sinpif(x); T[i] = f2bf(v * 0.125f); } }
    }
#endif
    PH_END
    PH_BEGIN
#ifndef SKIP_P1
    for (int rep = 0; rep < NREP_P; ++rep) {
        LAS float* vec = (LAS float*)lds; LAS float* red = (LAS float*)(lds + 36864);
        for (int it = bid; it < 4 * 124; it += G) { const int l = it / 124, j = it % 124; const bool up = j >= 36; const int chunk = up ? 3 : 0;
            for (int i = tid; i < 9216; i += 512) { const int v = i >> 10, k = i & 1023; vec[i] = MOD[((size_t)l * 9 + v) * 6144 + chunk * 1024 + k]; }
            __syncthreads();
            if (!up) gemv9_item(vec, red, a.in[I_WIN] + (size_t)l * DM * INC, INC, INC, nullptr, BIN + (size_t)l * 9 * INP, INP, j * 64, tid);
            else gemv9_item(vec, red, a.in[I_WUP] + (size_t)l * DM * UPC, UPC, UPC, nullptr, BUP + (size_t)l * 9 * UPC, UPC, (j - 36) * 64, tid);
        }
        for (int r = gw; r < MTOT; r += NGW) {
            const float* xr = (r < NCTX) ? a.in[I_XP] + (size_t)r * DM : a.in[I_XS] + (size_t)(r - NCTX) * DM;
            const int b9 = row_b9(r);
            const float* sc = MOD + (size_t)b9 * 6144 + 1024; const float* gm = a.in[I_GMIX];
            float ss = 0.f;
#pragma unroll
            for (int j = 0; j < 4; ++j) { const int c = 4 * lane + 256 * j; const f32x4 x = *(const f32x4*)(xr + c); const f32x4 g = *(const f32x4*)(gm + c), s = *(const f32x4*)(sc + c);
                ss += (x[0] * x[0] + x[1] * x[1]) + (x[2] * x[2] + x[3] * x[3]); const f32x4 y = x * g * (s + 1.0f);
                u32x2 w; w.x = pk2(y[0], y[1]); w.y = pk2(y[2], y[3]); *(u32x2*)(XS + (size_t)r * DM + c) = w; }
            ss = wave_sum(ss);
            if (lane == 0) SSQ[r] = ss;
        }
    }
#endif
    PH_END

#pragma unroll 1
    for (int l = 0; l < NLAYER; ++l) {
        PH_BEGIN
#ifndef SKIP_A
        {
            pg8::Gemm g{XS, (const bf16_t*)(ws + WS_WIN), MTOT, INP, DM}; pg8::StaticOrder S; S.init(MTOT, INP, G, bid);
            EpiA E{Pb, INP, SSQ + (size_t)(2 * l) * MTOT, BIN + (size_t)l * 9 * INP, INP, 0};
            for (int rep = 0; rep < NREP_A; ++rep) pg8::gemm_phase<EpiA, pg8::StaticOrder, true, true>(lds, g, S, E);
        }
#endif
        PH_END
        PH_BEGIN
#ifndef SKIP_B
        {
            if (l > 0) convert_weights(a, lds, l, 16, gw, NGW, wave, lane);
            __syncthreads();
            for (int rep = 0; rep < NREP_B; ++rep) phase_b(a, lds, l, tid);
        }
#endif
        PH_END
        PH_BEGIN
#ifndef SKIP_C
#pragma unroll 1
        for (int rep = 0; rep < NREP_C; ++rep) {
#pragma unroll 1
            for (int f = 0; f < 2; ++f) {
                pg8::Gemm g = (f == 0) ? pg8::Gemm{(const bf16_t*)(ws + WS_TLAT), (const bf16_t*)(ws + WS_FBL), 2048, 2048, 4096}
                                       : pg8::Gemm{(const bf16_t*)(ws + WS_TCTX), (const bf16_t*)(ws + WS_FBC), 256, 8192, 512};
                pg8::StaticOrder S; S.init(g.M, g.N, G, (f == 0) ? bid : (bid + G - 64) % G);
                EpiF E{OB, (f == 0) ? NCTX : 0, (f == 0) ? 2048 : 256};
                pg8::gemm_phase<EpiF, pg8::StaticOrder, true, true>(lds, g, S, E);
            }
            int tid2 = threadIdx.x; asm volatile("" : "+v"(tid2));
            unsigned char* ws2 = a.ws; asm volatile("" : "+s"(ws2));
            float lam, lam_init;
            { const float p1 = ((tid2 & 63) < 32) ? a.in[I_LQ1][l * 32 + (tid2 & 63)] * a.in[I_LK1][l * 32 + (tid2 & 63)] : 0.f, p2 = ((tid2 & 63) < 32) ? a.in[I_LQ2][l * 32 + (tid2 & 63)] * a.in[I_LK2][l * 32 + (tid2 & 63)] : 0.f;
              lam_init = 0.8f - 0.6f * expf(-0.3f * (float)l); lam = expf(wave_sum(p1)) - expf(wave_sum(p2)) + lam_init; }
            const float cm = 0.10206207261596575f * 1.4426950408889634f, cd = 0.17677669529663687f * 1.4426950408889634f;
            LAS int* qslot = (LAS int*)(lds + LDS_MISC);
            unsigned* qctr = (unsigned*)(ws2 + WS_CTL) + 64 * (1 + l + 8 * rep);
            for (;;) {
                __syncthreads();
                if (tid2 == 0) *qslot = (int)atomicAdd(qctr, 1u);
                __syncthreads();
                const int idx = *qslot;
                if (idx >= 1152) break;
                const bool lat = idx < 768;
                const bool diff = lat ? (idx < 384) : (idx < 960);
                int q0, vt_ld, nt_main, nt_total, qa_ld; size_t qa_off, k_off, vt_off; size_t qa_base, k_base, vt_base;
                int h;
                if (lat) { const int j = diff ? idx : idx - 384; const int bh = j >> 3, qb = j & 7, b = bh / 6; h = bh % 6;
                    const int lr0 = b * 2048 + qb * 256; q0 = NCTX + lr0; vt_ld = 2560; nt_main = 32; nt_total = 40;
                    qa_base = diff ? WS_QDR : WS_QMR; qa_ld = diff ? 384 : 576; qa_off = (size_t)lr0 * qa_ld + (diff ? 64 : 96) * h;
                    k_base = diff ? WS_KDL : WS_KML; k_off = (size_t)b * 2560 * (diff ? 384 : 576) + (diff ? 64 : 96) * h;
                    vt_base = diff ? WS_VDL : WS_VML; vt_off = (size_t)(b * 6 + h) * 64 * 2560; }
                else { const int j = diff ? idx - 768 : idx - 960; const int i = j / 6; h = j % 6; q0 = i * 256; vt_ld = 256; nt_main = 4; nt_total = 4;
                    qa_base = WS_P; qa_ld = INP; qa_off = (size_t)q0 * INP + (diff ? 736 + 64 * h : 96 * h);
                    k_base = diff ? WS_KDC : WS_KMC; k_off = (size_t)q0 * (diff ? 384 : 576) + (diff ? 64 : 96) * h;
                    vt_base = diff ? WS_VDC : WS_VMC; vt_off = (size_t)(i * 6 + h) * 64 * 256; }
                const bf16_t* Qa = (const bf16_t*)(ws2 + qa_base) + qa_off;
                const bf16_t* Qb = (const bf16_t*)(ws2 + WS_P) + (size_t)q0 * INP + (diff ? 736 + 64 * h : 96 * h);
                const bf16_t* Kp = (const bf16_t*)(ws2 + k_base) + k_off;
                const bf16_t* Vt = (const bf16_t*)(ws2 + vt_base) + vt_off;
                bf16_t* Oo = (bf16_t*)(ws2 + WS_OB) + (size_t)q0 * DM + (diff ? 384 : 0) + 64 * h;
                if (diff) attn_unit<true>(lds, Qa, qa_ld, Qb, INP, Kp, 384, Vt, vt_ld, nt_main, nt_total, Oo, cd, lam, a.in[I_GSUB] + l * 64, 1.0f - lam_init, tid2);
                else attn_unit<false>(lds, Qa, qa_ld, Qb, INP, Kp, 576, Vt, vt_ld, nt_main, nt_total, Oo, cm, 0.f, nullptr, 0.f, tid2);
            }
        }
#endif
        PH_END
        PH_BEGIN
#ifndef SKIP_D
        {
            pg8::Gemm g{OB, (const bf16_t*)(ws + WS_WOUT), MTOT, DM, DM}; pg8::StaticOrder S; S.init(MTOT, DM, G, bid);
            EpiRes E{(l == 0) ? a.in[I_XP] : a.out, (l == 0) ? a.in[I_XS] : a.out + (size_t)NCTX * DM, a.out, (MOD + (size_t)l * 9 * 6144) + 2 * 1024,
                     a.in[I_GFFN] + l * DM, (MOD + (size_t)l * 9 * 6144) + 4 * 1024, XS, SSQ + (size_t)(2 * l + 1) * MTOT, 0};
            pg8::gemm_phase<EpiRes, pg8::StaticOrder, true, true>(lds, g, S, E);
        }
#endif
        PH_END
#pragma unroll 1
        for (int ch = 0; ch < 2; ++ch) {
            const int row0 = (ch == 0) ? NCTX : 0, Mc = (ch == 0) ? NLAT : NCTX, seqlen = (ch == 0) ? 2048 : 256;
            PH_BEGIN
#ifndef SKIP_E
            {
                if (ch == 1 && l + 1 < NLAYER) { convert_weights(a, lds, l + 1, 7, gw, NGW, wave, lane); __syncthreads(); }
                pg8::Gemm g{XS + (size_t)row0 * DM, (const bf16_t*)(ws + WS_WUP), Mc, UPC, DM}; pg8::StaticOrder S; S.init(Mc, UPC, G, bid);
                EpiA E{(bf16_t*)(ws + WS_U), UPC, SSQ + (size_t)(2 * l + 1) * MTOT, BUP + (size_t)l * 9 * UPC, UPC, row0};
                for (int rep = 0; rep < NREP_E; ++rep) pg8::gemm_phase<EpiA, pg8::StaticOrder, true, true>(lds, g, S, E);
            }
#endif
            PH_END
            PH_BEGIN
#ifndef SKIP_F
            { for (int rep = 0; rep < NREP_F; ++rep) phase_f(a, l, Mc, seqlen, tid); }
#endif
            PH_END
            PH_BEGIN
#ifndef SKIP_G
            {
                if (ch == 1 && l + 1 < NLAYER) { convert_weights(a, lds, l + 1, 8, gw, NGW, wave, lane); __syncthreads(); }
                const bool nxt = (l + 1 < NLAYER);
                pg8::Gemm g{(const bf16_t*)(ws + WS_ACT), (const bf16_t*)(ws + WS_WDN), Mc, DM, DFF}; pg8::StaticOrder S; S.init(Mc, DM, G, bid);
                EpiRes E{a.out, a.out + (size_t)NCTX * DM, a.out, (MOD + (size_t)l * 9 * 6144) + 5 * 1024,
                         nxt ? a.in[I_GMIX] + (l + 1) * DM : nullptr, (MOD + (size_t)l * 9 * 6144) + 9 * 6144 + 1 * 1024, XS, SSQ + (size_t)(nxt ? 2 * l + 2 : 8) * MTOT, row0};
                pg8::gemm_phase<EpiRes, pg8::StaticOrder, true, true>(lds, g, S, E);
            }
#endif
            PH_END
        }
    }
    PH_BEGIN
#ifndef SKIP_FIN
    {
        const float* gf = a.in[I_GFINAL];
        for (int r = gw; r < MTOT; r += NGW) {
            float* xr = a.out + (size_t)r * DM;
            f32x4 x[4]; float ss = 0.f;
#pragma unroll
            for (int j = 0; j < 4; ++j) { x[j] = *(const f32x4*)(xr + 4 * lane + 256 * j); ss += (x[j][0] * x[j][0] + x[j][1] * x[j][1]) + (x[j][2] * x[j][2] + x[j][3] * x[j][3]); }
            ss = wave_sum(ss);
            const float rs = rsqrtf(ss * (1.0f / 1024.0f) + EPS);
#pragma unroll
            for (int j = 0; j < 4; ++j) { const f32x4 g = *(const f32x4*)(gf + 4 * lane + 256 * j); *(f32x4*)(xr + 4 * lane + 256 * j) = x[j] * rs * g; }
        }
    }
#endif
    PH_END
#undef PH_BEGIN
#undef PH_END
}
constexpr int N_PHASES = 2 + NLAYER * 10 + 1;

#ifndef MK_ONE_LAUNCH
#define MK_ONE_LAUNCH 1
#endif
extern "C" void kernel_launch(void* const* d_in, const int* in_sizes, int n_in, void* d_out, int out_size, void* d_ws, size_t ws_size, hipStream_t stream) {
    static int grid = 0;
    if (grid == 0) {
        if (n_in != 26 || ws_size < WS_END) { fprintf(stderr, "kernel_launch: unexpected inputs (n_in %d, ws %zu < %zu)\n", n_in, ws_size, (size_t)WS_END); grid = -1; return; }
        int dev = 0, cus = 0, per_cu = 0;
        hipGetDevice(&dev); hipDeviceGetAttribute(&cus, hipDeviceAttributeMultiprocessorCount, dev);
        if (hipFuncSetAttribute((const void*)mega_fwd, hipFuncAttributeMaxDynamicSharedMemorySize, LDS_BYTES) != hipSuccess) { fprintf(stderr, "kernel_launch: hipFuncSetAttribute failed\n"); grid = -1; return; }
        if (hipOccupancyMaxActiveBlocksPerMultiprocessor(&per_cu, (const void*)mega_fwd, 512, LDS_BYTES) != hipSuccess || per_cu < 1) { fprintf(stderr, "kernel_launch: occupancy query gave %d\n", per_cu); per_cu = 1; }
        (void)hipGetLastError();
        grid = cus * 1;
    }
    if (grid < 0) return;
    if (hipMemsetAsync((char*)d_ws + WS_CTL, 0, 1 << 20, stream) != hipSuccess) { fprintf(stderr, "kernel_launch: memset failed\n"); return; }
    Args a{};
    for (int i = 0; i < 26; ++i) a.in[i] = (const float*)d_in[i];
    a.out = (float*)d_out; a.ws = (unsigned char*)d_ws;
#if MK_ONE_LAUNCH
    a.ph_lo = 0; a.ph_hi = N_PHASES;
    void* args[] = {&a};
    hipError_t e = hipLaunchCooperativeKernel((const void*)mega_fwd, dim3(grid), dim3(512), args, LDS_BYTES, stream);
    if (e != hipSuccess) fprintf(stderr, "cooperative launch failed: %s (grid %d)\n", hipGetErrorString(e), grid);
#else
    for (int p = 0; p < N_PHASES; ++p) { a.ph_lo = p; a.ph_hi = p + 1; hipLaunchKernelGGL(mega_fwd, dim3(grid), dim3(512), LDS_BYTES, stream, a); }
#endif
}
```

```cpp
#include <hip/hip_runtime.h>
#include <hip/hip_cooperative_groups.h>
#include <cstdio>
#include <cstdint>
namespace cg = cooperative_groups;
namespace pg8 {
#define PG8_LAS __attribute__((address_space(3)))
typedef unsigned short bf16_t;
typedef short bf16x8 __attribute__((ext_vector_type(8)));
typedef float f32x4 __attribute__((ext_vector_type(4)));
typedef unsigned u32x4 __attribute__((ext_vector_type(4)));
constexpr int BM = 256, BK = 64, HALF = 128, HTB = HALF * BK * 2  , STAGE_BYTES = 8 * HTB, NXCD = 8, WGM = 8;

__host__ __device__ __forceinline__ int lds_byte(int r, int c) { const int st = (r >> 4) * 2 + (c >> 5), rr = r & 15, cc = c & 31, ob = rr * 64 + cc * 2; return st * 1024 + (ob ^ (((ob >> 9) & 1) << 5)); }
__host__ __device__ __forceinline__ void stage_rc(int b, int& R, int& C) { const int st = b / 1024, sb = b % 1024, swz = sb ^ (((sb >> 9) & 1) << 5); R = (st >> 1) * 16 + swz / 64; C = (st & 1) * 32 + (swz % 64) / 2; }
__host__ __device__ __forceinline__ int perm32(int rho) { const int n = rho >> 4, i = rho & 15; return 8 * (i >> 2) + 4 * n + (i & 3); }

struct Unit { int pm, pn; };
struct Gemm { const bf16_t* A; const bf16_t* Bt; int M, N, K; };

struct StaticOrder {
    int nM, nN, nwg, G, c;
    __host__ __device__ void init(int M, int N, int G_, int c_) { nM = M / BM; nN = N / BM; nwg = nM * nN; G = G_; c = c_; }
    __host__ __device__ bool next(int i, Unit& u) const {
        const long L = (long)i * G + c; if (L >= nwg) return false;
        int wgid = (int)L; { const int q = nwg / NXCD, r = nwg % NXCD, xcd = wgid % NXCD, off = wgid / NXCD; wgid = (xcd < r ? xcd * (q + 1) : r * (q + 1) + (xcd - r) * q) + off; }
        const int nig = WGM * nN, gid = wgid / nig, fm = gid * WGM, gsz = (nM - fm) < WGM ? (nM - fm) : WGM;
        u.pm = fm + ((wgid % nig) % gsz); u.pn = (wgid % nig) / gsz; return true;
    }
    __device__ __forceinline__ void a_ready(const Unit&) const {}
    __device__ __forceinline__ void done(const Unit&) const {}
};

__device__ __forceinline__ unsigned cvt_pk_bf16(float lo, float hi) { unsigned r; asm volatile("v_cvt_pk_bf16_f32 %0, %1, %2" : "=v"(r) : "v"(lo), "v"(hi)); return r; }
typedef float f32x2 __attribute__((ext_vector_type(2)));
__device__ __forceinline__ f32x2 gelu_pk(f32x2 v) {
    const f32x2 av = __builtin_elementwise_abs(v), d = av * 0.2316418882f + 1.0f;
    f32x2 t; t.x = __builtin_amdgcn_rcpf(d.x); t.y = __builtin_amdgcn_rcpf(d.y);
    f32x2 q = t * 0.5307027145f + (-0.7265760135f); q = q * t + 0.7107068705f; q = q * t + (-0.142248368f); q = q * t + 0.127414796f; q = q * t;
    const f32x2 s = (v * v) * (-0.72134752044f);
    f32x2 e; e.x = __builtin_amdgcn_exp2f(s.x); e.y = __builtin_amdgcn_exp2f(s.y);
    const f32x2 m = v * (q * e), r = v - m;
    f32x2 o; o.x = v.x < 0.f ? m.x : r.x; o.y = v.y < 0.f ? m.y : r.y; return o;
}

template <int ACT  > struct EpiBf16 {
    static constexpr bool PERM = true, AFTER_DRAIN = false; static_assert(ACT == 0 || ACT == 1, "EpiBf16: ACT is 0 (none) or 1 (gelu_pk)");
    bf16_t* O; int ldc; const float* bias; int split_cols; size_t split_stride; float scale0;
    __device__ __forceinline__ void operator()(const f32x4 (&acc)[2][2][4][2], const Unit& u, int wr, int wc, int fr, int fq) const {
        const int row0 = u.pm * BM + wr * 64 + fr; int colt = u.pn * BM; bf16_t* base = O;
        float sc = 1.f; if (split_cols) { const int t = colt / split_cols; base += (size_t)t * split_stride; colt -= t * split_cols; if (t == 0) sc = scale0; }
        const int col0 = colt + wc * 32 + 8 * fq, bcol0 = u.pn * BM + wc * 32 + 8 * fq;
        f32x4 bv[2][2];
#pragma unroll
        for (int bj = 0; bj < 2; ++bj)
#pragma unroll
            for (int n = 0; n < 2; ++n) bv[bj][n] = bias ? *(const f32x4*)(bias + bcol0 + bj * HALF + 4 * n) : (f32x4){0.f, 0.f, 0.f, 0.f};
#pragma unroll
        for (int ai = 0; ai < 2; ++ai)
#pragma unroll
            for (int m = 0; m < 4; ++m) { bf16_t* rowp = base + (size_t)(row0 + ai * HALF + m * 16) * ldc + col0;
#pragma unroll
                for (int bj = 0; bj < 2; ++bj) { f32x4 v0 = acc[ai][bj][m][0] + bv[bj][0], v1 = acc[ai][bj][m][1] + bv[bj][1];
                    if (ACT == 1) { f32x2 a = gelu_pk((f32x2){v0[0], v0[1]}), b = gelu_pk((f32x2){v0[2], v0[3]}), c = gelu_pk((f32x2){v1[0], v1[1]}), d = gelu_pk((f32x2){v1[2], v1[3]});
                        v0 = (f32x4){a.x, a.y, b.x, b.y}; v1 = (f32x4){c.x, c.y, d.x, d.y}; }
                    v0 = v0 * sc; v1 = v1 * sc; u32x4 w; w.x = cvt_pk_bf16(v0[0], v0[1]); w.y = cvt_pk_bf16(v0[2], v0[3]); w.z = cvt_pk_bf16(v1[0], v1[1]); w.w = cvt_pk_bf16(v1[2], v1[3]);
                    *(u32x4*)(rowp + bj * HALF) = w; } }
    }
};

struct PanelStats {
    unsigned* xbuf;
    unsigned* cnt;
    unsigned* tmo;
    int ntn; float eps;
    unsigned code;
    __device__ __forceinline__ bool run(const f32x4 (&v)[2][2][4][2], const Unit& u, int wr, int wc, int fr, int fq, PG8_LAS unsigned char* lds, int wid, int lane) const {
        typedef float f32x2v __attribute__((ext_vector_type(2)));
        PG8_LAS f32x2v* P = (PG8_LAS f32x2v*)lds;
        PG8_LAS f32x2v* S = (PG8_LAS f32x2v*)(lds + 8192);
        PG8_LAS unsigned* flag = (PG8_LAS unsigned*)(lds + 8192 + 2048);
#pragma unroll
        for (int ai = 0; ai < 2; ++ai)
#pragma unroll
            for (int m = 0; m < 4; ++m) {
                float s = 0.f;
#pragma unroll
                for (int bj = 0; bj < 2; ++bj)
#pragma unroll
                    for (int n = 0; n < 2; ++n) { const f32x4 x = v[ai][bj][m][n]; s += (x[0] + x[1]) + (x[2] + x[3]); }
                s += __shfl_xor(s, 16); s += __shfl_xor(s, 32);
                const float mw = s * (1.0f / 64.0f); float q = 0.f;
#pragma unroll
                for (int bj = 0; bj < 2; ++bj)
#pragma unroll
                    for (int n = 0; n < 2; ++n) { const f32x4 d = v[ai][bj][m][n] - mw; q += (d[0] * d[0] + d[1] * d[1]) + (d[2] * d[2] + d[3] * d[3]); }
                q += __shfl_xor(q, 16); q += __shfl_xor(q, 32);
                if (fq == 0) P[(ai * HALF + wr * 64 + m * 16 + fr) * 4 + wc] = (f32x2v){mw, q};
            }
        asm volatile("s_waitcnt lgkmcnt(0)" ::: "memory"); __builtin_amdgcn_s_barrier(); asm volatile("" ::: "memory");
#if defined(BROKEN_EXCHANGE_NO_WAIT)
#warning BROKEN CONTROL BUILD: the row-statistics exchange does not wait; results are wrong by design
        if (blockIdx.x >= 64) { const long long t0_ = clock64(); while (clock64() - t0_ < 60000) __builtin_amdgcn_s_sleep(8); }
#endif
        const int row = wid * 32 + (lane & 31);
        if (lane < 32) {
            const f32x2v a = P[row * 4 + 0], b = P[row * 4 + 1], c = P[row * 4 + 2], d = P[row * 4 + 3];
            const float mt = (a.x + b.x + c.x + d.x) * 0.25f;
            const float da = a.x - mt, db = b.x - mt, dc = c.x - mt, dd = d.x - mt;
            const float m2 = (a.y + b.y) + (c.y + d.y) + 64.0f * ((da * da + db * db) + (dc * dc + dd * dd));
            unsigned long long* slot = (unsigned long long*)xbuf + ((size_t)(u.pm * BM + row) * 4 + u.pn);
            __hip_atomic_store(slot, ((unsigned long long)__float_as_uint(m2) << 32) | __float_as_uint(mt), __ATOMIC_RELAXED, __HIP_MEMORY_SCOPE_AGENT);
        }
        asm volatile("s_waitcnt vmcnt(0)" ::: "memory");
        if (lane == 0) __hip_atomic_fetch_add(cnt + 64 * u.pm, 1u, __ATOMIC_RELAXED, __HIP_MEMORY_SCOPE_AGENT);
        if (wid == 0) {
            bool dead = false; const unsigned long long t0 = __builtin_amdgcn_s_memrealtime(); const unsigned want = 8u * (unsigned)ntn;
            for (;;) {
#if defined(BROKEN_EXCHANGE_NO_WAIT)
                break;
#endif
                if ((unsigned)__builtin_amdgcn_readfirstlane(__hip_atomic_load(cnt + 64 * u.pm, __ATOMIC_RELAXED, __HIP_MEMORY_SCOPE_AGENT)) >= want) break;
                if (__builtin_amdgcn_s_memrealtime() - t0 > 2000000ull) {
                    if (lane == 0) { unsigned expect = 0u; __hip_atomic_compare_exchange_strong(tmo + 1, &expect, code | (unsigned)(u.pm & 0xff), __ATOMIC_RELAXED, __ATOMIC_RELAXED, __HIP_MEMORY_SCOPE_AGENT);
                                     __hip_atomic_store(tmo, 1u, __ATOMIC_RELAXED, __HIP_MEMORY_SCOPE_AGENT); }
                    dead = true; break; }
                __builtin_amdgcn_s_sleep(2);
            }
            __builtin_amdgcn_fence(__ATOMIC_ACQUIRE, "agent");
            if (lane == 0) flag[0] = dead ? 1u : 0u;
        }
        asm volatile("s_waitcnt vmcnt(0) lgkmcnt(0)" ::: "memory"); __builtin_amdgcn_s_barrier(); asm volatile("" ::: "memory");
        const bool bad = flag[0] != 0u;
        if (lane < 32) {
            const unsigned long long* slot = (const unsigned long long*)xbuf + (size_t)(u.pm * BM + row) * 4; float mt[4], m2[4]; float ms = 0.f;
#pragma unroll
            for (int t = 0; t < 4; ++t) { if (t < ntn) { const unsigned long long w = __hip_atomic_load(slot + t, __ATOMIC_RELAXED, __HIP_MEMORY_SCOPE_AGENT); mt[t] = __uint_as_float((unsigned)w); m2[t] = __uint_as_float((unsigned)(w >> 32)); } else { mt[t] = 0.f; m2[t] = 0.f; } ms += mt[t]; }
            const float mean = ms / (float)ntn; float q = 0.f;
#pragma unroll
            for (int t = 0; t < 4; ++t) if (t < ntn) { const float dm = mt[t] - mean; q += m2[t] + 256.0f * dm * dm; }
            S[row] = (f32x2v){mean, 1.0f / sqrtf(q / (256.0f * (float)ntn) + eps)};
        }
        asm volatile("s_waitcnt lgkmcnt(0)" ::: "memory"); __builtin_amdgcn_s_barrier(); asm volatile("" ::: "memory");
        return bad;
    }
};
struct EpiLnRes {
    static constexpr bool PERM = false, AFTER_DRAIN = true;
    const float* base; float* out; int ldc; const float* bias; PanelStats st; unsigned poison;
    __device__ __forceinline__ void fused(f32x4 (&acc)[2][2][4][2], const Unit& u, int wr, int wc, int fr, int fq, PG8_LAS unsigned char* lds, int wid, int lane) const {
        typedef float f32x2v __attribute__((ext_vector_type(2)));
        const PG8_LAS f32x2v* S = (const PG8_LAS f32x2v*)(lds + 8192);
        const int col0 = u.pn * BM + wc * 32 + 4 * fq;
#pragma unroll
        for (int bj = 0; bj < 2; ++bj)
#pragma unroll
            for (int n = 0; n < 2; ++n) { const f32x4 bv = bias ? *(const f32x4*)(bias + col0 + bj * HALF + n * 16) : (f32x4){0.f, 0.f, 0.f, 0.f};
#pragma unroll
                for (int ai = 0; ai < 2; ++ai)
#pragma unroll
                    for (int m = 0; m < 4; ++m) acc[ai][bj][m][n] += bv; }
        f32x4 pre[4][2][2];
#pragma unroll
        for (int m = 0; m < 4; ++m) { const size_t off = (size_t)(u.pm * BM + wr * 64 + m * 16 + fr) * ldc + col0;
#pragma unroll
            for (int bj = 0; bj < 2; ++bj)
#pragma unroll
                for (int n = 0; n < 2; ++n) pre[m][bj][n] = *(const f32x4*)(base + off + bj * HALF + n * 16); }
        const bool bad = st.run(acc, u, wr, wc, fr, fq, lds, wid, lane) || poison != 0u;
        const float qnan = __builtin_nanf("");
#pragma unroll
        for (int ai = 0; ai < 2; ++ai)
#pragma unroll
            for (int m = 0; m < 4; ++m) { const int r = ai * HALF + wr * 64 + m * 16 + fr; const f32x2v sr = S[r]; const size_t off = (size_t)(u.pm * BM + r) * ldc + col0;
#pragma unroll
                for (int bj = 0; bj < 2; ++bj)
#pragma unroll
                    for (int n = 0; n < 2; ++n) { const f32x4 bs = ai == 0 ? pre[m][bj][n] : *(const f32x4*)(base + off + bj * HALF + n * 16); f32x4 o = bs + (acc[ai][bj][m][n] - sr.x) * sr.y;
                        if (bad) o = (f32x4){qnan, qnan, qnan, qnan}; *(f32x4*)(out + off + bj * HALF + n * 16) = o; }
                if (m & 1) asm volatile("" ::: "memory"); }
    }
};
struct EpiLnResLn {
    static constexpr bool PERM = false, AFTER_DRAIN = true;
    const float* base; float* out; bf16_t* xn; int ldc; const float* bias; PanelStats st1, st2; unsigned poison;
    __device__ __forceinline__ void fused(f32x4 (&acc)[2][2][4][2], const Unit& u, int wr, int wc, int fr, int fq, PG8_LAS unsigned char* lds, int wid, int lane) const {
        typedef float f32x2v __attribute__((ext_vector_type(2))); typedef unsigned u32x2v __attribute__((ext_vector_type(2)));
        const PG8_LAS f32x2v* S = (const PG8_LAS f32x2v*)(lds + 8192);
        const int col0 = u.pn * BM + wc * 32 + 4 * fq;
#pragma unroll
        for (int bj = 0; bj < 2; ++bj)
#pragma unroll
            for (int n = 0; n < 2; ++n) { const f32x4 bv = bias ? *(const f32x4*)(bias + col0 + bj * HALF + n * 16) : (f32x4){0.f, 0.f, 0.f, 0.f};
#pragma unroll
                for (int ai = 0; ai < 2; ++ai)
#pragma unroll
                    for (int m = 0; m < 4; ++m) acc[ai][bj][m][n] += bv; }
        bool bad = st1.run(acc, u, wr, wc, fr, fq, lds, wid, lane) || poison != 0u;
        const float qnan = __builtin_nanf("");
#pragma unroll
        for (int ai = 0; ai < 2; ++ai)
#pragma unroll
            for (int m = 0; m < 4; ++m) { const int r = ai * HALF + wr * 64 + m * 16 + fr; const f32x2v sr = S[r]; const size_t off = (size_t)(u.pm * BM + r) * ldc + col0;
#pragma unroll
                for (int bj = 0; bj < 2; ++bj)
#pragma unroll
                    for (int n = 0; n < 2; ++n) { const f32x4 bs = *(const f32x4*)(base + off + bj * HALF + n * 16); acc[ai][bj][m][n] = bs + (acc[ai][bj][m][n] - sr.x) * sr.y; }
                asm volatile("" : "+v"(acc[ai][0][m][0]), "+v"(acc[ai][0][m][1]), "+v"(acc[ai][1][m][0]), "+v"(acc[ai][1][m][1]));
                if (m & 1) asm volatile("" ::: "memory"); }
        const bool bad1 = bad;
        bad = st2.run(acc, u, wr, wc, fr, fq, lds, wid, lane) || bad;
#pragma unroll
        for (int ai = 0; ai < 2; ++ai)
#pragma unroll
            for (int m = 0; m < 4; ++m) { const int r = ai * HALF + wr * 64 + m * 16 + fr; const f32x2v sr = S[r]; const size_t off = (size_t)(u.pm * BM + r) * ldc + col0;
#pragma unroll
                for (int bj = 0; bj < 2; ++bj)
#pragma unroll
                    for (int n = 0; n < 2; ++n) { const f32x4 x1 = acc[ai][bj][m][n]; *(f32x4*)(out + off + bj * HALF + n * 16) = bad1 ? (f32x4){qnan, qnan, qnan, qnan} : x1;
                        const f32x4 o = (x1 - sr.x) * sr.y; u32x2v w; w.x = cvt_pk_bf16(o[0], o[1]); w.y = cvt_pk_bf16(o[2], o[3]);
                        if (bad) { w.x = 0x7fc07fc0u; w.y = 0x7fc07fc0u; } *(u32x2v*)(xn + off + bj * HALF + n * 16) = w; }
                asm volatile("" ::: "memory"); }
    }
};

template <class Epi, class Sched, bool ALIGN_EPI = false, bool SP2 = false>
__device__ __forceinline__ void gemm_phase(PG8_LAS unsigned char* lds, const Gemm g, const Sched& S, const Epi& E) {
    int tid = threadIdx.x; asm volatile("" : "+v"(tid));
    const int wid = __builtin_amdgcn_readfirstlane(tid >> 6), lane = tid & 63, wr = wid >> 2, wc = wid & 3, fr = lane & 15, fq = lane >> 4;
    const int K = g.K, nt = K / BK;
    unsigned voffA[2], voffB[2];
#pragma unroll
    for (int i = 0; i < 2; ++i) { int R, C; stage_rc(tid * 16 + i * 8192, R, C); const int Rb = Epi::PERM ? ((R & ~31) + perm32(R & 31)) : R;
        voffA[i] = (unsigned)(R * K + C) * 2u; voffB[i] = (unsigned)(Rb * K + C) * 2u; }
    const size_t kstep = (size_t)(BK * 2);
    const size_t hstep = (size_t)HALF * K * 2;
    const size_t tstep = 2 * hstep;
    const unsigned ldsw = (unsigned)wid * 1024u;
    const int aoff = lds_byte(wr * 64 + fr, fq * 8), boff = lds_byte(wc * 32 + fr, fq * 8);
#define PG8_SA(b, h) (((b) * 2 + (h)) * HTB)
#define PG8_SB(b, h) ((4 + (b) * 2 + (h)) * HTB)
#define PG8_STAGE(bufoff, gbase, voff) do { _Pragma("unroll") for (int _i = 0; _i < 2; ++_i) \
        __builtin_amdgcn_global_load_lds((const unsigned*)((const char*)(gbase) + (voff)[_i]), (PG8_LAS unsigned*)(lds + (bufoff) + ldsw + _i * 8192), 16, 0, 0); } while (0)
#define PG8_LDA(dst, b, h) do { _Pragma("unroll") for (int m = 0; m < 4; ++m) _Pragma("unroll") for (int k = 0; k < 2; ++k) dst[m][k] = *(const PG8_LAS bf16x8*)(lds + PG8_SA(b, h) + aoff + m * 2048 + k * 1024); } while (0)
#define PG8_LDB(dst, b, h) do { _Pragma("unroll") for (int n = 0; n < 2; ++n) _Pragma("unroll") for (int k = 0; k < 2; ++k) dst[n][k] = *(const PG8_LAS bf16x8*)(lds + PG8_SB(b, h) + boff + n * 2048 + k * 1024); } while (0)
#define PG8_MMA(ai, bj, At, Bt) do { __builtin_amdgcn_s_setprio(1); _Pragma("unroll") for (int m = 0; m < 4; ++m) _Pragma("unroll") for (int n = 0; n < 2; ++n) _Pragma("unroll") for (int k = 0; k < 2; ++k) \
        acc[ai][bj][m][n] = __builtin_amdgcn_mfma_f32_16x16x32_bf16(Bt[n][k], At[m][k], acc[ai][bj][m][n], 0, 0, 0); __builtin_amdgcn_s_setprio(0); } while (0)
#define PG8_WAIT_V(n) asm volatile("s_waitcnt vmcnt(" #n ")" ::: "memory")
#define PG8_WAIT_L(n) asm volatile("s_waitcnt lgkmcnt(" #n ")" ::: "memory")
#define PG8_BAR __builtin_amdgcn_s_barrier()
#define PG8_SCHED __builtin_amdgcn_sched_barrier(0)
    Unit cur, nxt; int ui = 0;
    if (!S.next(0, cur)) return;
    f32x4 acc[2][2][4][2];
#pragma unroll
    for (int a = 0; a < 2; ++a)
#pragma unroll
        for (int b = 0; b < 2; ++b)
#pragma unroll
            for (int m = 0; m < 4; ++m)
#pragma unroll
                for (int n = 0; n < 2; ++n) acc[a][b][m][n] = (f32x4){0.f, 0.f, 0.f, 0.f};
    bf16x8 At[4][2], B0[2][2], B1[2][2];
    const char* cA = (const char*)g.A + (size_t)cur.pm * tstep; const char* cB = (const char*)g.Bt + (size_t)cur.pn * tstep;
    S.a_ready(cur);
    if constexpr (SP2) {
        PG8_STAGE(PG8_SB(0, 0), cB, voffB); PG8_STAGE(PG8_SB(0, 1), cB + hstep, voffB); PG8_STAGE(PG8_SA(0, 0), cA, voffA); PG8_STAGE(PG8_SA(0, 1), cA + hstep, voffA);
        if (wr == 1) PG8_BAR;
        PG8_WAIT_V(2); PG8_BAR;
        PG8_STAGE(PG8_SB(1, 0), cB + kstep, voffB); PG8_STAGE(PG8_SA(1, 0), cA + kstep, voffA); PG8_STAGE(PG8_SB(1, 1), cB + hstep + kstep, voffB);
        PG8_WAIT_V(6); PG8_BAR;
    } else {
        PG8_STAGE(PG8_SB(0, 0), cB, voffB); PG8_STAGE(PG8_SA(0, 0), cA, voffA); PG8_STAGE(PG8_SB(0, 1), cB + hstep, voffB); PG8_STAGE(PG8_SA(0, 1), cA + hstep, voffA);
        if (wr == 1) PG8_BAR;
        PG8_WAIT_V(4); PG8_BAR;
        PG8_STAGE(PG8_SB(1, 0), cB + kstep, voffB); PG8_STAGE(PG8_SA(1, 0), cA + kstep, voffA); PG8_STAGE(PG8_SB(1, 1), cB + hstep + kstep, voffB);
        PG8_WAIT_V(6); PG8_BAR;
    }
    for (;;) {
        const bool has_next = S.next(ui + 1, nxt);
        const char* nA = has_next ? (const char*)g.A + (size_t)nxt.pm * tstep : cA; const char* nB = has_next ? (const char*)g.Bt + (size_t)nxt.pn * tstep : cB;
        for (int t = 0; t < nt; t += 2) {
            const bool last = (t == nt - 2);
            const char* a1 = cA + (size_t)(t + 1) * kstep;
            const char* a2 = last ? nA : cA + (size_t)(t + 2) * kstep; const char* b2 = last ? nB : cB + (size_t)(t + 2) * kstep;
            const char* a3 = a2 + kstep; const char* b3 = b2 + kstep;
            if (last && has_next) S.a_ready(nxt);
            if constexpr (SP2) {
            PG8_LDB(B0, 0, 0); PG8_LDB(B1, 0, 1); PG8_SCHED; PG8_LDA(At, 0, 0); PG8_STAGE(PG8_SA(1, 1), a1 + hstep, voffA);
            PG8_WAIT_V(8); PG8_WAIT_L(0); PG8_BAR; PG8_MMA(0, 0, At, B0); PG8_MMA(0, 1, At, B1); PG8_BAR; PG8_SCHED;
            PG8_LDA(At, 0, 1); PG8_STAGE(PG8_SB(0, 0), b2, voffB); PG8_STAGE(PG8_SB(0, 1), b2 + hstep, voffB); PG8_STAGE(PG8_SA(0, 0), a2, voffA);
            PG8_WAIT_V(8); PG8_WAIT_L(0); PG8_BAR; PG8_MMA(1, 0, At, B0); PG8_MMA(1, 1, At, B1); PG8_BAR; PG8_SCHED;
            PG8_LDB(B0, 1, 0); PG8_LDB(B1, 1, 1); PG8_SCHED; PG8_LDA(At, 1, 0); PG8_STAGE(PG8_SA(0, 1), a2 + hstep, voffA);
            PG8_WAIT_V(8); PG8_WAIT_L(0); PG8_BAR; PG8_MMA(0, 0, At, B0); PG8_MMA(0, 1, At, B1); PG8_BAR; PG8_SCHED;
            PG8_LDA(At, 1, 1); PG8_STAGE(PG8_SB(1, 0), b3, voffB); PG8_STAGE(PG8_SB(1, 1), b3 + hstep, voffB); PG8_STAGE(PG8_SA(1, 0), a3, voffA);
            PG8_WAIT_V(8); PG8_WAIT_L(0); PG8_BAR; PG8_MMA(1, 0, At, B0); PG8_MMA(1, 1, At, B1); PG8_BAR; PG8_SCHED;
            } else {
            PG8_LDB(B0, 0, 0); PG8_SCHED; PG8_LDA(At, 0, 0); PG8_STAGE(PG8_SA(1, 1), a1 + hstep, voffA);
            PG8_WAIT_L(8); PG8_BAR; PG8_WAIT_L(0); PG8_MMA(0, 0, At, B0); PG8_BAR; PG8_SCHED;
            PG8_LDB(B1, 0, 1); PG8_STAGE(PG8_SB(0, 0), b2, voffB);
            PG8_BAR; PG8_WAIT_L(0); PG8_MMA(0, 1, At, B1); PG8_BAR;
            PG8_LDA(At, 0, 1); PG8_STAGE(PG8_SA(0, 0), a2, voffA);
            PG8_BAR; PG8_WAIT_L(0); PG8_MMA(1, 0, At, B0); PG8_BAR; PG8_SCHED;
            PG8_STAGE(PG8_SB(0, 1), b2 + hstep, voffB);
            PG8_WAIT_V(6); PG8_BAR; PG8_MMA(1, 1, At, B1); PG8_BAR;
            PG8_LDB(B0, 1, 0); PG8_SCHED; PG8_LDA(At, 1, 0); PG8_STAGE(PG8_SA(0, 1), a2 + hstep, voffA);
            PG8_WAIT_L(8); PG8_BAR; PG8_WAIT_L(0); PG8_MMA(0, 0, At, B0); PG8_BAR; PG8_SCHED;
            PG8_LDB(B1, 1, 1); PG8_STAGE(PG8_SB(1, 0), b3, voffB);
            PG8_BAR; PG8_WAIT_L(0); PG8_MMA(0, 1, At, B1); PG8_BAR;
            PG8_LDA(At, 1, 1); PG8_STAGE(PG8_SA(1, 0), a3, voffA);
            PG8_BAR; PG8_WAIT_L(0); PG8_MMA(1, 0, At, B0); PG8_BAR; PG8_SCHED;
            PG8_STAGE(PG8_SB(1, 1), b3 + hstep, voffB);
            PG8_WAIT_V(6); PG8_BAR; PG8_MMA(1, 1, At, B1); PG8_BAR;
            }
        }
        if constexpr (ALIGN_EPI) { if (wr == 0) PG8_BAR; }
        if constexpr (!Epi::AFTER_DRAIN) { E(acc, cur, wr, wc, fr, fq); S.done(cur); }
        if (!has_next) break;
#pragma unroll
        for (int a = 0; a < 2; ++a)
#pragma unroll
            for (int b = 0; b < 2; ++b)
#pragma unroll
                for (int m = 0; m < 4; ++m)
#pragma unroll
                    for (int n = 0; n < 2; ++n) acc[a][b][m][n] = (f32x4){0.f, 0.f, 0.f, 0.f};
        cur = nxt; cA = nA; cB = nB; ++ui;
        if constexpr (ALIGN_EPI) { if (wr == 1) PG8_BAR; }
    }
    PG8_WAIT_V(0);
    if constexpr (!ALIGN_EPI) { if (wr == 0) PG8_BAR; }
    PG8_BAR;
    if constexpr (Epi::AFTER_DRAIN) { E.fused(acc, cur, wr, wc, fr, fq, lds, wid, lane); S.done(cur); }
#undef PG8_SA
#undef PG8_SB
#undef PG8_STAGE
#undef PG8_LDA
#undef PG8_LDB
#undef PG8_MMA
#undef PG8_WAIT_V
#undef PG8_WAIT_L
#undef PG8_BAR
#undef PG8_SCHED
}
}

#define DEV __device__ __forceinline__
#define LAS __attribute__((address_space(3)))
#define GAS __attribute__((address_space(1)))
typedef unsigned short bf16_t;
typedef short bf16x8 __attribute__((ext_vector_type(8)));
typedef short s16x4 __attribute__((ext_vector_type(4)));
typedef float f32x4 __attribute__((ext_vector_type(4)));
typedef float f32x2 __attribute__((ext_vector_type(2)));
typedef float f32x16 __attribute__((ext_vector_type(16)));
typedef unsigned u32x4 __attribute__((ext_vector_type(4)));
typedef unsigned u32x2 __attribute__((ext_vector_type(2)));
typedef __bf16 bf16x2_t __attribute__((ext_vector_type(2)));

constexpr int DM = 1024, NCTX = 8192, NLAT = 16384, MTOT = 24576;
constexpr int INP = 2304, INC = 2144, DFF = 2816, UPC = 5632;
constexpr int NLAYER = 4;
constexpr float EPS = 1e-6f;
constexpr size_t MiB = 1u << 20;
constexpr size_t WS_CTL = 0;
constexpr size_t WS_MOD = 1 * MiB;
constexpr size_t WS_BIN = 2 * MiB;
constexpr size_t WS_BUP = 3 * MiB;
constexpr size_t WS_SSQ = 4 * MiB;
constexpr size_t WS_WIN = 5 * MiB;
constexpr size_t WS_WUKV = WS_WIN + 4718592;
constexpr size_t WS_WOUT = 10 * MiB;
constexpr size_t WS_WUP = 12 * MiB;
constexpr size_t WS_WDN = 23 * MiB;
constexpr size_t WS_TLAT = 29 * MiB;
constexpr size_t WS_TCTX = 45 * MiB;
constexpr size_t WS_CS64 = WS_TCTX + 512 * 1024;
constexpr size_t WS_XS = 46 * MiB;
constexpr size_t WS_R = 94 * MiB;
constexpr size_t WS_P = WS_R;
constexpr size_t WS_OB = WS_P + 108 * MiB;
constexpr size_t WS_KML = WS_OB + 48 * MiB;
constexpr size_t WS_KMC = WS_KML + 23592960;
constexpr size_t WS_VML = WS_KMC + 9 * MiB;
constexpr size_t WS_VMC = WS_VML + 15 * MiB;
constexpr size_t WS_KDL = WS_VMC + 6 * MiB;
constexpr size_t WS_KDC = WS_KDL + 15 * MiB;
constexpr size_t WS_VDL = WS_KDC + 6 * MiB;
constexpr size_t WS_VDC = WS_VDL + 15 * MiB;
constexpr size_t WS_QMR = WS_VDC + 6 * MiB;
constexpr size_t WS_QDR = WS_QMR + 18 * MiB;
constexpr size_t WS_FBL = WS_QDR + 12 * MiB;
constexpr size_t WS_FBC = WS_FBL + 16 * MiB;
constexpr size_t WS_END = WS_FBC + 8 * MiB;
constexpr size_t WS_U = WS_R;
constexpr size_t WS_ACT = WS_R + 176 * MiB;
static_assert(WS_ACT + 88 * MiB <= WS_END, "overlay fits");
constexpr size_t OUT_CKV = 25165824, OUT_KROPE = OUT_CKV + 4194304, OUT_DK = OUT_KROPE + 1048576, OUT_DV = OUT_DK + 12582912;
constexpr int LDS_BYTES = 147456;
constexpr int RING_BYTES = 131072;
constexpr int LDS_MISC = RING_BYTES;

struct Args { const float* in[26]; float* out; unsigned char* ws; int ph_lo, ph_hi; };
enum { I_XP = 0, I_XS, I_C, I_CCKV, I_CKROPE, I_CDK, I_CDV, I_CCTX, I_WADA, I_BADA, I_GMIX, I_GFFN, I_WIN, I_GKV, I_WUK, I_WUV,
       I_LQ1, I_LK1, I_LQ2, I_LK2, I_GSUB, I_WOUT, I_WUP, I_WCONV, I_WDOWN, I_GFINAL };

DEV float bf2f(unsigned b) { return __uint_as_float(b << 16); }
DEV unsigned pk2(float lo, float hi) { f32x2 v = {lo, hi}; bf16x2_t b = __builtin_convertvector(v, bf16x2_t); return __builtin_bit_cast(unsigned, b); }
DEV bf16_t f2bf(float f) { return (bf16_t)(pk2(f, 0.f) & 0xffffu); }
DEV float wave_sum(float v) {
#pragma unroll
    for (int o = 1; o < 64; o <<= 1) v += __shfl_xor(v, o);
    return v;
}
DEV f32x4 mfma16(bf16x8 a, bf16x8 b, f32x4 c) { return __builtin_amdgcn_mfma_f32_16x16x32_bf16(a, b, c, 0, 0, 0); }
DEV f32x16 mfma32(bf16x8 a, bf16x8 b, f32x16 c) { return __builtin_amdgcn_mfma_f32_32x32x16_bf16(a, b, c, 0, 0, 0); }
DEV int row_b9(int row0) { return row0 < NCTX ? 0 : 1 + ((row0 - NCTX) >> 11); }

struct EpiA {
    static constexpr bool PERM = true, AFTER_DRAIN = false;
    bf16_t* O; int ldc; const float* ssq; const float* bias; int ldb; int row_off;
    DEV void operator()(const f32x4 (&acc)[2][2][4][2], const pg8::Unit& u, int wr, int wc, int fr, int fq) const {
        const int lrow0 = u.pm * 256, b9 = row_b9(row_off + lrow0);
        const int col0 = u.pn * 256 + wc * 32 + 8 * fq;
        f32x4 bv[2][2];
#pragma unroll
        for (int bj = 0; bj < 2; ++bj)
#pragma unroll
            for (int n = 0; n < 2; ++n) bv[bj][n] = *(const GAS f32x4*)(bias + (size_t)b9 * ldb + col0 + bj * 128 + 4 * n);
#pragma unroll
        for (int ai = 0; ai < 2; ++ai)
#pragma unroll
            for (int m = 0; m < 4; ++m) {
                const int lr = lrow0 + ai * 128 + wr * 64 + m * 16 + fr;
                const float rs = rsqrtf(((const GAS float*)ssq)[row_off + lr] * (1.0f / 1024.0f) + EPS);
                GAS bf16_t* rowp = (GAS bf16_t*)O + (size_t)lr * ldc + col0;
#pragma unroll
                for (int bj = 0; bj < 2; ++bj) {
                    const f32x4 v0 = acc[ai][bj][m][0] * rs + bv[bj][0], v1 = acc[ai][bj][m][1] * rs + bv[bj][1];
                    u32x4 w; w.x = pk2(v0[0], v0[1]); w.y = pk2(v0[2], v0[3]); w.z = pk2(v1[0], v1[1]); w.w = pk2(v1[2], v1[3]);
                    *(GAS u32x4*)(rowp + bj * 128) = w;
                }
            }
    }
};
struct EpiRes {
    static constexpr bool PERM = false, AFTER_DRAIN = false;
    const float* xold_c; const float* xold_l;
    float* X;
    const float* gate;
    const float* g; const float* scale;
    bf16_t* XS; float* ssq; int row_off;
    DEV void operator()(const f32x4 (&acc)[2][2][4][2], const pg8::Unit& u, int wr, int wc, int fr, int fq) const {
        const int row0 = row_off + u.pm * 256, b9 = row_b9(row0);
        const int col0 = u.pn * 256 + wc * 32 + 4 * fq;
        f32x4 gv[2][2], gs[2][2];
#pragma unroll
        for (int bj = 0; bj < 2; ++bj)
#pragma unroll
            for (int n = 0; n < 2; ++n) {
                const int c = col0 + bj * 128 + n * 16;
                gv[bj][n] = *(const GAS f32x4*)(gate + (size_t)b9 * 6144 + c);
                if (g) { const f32x4 gg = *(const GAS f32x4*)(g + c), sc = *(const GAS f32x4*)(scale + (size_t)b9 * 6144 + c); gs[bj][n] = gg * (sc + 1.0f); }
                else gs[bj][n] = (f32x4){0.f, 0.f, 0.f, 0.f};
            }
        const float* xo = (row0 < NCTX) ? xold_c : (xold_l - (size_t)NCTX * DM);
#pragma unroll
        for (int ai = 0; ai < 2; ++ai)
#pragma unroll
            for (int m = 0; m < 4; ++m) {
                const int r = row0 + ai * 128 + wr * 64 + m * 16 + fr;
                float ss = 0.f;
#pragma unroll
                for (int bj = 0; bj < 2; ++bj)
#pragma unroll
                    for (int n = 0; n < 2; ++n) {
                        const size_t off = (size_t)r * DM + col0 + bj * 128 + n * 16;
                        const f32x4 xv = *(const GAS f32x4*)(xo + off);
                        const f32x4 xn = xv + gv[bj][n] * acc[ai][bj][m][n];
                        *(GAS f32x4*)(X + off) = xn;
                        ss += (xn[0] * xn[0] + xn[1] * xn[1]) + (xn[2] * xn[2] + xn[3] * xn[3]);
                        if (g) { const f32x4 y = xn * gs[bj][n]; u32x2 w; w.x = pk2(y[0], y[1]); w.y = pk2(y[2], y[3]); *(GAS u32x2*)(XS + off) = w; }
                    }
                ss += __shfl_xor(ss, 16); ss += __shfl_xor(ss, 32);
                if (fq == 0) unsafeAtomicAdd(ssq + r, ss);
            }
    }
};
struct EpiF {
    static constexpr bool PERM = true, AFTER_DRAIN = false;
    bf16_t* OB; int rowbase; int nseq;
    DEV void operator()(const f32x4 (&acc)[2][2][4][2], const pg8::Unit& u, int wr, int wc, int fr, int fq) const {
        const int col0 = 768 + wc * 32 + 8 * fq;
#pragma unroll
        for (int ai = 0; ai < 2; ++ai)
#pragma unroll
            for (int m = 0; m < 4; ++m) {
                const int np = u.pm * 256 + ai * 128 + wr * 64 + m * 16 + fr;
                GAS bf16_t* rowp = (GAS bf16_t*)OB + (size_t)(rowbase + u.pn * nseq + np) * DM + col0;
#pragma unroll
                for (int bj = 0; bj < 2; ++bj) {
                    const f32x4 v0 = acc[ai][bj][m][0], v1 = acc[ai][bj][m][1];
                    u32x4 w; w.x = pk2(v0[0], v0[1]); w.y = pk2(v0[2], v0[3]); w.z = pk2(v1[0], v1[1]); w.w = pk2(v1[2], v1[3]);
                    *(GAS u32x4*)(rowp + bj * 128) = w;
                }
            }
    }
};

DEV void transpose_item(const float* W, int K, int N, bf16_t* WT, int row_off, LAS float* scr, int item, int lane) {
    const int nblk = N / 32, kb = item / nblk, nb = item % nblk, k0 = 64 * kb, n0 = 32 * nb;
#pragma unroll 8
    for (int i = 0; i < 32; ++i) { const int kk = 2 * i + (lane >> 5); scr[kk * 33 + (lane & 31)] = W[(size_t)(k0 + kk) * N + n0 + (lane & 31)]; }
    asm volatile("s_waitcnt lgkmcnt(0)" ::: "memory");
    const int c = lane & 7;
#pragma unroll
    for (int j = 0; j < 4; ++j) { const int n = (lane >> 3) + 8 * j; const LAS float* s = scr + (8 * c) * 33 + n;
        u32x4 o; o.x = pk2(s[0 * 33], s[1 * 33]); o.y = pk2(s[2 * 33], s[3 * 33]); o.z = pk2(s[4 * 33], s[5 * 33]); o.w = pk2(s[6 * 33], s[7 * 33]);
        *(u32x4*)(WT + (size_t)(row_off + n0 + n) * K + k0 + 8 * c) = o; }
    asm volatile("s_waitcnt lgkmcnt(0)" ::: "memory");
}
DEV void convert_weights(const Args& a, LAS unsigned char* lds, int l, int mask, int gw, int NGW, int wave, int lane) {
    LAS float* scr = (LAS float*)(lds + wave * 16384);
    unsigned char* ws = a.ws;
    const int n_in = (mask & 1) ? 16 * 67 : 0, n_uk = (mask & 2) ? 2 * 12 : 0, n_out = (mask & 4) ? 16 * 32 : 0, n_up = (mask & 8) ? 16 * 176 : 0, n_dn = (mask & 16) ? 44 * 32 : 0;
    const int total = n_in + 2 * n_uk + n_out + n_up + n_dn;
    for (int it = gw; it < total; it += NGW) {
        int r = it;
        if (r < n_in) { transpose_item(a.in[I_WIN] + (size_t)l * DM * INC, DM, INC, (bf16_t*)(ws + WS_WIN), 0, scr, r, lane); continue; } r -= n_in;
        if (r < n_uk) { transpose_item(a.in[I_WUK] + (size_t)l * 128 * 384, 128, 384, (bf16_t*)(ws + WS_WUKV), 0, scr, r, lane); continue; } r -= n_uk;
        if (r < n_uk) { transpose_item(a.in[I_WUV] + (size_t)l * 128 * 384, 128, 384, (bf16_t*)(ws + WS_WUKV), 384, scr, r, lane); continue; } r -= n_uk;
        if (r < n_out) { transpose_item(a.in[I_WOUT] + (size_t)l * DM * DM, DM, DM, (bf16_t*)(ws + WS_WOUT), 0, scr, r, lane); continue; } r -= n_out;
        if (r < n_up) { transpose_item(a.in[I_WUP] + (size_t)l * DM * UPC, DM, UPC, (bf16_t*)(ws + WS_WUP), 0, scr, r, lane); continue; } r -= n_up;
        transpose_item(a.in[I_WDOWN] + (size_t)l * DFF * DM, DFF, DM, (bf16_t*)(ws + WS_WDN), 0, scr, r, lane);
    }
}
DEV void gemv9_item(LAS float* vec, LAS float* red, const float* W, int N, int ldw, const float* bias, float* out, int ldo, int n0, int tid) {
    const int w = tid >> 6, lane = tid & 63; const int n = n0 + lane; const bool valid = n < N;
    float acc0 = 0.f, acc1 = 0.f, acc2 = 0.f, acc3 = 0.f, acc4 = 0.f, acc5 = 0.f, acc6 = 0.f, acc7 = 0.f, acc8 = 0.f;
    const float* wp = W + (size_t)(128 * w) * ldw + (valid ? n : 0);
    const LAS float* vp = vec + 128 * w;
#pragma unroll 4
    for (int k = 0; k < 128; ++k) {
        const float wv = valid ? wp[(size_t)k * ldw] : 0.f;
        acc0 += vp[k] * wv; acc1 += vp[1024 + k] * wv; acc2 += vp[2048 + k] * wv; acc3 += vp[3072 + k] * wv; acc4 += vp[4096 + k] * wv;
        acc5 += vp[5120 + k] * wv; acc6 += vp[6144 + k] * wv; acc7 += vp[7168 + k] * wv; acc8 += vp[8192 + k] * wv;
    }
    LAS float* rp = red + (w * 9) * 64 + lane;
    rp[0] = acc0; rp[64] = acc1; rp[128] = acc2; rp[192] = acc3; rp[256] = acc4; rp[320] = acc5; rp[384] = acc6; rp[448] = acc7; rp[512] = acc8;
    __syncthreads();
    for (int idx = tid; idx < 576; idx += 512) {
        const int v = idx >> 6, ln = idx & 63; float s = 0.f;
#pragma unroll
        for (int ww = 0; ww < 8; ++ww) s += red[(ww * 9 + v) * 64 + ln];
        const int nn = n0 + ln;
        out[(size_t)v * ldo + nn] = s + ((bias && nn < N) ? bias[nn] : 0.f);
    }
    __syncthreads();
}
#define XB_TMO      128
#define XB_XCNT(j)  (256  + 64 * (j))
#define XB_XSUB(j)  (1280 + 64 * (j))
#define XB_XGEN(j)  (2304 + 64 * (j))
#define XB_TOP      3328
#define XB_TOPGEN   3392
#define XCD_BAR_WORDS 3456
#define XB_SPIN_CAP (1u << 18)

__device__ __forceinline__ unsigned xb_ld(unsigned* p)              { return __hip_atomic_load(p, __ATOMIC_RELAXED, __HIP_MEMORY_SCOPE_AGENT); }
__device__ __forceinline__ unsigned xb_add(unsigned* p, unsigned v) { return __hip_atomic_fetch_add(p, v, __ATOMIC_RELAXED, __HIP_MEMORY_SCOPE_AGENT); }
__device__ __forceinline__ unsigned xb_xcc_id() { return (unsigned)__builtin_amdgcn_s_getreg((3 << 11) | 20) & 0xFu; }
#define XB_SPIN(cond, bar) do { unsigned _sp = 0; while (cond) { __builtin_amdgcn_s_sleep(1); \
    if ((++_sp & 255u) == 0u) { if (xb_ld(&(bar)[XB_TMO])) break; if (_sp > XB_SPIN_CAP) { atomicAdd(&(bar)[XB_TMO], 1u); break; } } } } while (0)

struct XcdBarrier {
    unsigned* bar; unsigned x;
    volatile LAS unsigned* st;
};

__device__ __forceinline__ XcdBarrier xcd_barrier_post(unsigned* bar, volatile LAS unsigned* st) {
    XcdBarrier b; b.bar = bar; b.x = xb_xcc_id(); b.st = st;
    if (threadIdx.x == 0) (void)xb_add(&bar[XB_XCNT(b.x)], 1u);
    return b;
}
__device__ __forceinline__ void xcd_barrier_complete(unsigned* bar, unsigned x, unsigned& nloc, unsigned& nx) {
    const unsigned G = gridDim.x * gridDim.y * gridDim.z;
    unsigned sum, cnt, mine, sp = 0u;
    for (;;) {
        sum = 0u; cnt = 0u; mine = 0u;
#pragma unroll
        for (unsigned j = 0; j < 16; ++j) { const unsigned c = xb_ld(&bar[XB_XCNT(j)]); sum += c; cnt += (c > 0u) ? 1u : 0u; mine = (j == x) ? c : mine; }
        if (sum == G) break;
        __builtin_amdgcn_s_sleep(1);
        if ((++sp & 255u) == 0u) { if (xb_ld(&bar[XB_TMO])) break; if (sp > XB_SPIN_CAP) { atomicAdd(&bar[XB_TMO], 1u); break; } }
    }
    nloc = mine > 0u ? mine : 1u; nx = cnt > 0u ? cnt : 1u;
}

__device__ __forceinline__ void xcd_barrier(const XcdBarrier& b) {
    asm volatile("s_waitcnt vmcnt(0)" ::: "memory");
    __syncthreads();
    if (threadIdx.x == 0) {
        unsigned* bar = b.bar;
        __builtin_amdgcn_s_waitcnt(0);
        unsigned nloc = b.st[0], nx = b.st[1];
        if (nloc == 0u) { xcd_barrier_complete(bar, b.x, nloc, nx); b.st[0] = nloc; b.st[1] = nx; }
        const unsigned old = xb_add(&bar[XB_XSUB(b.x)], 1u);
        const unsigned gen = old / nloc;
        if (old + 1u == (gen + 1u) * nloc) {
            __builtin_amdgcn_fence(__ATOMIC_RELEASE, "agent");
            asm volatile("s_waitcnt vmcnt(0)" ::: "memory");
            const unsigned og = xb_add(&bar[XB_TOP], 1u);
            const unsigned tg = og / nx;
            if (og + 1u == (tg + 1u) * nx) xb_add(&bar[XB_TOPGEN], 1u);
            else XB_SPIN(xb_ld(&bar[XB_TOPGEN]) == tg, bar);
            __builtin_amdgcn_fence(__ATOMIC_ACQUIRE, "agent");
            xb_add(&bar[XB_XGEN(b.x)], 1u);
            asm volatile("s_waitcnt vmcnt(0)" ::: "memory");
        } else {
            XB_SPIN(xb_ld(&bar[XB_XGEN(b.x)]) == gen, bar);
            __builtin_amdgcn_fence(__ATOMIC_ACQUIRE, "agent");
            asm volatile("s_waitcnt vmcnt(0)" ::: "memory");
        }
    }
    __syncthreads();
}

constexpr int B_AROW = 272, B_VROW = 772, B_UROW = 528;
constexpr int B_LDS_A = 0, B_LDS_V = 64 * B_AROW, B_LDS_U = B_LDS_V + 64 * B_VROW, B_LDS_TAB = B_LDS_U + 64 * B_UROW;
static_assert(B_LDS_TAB + 4096 <= RING_BYTES, "phase B LDS");

DEV float rope1(float x, int dd, int t, const LAS f32x2* tab) {
    const float xp = __shfl_xor(x, 8);
    const int pos = (dd < 16) ? (t >> 6) : (t & 63);
    const f32x2 cs = tab[pos * 8 + (dd & 7)];
    return (dd & 8) ? (x * cs.x + xp * cs.y) : (x * cs.x - xp * cs.y);
}

DEV void phase_b(const Args& a, LAS unsigned char* lds, int l, int tid) {
    unsigned char* ws = a.ws;
    const int wave = __builtin_amdgcn_readfirstlane(tid >> 6), lane = tid & 63, fr = lane & 15, fq = lane >> 4;
    const GAS bf16_t* P = (const GAS bf16_t*)(ws + WS_P);
    const GAS bf16_t* WUKV = (const GAS bf16_t*)(ws + WS_WUKV);
    const GAS bf16_t* CS64 = (const GAS bf16_t*)(ws + WS_CS64);
    GAS float* outg = (GAS float*)a.out;
    LAS f32x2* tab = (LAS f32x2*)(lds + B_LDS_TAB);
    {
        const int pos = tid >> 3, f = tid & 7;
        const float inv = __builtin_amdgcn_exp2f(-(float)f * (13.287712379549449f / 8.0f));
        const float ang = (float)pos * inv;
        tab[tid] = (f32x2){cosf(ang), sinf(ang)};
    }
    __syncthreads();
    const GAS float* gkv = (const GAS float*)a.in[I_GKV] + l * 128;
    for (int blk = blockIdx.x; blk < 448; blk += gridDim.x) {
        int kind, r0 = 0, bidx, t0;
        if (blk < 128) { kind = 0; r0 = blk * 64; bidx = r0 >> 8; t0 = r0 & 255; }
        else if (blk < 384) { kind = 1; r0 = NCTX + (blk - 128) * 64; bidx = (r0 - NCTX) >> 11; t0 = (r0 - NCTX) & 2047; }
        else { kind = 2; const int cb = blk - 384; bidx = cb >> 3; t0 = 2048 + 64 * (cb & 7); }
        GAS bf16_t* KM; GAS bf16_t* KD; GAS bf16_t* VMt; GAS bf16_t* VDt; int vt_ld;
        if (kind == 0) { KM = (GAS bf16_t*)(ws + WS_KMC) + (size_t)(bidx * 256 + t0) * 576; KD = (GAS bf16_t*)(ws + WS_KDC) + (size_t)(bidx * 256 + t0) * 384;
                         VMt = (GAS bf16_t*)(ws + WS_VMC) + (size_t)bidx * 6 * 64 * 256 + t0; VDt = (GAS bf16_t*)(ws + WS_VDC) + (size_t)bidx * 6 * 64 * 256 + t0; vt_ld = 256; }
        else { KM = (GAS bf16_t*)(ws + WS_KML) + (size_t)(bidx * 2560 + t0) * 576; KD = (GAS bf16_t*)(ws + WS_KDL) + (size_t)(bidx * 2560 + t0) * 384;
               VMt = (GAS bf16_t*)(ws + WS_VML) + (size_t)bidx * 6 * 64 * 2560 + t0; VDt = (GAS bf16_t*)(ws + WS_VDL) + (size_t)bidx * 6 * 64 * 2560 + t0; vt_ld = 2560; }
        if (kind == 2) {
            for (int i = 0; i < 8; ++i) {
                const int rr = wave * 8 + i;
                const int j = (t0 - 2048) + rr;
                const size_t crow = ((size_t)(bidx * 4 + l)) * 512 + j;
                const f32x2 cv = *(const f32x2*)(a.in[I_CCKV] + crow * 128 + 2 * lane);
                *(LAS unsigned*)(lds + B_LDS_A + rr * B_AROW + lane * 4) = pk2(cv.x, cv.y);
                const float kr = a.in[I_CKROPE][crow * 32 + (lane & 31)];
                const bf16_t krb = f2bf(kr);
                { const int hb = (lane >> 5) * 3;
#pragma unroll
                  for (int h = 0; h < 3; ++h) KM[(size_t)rr * 576 + (hb + h) * 96 + 64 + (lane & 31)] = krb; }
#pragma unroll
                for (int q = 0; q < 6; ++q) {
                    KD[(size_t)rr * 384 + 64 * q + lane] = f2bf(a.in[I_CDK][crow * 384 + 64 * q + lane]);
                    *(LAS bf16_t*)(lds + B_LDS_V + rr * B_VROW + (64 * q + lane) * 2) = f2bf(a.in[I_CDV][crow * 384 + 64 * q + lane]);
                }
            }
        } else {
            const size_t obase = ((size_t)(bidx * 4 + l)) * 256 + t0;
#pragma unroll
            for (int it = 0; it < 2; ++it) {
                const int rr = (tid >> 4) + 32 * it, cj = tid & 15;
                const u32x4 w = *(const GAS u32x4*)(P + (size_t)(r0 + rr) * INP + 576 + 8 * cj);
                float x[8]; x[0] = bf2f(w.x & 0xffffu); x[1] = bf2f(w.x >> 16); x[2] = bf2f(w.y & 0xffffu); x[3] = bf2f(w.y >> 16);
                x[4] = bf2f(w.z & 0xffffu); x[5] = bf2f(w.z >> 16); x[6] = bf2f(w.w & 0xffffu); x[7] = bf2f(w.w >> 16);
                float ss = 0.f;
#pragma unroll
                for (int j = 0; j < 8; ++j) ss += x[j] * x[j];
                ss += __shfl_xor(ss, 1); ss += __shfl_xor(ss, 2); ss += __shfl_xor(ss, 4); ss += __shfl_xor(ss, 8);
                const float rs = rsqrtf(ss * (1.0f / 128.0f) + EPS);
                const f32x4 ga = *(const GAS f32x4*)(gkv + 8 * cj), gb = *(const GAS f32x4*)(gkv + 8 * cj + 4);
                x[0] *= rs * ga[0]; x[1] *= rs * ga[1]; x[2] *= rs * ga[2]; x[3] *= rs * ga[3]; x[4] *= rs * gb[0]; x[5] *= rs * gb[1]; x[6] *= rs * gb[2]; x[7] *= rs * gb[3];
                u32x4 o; o.x = pk2(x[0], x[1]); o.y = pk2(x[2], x[3]); o.z = pk2(x[4], x[5]); o.w = pk2(x[6], x[7]);
                *(LAS u32x4*)(lds + B_LDS_A + rr * B_AROW + cj * 16) = o;
                if (kind == 0) { GAS float* op = outg + OUT_CKV + (obase + rr) * 128 + 8 * cj; *(GAS f32x4*)op = (f32x4){x[0], x[1], x[2], x[3]}; *(GAS f32x4*)(op + 4) = (f32x4){x[4], x[5], x[6], x[7]}; }
            }
#pragma unroll 2
            for (int c = tid; c < 64 * 268; c += 512) {
                const int rr = c / 268, ch = c - rr * 268;
                if (ch >= 72 && ch < 88) continue;
                if (kind == 0 && (ch < 72 || (ch >= 92 && ch < 140))) continue;
                const int r = r0 + rr, t = t0 + rr;
                u32x4 w = *(const GAS u32x4*)(P + (size_t)r * INP + 8 * ch);
                const bool ropeable = (ch < 72) ? ((ch % 12) >= 8) : (ch < 188);
                if (kind == 1 && ropeable) {
                    const int j = ch & 3;
                    const int pos = (j < 2) ? (t >> 6) : (t & 63);
                    float x[8]; x[0] = bf2f(w.x & 0xffffu); x[1] = bf2f(w.x >> 16); x[2] = bf2f(w.y & 0xffffu); x[3] = bf2f(w.y >> 16);
                    x[4] = bf2f(w.z & 0xffffu); x[5] = bf2f(w.z >> 16); x[6] = bf2f(w.w & 0xffffu); x[7] = bf2f(w.w >> 16);
                    const float sgn = (j & 1) ? 1.0f : -1.0f;
#pragma unroll
                    for (int i = 0; i < 8; ++i) {
                        const float xp = __builtin_bit_cast(float, __builtin_amdgcn_update_dpp(0, __builtin_bit_cast(int, x[i]), 0xB1, 0xF, 0xF, true));
                        const f32x2 cs = tab[pos * 8 + i];
                        x[i] = x[i] * cs.x + sgn * (xp * cs.y);
                    }
                    w.x = pk2(x[0], x[1]); w.y = pk2(x[2], x[3]); w.z = pk2(x[4], x[5]); w.w = pk2(x[6], x[7]);
                }
                if (ch < 72) { *(GAS u32x4*)((GAS bf16_t*)(ws + WS_QMR) + (size_t)(r - NCTX) * 576 + 8 * ch) = w; }
                else if (ch < 92) { const int j = ch - 88;
#pragma unroll
                    for (int h = 0; h < 6; ++h) *(GAS u32x4*)(KM + (size_t)rr * 576 + h * 96 + 64 + 8 * j) = w;
                    if (kind == 0) { GAS float* op = outg + OUT_KROPE + (obase + rr) * 32 + 8 * j;
                        *(GAS f32x4*)op = (f32x4){bf2f(w.x & 0xffffu), bf2f(w.x >> 16), bf2f(w.y & 0xffffu), bf2f(w.y >> 16)}; *(GAS f32x4*)(op + 4) = (f32x4){bf2f(w.z & 0xffffu), bf2f(w.z >> 16), bf2f(w.w & 0xffffu), bf2f(w.w >> 16)}; } }
                else if (ch < 140) { *(GAS u32x4*)((GAS bf16_t*)(ws + WS_QDR) + (size_t)(r - NCTX) * 384 + 8 * (ch - 92)) = w; }
                else if (ch < 188) { const int e = ch - 140; *(GAS u32x4*)(KD + (size_t)rr * 384 + 8 * e) = w;
                    if (kind == 0) { GAS float* op = outg + OUT_DK + (obase + rr) * 384 + 8 * e;
                        *(GAS f32x4*)op = (f32x4){bf2f(w.x & 0xffffu), bf2f(w.x >> 16), bf2f(w.y & 0xffffu), bf2f(w.y >> 16)}; *(GAS f32x4*)(op + 4) = (f32x4){bf2f(w.z & 0xffffu), bf2f(w.z >> 16), bf2f(w.w & 0xffffu), bf2f(w.w >> 16)}; } }
                else if (ch < 236) { const int e = ch - 188; LAS unsigned* vp = (LAS unsigned*)(lds + B_LDS_V + rr * B_VROW + e * 16); vp[0] = w.x; vp[1] = w.y; vp[2] = w.z; vp[3] = w.w;
                    if (kind == 0) { GAS float* op = outg + OUT_DV + (obase + rr) * 384 + 8 * e;
                        *(GAS f32x4*)op = (f32x4){bf2f(w.x & 0xffffu), bf2f(w.x >> 16), bf2f(w.y & 0xffffu), bf2f(w.y >> 16)}; *(GAS f32x4*)(op + 4) = (f32x4){bf2f(w.z & 0xffffu), bf2f(w.z >> 16), bf2f(w.w & 0xffffu), bf2f(w.w >> 16)}; } }
                else { *(LAS u32x4*)(lds + B_LDS_U + rr * B_UROW + (ch - 236) * 16) = w; }
            }
        }
        __syncthreads();
#pragma unroll 1
        for (int nt = 0; nt < 6; ++nt) {
            const int c0 = 96 * wave + 16 * nt;
            bf16x8 bw[4];
#pragma unroll
            for (int kk = 0; kk < 4; ++kk) bw[kk] = *(const GAS bf16x8*)(WUKV + (size_t)(c0 + fr) * 128 + 32 * kk + 8 * fq);
#pragma unroll
            for (int mt = 0; mt < 4; ++mt) {
                f32x4 acc = {0.f, 0.f, 0.f, 0.f};
#pragma unroll
                for (int kk = 0; kk < 4; ++kk) {
                    const bf16x8 af = *(const LAS bf16x8*)(lds + B_LDS_A + (16 * mt + fr) * B_AROW + (32 * kk + 8 * fq) * 2);
                    acc = (wave < 4) ? mfma16(bw[kk], af, acc) : mfma16(af, bw[kk], acc);
                }
                u32x2 w; w.x = pk2(acc[0], acc[1]); w.y = pk2(acc[2], acc[3]);
                if (wave < 4) { const int h = c0 >> 6, d = (c0 & 63) + 4 * fq; *(GAS u32x2*)(KM + (size_t)(16 * mt + fr) * 576 + h * 96 + d) = w; }
                else { const int col = c0 - 384 + fr, h = col >> 6, dv = col & 63; *(GAS u32x2*)(VMt + (size_t)(h * 64 + dv) * vt_ld + 16 * mt + 4 * fq) = w; }
            }
        }
        if (kind != 2) {
            const int g = wave >> 1, nseq = (kind == 0) ? 256 : 2048, ldk = 2 * nseq;
            GAS bf16_t* FB = (kind == 0) ? (GAS bf16_t*)(ws + WS_FBC) : (GAS bf16_t*)(ws + WS_FBL);
#pragma unroll 1
            for (int nt = 0; nt < 4; ++nt) {
                const int cc0 = 16 * ((wave & 1) * 4 + nt);
                bf16x8 bw[2];
#pragma unroll
                for (int kk = 0; kk < 2; ++kk) bw[kk] = *(const GAS bf16x8*)(CS64 + (size_t)(cc0 + fr) * 64 + 32 * kk + 8 * fq);
                const int cc = cc0 + fr, cp = cc & 63, koff = (cc >= 64) ? nseq : 0;
                GAS bf16_t* dst = FB + (size_t)(bidx * 256 + g * 64 + cp) * ldk + koff + (t0 & (nseq - 1));
#pragma unroll
                for (int mt = 0; mt < 4; ++mt) {
                    f32x4 acc = {0.f, 0.f, 0.f, 0.f};
#pragma unroll
                    for (int kk = 0; kk < 2; ++kk) {
                        const bf16x8 af = *(const LAS bf16x8*)(lds + B_LDS_U + (16 * mt + fr) * B_UROW + (64 * g + 32 * kk + 8 * fq) * 2);
                        acc = mfma16(af, bw[kk], acc);
                    }
                    u32x2 w; w.x = pk2(acc[0], acc[1]); w.y = pk2(acc[2], acc[3]);
                    *(GAS u32x2*)(dst + 16 * mt + 4 * fq) = w;
                }
            }
        }
#pragma unroll 4
        for (int q = 0; q < 48; ++q) {
            const int cr = 48 * wave + q;
            const bf16_t v = *(const LAS bf16_t*)(lds + B_LDS_V + lane * B_VROW + cr * 2);
            VDt[(size_t)cr * vt_ld + lane] = v;
        }
        __syncthreads();
    }
}

constexpr int AT_VROW = 136;
template <bool DIFF> struct AttnCfg {
    static constexpr int ND = DIFF ? 4 : 6;
    static constexpr int NM = DIFF ? 2 : 1;
    static constexpr int NDM = DIFF ? 2 : 6;
    static constexpr int KROW = DIFF ? 144 : 208;
    static constexpr int KT = 64 * KROW;
    static constexpr int CPR = 2 * ND;
    static constexpr int NKC = 64 * CPR;
};
constexpr int AT_LDS_K = 0, AT_LDS_V = 2 * 64 * 208, AT_LDS_SCR = AT_LDS_V + 2 * 64 * AT_VROW;
static_assert(AT_LDS_SCR + 2048 <= RING_BYTES, "attention LDS");

DEV float vmax3(float a, float b, float c) { float r; asm("v_max3_f32 %0, %1, %2, %3" : "=v"(r) : "v"(a), "v"(b), "v"(c)); return r; }
template <bool DIFF>
DEV void attn_unit(LAS unsigned char* lds, const bf16_t* Qa, int qa_ld, const bf16_t* Qb, int qb_ld, const bf16_t* Kp, int k_ld,
                   const bf16_t* Vt, int vt_ld, int nt_main, int nt_total, bf16_t* Oout, float cscale, float lam, const float* gsub, float subscale, int tid) {
    typedef AttnCfg<DIFF> C;
    const int wave = __builtin_amdgcn_readfirstlane(tid >> 6), lane = tid & 63, l31 = lane & 31, hi = lane >> 5;
    LAS float* scr = (LAS float*)(lds + AT_LDS_SCR) + wave * 64;
    const int kkey0 = tid / C::CPR, kpart0 = tid % C::CPR;
    const int kc1 = tid + 512; const bool has1 = kc1 < C::NKC; const int kkey1 = kc1 / C::CPR, kpart1 = kc1 % C::CPR;
    const int vdv = tid >> 3, vpart = tid & 7;
    const GAS bf16_t* kg0 = (const GAS bf16_t*)Kp + (size_t)kkey0 * k_ld + kpart0 * 8;
    const GAS bf16_t* kg1 = (const GAS bf16_t*)Kp + (size_t)kkey1 * k_ld + kpart1 * 8;
    const GAS bf16_t* vg = (const GAS bf16_t*)Vt + (size_t)vdv * vt_ld + vpart * 8;
    const int kl0 = kkey0 * C::KROW + kpart0 * 16, kl1 = kkey1 * C::KROW + kpart1 * 16, vl = vdv * AT_VROW + vpart * 16;
    u32x4 kr0, kr1 = {0, 0, 0, 0}, vr;
    bf16x8 qf[C::ND];
    { const GAS bf16_t* qp = (const GAS bf16_t*)Qa + (size_t)(32 * wave + l31) * qa_ld + 8 * hi;
#pragma unroll
      for (int d = 0; d < C::ND; ++d) qf[d] = *(const GAS bf16x8*)(qp + 16 * d); }
    kr0 = *(const GAS u32x4*)kg0; if (has1) kr1 = *(const GAS u32x4*)kg1; vr = *(const GAS u32x4*)vg;
    *(LAS u32x4*)(lds + AT_LDS_K + kl0) = kr0; if (has1) *(LAS u32x4*)(lds + AT_LDS_K + kl1) = kr1;
    *(LAS u32x2*)(lds + AT_LDS_V + vl) = (u32x2){vr.x, vr.y}; *(LAS u32x2*)(lds + AT_LDS_V + vl + 8) = (u32x2){vr.z, vr.w};
    __syncthreads();
    f32x16 O[C::NM][2];
    float mref[C::NM], lsum[C::NM];
#pragma unroll
    for (int mp = 0; mp < C::NM; ++mp) { mref[mp] = 0.f; lsum[mp] = 0.f;
#pragma unroll
        for (int r = 0; r < 16; ++r) { O[mp][0][r] = 0.f; O[mp][1][r] = 0.f; } }
#pragma unroll 1
    for (int t = 0; t < nt_total; ++t) {
        const int cur = t & 1;
        const bool more = (t + 1) < nt_total;
        if (more) {
            const size_t ko = (size_t)(t + 1) * 64 * k_ld;
            kr0 = *(const GAS u32x4*)(kg0 + ko); if (has1) kr1 = *(const GAS u32x4*)(kg1 + ko);
            vr = *(const GAS u32x4*)(vg + (t + 1) * 64);
        }
        if (t == nt_main) {
            const GAS bf16_t* qp = (const GAS bf16_t*)Qb + (size_t)(32 * wave + l31) * qb_ld + 8 * hi;
#pragma unroll
            for (int d = 0; d < C::ND; ++d) qf[d] = *(const GAS bf16x8*)(qp + 16 * d);
        }
        const LAS unsigned char* Kb = lds + AT_LDS_K + cur * C::KT;
        const LAS unsigned char* Vb = lds + AT_LDS_V + cur * (64 * AT_VROW);
        bf16x8 kf[2][C::NDM];
#pragma unroll
        for (int dd = 0; dd < C::NDM; ++dd) {
            kf[0][dd] = *(const LAS bf16x8*)(Kb + l31 * C::KROW + dd * 32 + hi * 16);
            kf[1][dd] = *(const LAS bf16x8*)(Kb + (32 + l31) * C::KROW + dd * 32 + hi * 16);
        }
        __builtin_amdgcn_sched_barrier(0);
        bf16x8 vf[4][2];
#pragma unroll
        for (int mp = 0; mp < C::NM; ++mp) {
            f32x16 s0, s1;
#pragma unroll
            for (int r = 0; r < 16; ++r) { s0[r] = 0.f; s1[r] = 0.f; }
#pragma unroll
            for (int dd = 0; dd < C::NDM; ++dd) {
                s0 = mfma32(kf[0][dd], qf[mp * C::NDM + dd], s0); s1 = mfma32(kf[1][dd], qf[mp * C::NDM + dd], s1);
            }
            __builtin_amdgcn_sched_barrier(0);
            if (mp == 0) {
#pragma unroll
                for (int j = 0; j < 4; ++j)
#pragma unroll
                    for (int db = 0; db < 2; ++db) {
                        const LAS unsigned char* vp = Vb + (32 * db + l31) * AT_VROW + (32 * (j >> 1) + 16 * (j & 1) + 4 * hi) * 2;
                        const s16x4 lo = *(const LAS s16x4*)vp, hh = *(const LAS s16x4*)(vp + 16);
                        vf[j][db] = (bf16x8){lo[0], lo[1], lo[2], lo[3], hh[0], hh[1], hh[2], hh[3]};
                    }
                if (C::NM > 1) {
#pragma unroll
                    for (int dd = 0; dd < C::NDM; ++dd) {
                        kf[0][dd] = *(const LAS bf16x8*)(Kb + l31 * C::KROW + (C::NDM + dd) * 32 + hi * 16);
                        kf[1][dd] = *(const LAS bf16x8*)(Kb + (32 + l31) * C::KROW + (C::NDM + dd) * 32 + hi * 16);
                    }
                }
                __builtin_amdgcn_sched_barrier(0);
            }
            float ma = vmax3(s0[0], s0[1], s1[0]), mb = vmax3(s0[2], s0[3], s1[1]); ma = vmax3(ma, s1[2], s1[3]);
#pragma unroll
            for (int r = 4; r < 16; r += 4) { ma = vmax3(ma, s0[r], s0[r + 1]); mb = vmax3(mb, s0[r + 2], s0[r + 3]); ma = vmax3(ma, s1[r], s1[r + 1]); mb = vmax3(mb, s1[r + 2], s1[r + 3]); }
            float mx = vmax3(ma, mb, mb);
            mx = vmax3(mx, __shfl_xor(mx, 32), mx);
            const float rm = mx * cscale;
            if (t == 0) mref[mp] = rm;
            else if (__any(rm > mref[mp] + 8.0f)) {
                const float mnew = vmax3(mref[mp], rm, rm);
                const float alpha = __builtin_amdgcn_exp2f(mref[mp] - mnew);
                lsum[mp] *= alpha; mref[mp] = mnew;
                if (hi == 0) scr[l31] = alpha;
                asm volatile("s_waitcnt lgkmcnt(0)" ::: "memory");
#pragma unroll
                for (int g4 = 0; g4 < 4; ++g4) { const f32x4 a4 = *(const LAS f32x4*)(scr + 8 * g4 + 4 * hi);
#pragma unroll
                    for (int j = 0; j < 4; ++j) { O[mp][0][4 * g4 + j] *= a4[j]; O[mp][1][4 * g4 + j] *= a4[j]; } }
                asm volatile("s_waitcnt lgkmcnt(0)" ::: "memory");
            }
            const float nm = -mref[mp];
            float ls = 0.f;
#pragma unroll
            for (int r = 0; r < 16; ++r) { s0[r] = __builtin_amdgcn_exp2f(fmaf(s0[r], cscale, nm)); s1[r] = __builtin_amdgcn_exp2f(fmaf(s1[r], cscale, nm)); ls += s0[r] + s1[r]; }
            lsum[mp] += ls;
            bf16x8 pa[4];
#pragma unroll
            for (int j = 0; j < 4; ++j) {
                u32x4 w;
                if (j < 2) { w.x = pk2(s0[8 * j], s0[8 * j + 1]); w.y = pk2(s0[8 * j + 2], s0[8 * j + 3]); w.z = pk2(s0[8 * j + 4], s0[8 * j + 5]); w.w = pk2(s0[8 * j + 6], s0[8 * j + 7]); }
                else { const int jj = j - 2; w.x = pk2(s1[8 * jj], s1[8 * jj + 1]); w.y = pk2(s1[8 * jj + 2], s1[8 * jj + 3]); w.z = pk2(s1[8 * jj + 4], s1[8 * jj + 5]); w.w = pk2(s1[8 * jj + 6], s1[8 * jj + 7]); }
                pa[j] = __builtin_bit_cast(bf16x8, w);
            }
#pragma unroll
            for (int j = 0; j < 4; ++j)
#pragma unroll
                for (int db = 0; db < 2; ++db) O[mp][db] = mfma32(pa[j], vf[j][db], O[mp][db]);
        }
        if (more) {
            const int nb = cur ^ 1;
            *(LAS u32x4*)(lds + AT_LDS_K + nb * C::KT + kl0) = kr0; if (has1) *(LAS u32x4*)(lds + AT_LDS_K + nb * C::KT + kl1) = kr1;
            *(LAS u32x2*)(lds + AT_LDS_V + nb * (64 * AT_VROW) + vl) = (u32x2){vr.x, vr.y}; *(LAS u32x2*)(lds + AT_LDS_V + nb * (64 * AT_VROW) + vl + 8) = (u32x2){vr.z, vr.w};
        }
        __syncthreads();
    }
    float inv[C::NM][16];
#pragma unroll
    for (int mp = 0; mp < C::NM; ++mp) {
        float lt = lsum[mp]; lt += __shfl_xor(lt, 32);
        if (hi == 0) scr[l31] = 1.0f / lt;
        asm volatile("s_waitcnt lgkmcnt(0)" ::: "memory");
#pragma unroll
        for (int g4 = 0; g4 < 4; ++g4) { const f32x4 a4 = *(const LAS f32x4*)(scr + 8 * g4 + 4 * hi);
#pragma unroll
            for (int j = 0; j < 4; ++j) inv[mp][4 * g4 + j] = a4[j]; }
        asm volatile("s_waitcnt lgkmcnt(0)" ::: "memory");
    }
    GAS bf16_t* ow = (GAS bf16_t*)Oout + (size_t)(32 * wave) * DM;
    if constexpr (!DIFF) {
#pragma unroll
        for (int r = 0; r < 16; ++r) { const int q = (r & 3) + 8 * (r >> 2) + 4 * hi;
#pragma unroll
            for (int db = 0; db < 2; ++db) ow[(size_t)q * DM + 32 * db + l31] = f2bf(O[0][db][r] * inv[0][r]); }
    } else {
        const float gs0 = ((const GAS float*)gsub)[l31] * subscale, gs1 = ((const GAS float*)gsub)[32 + l31] * subscale;
#pragma unroll
        for (int r = 0; r < 16; ++r) { const int q = (r & 3) + 8 * (r >> 2) + 4 * hi;
            const float o0 = O[0][0][r] * inv[0][r] - lam * (O[1][0][r] * inv[1][r]);
            const float o1 = O[0][1][r] * inv[0][r] - lam * (O[1][1][r] * inv[1][r]);
            float ss = o0 * o0 + o1 * o1;
#pragma unroll
            for (int o = 1; o < 32; o <<= 1) ss += __shfl_xor(ss, o);
            const float rs = rsqrtf(ss * (1.0f / 64.0f) + EPS);
            ow[(size_t)q * DM + l31] = f2bf(o0 * rs * gs0); ow[(size_t)q * DM + 32 + l31] = f2bf(o1 * rs * gs1); }
    }
}

DEV void load8(const GAS bf16_t* p, float (&v)[8]) {
    const u32x4 w = *(const GAS u32x4*)p;
    v[0] = bf2f(w.x & 0xffffu); v[1] = bf2f(w.x >> 16); v[2] = bf2f(w.y & 0xffffu); v[3] = bf2f(w.y >> 16);
    v[4] = bf2f(w.z & 0xffffu); v[5] = bf2f(w.z >> 16); v[6] = bf2f(w.w & 0xffffu); v[7] = bf2f(w.w >> 16);
}
DEV void phase_f(const Args& a, int l, int nrows, int seqlen, int tid) {
    const GAS bf16_t* U = (const GAS bf16_t*)(a.ws + WS_U);
    GAS bf16_t* ACT = (GAS bf16_t*)(a.ws + WS_ACT);
    const GAS float* wc = (const GAS float*)a.in[I_WCONV] + (size_t)l * 3 * UPC;
    const int nitems = (nrows / 8) * 352;
    for (int it = blockIdx.x * 512 + tid; it < nitems; it += gridDim.x * 512) {
        const int rb = it / 352, j8 = it - rb * 352, r0 = rb * 8, c0 = j8 * 8;
        float wg[3][8], wv[3][8];
#pragma unroll
        for (int k = 0; k < 3; ++k) {
            const f32x4 g0 = *(const GAS f32x4*)(wc + k * UPC + c0), g1 = *(const GAS f32x4*)(wc + k * UPC + c0 + 4);
            const f32x4 v0 = *(const GAS f32x4*)(wc + k * UPC + DFF + c0), v1 = *(const GAS f32x4*)(wc + k * UPC + DFF + c0 + 4);
#pragma unroll
            for (int j = 0; j < 4; ++j) { wg[k][j] = g0[j]; wg[k][4 + j] = g1[j]; wv[k][j] = v0[j]; wv[k][4 + j] = v1[j]; }
        }
        float pg[8], pv[8], cg_[8], cv[8], ng[8], nv[8];
        const bool hasp = (r0 % seqlen) != 0, hasn = ((r0 + 8) % seqlen) != 0;
        if (hasp) { load8(U + (size_t)(r0 - 1) * UPC + c0, pg); load8(U + (size_t)(r0 - 1) * UPC + DFF + c0, pv); }
        else {
#pragma unroll
            for (int j = 0; j < 8; ++j) { pg[j] = 0.f; pv[j] = 0.f; } }
        load8(U + (size_t)r0 * UPC + c0, cg_); load8(U + (size_t)r0 * UPC + DFF + c0, cv);
#pragma unroll
        for (int i = 0; i < 8; ++i) {
            const int r = r0 + i;
            if (i < 7 || hasn) { load8(U + (size_t)(r + 1) * UPC + c0, ng); load8(U + (size_t)(r + 1) * UPC + DFF + c0, nv); }
            else {
#pragma unroll
                for (int j = 0; j < 8; ++j) { ng[j] = 0.f; nv[j] = 0.f; } }
            float o[8];
#pragma unroll
            for (int j = 0; j < 8; ++j) {
                const float gt = wg[0][j] * pg[j] + wg[1][j] * cg_[j] + wg[2][j] * ng[j];
                const float vl = wv[0][j] * pv[j] + wv[1][j] * cv[j] + wv[2][j] * nv[j];
                const float sg = gt * __builtin_amdgcn_rcpf(1.0f + __expf(-gt));
                o[j] = sg * vl;
            }
            u32x4 w; w.x = pk2(o[0], o[1]); w.y = pk2(o[2], o[3]); w.z = pk2(o[4], o[5]); w.w = pk2(o[6], o[7]);
            *(GAS u32x4*)(ACT + (size_t)r * DFF + c0) = w;
#pragma unroll
            for (int j = 0; j < 8; ++j) { pg[j] = cg_[j]; pv[j] = cv[j]; cg_[j] = ng[j]; cv[j] = nv[j]; }
        }
    }
}

struct ShiftOrder {
    pg8::StaticOrder S;
    __device__ void init(int M, int N, int G, int c) { S.init(M, N, G, c); }
    __device__ bool next(int i, pg8::Unit& u) const { return S.next(i, u); }
    DEV void a_ready(const pg8::Unit&) const {}
    DEV void done(const pg8::Unit&) const {}
};

#ifndef NREP_SYNC
#define NREP_SYNC 1
#endif
#ifndef NREP_P
#define NREP_P 1
#endif
#ifndef NREP_A
#define NREP_A 1
#endif
#ifndef NREP_B
#define NREP_B 1
#endif
#ifndef NREP_C
#define NREP_C 1
#endif
#ifndef NREP_E
#define NREP_E 1
#endif
#ifndef NREP_F
#define NREP_F 1
#endif
__global__ void __launch_bounds__(512, 2) mega_fwd(Args a) {
    extern __shared__ __attribute__((aligned(16))) unsigned char lds_raw[];
    LAS unsigned char* lds = (LAS unsigned char*)lds_raw;
    cg::grid_group grid = cg::this_grid();
    const int G = gridDim.x, bid = blockIdx.x;
#define PH_LOCALS \
    unsigned char* ws = a.ws; asm volatile("" : "+s"(ws)); \
    int tid = threadIdx.x; asm volatile("" : "+v"(tid)); \
    const int lane = tid & 63, wave = __builtin_amdgcn_readfirstlane(tid >> 6); \
    const int gw = bid * 8 + wave, NGW = G * 8, gt = bid * 512 + tid, NGT = G * 512; \
    float* MOD = (float*)(ws + WS_MOD); float* BIN = (float*)(ws + WS_BIN); float* BUP = (float*)(ws + WS_BUP); float* SSQ = (float*)(ws + WS_SSQ); \
    bf16_t* XS = (bf16_t*)(ws + WS_XS); bf16_t* Pb = (bf16_t*)(ws + WS_P); bf16_t* OB = (bf16_t*)(ws + WS_OB); \
    unsigned* CTL = (unsigned*)(ws + WS_CTL); \
    (void)lane; (void)wave; (void)gw; (void)NGW; (void)gt; (void)NGT; (void)MOD; (void)BIN; (void)BUP; (void)SSQ; (void)XS; (void)Pb; (void)OB; (void)CTL;
    const bool one = (a.ph_hi - a.ph_lo) > 1;
    if (threadIdx.x < 16) ((LAS unsigned*)(lds + LDS_MISC))[threadIdx.x] = 0u;
    __syncthreads();
    XcdBarrier xbar; xbar.bar = (unsigned*)(a.ws + WS_CTL) + 16384; xbar.x = 0; xbar.st = nullptr;
    if (one) xbar = xcd_barrier_post((unsigned*)(a.ws + WS_CTL) + 16384, (volatile LAS unsigned*)(lds + LDS_MISC + 32));
    int ph = 0;
#define PH_BEGIN if (ph >= a.ph_lo && ph < a.ph_hi) { PH_LOCALS
#define PH_END   if (one && ph + 1 < a.ph_hi) { if (ph == 0) grid.sync(); else { for (int rs_ = 0; rs_ < NREP_SYNC; ++rs_) xcd_barrier(xbar); } } } ++ph;

    PH_BEGIN
#ifndef SKIP_P0
    for (int rep = 0; rep < NREP_P; ++rep) {
        LAS float* vec = (LAS float*)lds; LAS float* red = (LAS float*)(lds + 36864);
        for (int i = tid; i < 9216; i += 512) { const int v = i >> 10, k = i & 1023; const float x = (v == 0) ? a.in[I_CCTX][k] : a.in[I_C][(v - 1) * 1024 + k]; vec[i] = x / (1.0f + __expf(-x)); }
        __syncthreads();
        for (int it = bid; it < 4 * 96; it += G) { const int l = it / 96, nb = it % 96;
            gemv9_item(vec, red, a.in[I_WADA] + (size_t)l * DM * 6144, 6144, 6144, a.in[I_BADA] + l * 6144, MOD + (size_t)l * 9 * 6144, 6144, nb * 64, tid); }
        __syncthreads();
        convert_weights(a, lds, 0, 31, gw, NGW, wave, lane);
        for (int i = gt; i < 9 * MTOT; i += NGT) SSQ[i] = 0.f;
        for (int i = gt; i < 1024; i += NGT) CTL[i] = 0u;
        { unsigned* padp = (unsigned*)(ws + WS_WIN + (size_t)INC * DM * 2); for (int i = gt; i < (INP - INC) * DM / 2; i += NGT) padp[i] = 0u; }
        { bf16_t* T = (bf16_t*)(ws + WS_TLAT);
          for (int i = gt; i < 2048 * 4096; i += NGT) { const int np = i >> 12, k = i & 4095, n = k & 2047; const int m = (np * n) & 2047; const float x = (float)m * (1.0f / 1024.0f);
              const float v = (k < 2048) ? cospif(x) : -sinpif(x); T[i] = f2bf(v * 0.02209708691207961f); } }
        { bf16_t* T = (bf16_t*)(ws + WS_TCTX);
          for (int i = gt; i < 256 * 512; i += NGT) { const int np = i >> 9, k = i & 511, n = k & 255; const int m = (np * n) & 255; const float x = (float)m * (1.0f / 128.0f);
              const float v = (k < 256) ? cospif(x) : -sinpif(x); T[i] = f2bf(v * 0.0625f); } }
        { bf16_t* T = (bf16_t*)(ws + WS_CS64);
          for (int i = gt; i < 128 * 64; i += NGT) { const int cc = i >> 6, c = i & 63, cp = cc & 63; const int m = (cp * c) & 63; const float x = (float)m * (1.0f / 32.0f);
              const float v = (cc < 64) ? cospif(x) : sinpif(x); T[i] = f2bf(v * 0.125f); } }
    }
#endif
    PH_END
    PH_BEGIN
#ifndef SKIP_P1
    for (int rep = 0; rep < NREP_P; ++rep) {
        LAS float* vec = (LAS float*)lds; LAS float* red = (LAS float*)(lds + 36864);
        for (int it = bid; it < 4 * 124; it += G) { const int l = it / 124, j = it % 124; const bool up = j >= 36; const int chunk = up ? 3 : 0;
            for (int i = tid; i < 9216; i += 512) { const int v = i >> 10, k = i & 1023; vec[i] = MOD[((size_t)l * 9 + v) * 6144 + chunk * 1024 + k]; }
            __syncthreads();
            if (!up) gemv9_item(vec, red, a.in[I_WIN] + (size_t)l * DM * INC, INC, INC, nullptr, BIN + (size_t)l * 9 * INP, INP, j * 64, tid);
            else gemv9_item(vec, red, a.in[I_WUP] + (size_t)l * DM * UPC, UPC, UPC, nullptr, BUP + (size_t)l * 9 * UPC, UPC, (j - 36) * 64, tid);
        }
        for (int r = gw; r < MTOT; r += NGW) {
            const float* xr = (r < NCTX) ? a.in[I_XP] + (size_t)r * DM : a.in[I_XS] + (size_t)(r - NCTX) * DM;
            const int b9 = row_b9(r);
            const float* sc = MOD + (size_t)b9 * 6144 + 1024; const float* gm = a.in[I_GMIX];
            float ss = 0.f;
#pragma unroll
            for (int j = 0; j < 4; ++j) { const int c = 4 * lane + 256 * j; const f32x4 x = *(const f32x4*)(xr + c); const f32x4 g = *(const f32x4*)(gm + c), s = *(const f32x4*)(sc + c);
                ss += (x[0] * x[0] + x[1] * x[1]) + (x[2] * x[2] + x[3] * x[3]); const f32x4 y = x * g * (s + 1.0f);
                u32x2 w; w.x = pk2(y[0], y[1]); w.y = pk2(y[2], y[3]); *(u32x2*)(XS + (size_t)r * DM + c) = w; }
            ss = wave_sum(ss);
            if (lane == 0) SSQ[r] = ss;
        }
    }
#endif
    PH_END

#pragma unroll 1
    for (int l = 0; l < NLAYER; ++l) {
        PH_BEGIN
#ifndef SKIP_A
        {
            pg8::Gemm g{XS, (const bf16_t*)(ws + WS_WIN), MTOT, INP, DM}; pg8::StaticOrder S; S.init(MTOT, INP, G, bid);
            EpiA E{Pb, INP, SSQ + (size_t)(2 * l) * MTOT, BIN + (size_t)l * 9 * INP, INP, 0};
            for (int rep = 0; rep < NREP_A; ++rep) pg8::gemm_phase<EpiA, pg8::StaticOrder, true, true>(lds, g, S, E);
        }
#endif
        PH_END
        PH_BEGIN
#ifndef SKIP_B
        {
            if (l > 0) convert_weights(a, lds, l, 16, gw, NGW, wave, lane);
            __syncthreads();
            for (int rep = 0; rep < NREP_B; ++rep) phase_b(a, lds, l, tid);
        }
#endif
        PH_END
        PH_BEGIN
#ifndef SKIP_C
#pragma unroll 1
        for (int rep = 0; rep < NREP_C; ++rep) {
#pragma unroll 1
            for (int f = 0; f < 2; ++f) {
                pg8::Gemm g = (f == 0) ? pg8::Gemm{(const bf16_t*)(ws + WS_TLAT), (const bf16_t*)(ws + WS_FBL), 2048, 2048, 4096}
                                       : pg8::Gemm{(const bf16_t*)(ws + WS_TCTX), (const bf16_t*)(ws + WS_FBC), 256, 8192, 512};
                pg8::StaticOrder S; S.init(g.M, g.N, G, (f == 0) ? bid : (bid + G - 64) % G);
                EpiF E{OB, (f == 0) ? NCTX : 0, (f == 0) ? 2048 : 256};
                pg8::gemm_phase<EpiF, pg8::StaticOrder, true, true>(lds, g, S, E);
            }
            int tid2 = threadIdx.x; asm volatile("" : "+v"(tid2));
            unsigned char* ws2 = a.ws; asm volatile("" : "+s"(ws2));
            float lam, lam_init;
            { const float p1 = ((tid2 & 63) < 32) ? a.in[I_LQ1][l * 32 + (tid2 & 63)] * a.in[I_LK1][l * 32 + (tid2 & 63)] : 0.f, p2 = ((tid2 & 63) < 32) ? a.in[I_LQ2][l * 32 + (tid2 & 63)] * a.in[I_LK2][l * 32 + (tid2 & 63)] : 0.f;
              lam_init = 0.8f - 0.6f * expf(-0.3f * (float)l); lam = expf(wave_sum(p1)) - expf(wave_sum(p2)) + lam_init; }
            const float cm = 0.10206207261596575f * 1.4426950408889634f, cd = 0.17677669529663687f * 1.4426950408889634f;
            LAS int* qslot = (LAS int*)(lds + LDS_MISC);
            unsigned* qctr = (unsigned*)(ws2 + WS_CTL) + 64 * (1 + l + 8 * rep);
            for (;;) {
                __syncthreads();
                if (tid2 == 0) *qslot = (int)atomicAdd(qctr, 1u);
                __syncthreads();
                const int idx = *qslot;
                if (idx >= 1152) break;
                const bool lat = idx < 768;
                const bool diff = lat ? (idx < 384) : (idx < 960);
                int q0, vt_ld, nt_main, nt_total, qa_ld; size_t qa_off, k_off, vt_off; size_t qa_base, k_base, vt_base;
                int h;
                if (lat) { const int j = diff ? idx : idx - 384; const int bh = j >> 3, qb = j & 7, b = bh / 6; h = bh % 6;
                    const int lr0 = b * 2048 + qb * 256; q0 = NCTX + lr0; vt_ld = 2560; nt_main = 32; nt_total = 40;
                    qa_base = diff ? WS_QDR : WS_QMR; qa_ld = diff ? 384 : 576; qa_off = (size_t)lr0 * qa_ld + (diff ? 64 : 96) * h;
                    k_base = diff ? WS_KDL : WS_KML; k_off = (size_t)b * 2560 * (diff ? 384 : 576) + (diff ? 64 : 96) * h;
                    vt_base = diff ? WS_VDL : WS_VML; vt_off = (size_t)(b * 6 + h) * 64 * 2560; }
                else { const int j = diff ? idx - 768 : idx - 960; const int i = j / 6; h = j % 6; q0 = i * 256; vt_ld = 256; nt_main = 4; nt_total = 4;
                    qa_base = WS_P; qa_ld = INP; qa_off = (size_t)q0 * INP + (diff ? 736 + 64 * h : 96 * h);
                    k_base = diff ? WS_KDC : WS_KMC; k_off = (size_t)q0 * (diff ? 384 : 576) + (diff ? 64 : 96) * h;
                    vt_base = diff ? WS_VDC : WS_VMC; vt_off = (size_t)(i * 6 + h) * 64 * 256; }
                const bf16_t* Qa = (const bf16_t*)(ws2 + qa_base) + qa_off;
                const bf16_t* Qb = (const bf16_t*)(ws2 + WS_P) + (size_t)q0 * INP + (diff ? 736 + 64 * h : 96 * h);
                const bf16_t* Kp = (const bf16_t*)(ws2 + k_base) + k_off;
                const bf16_t* Vt = (const bf16_t*)(ws2 + vt_base) + vt_off;
                bf16_t* Oo = (bf16_t*)(ws2 + WS_OB) + (size_t)q0 * DM + (diff ? 384 : 0) + 64 * h;
                if (diff) { int tt = threadIdx.x; asm volatile("" : "+v"(tt)); attn_unit<true>(lds, Qa, qa_ld, Qb, INP, Kp, 384, Vt, vt_ld, nt_main, nt_total, Oo, cd, lam, a.in[I_GSUB] + l * 64, 1.0f - lam_init, tt); }
                else { int tt = threadIdx.x; asm volatile("" : "+v"(tt)); attn_unit<false>(lds, Qa, qa_ld, Qb, INP, Kp, 576, Vt, vt_ld, nt_main, nt_total, Oo, cm, 0.f, nullptr, 0.f, tt); }
            }
        }
#endif
        PH_END
        PH_BEGIN
#ifndef SKIP_D
        {
            pg8::Gemm g{OB, (const bf16_t*)(ws + WS_WOUT), MTOT, DM, DM}; pg8::StaticOrder S; S.init(MTOT, DM, G, bid);
            EpiRes E{(l == 0) ? a.in[I_XP] : a.out, (l == 0) ? a.in[I_XS] : a.out + (size_t)NCTX * DM, a.out, (MOD + (size_t)l * 9 * 6144) + 2 * 1024,
                     a.in[I_GFFN] + l * DM, (MOD + (size_t)l * 9 * 6144) + 4 * 1024, XS, SSQ + (size_t)(2 * l + 1) * MTOT, 0};
            pg8::gemm_phase<EpiRes, pg8::StaticOrder, true, true>(lds, g, S, E);
        }
#endif
        PH_END
#pragma unroll 1
        for (int ch = 0; ch < 2; ++ch) {
            const int row0 = (ch == 0) ? NCTX : 0, Mc = (ch == 0) ? NLAT : NCTX, seqlen = (ch == 0) ? 2048 : 256;
            PH_BEGIN
#ifndef SKIP_E
            {
                if (ch == 1 && l + 1 < NLAYER) { convert_weights(a, lds, l + 1, 7, gw, NGW, wave, lane); __syncthreads(); }
                pg8::Gemm g{XS + (size_t)row0 * DM, (const bf16_t*)(ws + WS_WUP), Mc, UPC, DM}; pg8::StaticOrder S; S.init(Mc, UPC, G, bid);
                EpiA E{(bf16_t*)(ws + WS_U), UPC, SSQ + (size_t)(2 * l + 1) * MTOT, BUP + (size_t)l * 9 * UPC, UPC, row0};
                for (int rep = 0; rep < NREP_E; ++rep) pg8::gemm_phase<EpiA, pg8::StaticOrder, true, true>(lds, g, S, E);
            }
#endif
            PH_END
            PH_BEGIN
#ifndef SKIP_F
            { for (int rep = 0; rep < NREP_F; ++rep) phase_f(a, l, Mc, seqlen, tid); }
#endif
            PH_END
            PH_BEGIN
#ifndef SKIP_G
            {
                if (ch == 1 && l + 1 < NLAYER) { convert_weights(a, lds, l + 1, 8, gw, NGW, wave, lane); __syncthreads(); }
                const bool nxt = (l + 1 < NLAYER);
                pg8::Gemm g{(const bf16_t*)(ws + WS_ACT), (const bf16_t*)(ws + WS_WDN), Mc, DM, DFF}; pg8::StaticOrder S; S.init(Mc, DM, G, bid);
                EpiRes E{a.out, a.out + (size_t)NCTX * DM, a.out, (MOD + (size_t)l * 9 * 6144) + 5 * 1024,
                         nxt ? a.in[I_GMIX] + (l + 1) * DM : nullptr, (MOD + (size_t)l * 9 * 6144) + 9 * 6144 + 1 * 1024, XS, SSQ + (size_t)(nxt ? 2 * l + 2 : 8) * MTOT, row0};
                pg8::gemm_phase<EpiRes, pg8::StaticOrder, true, true>(lds, g, S, E);
            }
#endif
            PH_END
        }
    }
    PH_BEGIN
#ifndef SKIP_FIN
    {
        const float* gf = a.in[I_GFINAL];
        for (int r = gw; r < MTOT; r += NGW) {
            float* xr = a.out + (size_t)r * DM;
            f32x4 x[4]; float ss = 0.f;
#pragma unroll
            for (int j = 0; j < 4; ++j) { x[j] = *(const f32x4*)(xr + 4 * lane + 256 * j); ss += (x[j][0] * x[j][0] + x[j][1] * x[j][1]) + (x[j][2] * x[j][2] + x[j][3] * x[j][3]); }
            ss = wave_sum(ss);
            const float rs = rsqrtf(ss * (1.0f / 1024.0f) + EPS);
#pragma unroll
            for (int j = 0; j < 4; ++j) { const f32x4 g = *(const f32x4*)(gf + 4 * lane + 256 * j); *(f32x4*)(xr + 4 * lane + 256 * j) = x[j] * rs * g; }
        }
    }
#endif
    PH_END
#undef PH_BEGIN
#undef PH_END
}
constexpr int N_PHASES = 2 + NLAYER * 10 + 1;

#ifndef MK_ONE_LAUNCH
#define MK_ONE_LAUNCH 1
#endif
extern "C" void kernel_launch(void* const* d_in, const int* in_sizes, int n_in, void* d_out, int out_size, void* d_ws, size_t ws_size, hipStream_t stream) {
    static int grid = 0;
    if (grid == 0) {
        if (n_in != 26 || ws_size < WS_END) { fprintf(stderr, "kernel_launch: unexpected inputs (n_in %d, ws %zu < %zu)\n", n_in, ws_size, (size_t)WS_END); grid = -1; return; }
        int dev = 0, cus = 0, per_cu = 0;
        hipGetDevice(&dev); hipDeviceGetAttribute(&cus, hipDeviceAttributeMultiprocessorCount, dev);
        if (hipFuncSetAttribute((const void*)mega_fwd, hipFuncAttributeMaxDynamicSharedMemorySize, LDS_BYTES) != hipSuccess) { fprintf(stderr, "kernel_launch: hipFuncSetAttribute failed\n"); grid = -1; return; }
        if (hipOccupancyMaxActiveBlocksPerMultiprocessor(&per_cu, (const void*)mega_fwd, 512, LDS_BYTES) != hipSuccess || per_cu < 1) { fprintf(stderr, "kernel_launch: occupancy query gave %d\n", per_cu); per_cu = 1; }
        (void)hipGetLastError();
        grid = cus * 1;
    }
    if (grid < 0) return;
    if (hipMemsetAsync((char*)d_ws + WS_CTL, 0, 1 << 20, stream) != hipSuccess) { fprintf(stderr, "kernel_launch: memset failed\n"); return; }
    Args a{};
    for (int i = 0; i < 26; ++i) a.in[i] = (const float*)d_in[i];
    a.out = (float*)d_out; a.ws = (unsigned char*)d_ws;
#if MK_ONE_LAUNCH
    a.ph_lo = 0; a.ph_hi = N_PHASES;
    void* args[] = {&a};
    hipError_t e = hipLaunchCooperativeKernel((const void*)mega_fwd, dim3(grid), dim3(512), args, LDS_BYTES, stream);
    if (e != hipSuccess) fprintf(stderr, "cooperative launch failed: %s (grid %d)\n", hipGetErrorString(e), grid);
#else
    for (int p = 0; p < N_PHASES; ++p) { a.ph_lo = p; a.ph_hi = p + 1; hipLaunchKernelGGL(mega_fwd, dim3(grid), dim3(512), LDS_BYTES, stream, a); }
#endif
}
```

```cpp
#include <hip/hip_runtime.h>
#include <hip/hip_cooperative_groups.h>
#include <cstdio>
#include <cstdint>
namespace cg = cooperative_groups;
namespace pg8 {
#define PG8_LAS __attribute__((address_space(3)))
typedef unsigned short bf16_t;
typedef short bf16x8 __attribute__((ext_vector_type(8)));
typedef float f32x4 __attribute__((ext_vector_type(4)));
typedef unsigned u32x4 __attribute__((ext_vector_type(4)));
constexpr int BM = 256, BK = 64, HALF = 128, HTB = HALF * BK * 2  , STAGE_BYTES = 8 * HTB, NXCD = 8, WGM = 8;

__host__ __device__ __forceinline__ int lds_byte(int r, int c) { const int st = (r >> 4) * 2 + (c >> 5), rr = r & 15, cc = c & 31, ob = rr * 64 + cc * 2; return st * 1024 + (ob ^ (((ob >> 9) & 1) << 5)); }
__host__ __device__ __forceinline__ void stage_rc(int b, int& R, int& C) { const int st = b / 1024, sb = b % 1024, swz = sb ^ (((sb >> 9) & 1) << 5); R = (st >> 1) * 16 + swz / 64; C = (st & 1) * 32 + (swz % 64) / 2; }
__host__ __device__ __forceinline__ int perm32(int rho) { const int n = rho >> 4, i = rho & 15; return 8 * (i >> 2) + 4 * n + (i & 3); }

struct Unit { int pm, pn; };
struct Gemm { const bf16_t* A; const bf16_t* Bt; int M, N, K; };

struct StaticOrder {
    int nM, nN, nwg, G, c;
    __host__ __device__ void init(int M, int N, int G_, int c_) { nM = M / BM; nN = N / BM; nwg = nM * nN; G = G_; c = c_; }
    __host__ __device__ bool next(int i, Unit& u) const {
        const long L = (long)i * G + c; if (L >= nwg) return false;
        int wgid = (int)L; { const int q = nwg / NXCD, r = nwg % NXCD, xcd = wgid % NXCD, off = wgid / NXCD; wgid = (xcd < r ? xcd * (q + 1) : r * (q + 1) + (xcd - r) * q) + off; }
        const int nig = WGM * nN, gid = wgid / nig, fm = gid * WGM, gsz = (nM - fm) < WGM ? (nM - fm) : WGM;
        u.pm = fm + ((wgid % nig) % gsz); u.pn = (wgid % nig) / gsz; return true;
    }
    __device__ __forceinline__ void a_ready(const Unit&) const {}
    __device__ __forceinline__ void done(const Unit&) const {}
};

__device__ __forceinline__ unsigned cvt_pk_bf16(float lo, float hi) { unsigned r; asm volatile("v_cvt_pk_bf16_f32 %0, %1, %2" : "=v"(r) : "v"(lo), "v"(hi)); return r; }
typedef float f32x2 __attribute__((ext_vector_type(2)));
__device__ __forceinline__ f32x2 gelu_pk(f32x2 v) {
    const f32x2 av = __builtin_elementwise_abs(v), d = av * 0.2316418882f + 1.0f;
    f32x2 t; t.x = __builtin_amdgcn_rcpf(d.x); t.y = __builtin_amdgcn_rcpf(d.y);
    f32x2 q = t * 0.5307027145f + (-0.7265760135f); q = q * t + 0.7107068705f; q = q * t + (-0.142248368f); q = q * t + 0.127414796f; q = q * t;
    const f32x2 s = (v * v) * (-0.72134752044f);
    f32x2 e; e.x = __builtin_amdgcn_exp2f(s.x); e.y = __builtin_amdgcn_exp2f(s.y);
    const f32x2 m = v * (q * e), r = v - m;
    f32x2 o; o.x = v.x < 0.f ? m.x : r.x; o.y = v.y < 0.f ? m.y : r.y; return o;
}

template <int ACT  > struct EpiBf16 {
    static constexpr bool PERM = true, AFTER_DRAIN = false; static_assert(ACT == 0 || ACT == 1, "EpiBf16: ACT is 0 (none) or 1 (gelu_pk)");
    bf16_t* O; int ldc; const float* bias; int split_cols; size_t split_stride; float scale0;
    __device__ __forceinline__ void operator()(const f32x4 (&acc)[2][2][4][2], const Unit& u, int wr, int wc, int fr, int fq) const {
        const int row0 = u.pm * BM + wr * 64 + fr; int colt = u.pn * BM; bf16_t* base = O;
        float sc = 1.f; if (split_cols) { const int t = colt / split_cols; base += (size_t)t * split_stride; colt -= t * split_cols; if (t == 0) sc = scale0; }
        const int col0 = colt + wc * 32 + 8 * fq, bcol0 = u.pn * BM + wc * 32 + 8 * fq;
        f32x4 bv[2][2];
#pragma unroll
        for (int bj = 0; bj < 2; ++bj)
#pragma unroll
            for (int n = 0; n < 2; ++n) bv[bj][n] = bias ? *(const f32x4*)(bias + bcol0 + bj * HALF + 4 * n) : (f32x4){0.f, 0.f, 0.f, 0.f};
#pragma unroll
        for (int ai = 0; ai < 2; ++ai)
#pragma unroll
            for (int m = 0; m < 4; ++m) { bf16_t* rowp = base + (size_t)(row0 + ai * HALF + m * 16) * ldc + col0;
#pragma unroll
                for (int bj = 0; bj < 2; ++bj) { f32x4 v0 = acc[ai][bj][m][0] + bv[bj][0], v1 = acc[ai][bj][m][1] + bv[bj][1];
                    if (ACT == 1) { f32x2 a = gelu_pk((f32x2){v0[0], v0[1]}), b = gelu_pk((f32x2){v0[2], v0[3]}), c = gelu_pk((f32x2){v1[0], v1[1]}), d = gelu_pk((f32x2){v1[2], v1[3]});
                        v0 = (f32x4){a.x, a.y, b.x, b.y}; v1 = (f32x4){c.x, c.y, d.x, d.y}; }
                    v0 = v0 * sc; v1 = v1 * sc; u32x4 w; w.x = cvt_pk_bf16(v0[0], v0[1]); w.y = cvt_pk_bf16(v0[2], v0[3]); w.z = cvt_pk_bf16(v1[0], v1[1]); w.w = cvt_pk_bf16(v1[2], v1[3]);
                    *(u32x4*)(rowp + bj * HALF) = w; } }
    }
};

struct PanelStats {
    unsigned* xbuf;
    unsigned* cnt;
    unsigned* tmo;
    int ntn; float eps;
    unsigned code;
    __device__ __forceinline__ bool run(const f32x4 (&v)[2][2][4][2], const Unit& u, int wr, int wc, int fr, int fq, PG8_LAS unsigned char* lds, int wid, int lane) const {
        typedef float f32x2v __attribute__((ext_vector_type(2)));
        PG8_LAS f32x2v* P = (PG8_LAS f32x2v*)lds;
        PG8_LAS f32x2v* S = (PG8_LAS f32x2v*)(lds + 8192);
        PG8_LAS unsigned* flag = (PG8_LAS unsigned*)(lds + 8192 + 2048);
#pragma unroll
        for (int ai = 0; ai < 2; ++ai)
#pragma unroll
            for (int m = 0; m < 4; ++m) {
                float s = 0.f;
#pragma unroll
                for (int bj = 0; bj < 2; ++bj)
#pragma unroll
                    for (int n = 0; n < 2; ++n) { const f32x4 x = v[ai][bj][m][n]; s += (x[0] + x[1]) + (x[2] + x[3]); }
                s += __shfl_xor(s, 16); s += __shfl_xor(s, 32);
                const float mw = s * (1.0f / 64.0f); float q = 0.f;
#pragma unroll
                for (int bj = 0; bj < 2; ++bj)
#pragma unroll
                    for (int n = 0; n < 2; ++n) { const f32x4 d = v[ai][bj][m][n] - mw; q += (d[0] * d[0] + d[1] * d[1]) + (d[2] * d[2] + d[3] * d[3]); }
                q += __shfl_xor(q, 16); q += __shfl_xor(q, 32);
                if (fq == 0) P[(ai * HALF + wr * 64 + m * 16 + fr) * 4 + wc] = (f32x2v){mw, q};
            }
        asm volatile("s_waitcnt lgkmcnt(0)" ::: "memory"); __builtin_amdgcn_s_barrier(); asm volatile("" ::: "memory");
#if defined(BROKEN_EXCHANGE_NO_WAIT)
#warning BROKEN CONTROL BUILD: the row-statistics exchange does not wait; results are wrong by design
        if (blockIdx.x >= 64) { const long long t0_ = clock64(); while (clock64() - t0_ < 60000) __builtin_amdgcn_s_sleep(8); }
#endif
        const int row = wid * 32 + (lane & 31);
        if (lane < 32) {
            const f32x2v a = P[row * 4 + 0], b = P[row * 4 + 1], c = P[row * 4 + 2], d = P[row * 4 + 3];
            const float mt = (a.x + b.x + c.x + d.x) * 0.25f;
            const float da = a.x - mt, db = b.x - mt, dc = c.x - mt, dd = d.x - mt;
            const float m2 = (a.y + b.y) + (c.y + d.y) + 64.0f * ((da * da + db * db) + (dc * dc + dd * dd));
            unsigned long long* slot = (unsigned long long*)xbuf + ((size_t)(u.pm * BM + row) * 4 + u.pn);
            __hip_atomic_store(slot, ((unsigned long long)__float_as_uint(m2) << 32) | __float_as_uint(mt), __ATOMIC_RELAXED, __HIP_MEMORY_SCOPE_AGENT);
        }
        asm volatile("s_waitcnt vmcnt(0)" ::: "memory");
        if (lane == 0) __hip_atomic_fetch_add(cnt + 64 * u.pm, 1u, __ATOMIC_RELAXED, __HIP_MEMORY_SCOPE_AGENT);
        if (wid == 0) {
            bool dead = false; const unsigned long long t0 = __builtin_amdgcn_s_memrealtime(); const unsigned want = 8u * (unsigned)ntn;
            for (;;) {
#if defined(BROKEN_EXCHANGE_NO_WAIT)
                break;
#endif
                if ((unsigned)__builtin_amdgcn_readfirstlane(__hip_atomic_load(cnt + 64 * u.pm, __ATOMIC_RELAXED, __HIP_MEMORY_SCOPE_AGENT)) >= want) break;
                if (__builtin_amdgcn_s_memrealtime() - t0 > 2000000ull) {
                    if (lane == 0) { unsigned expect = 0u; __hip_atomic_compare_exchange_strong(tmo + 1, &expect, code | (unsigned)(u.pm & 0xff), __ATOMIC_RELAXED, __ATOMIC_RELAXED, __HIP_MEMORY_SCOPE_AGENT);
                                     __hip_atomic_store(tmo, 1u, __ATOMIC_RELAXED, __HIP_MEMORY_SCOPE_AGENT); }
                    dead = true; break; }
                __builtin_amdgcn_s_sleep(2);
            }
            __builtin_amdgcn_fence(__ATOMIC_ACQUIRE, "agent");
            if (lane == 0) flag[0] = dead ? 1u : 0u;
        }
        asm volatile("s_waitcnt vmcnt(0) lgkmcnt(0)" ::: "memory"); __builtin_amdgcn_s_barrier(); asm volatile("" ::: "memory");
        const bool bad = flag[0] != 0u;
        if (lane < 32) {
            const unsigned long long* slot = (const unsigned long long*)xbuf + (size_t)(u.pm * BM + row) * 4; float mt[4], m2[4]; float ms = 0.f;
#pragma unroll
            for (int t = 0; t < 4; ++t) { if (t < ntn) { const unsigned long long w = __hip_atomic_load(slot + t, __ATOMIC_RELAXED, __HIP_MEMORY_SCOPE_AGENT); mt[t] = __uint_as_float((unsigned)w); m2[t] = __uint_as_float((unsigned)(w >> 32)); } else { mt[t] = 0.f; m2[t] = 0.f; } ms += mt[t]; }
            const float mean = ms / (float)ntn; float q = 0.f;
#pragma unroll
            for (int t = 0; t < 4; ++t) if (t < ntn) { const float dm = mt[t] - mean; q += m2[t] + 256.0f * dm * dm; }
            S[row] = (f32x2v){mean, 1.0f / sqrtf(q / (256.0f * (float)ntn) + eps)};
        }
        asm volatile("s_waitcnt lgkmcnt(0)" ::: "memory"); __builtin_amdgcn_s_barrier(); asm volatile("" ::: "memory");
        return bad;
    }
};
struct EpiLnRes {
    static constexpr bool PERM = false, AFTER_DRAIN = true;
    const float* base; float* out; int ldc; const float* bias; PanelStats st; unsigned poison;
    __device__ __forceinline__ void fused(f32x4 (&acc)[2][2][4][2], const Unit& u, int wr, int wc, int fr, int fq, PG8_LAS unsigned char* lds, int wid, int lane) const {
        typedef float f32x2v __attribute__((ext_vector_type(2)));
        const PG8_LAS f32x2v* S = (const PG8_LAS f32x2v*)(lds + 8192);
        const int col0 = u.pn * BM + wc * 32 + 4 * fq;
#pragma unroll
        for (int bj = 0; bj < 2; ++bj)
#pragma unroll
            for (int n = 0; n < 2; ++n) { const f32x4 bv = bias ? *(const f32x4*)(bias + col0 + bj * HALF + n * 16) : (f32x4){0.f, 0.f, 0.f, 0.f};
#pragma unroll
                for (int ai = 0; ai < 2; ++ai)
#pragma unroll
                    for (int m = 0; m < 4; ++m) acc[ai][bj][m][n] += bv; }
        f32x4 pre[4][2][2];
#pragma unroll
        for (int m = 0; m < 4; ++m) { const size_t off = (size_t)(u.pm * BM + wr * 64 + m * 16 + fr) * ldc + col0;
#pragma unroll
            for (int bj = 0; bj < 2; ++bj)
#pragma unroll
                for (int n = 0; n < 2; ++n) pre[m][bj][n] = *(const f32x4*)(base + off + bj * HALF + n * 16); }
        const bool bad = st.run(acc, u, wr, wc, fr, fq, lds, wid, lane) || poison != 0u;
        const float qnan = __builtin_nanf("");
#pragma unroll
        for (int ai = 0; ai < 2; ++ai)
#pragma unroll
            for (int m = 0; m < 4; ++m) { const int r = ai * HALF + wr * 64 + m * 16 + fr; const f32x2v sr = S[r]; const size_t off = (size_t)(u.pm * BM + r) * ldc + col0;
#pragma unroll
                for (int bj = 0; bj < 2; ++bj)
#pragma unroll
                    for (int n = 0; n < 2; ++n) { const f32x4 bs = ai == 0 ? pre[m][bj][n] : *(const f32x4*)(base + off + bj * HALF + n * 16); f32x4 o = bs + (acc[ai][bj][m][n] - sr.x) * sr.y;
                        if (bad) o = (f32x4){qnan, qnan, qnan, qnan}; *(f32x4*)(out + off + bj * HALF + n * 16) = o; }
                if (m & 1) asm volatile("" ::: "memory"); }
    }
};
struct EpiLnResLn {
    static constexpr bool PERM = false, AFTER_DRAIN = true;
    const float* base; float* out; bf16_t* xn; int ldc; const float* bias; PanelStats st1, st2; unsigned poison;
    __device__ __forceinline__ void fused(f32x4 (&acc)[2][2][4][2], const Unit& u, int wr, int wc, int fr, int fq, PG8_LAS unsigned char* lds, int wid, int lane) const {
        typedef float f32x2v __attribute__((ext_vector_type(2))); typedef unsigned u32x2v __attribute__((ext_vector_type(2)));
        const PG8_LAS f32x2v* S = (const PG8_LAS f32x2v*)(lds + 8192);
        const int col0 = u.pn * BM + wc * 32 + 4 * fq;
#pragma unroll
        for (int bj = 0; bj < 2; ++bj)
#pragma unroll
            for (int n = 0; n < 2; ++n) { const f32x4 bv = bias ? *(const f32x4*)(bias + col0 + bj * HALF + n * 16) : (f32x4){0.f, 0.f, 0.f, 0.f};
#pragma unroll
                for (int ai = 0; ai < 2; ++ai)
#pragma unroll
                    for (int m = 0; m < 4; ++m) acc[ai][bj][m][n] += bv; }
        bool bad = st1.run(acc, u, wr, wc, fr, fq, lds, wid, lane) || poison != 0u;
        const float qnan = __builtin_nanf("");
#pragma unroll
        for (int ai = 0; ai < 2; ++ai)
#pragma unroll
            for (int m = 0; m < 4; ++m) { const int r = ai * HALF + wr * 64 + m * 16 + fr; const f32x2v sr = S[r]; const size_t off = (size_t)(u.pm * BM + r) * ldc + col0;
#pragma unroll
                for (int bj = 0; bj < 2; ++bj)
#pragma unroll
                    for (int n = 0; n < 2; ++n) { const f32x4 bs = *(const f32x4*)(base + off + bj * HALF + n * 16); acc[ai][bj][m][n] = bs + (acc[ai][bj][m][n] - sr.x) * sr.y; }
                asm volatile("" : "+v"(acc[ai][0][m][0]), "+v"(acc[ai][0][m][1]), "+v"(acc[ai][1][m][0]), "+v"(acc[ai][1][m][1]));
                if (m & 1) asm volatile("" ::: "memory"); }
        const bool bad1 = bad;
        bad = st2.run(acc, u, wr, wc, fr, fq, lds, wid, lane) || bad;
#pragma unroll
        for (int ai = 0; ai < 2; ++ai)
#pragma unroll
            for (int m = 0; m < 4; ++m) { const int r = ai * HALF + wr * 64 + m * 16 + fr; const f32x2v sr = S[r]; const size_t off = (size_t)(u.pm * BM + r) * ldc + col0;
#pragma unroll
                for (int bj = 0; bj < 2; ++bj)
#pragma unroll
                    for (int n = 0; n < 2; ++n) { const f32x4 x1 = acc[ai][bj][m][n]; *(f32x4*)(out + off + bj * HALF + n * 16) = bad1 ? (f32x4){qnan, qnan, qnan, qnan} : x1;
                        const f32x4 o = (x1 - sr.x) * sr.y; u32x2v w; w.x = cvt_pk_bf16(o[0], o[1]); w.y = cvt_pk_bf16(o[2], o[3]);
                        if (bad) { w.x = 0x7fc07fc0u; w.y = 0x7fc07fc0u; } *(u32x2v*)(xn + off + bj * HALF + n * 16) = w; }
                asm volatile("" ::: "memory"); }
    }
};

template <class Epi, class Sched, bool ALIGN_EPI = false, bool SP2 = false>
__device__ __forceinline__ void gemm_phase(PG8_LAS unsigned char* lds, const Gemm g, const Sched& S, const Epi& E) {
    int tid = threadIdx.x; asm volatile("" : "+v"(tid));
    const int wid = __builtin_amdgcn_readfirstlane(tid >> 6), lane = tid & 63, wr = wid >> 2, wc = wid & 3, fr = lane & 15, fq = lane >> 4;
    const int K = g.K, nt = K / BK;
    unsigned voffA[2], voffB[2];
#pragma unroll
    for (int i = 0; i < 2; ++i) { int R, C; stage_rc(tid * 16 + i * 8192, R, C); const int Rb = Epi::PERM ? ((R & ~31) + perm32(R & 31)) : R;
        voffA[i] = (unsigned)(R * K + C) * 2u; voffB[i] = (unsigned)(Rb * K + C) * 2u; }
    const size_t kstep = (size_t)(BK * 2);
    const size_t hstep = (size_t)HALF * K * 2;
    const size_t tstep = 2 * hstep;
    const unsigned ldsw = (unsigned)wid * 1024u;
    const int aoff = lds_byte(wr * 64 + fr, fq * 8), boff = lds_byte(wc * 32 + fr, fq * 8);
#define PG8_SA(b, h) (((b) * 2 + (h)) * HTB)
#define PG8_SB(b, h) ((4 + (b) * 2 + (h)) * HTB)
#define PG8_STAGE(bufoff, gbase, voff) do { _Pragma("unroll") for (int _i = 0; _i < 2; ++_i) \
        __builtin_amdgcn_global_load_lds((const unsigned*)((const char*)(gbase) + (voff)[_i]), (PG8_LAS unsigned*)(lds + (bufoff) + ldsw + _i * 8192), 16, 0, 0); } while (0)
#define PG8_LDA(dst, b, h) do { _Pragma("unroll") for (int m = 0; m < 4; ++m) _Pragma("unroll") for (int k = 0; k < 2; ++k) dst[m][k] = *(const PG8_LAS bf16x8*)(lds + PG8_SA(b, h) + aoff + m * 2048 + k * 1024); } while (0)
#define PG8_LDB(dst, b, h) do { _Pragma("unroll") for (int n = 0; n < 2; ++n) _Pragma("unroll") for (int k = 0; k < 2; ++k) dst[n][k] = *(const PG8_LAS bf16x8*)(lds + PG8_SB(b, h) + boff + n * 2048 + k * 1024); } while (0)
#define PG8_MMA(ai, bj, At, Bt) do { __builtin_amdgcn_s_setprio(1); _Pragma("unroll") for (int m = 0; m < 4; ++m) _Pragma("unroll") for (int n = 0; n < 2; ++n) _Pragma("unroll") for (int k = 0; k < 2; ++k) \
        acc[ai][bj][m][n] = __builtin_amdgcn_mfma_f32_16x16x32_bf16(Bt[n][k], At[m][k], acc[ai][bj][m][n], 0, 0, 0); __builtin_amdgcn_s_setprio(0); } while (0)
#define PG8_WAIT_V(n) asm volatile("s_waitcnt vmcnt(" #n ")" ::: "memory")
#define PG8_WAIT_L(n) asm volatile("s_waitcnt lgkmcnt(" #n ")" ::: "memory")
#define PG8_BAR __builtin_amdgcn_s_barrier()
#define PG8_SCHED __builtin_amdgcn_sched_barrier(0)
    Unit cur, nxt; int ui = 0;
    if (!S.next(0, cur)) return;
    f32x4 acc[2][2][4][2];
#pragma unroll
    for (int a = 0; a < 2; ++a)
#pragma unroll
        for (int b = 0; b < 2; ++b)
#pragma unroll
            for (int m = 0; m < 4; ++m)
#pragma unroll
                for (int n = 0; n < 2; ++n) acc[a][b][m][n] = (f32x4){0.f, 0.f, 0.f, 0.f};
    bf16x8 At[4][2], B0[2][2], B1[2][2];
    const char* cA = (const char*)g.A + (size_t)cur.pm * tstep; const char* cB = (const char*)g.Bt + (size_t)cur.pn * tstep;
    S.a_ready(cur);
    if constexpr (SP2) {
        PG8_STAGE(PG8_SB(0, 0), cB, voffB); PG8_STAGE(PG8_SB(0, 1), cB + hstep, voffB); PG8_STAGE(PG8_SA(0, 0), cA, voffA); PG8_STAGE(PG8_SA(0, 1), cA + hstep, voffA);
        if (wr == 1) PG8_BAR;
        PG8_WAIT_V(2); PG8_BAR;
        PG8_STAGE(PG8_SB(1, 0), cB + kstep, voffB); PG8_STAGE(PG8_SA(1, 0), cA + kstep, voffA); PG8_STAGE(PG8_SB(1, 1), cB + hstep + kstep, voffB);
        PG8_WAIT_V(6); PG8_BAR;
    } else {
        PG8_STAGE(PG8_SB(0, 0), cB, voffB); PG8_STAGE(PG8_SA(0, 0), cA, voffA); PG8_STAGE(PG8_SB(0, 1), cB + hstep, voffB); PG8_STAGE(PG8_SA(0, 1), cA + hstep, voffA);
        if (wr == 1) PG8_BAR;
        PG8_WAIT_V(4); PG8_BAR;
        PG8_STAGE(PG8_SB(1, 0), cB + kstep, voffB); PG8_STAGE(PG8_SA(1, 0), cA + kstep, voffA); PG8_STAGE(PG8_SB(1, 1), cB + hstep + kstep, voffB);
        PG8_WAIT_V(6); PG8_BAR;
    }
    for (;;) {
        const bool has_next = S.next(ui + 1, nxt);
        const char* nA = has_next ? (const char*)g.A + (size_t)nxt.pm * tstep : cA; const char* nB = has_next ? (const char*)g.Bt + (size_t)nxt.pn * tstep : cB;
        for (int t = 0; t < nt; t += 2) {
            const bool last = (t == nt - 2);
            const char* a1 = cA + (size_t)(t + 1) * kstep;
            const char* a2 = last ? nA : cA + (size_t)(t + 2) * kstep; const char* b2 = last ? nB : cB + (size_t)(t + 2) * kstep;
            const char* a3 = a2 + kstep; const char* b3 = b2 + kstep;
            if (last && has_next) S.a_ready(nxt);
            if constexpr (SP2) {
            PG8_LDB(B0, 0, 0); PG8_LDB(B1, 0, 1); PG8_SCHED; PG8_LDA(At, 0, 0); PG8_STAGE(PG8_SA(1, 1), a1 + hstep, voffA);
            PG8_WAIT_V(8); PG8_WAIT_L(0); PG8_BAR; PG8_MMA(0, 0, At, B0); PG8_MMA(0, 1, At, B1); PG8_BAR; PG8_SCHED;
            PG8_LDA(At, 0, 1); PG8_STAGE(PG8_SB(0, 0), b2, voffB); PG8_STAGE(PG8_SB(0, 1), b2 + hstep, voffB); PG8_STAGE(PG8_SA(0, 0), a2, voffA);
            PG8_WAIT_V(8); PG8_WAIT_L(0); PG8_BAR; PG8_MMA(1, 0, At, B0); PG8_MMA(1, 1, At, B1); PG8_BAR; PG8_SCHED;
            PG8_LDB(B0, 1, 0); PG8_LDB(B1, 1, 1); PG8_SCHED; PG8_LDA(At, 1, 0); PG8_STAGE(PG8_SA(0, 1), a2 + hstep, voffA);
            PG8_WAIT_V(8); PG8_WAIT_L(0); PG8_BAR; PG8_MMA(0, 0, At, B0); PG8_MMA(0, 1, At, B1); PG8_BAR; PG8_SCHED;
            PG8_LDA(At, 1, 1); PG8_STAGE(PG8_SB(1, 0), b3, voffB); PG8_STAGE(PG8_SB(1, 1), b3 + hstep, voffB); PG8_STAGE(PG8_SA(1, 0), a3, voffA);
            PG8_WAIT_V(8); PG8_WAIT_L(0); PG8_BAR; PG8_MMA(1, 0, At, B0); PG8_MMA(1, 1, At, B1); PG8_BAR; PG8_SCHED;
            } else {
            PG8_LDB(B0, 0, 0); PG8_SCHED; PG8_LDA(At, 0, 0); PG8_STAGE(PG8_SA(1, 1), a1 + hstep, voffA);
            PG8_WAIT_L(8); PG8_BAR; PG8_WAIT_L(0); PG8_MMA(0, 0, At, B0); PG8_BAR; PG8_SCHED;
            PG8_LDB(B1, 0, 1); PG8_STAGE(PG8_SB(0, 0), b2, voffB);
            PG8_BAR; PG8_WAIT_L(0); PG8_MMA(0, 1, At, B1); PG8_BAR;
            PG8_LDA(At, 0, 1); PG8_STAGE(PG8_SA(0, 0), a2, voffA);
            PG8_BAR; PG8_WAIT_L(0); PG8_MMA(1, 0, At, B0); PG8_BAR; PG8_SCHED;
            PG8_STAGE(PG8_SB(0, 1), b2 + hstep, voffB);
            PG8_WAIT_V(6); PG8_BAR; PG8_MMA(1, 1, At, B1); PG8_BAR;
            PG8_LDB(B0, 1, 0); PG8_SCHED; PG8_LDA(At, 1, 0); PG8_STAGE(PG8_SA(0, 1), a2 + hstep, voffA);
            PG8_WAIT_L(8); PG8_BAR; PG8_WAIT_L(0); PG8_MMA(0, 0, At, B0); PG8_BAR; PG8_SCHED;
            PG8_LDB(B1, 1, 1); PG8_STAGE(PG8_SB(1, 0), b3, voffB);
            PG8_BAR; PG8_WAIT_L(0); PG8_MMA(0, 1, At, B1); PG8_BAR;
            PG8_LDA(At, 1, 1); PG8_STAGE(PG8_SA(1, 0), a3, voffA);
            PG8_BAR; PG8_WAIT_L(0); PG8_MMA(1, 0, At, B0); PG8_BAR; PG8_SCHED;
            PG8_STAGE(PG8_SB(1, 1), b3 + hstep, voffB);
            PG8_WAIT_V(6); PG8_BAR; PG8_MMA(1, 1, At, B1); PG8_BAR;
            }
        }
        if constexpr (ALIGN_EPI) { if (wr == 0) PG8_BAR; }
        if constexpr (!Epi::AFTER_DRAIN) { E(acc, cur, wr, wc, fr, fq); S.done(cur); }
        if (!has_next) break;
#pragma unroll
        for (int a = 0; a < 2; ++a)
#pragma unroll
            for (int b = 0; b < 2; ++b)
#pragma unroll
                for (int m = 0; m < 4; ++m)
#pragma unroll
                    for (int n = 0; n < 2; ++n) acc[a][b][m][n] = (f32x4){0.f, 0.f, 0.f, 0.f};
        cur = nxt; cA = nA; cB = nB; ++ui;
        if constexpr (ALIGN_EPI) { if (wr == 1) PG8_BAR; }
    }
    PG8_WAIT_V(0);
    if constexpr (!ALIGN_EPI) { if (wr == 0) PG8_BAR; }
    PG8_BAR;
    if constexpr (Epi::AFTER_DRAIN) { E.fused(acc, cur, wr, wc, fr, fq, lds, wid, lane); S.done(cur); }
#undef PG8_SA
#undef PG8_SB
#undef PG8_STAGE
#undef PG8_LDA
#undef PG8_LDB
#undef PG8_MMA
#undef PG8_WAIT_V
#undef PG8_WAIT_L
#undef PG8_BAR
#undef PG8_SCHED
}
}

#define DEV __device__ __forceinline__
#define LAS __attribute__((address_space(3)))
#define GAS __attribute__((address_space(1)))
typedef unsigned short bf16_t;
typedef short bf16x8 __attribute__((ext_vector_type(8)));
typedef short s16x4 __attribute__((ext_vector_type(4)));
typedef float f32x4 __attribute__((ext_vector_type(4)));
typedef float f32x2 __attribute__((ext_vector_type(2)));
typedef float f32x16 __attribute__((ext_vector_type(16)));
typedef unsigned u32x4 __attribute__((ext_vector_type(4)));
typedef unsigned u32x2 __attribute__((ext_vector_type(2)));
typedef __bf16 bf16x2_t __attribute__((ext_vector_type(2)));

constexpr int DM = 1024, NCTX = 8192, NLAT = 16384, MTOT = 24576;
constexpr int INP = 2304, INC = 2144, DFF = 2816, UPC = 5632;
constexpr int NLAYER = 4;
constexpr float EPS = 1e-6f;
constexpr size_t MiB = 1u << 20;
constexpr size_t WS_CTL = 0;
constexpr size_t WS_MOD = 1 * MiB;
constexpr size_t WS_BIN = 2 * MiB;
constexpr size_t WS_BUP = 3 * MiB;
constexpr size_t WS_SSQ = 4 * MiB;
constexpr size_t WS_WIN = 5 * MiB;
constexpr size_t WS_WUKV = WS_WIN + 4718592;
constexpr size_t WS_WOUT = 10 * MiB;
constexpr size_t WS_WUP = 12 * MiB;
constexpr size_t WS_WDN = 23 * MiB;
constexpr size_t WS_TLAT = 29 * MiB;
constexpr size_t WS_TCTX = 45 * MiB;
constexpr size_t WS_CS64 = WS_TCTX + 512 * 1024;
constexpr size_t WS_XS = 46 * MiB;
constexpr size_t WS_R = 94 * MiB;
constexpr size_t WS_P = WS_R;
constexpr size_t WS_OB = WS_P + 108 * MiB;
constexpr size_t WS_KML = WS_OB + 48 * MiB;
constexpr size_t WS_KMC = WS_KML + 23592960;
constexpr size_t WS_VML = WS_KMC + 9 * MiB;
constexpr size_t WS_VMC = WS_VML + 15 * MiB;
constexpr size_t WS_KDL = WS_VMC + 6 * MiB;
constexpr size_t WS_KDC = WS_KDL + 15 * MiB;
constexpr size_t WS_VDL = WS_KDC + 6 * MiB;
constexpr size_t WS_VDC = WS_VDL + 15 * MiB;
constexpr size_t WS_QMR = WS_VDC + 6 * MiB;
constexpr size_t WS_QDR = WS_QMR + 18 * MiB;
constexpr size_t WS_FBL = WS_QDR + 12 * MiB;
constexpr size_t WS_FBC = WS_FBL + 16 * MiB;
constexpr size_t WS_END = WS_FBC + 8 * MiB;
constexpr size_t WS_U = WS_R;
constexpr size_t WS_ACT = WS_R + 176 * MiB;
static_assert(WS_ACT + 88 * MiB <= WS_END, "overlay fits");
constexpr size_t OUT_CKV = 25165824, OUT_KROPE = OUT_CKV + 4194304, OUT_DK = OUT_KROPE + 1048576, OUT_DV = OUT_DK + 12582912;
constexpr int LDS_BYTES = 147456;
constexpr int RING_BYTES = 131072;
constexpr int LDS_MISC = RING_BYTES;

struct Args { const float* in[26]; float* out; unsigned char* ws; int ph_lo, ph_hi; };
enum { I_XP = 0, I_XS, I_C, I_CCKV, I_CKROPE, I_CDK, I_CDV, I_CCTX, I_WADA, I_BADA, I_GMIX, I_GFFN, I_WIN, I_GKV, I_WUK, I_WUV,
       I_LQ1, I_LK1, I_LQ2, I_LK2, I_GSUB, I_WOUT, I_WUP, I_WCONV, I_WDOWN, I_GFINAL };

DEV float bf2f(unsigned b) { return __uint_as_float(b << 16); }
DEV unsigned pk2(float lo, float hi) { f32x2 v = {lo, hi}; bf16x2_t b = __builtin_convertvector(v, bf16x2_t); return __builtin_bit_cast(unsigned, b); }
DEV bf16_t f2bf(float f) { return (bf16_t)(pk2(f, 0.f) & 0xffffu); }
DEV float wave_sum(float v) {
#pragma unroll
    for (int o = 1; o < 64; o <<= 1) v += __shfl_xor(v, o);
    return v;
}
DEV f32x4 mfma16(bf16x8 a, bf16x8 b, f32x4 c) { return __builtin_amdgcn_mfma_f32_16x16x32_bf16(a, b, c, 0, 0, 0); }
DEV f32x16 mfma32(bf16x8 a, bf16x8 b, f32x16 c) { return __builtin_amdgcn_mfma_f32_32x32x16_bf16(a, b, c, 0, 0, 0); }
DEV int row_b9(int row0) { return row0 < NCTX ? 0 : 1 + ((row0 - NCTX) >> 11); }

struct EpiA {
    static constexpr bool PERM = true, AFTER_DRAIN = false;
    bf16_t* O; int ldc; const float* ssq; const float* bias; int ldb; int row_off;
    DEV void operator()(const f32x4 (&acc)[2][2][4][2], const pg8::Unit& u, int wr, int wc, int fr, int fq) const {
        const int lrow0 = u.pm * 256, b9 = row_b9(row_off + lrow0);
        const int col0 = u.pn * 256 + wc * 32 + 8 * fq;
        f32x4 bv[2][2];
#pragma unroll
        for (int bj = 0; bj < 2; ++bj)
#pragma unroll
            for (int n = 0; n < 2; ++n) bv[bj][n] = *(const GAS f32x4*)(bias + (size_t)b9 * ldb + col0 + bj * 128 + 4 * n);
#pragma unroll
        for (int ai = 0; ai < 2; ++ai)
#pragma unroll
            for (int m = 0; m < 4; ++m) {
                const int lr = lrow0 + ai * 128 + wr * 64 + m * 16 + fr;
                const float rs = rsqrtf(((const GAS float*)ssq)[row_off + lr] * (1.0f / 1024.0f) + EPS);
                GAS bf16_t* rowp = (GAS bf16_t*)O + (size_t)lr * ldc + col0;
#pragma unroll
                for (int bj = 0; bj < 2; ++bj) {
                    const f32x4 v0 = acc[ai][bj][m][0] * rs + bv[bj][0], v1 = acc[ai][bj][m][1] * rs + bv[bj][1];
                    u32x4 w; w.x = pk2(v0[0], v0[1]); w.y = pk2(v0[2], v0[3]); w.z = pk2(v1[0], v1[1]); w.w = pk2(v1[2], v1[3]);
                    *(GAS u32x4*)(rowp + bj * 128) = w;
                }
            }
    }
};
struct EpiRes {
    static constexpr bool PERM = false, AFTER_DRAIN = false;
    const float* xold_c; const float* xold_l;
    float* X;
    const float* gate;
    const float* g; const float* scale;
    bf16_t* XS; float* ssq; int row_off;
    DEV void operator()(const f32x4 (&acc)[2][2][4][2], const pg8::Unit& u, int wr, int wc, int fr, int fq) const {
        const int row0 = row_off + u.pm * 256, b9 = row_b9(row0);
        const int col0 = u.pn * 256 + wc * 32 + 4 * fq;
        f32x4 gv[2][2], gs[2][2];
#pragma unroll
        for (int bj = 0; bj < 2; ++bj)
#pragma unroll
            for (int n = 0; n < 2; ++n) {
                const int c = col0 + bj * 128 + n * 16;
                gv[bj][n] = *(const GAS f32x4*)(gate + (size_t)b9 * 6144 + c);
                if (g) { const f32x4 gg = *(const GAS f32x4*)(g + c), sc = *(const GAS f32x4*)(scale + (size_t)b9 * 6144 + c); gs[bj][n] = gg * (sc + 1.0f); }
                else gs[bj][n] = (f32x4){0.f, 0.f, 0.f, 0.f};
            }
        const float* xo = (row0 < NCTX) ? xold_c : (xold_l - (size_t)NCTX * DM);
#pragma unroll
        for (int ai = 0; ai < 2; ++ai)
#pragma unroll
            for (int m = 0; m < 4; ++m) {
                const int r = row0 + ai * 128 + wr * 64 + m * 16 + fr;
                float ss = 0.f;
#pragma unroll
                for (int bj = 0; bj < 2; ++bj)
#pragma unroll
                    for (int n = 0; n < 2; ++n) {
                        const size_t off = (size_t)r * DM + col0 + bj * 128 + n * 16;
                        const f32x4 xv = *(const GAS f32x4*)(xo + off);
                        const f32x4 xn = xv + gv[bj][n] * acc[ai][bj][m][n];
                        *(GAS f32x4*)(X + off) = xn;
                        ss += (xn[0] * xn[0] + xn[1] * xn[1]) + (xn[2] * xn[2] + xn[3] * xn[3]);
                        if (g) { const f32x4 y = xn * gs[bj][n]; u32x2 w; w.x = pk2(y[0], y[1]); w.y = pk2(y[2], y[3]); *(GAS u32x2*)(XS + off) = w; }
                    }
                ss += __shfl_xor(ss, 16); ss += __shfl_xor(ss, 32);
                if (fq == 0) unsafeAtomicAdd(ssq + r, ss);
            }
    }
};
struct EpiF {
    static constexpr bool PERM = true, AFTER_DRAIN = false;
    bf16_t* OB; int rowbase; int nseq;
    DEV void operator()(const f32x4 (&acc)[2][2][4][2], const pg8::Unit& u, int wr, int wc, int fr, int fq) const {
        const int col0 = 768 + wc * 32 + 8 * fq;
#pragma unroll
        for (int ai = 0; ai < 2; ++ai)
#pragma unroll
            for (int m = 0; m < 4; ++m) {
                const int np = u.pm * 256 + ai * 128 + wr * 64 + m * 16 + fr;
                GAS bf16_t* rowp = (GAS bf16_t*)OB + (size_t)(rowbase + u.pn * nseq + np) * DM + col0;
#pragma unroll
                for (int bj = 0; bj < 2; ++bj) {
                    const f32x4 v0 = acc[ai][bj][m][0], v1 = acc[ai][bj][m][1];
                    u32x4 w; w.x = pk2(v0[0], v0[1]); w.y = pk2(v0[2], v0[3]); w.z = pk2(v1[0], v1[1]); w.w = pk2(v1[2], v1[3]);
                    *(GAS u32x4*)(rowp + bj * 128) = w;
                }
            }
    }
};

DEV void transpose_item(const float* W, int K, int N, bf16_t* WT, int row_off, LAS float* scr, int item, int lane) {
    const int nblk = N / 32, kb = item / nblk, nb = item % nblk, k0 = 64 * kb, n0 = 32 * nb;
#pragma unroll 8
    for (int i = 0; i < 32; ++i) { const int kk = 2 * i + (lane >> 5); scr[kk * 33 + (lane & 31)] = W[(size_t)(k0 + kk) * N + n0 + (lane & 31)]; }
    asm volatile("s_waitcnt lgkmcnt(0)" ::: "memory");
    const int c = lane & 7;
#pragma unroll
    for (int j = 0; j < 4; ++j) { const int n = (lane >> 3) + 8 * j; const LAS float* s = scr + (8 * c) * 33 + n;
        u32x4 o; o.x = pk2(s[0 * 33], s[1 * 33]); o.y = pk2(s[2 * 33], s[3 * 33]); o.z = pk2(s[4 * 33], s[5 * 33]); o.w = pk2(s[6 * 33], s[7 * 33]);
        *(u32x4*)(WT + (size_t)(row_off + n0 + n) * K + k0 + 8 * c) = o; }
    asm volatile("s_waitcnt lgkmcnt(0)" ::: "memory");
}
DEV void convert_weights(const Args& a, LAS unsigned char* lds, int l, int mask, int gw, int NGW, int wave, int lane) {
    LAS float* scr = (LAS float*)(lds + wave * 16384);
    unsigned char* ws = a.ws;
    const int n_in = (mask & 1) ? 16 * 67 : 0, n_uk = (mask & 2) ? 2 * 12 : 0, n_out = (mask & 4) ? 16 * 32 : 0, n_up = (mask & 8) ? 16 * 176 : 0, n_dn = (mask & 16) ? 44 * 32 : 0;
    const int total = n_in + 2 * n_uk + n_out + n_up + n_dn;
    for (int it = gw; it < total; it += NGW) {
        int r = it;
        if (r < n_in) { transpose_item(a.in[I_WIN] + (size_t)l * DM * INC, DM, INC, (bf16_t*)(ws + WS_WIN), 0, scr, r, lane); continue; } r -= n_in;
        if (r < n_uk) { transpose_item(a.in[I_WUK] + (size_t)l * 128 * 384, 128, 384, (bf16_t*)(ws + WS_WUKV), 0, scr, r, lane); continue; } r -= n_uk;
        if (r < n_uk) { transpose_item(a.in[I_WUV] + (size_t)l * 128 * 384, 128, 384, (bf16_t*)(ws + WS_WUKV), 384, scr, r, lane); continue; } r -= n_uk;
        if (r < n_out) { transpose_item(a.in[I_WOUT] + (size_t)l * DM * DM, DM, DM, (bf16_t*)(ws + WS_WOUT), 0, scr, r, lane); continue; } r -= n_out;
        if (r < n_up) { transpose_item(a.in[I_WUP] + (size_t)l * DM * UPC, DM, UPC, (bf16_t*)(ws + WS_WUP), 0, scr, r, lane); continue; } r -= n_up;
        transpose_item(a.in[I_WDOWN] + (size_t)l * DFF * DM, DFF, DM, (bf16_t*)(ws + WS_WDN), 0, scr, r, lane);
    }
}
DEV void gemv9_item(LAS float* vec, LAS float* red, const float* W, int N, int ldw, const float* bias, float* out, int ldo, int n0, int tid) {
    const int w = tid >> 6, lane = tid & 63; const int n = n0 + lane; const bool valid = n < N;
    float acc0 = 0.f, acc1 = 0.f, acc2 = 0.f, acc3 = 0.f, acc4 = 0.f, acc5 = 0.f, acc6 = 0.f, acc7 = 0.f, acc8 = 0.f;
    const float* wp = W + (size_t)(128 * w) * ldw + (valid ? n : 0);
    const LAS float* vp = vec + 128 * w;
#pragma unroll 4
    for (int k = 0; k < 128; ++k) {
        const float wv = valid ? wp[(size_t)k * ldw] : 0.f;
        acc0 += vp[k] * wv; acc1 += vp[1024 + k] * wv; acc2 += vp[2048 + k] * wv; acc3 += vp[3072 + k] * wv; acc4 += vp[4096 + k] * wv;
        acc5 += vp[5120 + k] * wv; acc6 += vp[6144 + k] * wv; acc7 += vp[7168 + k] * wv; acc8 += vp[8192 + k] * wv;
    }
    LAS float* rp = red + (w * 9) * 64 + lane;
    rp[0] = acc0; rp[64] = acc1; rp[128] = acc2; rp[192] = acc3; rp[256] = acc4; rp[320] = acc5; rp[384] = acc6; rp[448] = acc7; rp[512] = acc8;
    __syncthreads();
    for (int idx = tid; idx < 576; idx += 512) {
        const int v = idx >> 6, ln = idx & 63; float s = 0.f;
#pragma unroll
        for (int ww = 0; ww < 8; ++ww) s += red[(ww * 9 + v) * 64 + ln];
        const int nn = n0 + ln;
        out[(size_t)v * ldo + nn] = s + ((bias && nn < N) ? bias[nn] : 0.f);
    }
    __syncthreads();
}
#define XB_TMO      128
#define XB_XCNT(j)  (256  + 64 * (j))
#define XB_XSUB(j)  (1280 + 64 * (j))
#define XB_XGEN(j)  (2304 + 64 * (j))
#define XB_TOP      3328
#define XB_TOPGEN   3392
#define XCD_BAR_WORDS 3456
#define XB_SPIN_CAP (1u << 18)

__device__ __forceinline__ unsigned xb_ld(unsigned* p)              { return __hip_atomic_load(p, __ATOMIC_RELAXED, __HIP_MEMORY_SCOPE_AGENT); }
__device__ __forceinline__ unsigned xb_add(unsigned* p, unsigned v) { return __hip_atomic_fetch_add(p, v, __ATOMIC_RELAXED, __HIP_MEMORY_SCOPE_AGENT); }
__device__ __forceinline__ unsigned xb_xcc_id() { return (unsigned)__builtin_amdgcn_s_getreg((3 << 11) | 20) & 0xFu; }
#define XB_SPIN(cond, bar) do { unsigned _sp = 0; while (cond) { __builtin_amdgcn_s_sleep(1); \
    if ((++_sp & 255u) == 0u) { if (xb_ld(&(bar)[XB_TMO])) break; if (_sp > XB_SPIN_CAP) { atomicAdd(&(bar)[XB_TMO], 1u); break; } } } } while (0)

struct XcdBarrier {
    unsigned* bar; unsigned x;
    volatile LAS unsigned* st;
};

__device__ __forceinline__ XcdBarrier xcd_barrier_post(unsigned* bar, volatile LAS unsigned* st) {
    XcdBarrier b; b.bar = bar; b.x = xb_xcc_id(); b.st = st;
    if (threadIdx.x == 0) (void)xb_add(&bar[XB_XCNT(b.x)], 1u);
    return b;
}
__device__ __forceinline__ void xcd_barrier_complete(unsigned* bar, unsigned x, unsigned& nloc, unsigned& nx) {
    const unsigned G = gridDim.x * gridDim.y * gridDim.z;
    unsigned sum, cnt, mine, sp = 0u;
    for (;;) {
        sum = 0u; cnt = 0u; mine = 0u;
#pragma unroll
        for (unsigned j = 0; j < 16; ++j) { const unsigned c = xb_ld(&bar[XB_XCNT(j)]); sum += c; cnt += (c > 0u) ? 1u : 0u; mine = (j == x) ? c : mine; }
        if (sum == G) break;
        __builtin_amdgcn_s_sleep(1);
        if ((++sp & 255u) == 0u) { if (xb_ld(&bar[XB_TMO])) break; if (sp > XB_SPIN_CAP) { atomicAdd(&bar[XB_TMO], 1u); break; } }
    }
    nloc = mine > 0u ? mine : 1u; nx = cnt > 0u ? cnt : 1u;
}

__device__ __forceinline__ void xcd_barrier(const XcdBarrier& b) {
    asm volatile("s_waitcnt vmcnt(0)" ::: "memory");
    __syncthreads();
    if (threadIdx.x == 0) {
        unsigned* bar = b.bar;
        __builtin_amdgcn_s_waitcnt(0);
        unsigned nloc = b.st[0], nx = b.st[1];
        if (nloc == 0u) { xcd_barrier_complete(bar, b.x, nloc, nx); b.st[0] = nloc; b.st[1] = nx; }
        const unsigned old = xb_add(&bar[XB_XSUB(b.x)], 1u);
        const unsigned gen = old / nloc;
        if (old + 1u == (gen + 1u) * nloc) {
            __builtin_amdgcn_fence(__ATOMIC_RELEASE, "agent");
            asm volatile("s_waitcnt vmcnt(0)" ::: "memory");
            const unsigned og = xb_add(&bar[XB_TOP], 1u);
            const unsigned tg = og / nx;
            if (og + 1u == (tg + 1u) * nx) xb_add(&bar[XB_TOPGEN], 1u);
            else XB_SPIN(xb_ld(&bar[XB_TOPGEN]) == tg, bar);
            __builtin_amdgcn_fence(__ATOMIC_ACQUIRE, "agent");
            xb_add(&bar[XB_XGEN(b.x)], 1u);
            asm volatile("s_waitcnt vmcnt(0)" ::: "memory");
        } else {
            XB_SPIN(xb_ld(&bar[XB_XGEN(b.x)]) == gen, bar);
            __builtin_amdgcn_fence(__ATOMIC_ACQUIRE, "agent");
            asm volatile("s_waitcnt vmcnt(0)" ::: "memory");
        }
    }
    __syncthreads();
}

constexpr int B_AROW = 272, B_VROW = 772, B_UROW = 528;
constexpr int B_LDS_A = 0, B_LDS_V = 64 * B_AROW, B_LDS_U = B_LDS_V + 64 * B_VROW, B_LDS_TAB = B_LDS_U + 64 * B_UROW;
static_assert(B_LDS_TAB + 4096 <= RING_BYTES, "phase B LDS");

DEV float rope1(float x, int dd, int t, const LAS f32x2* tab) {
    const float xp = __shfl_xor(x, 8);
    const int pos = (dd < 16) ? (t >> 6) : (t & 63);
    const f32x2 cs = tab[pos * 8 + (dd & 7)];
    return (dd & 8) ? (x * cs.x + xp * cs.y) : (x * cs.x - xp * cs.y);
}

DEV void phase_b(const Args& a, LAS unsigned char* lds, int l, int tid, int mode, int blk_start, int blk_stride) {
    unsigned char* ws = a.ws;
    const int wave = __builtin_amdgcn_readfirstlane(tid >> 6), lane = tid & 63, fr = lane & 15, fq = lane >> 4;
    const GAS bf16_t* P = (const GAS bf16_t*)(ws + WS_P);
    const GAS bf16_t* WUKV = (const GAS bf16_t*)(ws + WS_WUKV);
    const GAS bf16_t* CS64 = (const GAS bf16_t*)(ws + WS_CS64);
    GAS float* outg = (GAS float*)a.out;
    LAS f32x2* tab = (LAS f32x2*)(lds + B_LDS_TAB);
    {
        const int pos = tid >> 3, f = tid & 7;
        const float inv = __builtin_amdgcn_exp2f(-(float)f * (13.287712379549449f / 8.0f));
        const float ang = (float)pos * inv;
        tab[tid] = (f32x2){cosf(ang), sinf(ang)};
    }
    __syncthreads();
    const GAS float* gkv = (const GAS float*)a.in[I_GKV] + l * 128;
    for (int blk = blk_start; blk < (mode == 0 ? 384 : 448); blk += blk_stride) {
        int kind, r0 = 0, bidx, t0;
        if (blk < 128) { kind = 0; r0 = blk * 64; bidx = r0 >> 8; t0 = r0 & 255; }
        else if (blk < 384) { kind = 1; r0 = NCTX + (blk - 128) * 64; bidx = (r0 - NCTX) >> 11; t0 = (r0 - NCTX) & 2047; }
        else { kind = 2; const int cb = blk - 384; bidx = cb >> 3; t0 = 2048 + 64 * (cb & 7); }
        GAS bf16_t* KM; GAS bf16_t* KD; GAS bf16_t* VMt; GAS bf16_t* VDt; int vt_ld;
        if (kind == 0) { KM = (GAS bf16_t*)(ws + WS_KMC) + (size_t)(bidx * 256 + t0) * 576; KD = (GAS bf16_t*)(ws + WS_KDC) + (size_t)(bidx * 256 + t0) * 384;
                         VMt = (GAS bf16_t*)(ws + WS_VMC) + (size_t)bidx * 6 * 64 * 256 + t0; VDt = (GAS bf16_t*)(ws + WS_VDC) + (size_t)bidx * 6 * 64 * 256 + t0; vt_ld = 256; }
        else { KM = (GAS bf16_t*)(ws + WS_KML) + (size_t)(bidx * 2560 + t0) * 576; KD = (GAS bf16_t*)(ws + WS_KDL) + (size_t)(bidx * 2560 + t0) * 384;
               VMt = (GAS bf16_t*)(ws + WS_VML) + (size_t)bidx * 6 * 64 * 2560 + t0; VDt = (GAS bf16_t*)(ws + WS_VDL) + (size_t)bidx * 6 * 64 * 2560 + t0; vt_ld = 2560; }
        if (mode == 0) {
            for (int c = tid; c < 64 * 32; c += 512) { const int rr = c >> 5, e = c & 31;
                *(LAS u32x4*)(lds + B_LDS_U + rr * B_UROW + e * 16) = *(const GAS u32x4*)(P + (size_t)(r0 + rr) * INP + 1888 + 8 * e); }
            __syncthreads();
        } else {
        if (kind == 2) {
            for (int i = 0; i < 8; ++i) {
                const int rr = wave * 8 + i;
                const int j = (t0 - 2048) + rr;
                const size_t crow = ((size_t)(bidx * 4 + l)) * 512 + j;
                const f32x2 cv = *(const f32x2*)(a.in[I_CCKV] + crow * 128 + 2 * lane);
                *(LAS unsigned*)(lds + B_LDS_A + rr * B_AROW + lane * 4) = pk2(cv.x, cv.y);
                const float kr = a.in[I_CKROPE][crow * 32 + (lane & 31)];
                const bf16_t krb = f2bf(kr);
                { const int hb = (lane >> 5) * 3;
#pragma unroll
                  for (int h = 0; h < 3; ++h) KM[(size_t)rr * 576 + (hb + h) * 96 + 64 + (lane & 31)] = krb; }
#pragma unroll
                for (int q = 0; q < 6; ++q) {
                    KD[(size_t)rr * 384 + 64 * q + lane] = f2bf(a.in[I_CDK][crow * 384 + 64 * q + lane]);
                    *(LAS bf16_t*)(lds + B_LDS_V + rr * B_VROW + (64 * q + lane) * 2) = f2bf(a.in[I_CDV][crow * 384 + 64 * q + lane]);
                }
            }
        } else {
            const size_t obase = ((size_t)(bidx * 4 + l)) * 256 + t0;
#pragma unroll
            for (int it = 0; it < 2; ++it) {
                const int rr = (tid >> 4) + 32 * it, cj = tid & 15;
                const u32x4 w = *(const GAS u32x4*)(P + (size_t)(r0 + rr) * INP + 576 + 8 * cj);
                float x[8]; x[0] = bf2f(w.x & 0xffffu); x[1] = bf2f(w.x >> 16); x[2] = bf2f(w.y & 0xffffu); x[3] = bf2f(w.y >> 16);
                x[4] = bf2f(w.z & 0xffffu); x[5] = bf2f(w.z >> 16); x[6] = bf2f(w.w & 0xffffu); x[7] = bf2f(w.w >> 16);
                float ss = 0.f;
#pragma unroll
                for (int j = 0; j < 8; ++j) ss += x[j] * x[j];
                ss += __shfl_xor(ss, 1); ss += __shfl_xor(ss, 2); ss += __shfl_xor(ss, 4); ss += __shfl_xor(ss, 8);
                const float rs = rsqrtf(ss * (1.0f / 128.0f) + EPS);
                const f32x4 ga = *(const GAS f32x4*)(gkv + 8 * cj), gb = *(const GAS f32x4*)(gkv + 8 * cj + 4);
                x[0] *= rs * ga[0]; x[1] *= rs * ga[1]; x[2] *= rs * ga[2]; x[3] *= rs * ga[3]; x[4] *= rs * gb[0]; x[5] *= rs * gb[1]; x[6] *= rs * gb[2]; x[7] *= rs * gb[3];
                u32x4 o; o.x = pk2(x[0], x[1]); o.y = pk2(x[2], x[3]); o.z = pk2(x[4], x[5]); o.w = pk2(x[6], x[7]);
                *(LAS u32x4*)(lds + B_LDS_A + rr * B_AROW + cj * 16) = o;
                if (kind == 0) { GAS float* op = outg + OUT_CKV + (obase + rr) * 128 + 8 * cj; *(GAS f32x4*)op = (f32x4){x[0], x[1], x[2], x[3]}; *(GAS f32x4*)(op + 4) = (f32x4){x[4], x[5], x[6], x[7]}; }
            }
#pragma unroll 1
            for (int cb = 0; cb < 35; cb += 7) {
              u32x4 wv[7];
#pragma unroll
              for (int i = 0; i < 7; ++i) {
                const int c = tid + 512 * (cb + i); const int rr = c / 268, ch = c - rr * 268;
                const bool need = (c < 64 * 268) && (ch < 236) && !(ch >= 72 && ch < 88) && !(kind == 0 && (ch < 72 || (ch >= 92 && ch < 140)));
                wv[i] = (u32x4){0u, 0u, 0u, 0u};
                if (need) wv[i] = *(const GAS u32x4*)(P + (size_t)(r0 + rr) * INP + 8 * ch);
              }
#pragma unroll
              for (int i = 0; i < 7; ++i) {
                const int c = tid + 512 * (cb + i); const int rr = c / 268, ch = c - rr * 268;
                const bool need = (c < 64 * 268) && (ch < 236) && !(ch >= 72 && ch < 88) && !(kind == 0 && (ch < 72 || (ch >= 92 && ch < 140)));
                if (!need) continue;
                const int r = r0 + rr, t = t0 + rr;
                u32x4 w = wv[i];
                const bool ropeable = (ch < 72) ? ((ch % 12) >= 8) : (ch < 188);
                if (kind == 1 && ropeable) {
                    const int j = ch & 3;
                    const int pos = (j < 2) ? (t >> 6) : (t & 63);
                    float x[8]; x[0] = bf2f(w.x & 0xffffu); x[1] = bf2f(w.x >> 16); x[2] = bf2f(w.y & 0xffffu); x[3] = bf2f(w.y >> 16);
                    x[4] = bf2f(w.z & 0xffffu); x[5] = bf2f(w.z >> 16); x[6] = bf2f(w.w & 0xffffu); x[7] = bf2f(w.w >> 16);
                    const float sgn = (j & 1) ? 1.0f : -1.0f;
#pragma unroll
                    for (int i = 0; i < 8; ++i) {
                        const float xp = __builtin_bit_cast(float, __builtin_amdgcn_update_dpp(0, __builtin_bit_cast(int, x[i]), 0xB1, 0xF, 0xF, true));
                        const f32x2 cs = tab[pos * 8 + i];
                        x[i] = x[i] * cs.x + sgn * (xp * cs.y);
                    }
                    w.x = pk2(x[0], x[1]); w.y = pk2(x[2], x[3]); w.z = pk2(x[4], x[5]); w.w = pk2(x[6], x[7]);
                }
                if (ch < 72) { *(GAS u32x4*)((GAS bf16_t*)(ws + WS_QMR) + (size_t)(r - NCTX) * 576 + 8 * ch) = w; }
                else if (ch < 92) { const int j = ch - 88;
#pragma unroll
                    for (int h = 0; h < 6; ++h) *(GAS u32x4*)(KM + (size_t)rr * 576 + h * 96 + 64 + 8 * j) = w;
                    if (kind == 0) { GAS float* op = outg + OUT_KROPE + (obase + rr) * 32 + 8 * j;
                        *(GAS f32x4*)op = (f32x4){bf2f(w.x & 0xffffu), bf2f(w.x >> 16), bf2f(w.y & 0xffffu), bf2f(w.y >> 16)}; *(GAS f32x4*)(op + 4) = (f32x4){bf2f(w.z & 0xffffu), bf2f(w.z >> 16), bf2f(w.w & 0xffffu), bf2f(w.w >> 16)}; } }
                else if (ch < 140) { *(GAS u32x4*)((GAS bf16_t*)(ws + WS_QDR) + (size_t)(r - NCTX) * 384 + 8 * (ch - 92)) = w; }
                else if (ch < 188) { const int e = ch - 140; *(GAS u32x4*)(KD + (size_t)rr * 384 + 8 * e) = w;
                    if (kind == 0) { GAS float* op = outg + OUT_DK + (obase + rr) * 384 + 8 * e;
                        *(GAS f32x4*)op = (f32x4){bf2f(w.x & 0xffffu), bf2f(w.x >> 16), bf2f(w.y & 0xffffu), bf2f(w.y >> 16)}; *(GAS f32x4*)(op + 4) = (f32x4){bf2f(w.z & 0xffffu), bf2f(w.z >> 16), bf2f(w.w & 0xffffu), bf2f(w.w >> 16)}; } }
                else if (ch < 236) { const int e = ch - 188; LAS unsigned* vp = (LAS unsigned*)(lds + B_LDS_V + rr * B_VROW + e * 16); vp[0] = w.x; vp[1] = w.y; vp[2] = w.z; vp[3] = w.w;
                    if (kind == 0) { GAS float* op = outg + OUT_DV + (obase + rr) * 384 + 8 * e;
                        *(GAS f32x4*)op = (f32x4){bf2f(w.x & 0xffffu), bf2f(w.x >> 16), bf2f(w.y & 0xffffu), bf2f(w.y >> 16)}; *(GAS f32x4*)(op + 4) = (f32x4){bf2f(w.z & 0xffffu), bf2f(w.z >> 16), bf2f(w.w & 0xffffu), bf2f(w.w >> 16)}; } }
                else { *(LAS u32x4*)(lds + B_LDS_U + rr * B_UROW + (ch - 236) * 16) = w; }
              }
            }
        }
        bf16x8 bwa[6][4];
#pragma unroll
        for (int nt = 0; nt < 6; ++nt)
#pragma unroll
            for (int kk = 0; kk < 4; ++kk) bwa[nt][kk] = *(const GAS bf16x8*)(WUKV + (size_t)(96 * wave + 16 * nt + fr) * 128 + 32 * kk + 8 * fq);
        __syncthreads();
#pragma unroll
        for (int nt = 0; nt < 6; ++nt) {
            const int c0 = 96 * wave + 16 * nt;
            bf16x8 bw[4];
#pragma unroll
            for (int kk = 0; kk < 4; ++kk) bw[kk] = bwa[nt][kk];
#pragma unroll
            for (int mt = 0; mt < 4; ++mt) {
                f32x4 acc = {0.f, 0.f, 0.f, 0.f};
#pragma unroll
                for (int kk = 0; kk < 4; ++kk) {
                    const bf16x8 af = *(const LAS bf16x8*)(lds + B_LDS_A + (16 * mt + fr) * B_AROW + (32 * kk + 8 * fq) * 2);
                    acc = (wave < 4) ? mfma16(bw[kk], af, acc) : mfma16(af, bw[kk], acc);
                }
                u32x2 w; w.x = pk2(acc[0], acc[1]); w.y = pk2(acc[2], acc[3]);
                if (wave < 4) { const int h = c0 >> 6, d = (c0 & 63) + 4 * fq; *(GAS u32x2*)(KM + (size_t)(16 * mt + fr) * 576 + h * 96 + d) = w; }
                else { const int col = c0 - 384 + fr, h = col >> 6, dv = col & 63; *(GAS u32x2*)(VMt + (size_t)(h * 64 + dv) * vt_ld + 16 * mt + 4 * fq) = w; }
            }
        }
        }
        if (mode == 0) {
            const int g = wave >> 1, nseq = (kind == 0) ? 256 : 2048, ldk = 2 * nseq;
            GAS bf16_t* FB = (kind == 0) ? (GAS bf16_t*)(ws + WS_FBC) : (GAS bf16_t*)(ws + WS_FBL);
#pragma unroll 1
            for (int nt = 0; nt < 4; ++nt) {
                const int cc0 = 16 * ((wave & 1) * 4 + nt);
                bf16x8 bw[2];
#pragma unroll
                for (int kk = 0; kk < 2; ++kk) bw[kk] = *(const GAS bf16x8*)(CS64 + (size_t)(cc0 + fr) * 64 + 32 * kk + 8 * fq);
                const int cc = cc0 + fr, cp = cc & 63, koff = (cc >= 64) ? nseq : 0;
                GAS bf16_t* dst = FB + (size_t)(bidx * 256 + g * 64 + cp) * ldk + koff + (t0 & (nseq - 1));
#pragma unroll
                for (int mt = 0; mt < 4; ++mt) {
                    f32x4 acc = {0.f, 0.f, 0.f, 0.f};
#pragma unroll
                    for (int kk = 0; kk < 2; ++kk) {
                        const bf16x8 af = *(const LAS bf16x8*)(lds + B_LDS_U + (16 * mt + fr) * B_UROW + (64 * g + 32 * kk + 8 * fq) * 2);
                        acc = mfma16(af, bw[kk], acc);
                    }
                    u32x2 w; w.x = pk2(acc[0], acc[1]); w.y = pk2(acc[2], acc[3]);
                    *(GAS u32x2*)(dst + 16 * mt + 4 * fq) = w;
                }
            }
        }
        if (mode == 1)
#pragma unroll 4
        for (int q = 0; q < 48; ++q) {
            const int cr = 48 * wave + q;
            const bf16_t v = *(const LAS bf16_t*)(lds + B_LDS_V + lane * B_VROW + cr * 2);
            VDt[(size_t)cr * vt_ld + lane] = v;
        }
        __syncthreads();
    }
}

constexpr int AT_VROW = 136;
template <bool DIFF> struct AttnCfg {
    static constexpr int ND = DIFF ? 4 : 6;
    static constexpr int NM = DIFF ? 2 : 1;
    static constexpr int NDM = DIFF ? 2 : 6;
    static constexpr int KROW = DIFF ? 144 : 208;
    static constexpr int KT = 64 * KROW;
    static constexpr int CPR = 2 * ND;
    static constexpr int NKC = 64 * CPR;
};
constexpr int AT_LDS_K = 0, AT_LDS_V = 2 * 64 * 208, AT_LDS_SCR = AT_LDS_V + 2 * 64 * AT_VROW;
static_assert(AT_LDS_SCR + 2048 <= RING_BYTES, "attention LDS");

DEV float vmax3(float a, float b, float c) { float r; asm("v_max3_f32 %0, %1, %2, %3" : "=v"(r) : "v"(a), "v"(b), "v"(c)); return r; }
template <bool DIFF>
DEV void attn_unit(LAS unsigned char* lds, const bf16_t* Qa, int qa_ld, const bf16_t* Qb, int qb_ld, const bf16_t* Kp, int k_ld,
                   const bf16_t* Vt, int vt_ld, int nt_main, int nt_total, bf16_t* Oout, float cscale, float lam, const float* gsub, float subscale, int tid) {
    typedef AttnCfg<DIFF> C;
    const int wave = __builtin_amdgcn_readfirstlane(tid >> 6), lane = tid & 63, l31 = lane & 31, hi = lane >> 5;
    LAS float* scr = (LAS float*)(lds + AT_LDS_SCR) + wave * 64;
    const int kkey0 = tid / C::CPR, kpart0 = tid % C::CPR;
    const int kc1 = tid + 512; const bool has1 = kc1 < C::NKC; const int kkey1 = kc1 / C::CPR, kpart1 = kc1 % C::CPR;
    const int vdv = tid >> 3, vpart = tid & 7;
    const GAS bf16_t* kg0 = (const GAS bf16_t*)Kp + (size_t)kkey0 * k_ld + kpart0 * 8;
    const GAS bf16_t* kg1 = (const GAS bf16_t*)Kp + (size_t)kkey1 * k_ld + kpart1 * 8;
    const GAS bf16_t* vg = (const GAS bf16_t*)Vt + (size_t)vdv * vt_ld + vpart * 8;
    const int kl0 = kkey0 * C::KROW + kpart0 * 16, kl1 = kkey1 * C::KROW + kpart1 * 16, vl = vdv * AT_VROW + vpart * 16;
    u32x4 kr0, kr1 = {0, 0, 0, 0}, vr;
    bf16x8 qf[C::ND];
    { const GAS bf16_t* qp = (const GAS bf16_t*)Qa + (size_t)(32 * wave + l31) * qa_ld + 8 * hi;
#pragma unroll
      for (int d = 0; d < C::ND; ++d) qf[d] = *(const GAS bf16x8*)(qp + 16 * d); }
    kr0 = *(const GAS u32x4*)kg0; if (has1) kr1 = *(const GAS u32x4*)kg1; vr = *(const GAS u32x4*)vg;
    *(LAS u32x4*)(lds + AT_LDS_K + kl0) = kr0; if (has1) *(LAS u32x4*)(lds + AT_LDS_K + kl1) = kr1;
    *(LAS u32x2*)(lds + AT_LDS_V + vl) = (u32x2){vr.x, vr.y}; *(LAS u32x2*)(lds + AT_LDS_V + vl + 8) = (u32x2){vr.z, vr.w};
    __syncthreads();
    f32x16 O[C::NM][2];
    float mref[C::NM], lsum[C::NM];
#pragma unroll
    for (int mp = 0; mp < C::NM; ++mp) { mref[mp] = 0.f; lsum[mp] = 0.f;
#pragma unroll
        for (int r = 0; r < 16; ++r) { O[mp][0][r] = 0.f; O[mp][1][r] = 0.f; } }
#pragma unroll 1
    for (int t = 0; t < nt_total; ++t) {
        const int cur = t & 1;
        const bool more = (t + 1) < nt_total;
        if (more) {
            const size_t ko = (size_t)(t + 1) * 64 * k_ld;
            kr0 = *(const GAS u32x4*)(kg0 + ko); if (has1) kr1 = *(const GAS u32x4*)(kg1 + ko);
            vr = *(const GAS u32x4*)(vg + (t + 1) * 64);
        }
        if (t == nt_main) {
            const GAS bf16_t* qp = (const GAS bf16_t*)Qb + (size_t)(32 * wave + l31) * qb_ld + 8 * hi;
#pragma unroll
            for (int d = 0; d < C::ND; ++d) qf[d] = *(const GAS bf16x8*)(qp + 16 * d);
        }
        const LAS unsigned char* Kb = lds + AT_LDS_K + cur * C::KT;
        const LAS unsigned char* Vb = lds + AT_LDS_V + cur * (64 * AT_VROW);
        bf16x8 kf[2][C::NDM];
#pragma unroll
        for (int dd = 0; dd < C::NDM; ++dd) {
            kf[0][dd] = *(const LAS bf16x8*)(Kb + l31 * C::KROW + dd * 32 + hi * 16);
            kf[1][dd] = *(const LAS bf16x8*)(Kb + (32 + l31) * C::KROW + dd * 32 + hi * 16);
        }
        __builtin_amdgcn_sched_barrier(0);
        bf16x8 vf[4][2];
#pragma unroll
        for (int mp = 0; mp < C::NM; ++mp) {
            f32x16 s0, s1;
#pragma unroll
            for (int r = 0; r < 16; ++r) { s0[r] = 0.f; s1[r] = 0.f; }
#pragma unroll
            for (int dd = 0; dd < C::NDM; ++dd) {
                s0 = mfma32(kf[0][dd], qf[mp * C::NDM + dd], s0); s1 = mfma32(kf[1][dd], qf[mp * C::NDM + dd], s1);
            }
            __builtin_amdgcn_sched_barrier(0);
            if (mp == 0) {
#pragma unroll
                for (int j = 0; j < 4; ++j)
#pragma unroll
                    for (int db = 0; db < 2; ++db) {
                        const LAS unsigned char* vp = Vb + (32 * db + l31) * AT_VROW + (32 * (j >> 1) + 16 * (j & 1) + 4 * hi) * 2;
                        const s16x4 lo = *(const LAS s16x4*)vp, hh = *(const LAS s16x4*)(vp + 16);
                        vf[j][db] = (bf16x8){lo[0], lo[1], lo[2], lo[3], hh[0], hh[1], hh[2], hh[3]};
                    }
                if (C::NM > 1) {
#pragma unroll
                    for (int dd = 0; dd < C::NDM; ++dd) {
                        kf[0][dd] = *(const LAS bf16x8*)(Kb + l31 * C::KROW + (C::NDM + dd) * 32 + hi * 16);
                        kf[1][dd] = *(const LAS bf16x8*)(Kb + (32 + l31) * C::KROW + (C::NDM + dd) * 32 + hi * 16);
                    }
                }
                __builtin_amdgcn_sched_barrier(0);
            }
            float ma = vmax3(s0[0], s0[1], s1[0]), mb = vmax3(s0[2], s0[3], s1[1]); ma = vmax3(ma, s1[2], s1[3]);
#pragma unroll
            for (int r = 4; r < 16; r += 4) { ma = vmax3(ma, s0[r], s0[r + 1]); mb = vmax3(mb, s0[r + 2], s0[r + 3]); ma = vmax3(ma, s1[r], s1[r + 1]); mb = vmax3(mb, s1[r + 2], s1[r + 3]); }
            float mx = vmax3(ma, mb, mb);
            mx = vmax3(mx, __shfl_xor(mx, 32), mx);
            const float rm = mx * cscale;
            if (t == 0) mref[mp] = rm;
            else if (__any(rm > mref[mp] + 8.0f)) {
                const float mnew = vmax3(mref[mp], rm, rm);
                const float alpha = __builtin_amdgcn_exp2f(mref[mp] - mnew);
                lsum[mp] *= alpha; mref[mp] = mnew;
                if (hi == 0) scr[l31] = alpha;
                asm volatile("s_waitcnt lgkmcnt(0)" ::: "memory");
#pragma unroll
                for (int g4 = 0; g4 < 4; ++g4) { const f32x4 a4 = *(const LAS f32x4*)(scr + 8 * g4 + 4 * hi);
#pragma unroll
                    for (int j = 0; j < 4; ++j) { O[mp][0][4 * g4 + j] *= a4[j]; O[mp][1][4 * g4 + j] *= a4[j]; } }
                asm volatile("s_waitcnt lgkmcnt(0)" ::: "memory");
            }
            const float nm = -mref[mp];
            float ls = 0.f;
#pragma unroll
            for (int r = 0; r < 16; ++r) { s0[r] = __builtin_amdgcn_exp2f(fmaf(s0[r], cscale, nm)); s1[r] = __builtin_amdgcn_exp2f(fmaf(s1[r], cscale, nm)); ls += s0[r] + s1[r]; }
            lsum[mp] += ls;
            bf16x8 pa[4];
#pragma unroll
            for (int j = 0; j < 4; ++j) {
                u32x4 w;
                if (j < 2) { w.x = pk2(s0[8 * j], s0[8 * j + 1]); w.y = pk2(s0[8 * j + 2], s0[8 * j + 3]); w.z = pk2(s0[8 * j + 4], s0[8 * j + 5]); w.w = pk2(s0[8 * j + 6], s0[8 * j + 7]); }
                else { const int jj = j - 2; w.x = pk2(s1[8 * jj], s1[8 * jj + 1]); w.y = pk2(s1[8 * jj + 2], s1[8 * jj + 3]); w.z = pk2(s1[8 * jj + 4], s1[8 * jj + 5]); w.w = pk2(s1[8 * jj + 6], s1[8 * jj + 7]); }
                pa[j] = __builtin_bit_cast(bf16x8, w);
            }
#pragma unroll
            for (int j = 0; j < 4; ++j)
#pragma unroll
                for (int db = 0; db < 2; ++db) O[mp][db] = mfma32(pa[j], vf[j][db], O[mp][db]);
        }
        if (more) {
            const int nb = cur ^ 1;
            *(LAS u32x4*)(lds + AT_LDS_K + nb * C::KT + kl0) = kr0; if (has1) *(LAS u32x4*)(lds + AT_LDS_K + nb * C::KT + kl1) = kr1;
            *(LAS u32x2*)(lds + AT_LDS_V + nb * (64 * AT_VROW) + vl) = (u32x2){vr.x, vr.y}; *(LAS u32x2*)(lds + AT_LDS_V + nb * (64 * AT_VROW) + vl + 8) = (u32x2){vr.z, vr.w};
        }
        __syncthreads();
    }
    float inv[C::NM][16];
#pragma unroll
    for (int mp = 0; mp < C::NM; ++mp) {
        float lt = lsum[mp]; lt += __shfl_xor(lt, 32);
        if (hi == 0) scr[l31] = 1.0f / lt;
        asm volatile("s_waitcnt lgkmcnt(0)" ::: "memory");
#pragma unroll
        for (int g4 = 0; g4 < 4; ++g4) { const f32x4 a4 = *(const LAS f32x4*)(scr + 8 * g4 + 4 * hi);
#pragma unroll
            for (int j = 0; j < 4; ++j) inv[mp][4 * g4 + j] = a4[j]; }
        asm volatile("s_waitcnt lgkmcnt(0)" ::: "memory");
    }
    GAS bf16_t* ow = (GAS bf16_t*)Oout + (size_t)(32 * wave) * DM;
    if constexpr (!DIFF) {
#pragma unroll
        for (int r = 0; r < 16; ++r) { const int q = (r & 3) + 8 * (r >> 2) + 4 * hi;
#pragma unroll
            for (int db = 0; db < 2; ++db) ow[(size_t)q * DM + 32 * db + l31] = f2bf(O[0][db][r] * inv[0][r]); }
    } else {
        const float gs0 = ((const GAS float*)gsub)[l31] * subscale, gs1 = ((const GAS float*)gsub)[32 + l31] * subscale;
#pragma unroll
        for (int r = 0; r < 16; ++r) { const int q = (r & 3) + 8 * (r >> 2) + 4 * hi;
            const float o0 = O[0][0][r] * inv[0][r] - lam * (O[1][0][r] * inv[1][r]);
            const float o1 = O[0][1][r] * inv[0][r] - lam * (O[1][1][r] * inv[1][r]);
            float ss = o0 * o0 + o1 * o1;
#pragma unroll
            for (int o = 1; o < 32; o <<= 1) ss += __shfl_xor(ss, o);
            const float rs = rsqrtf(ss * (1.0f / 64.0f) + EPS);
            ow[(size_t)q * DM + l31] = f2bf(o0 * rs * gs0); ow[(size_t)q * DM + 32 + l31] = f2bf(o1 * rs * gs1); }
    }
}

DEV void load8(const GAS bf16_t* p, float (&v)[8]) {
    const u32x4 w = *(const GAS u32x4*)p;
    v[0] = bf2f(w.x & 0xffffu); v[1] = bf2f(w.x >> 16); v[2] = bf2f(w.y & 0xffffu); v[3] = bf2f(w.y >> 16);
    v[4] = bf2f(w.z & 0xffffu); v[5] = bf2f(w.z >> 16); v[6] = bf2f(w.w & 0xffffu); v[7] = bf2f(w.w >> 16);
}
DEV void phase_f(const Args& a, int l, int nrows, int seqlen, int tid) {
    const GAS bf16_t* U = (const GAS bf16_t*)(a.ws + WS_U);
    GAS bf16_t* ACT = (GAS bf16_t*)(a.ws + WS_ACT);
    const GAS float* wc = (const GAS float*)a.in[I_WCONV] + (size_t)l * 3 * UPC;
    const int nitems = (nrows / 8) * 352;
    for (int it = blockIdx.x * 512 + tid; it < nitems; it += gridDim.x * 512) {
        const int rb = it / 352, j8 = it - rb * 352, r0 = rb * 8, c0 = j8 * 8;
        float wg[3][8], wv[3][8];
#pragma unroll
        for (int k = 0; k < 3; ++k) {
            const f32x4 g0 = *(const GAS f32x4*)(wc + k * UPC + c0), g1 = *(const GAS f32x4*)(wc + k * UPC + c0 + 4);
            const f32x4 v0 = *(const GAS f32x4*)(wc + k * UPC + DFF + c0), v1 = *(const GAS f32x4*)(wc + k * UPC + DFF + c0 + 4);
#pragma unroll
            for (int j = 0; j < 4; ++j) { wg[k][j] = g0[j]; wg[k][4 + j] = g1[j]; wv[k][j] = v0[j]; wv[k][4 + j] = v1[j]; }
        }
        float pg[8], pv[8], cg_[8], cv[8], ng[8], nv[8];
        const bool hasp = (r0 % seqlen) != 0, hasn = ((r0 + 8) % seqlen) != 0;
        if (hasp) { load8(U + (size_t)(r0 - 1) * UPC + c0, pg); load8(U + (size_t)(r0 - 1) * UPC + DFF + c0, pv); }
        else {
#pragma unroll
            for (int j = 0; j < 8; ++j) { pg[j] = 0.f; pv[j] = 0.f; } }
        load8(U + (size_t)r0 * UPC + c0, cg_); load8(U + (size_t)r0 * UPC + DFF + c0, cv);
#pragma unroll
        for (int i = 0; i < 8; ++i) {
            const int r = r0 + i;
            if (i < 7 || hasn) { load8(U + (size_t)(r + 1) * UPC + c0, ng); load8(U + (size_t)(r + 1) * UPC + DFF + c0, nv); }
            else {
#pragma unroll
                for (int j = 0; j < 8; ++j) { ng[j] = 0.f; nv[j] = 0.f; } }
            float o[8];
#pragma unroll
            for (int j = 0; j < 8; ++j) {
                const float gt = wg[0][j] * pg[j] + wg[1][j] * cg_[j] + wg[2][j] * ng[j];
                const float vl = wv[0][j] * pv[j] + wv[1][j] * cv[j] + wv[2][j] * nv[j];
                const float sg = gt * __builtin_amdgcn_rcpf(1.0f + __expf(-gt));
                o[j] = sg * vl;
            }
            u32x4 w; w.x = pk2(o[0], o[1]); w.y = pk2(o[2], o[3]); w.z = pk2(o[4], o[5]); w.w = pk2(o[6], o[7]);
            *(GAS u32x4*)(ACT + (size_t)r * DFF + c0) = w;
#pragma unroll
            for (int j = 0; j < 8; ++j) { pg[j] = cg_[j]; pv[j] = cv[j]; cg_[j] = ng[j]; cv[j] = nv[j]; }
        }
    }
}

struct ShiftOrder {
    pg8::StaticOrder S;
    __device__ void init(int M, int N, int G, int c) { S.init(M, N, G, c); }
    __device__ bool next(int i, pg8::Unit& u) const { return S.next(i, u); }
    DEV void a_ready(const pg8::Unit&) const {}
    DEV void done(const pg8::Unit&) const {}
};

#ifndef NREP_SYNC
#define NREP_SYNC 1
#endif
#ifndef NREP_P
#define NREP_P 1
#endif
#ifndef NREP_A
#define NREP_A 1
#endif
#ifndef NREP_B1
#define NREP_B1 1
#endif
#ifndef NREP_B
#define NREP_B 1
#endif
#ifndef NREP_C
#define NREP_C 1
#endif
#ifndef NREP_E
#define NREP_E 1
#endif
#ifndef NREP_F
#define NREP_F 1
#endif
__global__ void __launch_bounds__(512, 2) mega_fwd(Args a) {
    extern __shared__ __attribute__((aligned(16))) unsigned char lds_raw[];
    LAS unsigned char* lds = (LAS unsigned char*)lds_raw;
    cg::grid_group grid = cg::this_grid();
    const int G = gridDim.x, bid = blockIdx.x;
#define PH_LOCALS \
    unsigned char* ws = a.ws; asm volatile("" : "+s"(ws)); \
    int tid = threadIdx.x; asm volatile("" : "+v"(tid)); \
    const int lane = tid & 63, wave = __builtin_amdgcn_readfirstlane(tid >> 6); \
    const int gw = bid * 8 + wave, NGW = G * 8, gt = bid * 512 + tid, NGT = G * 512; \
    float* MOD = (float*)(ws + WS_MOD); float* BIN = (float*)(ws + WS_BIN); float* BUP = (float*)(ws + WS_BUP); float* SSQ = (float*)(ws + WS_SSQ); \
    bf16_t* XS = (bf16_t*)(ws + WS_XS); bf16_t* Pb = (bf16_t*)(ws + WS_P); bf16_t* OB = (bf16_t*)(ws + WS_OB); \
    unsigned* CTL = (unsigned*)(ws + WS_CTL); \
    (void)lane; (void)wave; (void)gw; (void)NGW; (void)gt; (void)NGT; (void)MOD; (void)BIN; (void)BUP; (void)SSQ; (void)XS; (void)Pb; (void)OB; (void)CTL;
    const bool one = (a.ph_hi - a.ph_lo) > 1;
    if (threadIdx.x < 16) ((LAS unsigned*)(lds + LDS_MISC))[threadIdx.x] = 0u;
    __syncthreads();
    XcdBarrier xbar; xbar.bar = (unsigned*)(a.ws + WS_CTL) + 16384; xbar.x = 0; xbar.st = nullptr;
    if (one) xbar = xcd_barrier_post((unsigned*)(a.ws + WS_CTL) + 16384, (volatile LAS unsigned*)(lds + LDS_MISC + 32));
    int ph = 0;
#define PH_BEGIN if (ph >= a.ph_lo && ph < a.ph_hi) { PH_LOCALS
#define PH_END   if (one && ph + 1 < a.ph_hi) { if (ph == 0) grid.sync(); else { for (int rs_ = 0; rs_ < NREP_SYNC; ++rs_) xcd_barrier(xbar); } } } ++ph;

    PH_BEGIN
#ifndef SKIP_P0
    for (int rep = 0; rep < NREP_P; ++rep) {
        LAS float* vec = (LAS float*)lds; LAS float* red = (LAS float*)(lds + 36864);
        for (int i = tid; i < 9216; i += 512) { const int v = i >> 10, k = i & 1023; const float x = (v == 0) ? a.in[I_CCTX][k] : a.in[I_C][(v - 1) * 1024 + k]; vec[i] = x / (1.0f + __expf(-x)); }
        __syncthreads();
        for (int it = bid; it < 4 * 96; it += G) { const int l = it / 96, nb = it % 96;
            gemv9_item(vec, red, a.in[I_WADA] + (size_t)l * DM * 6144, 6144, 6144, a.in[I_BADA] + l * 6144, MOD + (size_t)l * 9 * 6144, 6144, nb * 64, tid); }
        __syncthreads();
        convert_weights(a, lds, 0, 31, gw, NGW, wave, lane);
        for (int i = gt; i < 9 * MTOT; i += NGT) SSQ[i] = 0.f;
        for (int i = gt; i < 1024; i += NGT) CTL[i] = 0u;
        { unsigned* padp = (unsigned*)(ws + WS_WIN + (size_t)INC * DM * 2); for (int i = gt; i < (INP - INC) * DM / 2; i += NGT) padp[i] = 0u; }
        { bf16_t* T = (bf16_t*)(ws + WS_TLAT);
          for (int i = gt; i < 2048 * 4096; i += NGT) { const int np = i >> 12, k = i & 4095, n = k & 2047; const int m = (np * n) & 2047; const float x = (float)m * (1.0f / 1024.0f);
              const float v = (k < 2048) ? cospif(x) : -sinpif(x); T[i] = f2bf(v * 0.02209708691207961f); } }
        { bf16_t* T = (bf16_t*)(ws + WS_TCTX);
          for (int i = gt; i < 256 * 512; i += NGT) { const int np = i >> 9, k = i & 511, n = k & 255; const int m = (np * n) & 255; const float x = (float)m * (1.0f / 128.0f);
              const float v = (k < 256) ? cospif(x) : -sinpif(x); T[i] = f2bf(v * 0.0625f); } }
        { bf16_t* T = (bf16_t*)(ws + WS_CS64);
          for (int i = gt; i < 128 * 64; i += NGT) { const int cc = i >> 6, c = i & 63, cp = cc & 63; const int m = (cp * c) & 63; const float x = (float)m * (1.0f / 32.0f);
              const float v = (cc < 64) ? cospif(x) : sinpif(x); T[i] = f2bf(v * 0.125f); } }
    }
#endif
    PH_END
    PH_BEGIN
#ifndef SKIP_P1
    for (int rep = 0; rep < NREP_P; ++rep) {
        LAS float* vec = (LAS float*)lds; LAS float* red = (LAS float*)(lds + 36864);
        for (int it = bid; it < 4 * 124; it += G) { const int l = it / 124, j = it % 124; const bool up = j >= 36; const int chunk = up ? 3 : 0;
            for (int i = tid; i < 9216; i += 512) { const int v = i >> 10, k = i & 1023; vec[i] = MOD[((size_t)l * 9 + v) * 6144 + chunk * 1024 + k]; }
            __syncthreads();
            if (!up) gemv9_item(vec, red, a.in[I_WIN] + (size_t)l * DM * INC, INC, INC, nullptr, BIN + (size_t)l * 9 * INP, INP, j * 64, tid);
            else gemv9_item(vec, red, a.in[I_WUP] + (size_t)l * DM * UPC, UPC, UPC, nullptr, BUP + (size_t)l * 9 * UPC, UPC, (j - 36) * 64, tid);
        }
        for (int r = gw; r < MTOT; r += NGW) {
            const float* xr = (r < NCTX) ? a.in[I_XP] + (size_t)r * DM : a.in[I_XS] + (size_t)(r - NCTX) * DM;
            const int b9 = row_b9(r);
            const float* sc = MOD + (size_t)b9 * 6144 + 1024; const float* gm = a.in[I_GMIX];
            float ss = 0.f;
#pragma unroll
            for (int j = 0; j < 4; ++j) { const int c = 4 * lane + 256 * j; const f32x4 x = *(const f32x4*)(xr + c); const f32x4 g = *(const f32x4*)(gm + c), s = *(const f32x4*)(sc + c);
                ss += (x[0] * x[0] + x[1] * x[1]) + (x[2] * x[2] + x[3] * x[3]); const f32x4 y = x * g * (s + 1.0f);
                u32x2 w; w.x = pk2(y[0], y[1]); w.y = pk2(y[2], y[3]); *(u32x2*)(XS + (size_t)r * DM + c) = w; }
            ss = wave_sum(ss);
            if (lane == 0) SSQ[r] = ss;
        }
    }
#endif
    PH_END

#pragma unroll 1
    for (int l = 0; l < NLAYER; ++l) {
        PH_BEGIN
#ifndef SKIP_A
        {
            pg8::Gemm g{XS, (const bf16_t*)(ws + WS_WIN), MTOT, INP, DM}; pg8::StaticOrder S; S.init(MTOT, INP, G, bid);
            EpiA E{Pb, INP, SSQ + (size_t)(2 * l) * MTOT, BIN + (size_t)l * 9 * INP, INP, 0};
            for (int rep = 0; rep < NREP_A; ++rep) pg8::gemm_phase<EpiA, pg8::StaticOrder, true, true>(lds, g, S, E);
        }
#endif
        PH_END
        PH_BEGIN
#ifndef SKIP_B
        {
            for (int rep = 0; rep < NREP_B1; ++rep) phase_b(a, lds, l, tid, 0, bid, G);
        }
#endif
        PH_END
        PH_BEGIN
#ifndef SKIP_B
#pragma unroll 1
        for (int repb = 0; repb < NREP_B; ++repb) {
            if (bid < 96 && G > 128) {
#pragma unroll 1
                for (int f = 0; f < 2; ++f) {
                    pg8::Gemm g = (f == 0) ? pg8::Gemm{(const bf16_t*)(ws + WS_TLAT), (const bf16_t*)(ws + WS_FBL), 2048, 2048, 4096}
                                           : pg8::Gemm{(const bf16_t*)(ws + WS_TCTX), (const bf16_t*)(ws + WS_FBC), 256, 8192, 512};
                    pg8::StaticOrder S; S.init(g.M, g.N, G, (f == 0) ? bid : (bid + G - 64) % G);
                    EpiF E{OB, (f == 0) ? NCTX : 0, (f == 0) ? 2048 : 256};
                    pg8::gemm_phase<EpiF, pg8::StaticOrder, true, true>(lds, g, S, E);
                }
            } else {
                phase_b(a, lds, l, tid, 1, bid - 96, G - 96);
            }
        }
#endif
        PH_END
        PH_BEGIN
#ifndef SKIP_C
#pragma unroll 1
        for (int rep = 0; rep < NREP_C; ++rep) {
            int tid2 = threadIdx.x; asm volatile("" : "+v"(tid2));
            unsigned char* ws2 = a.ws; asm volatile("" : "+s"(ws2));
            float lam, lam_init;
            { const float p1 = ((tid2 & 63) < 32) ? a.in[I_LQ1][l * 32 + (tid2 & 63)] * a.in[I_LK1][l * 32 + (tid2 & 63)] : 0.f, p2 = ((tid2 & 63) < 32) ? a.in[I_LQ2][l * 32 + (tid2 & 63)] * a.in[I_LK2][l * 32 + (tid2 & 63)] : 0.f;
              lam_init = 0.8f - 0.6f * expf(-0.3f * (float)l); lam = expf(wave_sum(p1)) - expf(wave_sum(p2)) + lam_init; }
            const float cm = 0.10206207261596575f * 1.4426950408889634f, cd = 0.17677669529663687f * 1.4426950408889634f;
            LAS int* qslot = (LAS int*)(lds + LDS_MISC);
            unsigned* qctr = (unsigned*)(ws2 + WS_CTL) + 64 * (1 + l + 8 * rep);
            for (;;) {
                __syncthreads();
                if (tid2 == 0) *qslot = (int)atomicAdd(qctr, 1u);
                __syncthreads();
                const int idx = *qslot;
                if (idx >= 1152) break;
                const bool lat = idx < 768;
                const bool diff = lat ? (idx < 384) : (idx < 960);
                int q0, vt_ld, nt_main, nt_total, qa_ld; size_t qa_off, k_off, vt_off; size_t qa_base, k_base, vt_base;
                int h;
                if (lat) { const int j = diff ? idx : idx - 384; const int bh = j >> 3, qb = j & 7, b = bh / 6; h = bh % 6;
                    const int lr0 = b * 2048 + qb * 256; q0 = NCTX + lr0; vt_ld = 2560; nt_main = 32; nt_total = 40;
                    qa_base = diff ? WS_QDR : WS_QMR; qa_ld = diff ? 384 : 576; qa_off = (size_t)lr0 * qa_ld + (diff ? 64 : 96) * h;
                    k_base = diff ? WS_KDL : WS_KML; k_off = (size_t)b * 2560 * (diff ? 384 : 576) + (diff ? 64 : 96) * h;
                    vt_base = diff ? WS_VDL : WS_VML; vt_off = (size_t)(b * 6 + h) * 64 * 2560; }
                else { const int j = diff ? idx - 768 : idx - 960; const int i = j / 6; h = j % 6; q0 = i * 256; vt_ld = 256; nt_main = 4; nt_total = 4;
                    qa_base = WS_P; qa_ld = INP; qa_off = (size_t)q0 * INP + (diff ? 736 + 64 * h : 96 * h);
                    k_base = diff ? WS_KDC : WS_KMC; k_off = (size_t)q0 * (diff ? 384 : 576) + (diff ? 64 : 96) * h;
                    vt_base = diff ? WS_VDC : WS_VMC; vt_off = (size_t)(i * 6 + h) * 64 * 256; }
                const bf16_t* Qa = (const bf16_t*)(ws2 + qa_base) + qa_off;
                const bf16_t* Qb = (const bf16_t*)(ws2 + WS_P) + (size_t)q0 * INP + (diff ? 736 + 64 * h : 96 * h);
                const bf16_t* Kp = (const bf16_t*)(ws2 + k_base) + k_off;
                const bf16_t* Vt = (const bf16_t*)(ws2 + vt_base) + vt_off;
                bf16_t* Oo = (bf16_t*)(ws2 + WS_OB) + (size_t)q0 * DM + (diff ? 384 : 0) + 64 * h;
                if (diff) { int tt = threadIdx.x; asm volatile("" : "+v"(tt)); attn_unit<true>(lds, Qa, qa_ld, Qb, INP, Kp, 384, Vt, vt_ld, nt_main, nt_total, Oo, cd, lam, a.in[I_GSUB] + l * 64, 1.0f - lam_init, tt); }
                else { int tt = threadIdx.x; asm volatile("" : "+v"(tt)); attn_unit<false>(lds, Qa, qa_ld, Qb, INP, Kp, 576, Vt, vt_ld, nt_main, nt_total, Oo, cm, 0.f, nullptr, 0.f, tt); }
            }
        }
#endif
        PH_END
        PH_BEGIN
#ifndef SKIP_D
        {
            if (l > 0 && bid >= 128) { convert_weights(a, lds, l, 16, gw - 128 * 8, NGW - 128 * 8, wave, lane); __syncthreads(); }
            pg8::Gemm g{OB, (const bf16_t*)(ws + WS_WOUT), MTOT, DM, DM}; pg8::StaticOrder S; S.init(MTOT, DM, G, bid);
            EpiRes E{(l == 0) ? a.in[I_XP] : a.out, (l == 0) ? a.in[I_XS] : a.out + (size_t)NCTX * DM, a.out, (MOD + (size_t)l * 9 * 6144) + 2 * 1024,
                     a.in[I_GFFN] + l * DM, (MOD + (size_t)l * 9 * 6144) + 4 * 1024, XS, SSQ + (size_t)(2 * l + 1) * MTOT, 0};
            pg8::gemm_phase<EpiRes, pg8::StaticOrder, true, true>(lds, g, S, E);
        }
#endif
        PH_END
#pragma unroll 1
        for (int ch = 0; ch < 2; ++ch) {
            const int row0 = (ch == 0) ? NCTX : 0, Mc = (ch == 0) ? NLAT : NCTX, seqlen = (ch == 0) ? 2048 : 256;
            PH_BEGIN
#ifndef SKIP_E
            {
                pg8::Gemm g{XS + (size_t)row0 * DM, (const bf16_t*)(ws + WS_WUP), Mc, UPC, DM}; pg8::StaticOrder S; S.init(Mc, UPC, G, bid);
                EpiA E{(bf16_t*)(ws + WS_U), UPC, SSQ + (size_t)(2 * l + 1) * MTOT, BUP + (size_t)l * 9 * UPC, UPC, row0};
                for (int rep = 0; rep < NREP_E; ++rep) pg8::gemm_phase<EpiA, pg8::StaticOrder, true, true>(lds, g, S, E);
            }
#endif
            PH_END
            PH_BEGIN
#ifndef SKIP_F
            { for (int rep = 0; rep < NREP_F; ++rep) phase_f(a, l, Mc, seqlen, tid); }
#endif
            PH_END
            PH_BEGIN
#ifndef SKIP_G
            {
                if (ch == 1 && l + 1 < NLAYER && bid >= 128) { convert_weights(a, lds, l + 1, 15, gw - 128 * 8, NGW - 128 * 8, wave, lane); __syncthreads(); }
                const bool nxt = (l + 1 < NLAYER);
                pg8::Gemm g{(const bf16_t*)(ws + WS_ACT), (const bf16_t*)(ws + WS_WDN), Mc, DM, DFF}; pg8::StaticOrder S; S.init(Mc, DM, G, bid);
                EpiRes E{a.out, a.out + (size_t)NCTX * DM, a.out, (MOD + (size_t)l * 9 * 6144) + 5 * 1024,
                         nxt ? a.in[I_GMIX] + (l + 1) * DM : nullptr, (MOD + (size_t)l * 9 * 6144) + 9 * 6144 + 1 * 1024, XS, SSQ + (size_t)(nxt ? 2 * l + 2 : 8) * MTOT, row0};
                pg8::gemm_phase<EpiRes, pg8::StaticOrder, true, true>(lds, g, S, E);
            }
#endif
            PH_END
        }
    }
    PH_BEGIN
#ifndef SKIP_FIN
    {
        const float* gf = a.in[I_GFINAL];
        for (int r = gw; r < MTOT; r += NGW) {
            float* xr = a.out + (size_t)r * DM;
            f32x4 x[4]; float ss = 0.f;
#pragma unroll
            for (int j = 0; j < 4; ++j) { x[j] = *(const f32x4*)(xr + 4 * lane + 256 * j); ss += (x[j][0] * x[j][0] + x[j][1] * x[j][1]) + (x[j][2] * x[j][2] + x[j][3] * x[j][3]); }
            ss = wave_sum(ss);
            const float rs = rsqrtf(ss * (1.0f / 1024.0f) + EPS);
#pragma unroll
            for (int j = 0; j < 4; ++j) { const f32x4 g = *(const f32x4*)(gf + 4 * lane + 256 * j); *(f32x4*)(xr + 4 * lane + 256 * j) = x[j] * rs * g; }
        }
    }
#endif
    PH_END
#undef PH_BEGIN
#undef PH_END
}
constexpr int N_PHASES = 2 + NLAYER * 11 + 1;

#ifndef MK_ONE_LAUNCH
#define MK_ONE_LAUNCH 1
#endif
extern "C" void kernel_launch(void* const* d_in, const int* in_sizes, int n_in, void* d_out, int out_size, void* d_ws, size_t ws_size, hipStream_t stream) {
    static int grid = 0;
    if (grid == 0) {
        if (n_in != 26 || ws_size < WS_END) { fprintf(stderr, "kernel_launch: unexpected inputs (n_in %d, ws %zu < %zu)\n", n_in, ws_size, (size_t)WS_END); grid = -1; return; }
        int dev = 0, cus = 0, per_cu = 0;
        hipGetDevice(&dev); hipDeviceGetAttribute(&cus, hipDeviceAttributeMultiprocessorCount, dev);
        if (hipFuncSetAttribute((const void*)mega_fwd, hipFuncAttributeMaxDynamicSharedMemorySize, LDS_BYTES) != hipSuccess) { fprintf(stderr, "kernel_launch: hipFuncSetAttribute failed\n"); grid = -1; return; }
        if (hipOccupancyMaxActiveBlocksPerMultiprocessor(&per_cu, (const void*)mega_fwd, 512, LDS_BYTES) != hipSuccess || per_cu < 1) { fprintf(stderr, "kernel_launch: occupancy query gave %d\n", per_cu); per_cu = 1; }
        (void)hipGetLastError();
        grid = cus * 1;
    }
    if (grid < 0) return;
    if (hipMemsetAsync((char*)d_ws + WS_CTL, 0, 1 << 20, stream) != hipSuccess) { fprintf(stderr, "kernel_launch: memset failed\n"); return; }
    Args a{};
    for (int i = 0; i < 26; ++i) a.in[i] = (const float*)d_in[i];
    a.out = (float*)d_out; a.ws = (unsigned char*)d_ws;
#if MK_ONE_LAUNCH
    a.ph_lo = 0; a.ph_hi = N_PHASES;
    void* args[] = {&a};
    hipError_t e = hipLaunchCooperativeKernel((const void*)mega_fwd, dim3(grid), dim3(512), args, LDS_BYTES, stream);
    if (e != hipSuccess) fprintf(stderr, "cooperative launch failed: %s (grid %d)\n", hipGetErrorString(e), grid);
#else
    for (int p = 0; p < N_PHASES; ++p) { a.ph_lo = p; a.ph_hi = p + 1; hipLaunchKernelGGL(mega_fwd, dim3(grid), dim3(512), LDS_BYTES, stream, a); }
#endif
}
```

```cpp
#include <hip/hip_runtime.h>
#include <hip/hip_cooperative_groups.h>
#include <cstdio>
#include <cstdint>
namespace cg = cooperative_groups;
namespace pg8 {
#define PG8_LAS __attribute__((address_space(3)))
typedef unsigned short bf16_t;
typedef short bf16x8 __attribute__((ext_vector_type(8)));
typedef float f32x4 __attribute__((ext_vector_type(4)));
typedef unsigned u32x4 __attribute__((ext_vector_type(4)));
constexpr int BM = 256, BK = 64, HALF = 128, HTB = HALF * BK * 2  , STAGE_BYTES = 8 * HTB, NXCD = 8, WGM = 8;

__host__ __device__ __forceinline__ int lds_byte(int r, int c) { const int st = (r >> 4) * 2 + (c >> 5), rr = r & 15, cc = c & 31, ob = rr * 64 + cc * 2; return st * 1024 + (ob ^ (((ob >> 9) & 1) << 5)); }
__host__ __device__ __forceinline__ void stage_rc(int b, int& R, int& C) { const int st = b / 1024, sb = b % 1024, swz = sb ^ (((sb >> 9) & 1) << 5); R = (st >> 1) * 16 + swz / 64; C = (st & 1) * 32 + (swz % 64) / 2; }
__host__ __device__ __forceinline__ int perm32(int rho) { const int n = rho >> 4, i = rho & 15; return 8 * (i >> 2) + 4 * n + (i & 3); }

struct Unit { int pm, pn; };
struct Gemm { const bf16_t* A; const bf16_t* Bt; int M, N, K; };

struct StaticOrder {
    int nM, nN, nwg, G, c;
    __host__ __device__ void init(int M, int N, int G_, int c_) { nM = M / BM; nN = N / BM; nwg = nM * nN; G = G_; c = c_; }
    __host__ __device__ bool next(int i, Unit& u) const {
        const long L = (long)i * G + c; if (L >= nwg) return false;
        int wgid = (int)L; { const int q = nwg / NXCD, r = nwg % NXCD, xcd = wgid % NXCD, off = wgid / NXCD; wgid = (xcd < r ? xcd * (q + 1) : r * (q + 1) + (xcd - r) * q) + off; }
        const int nig = WGM * nN, gid = wgid / nig, fm = gid * WGM, gsz = (nM - fm) < WGM ? (nM - fm) : WGM;
        u.pm = fm + ((wgid % nig) % gsz); u.pn = (wgid % nig) / gsz; return true;
    }
    __device__ __forceinline__ int arow(const Unit& u) const { return u.pm * BM; }
    __device__ __forceinline__ void a_ready(const Unit&) const {}
    __device__ __forceinline__ void done(const Unit&) const {}
};

__device__ __forceinline__ unsigned cvt_pk_bf16(float lo, float hi) { unsigned r; asm volatile("v_cvt_pk_bf16_f32 %0, %1, %2" : "=v"(r) : "v"(lo), "v"(hi)); return r; }
typedef float f32x2 __attribute__((ext_vector_type(2)));
__device__ __forceinline__ f32x2 gelu_pk(f32x2 v) {
    const f32x2 av = __builtin_elementwise_abs(v), d = av * 0.2316418882f + 1.0f;
    f32x2 t; t.x = __builtin_amdgcn_rcpf(d.x); t.y = __builtin_amdgcn_rcpf(d.y);
    f32x2 q = t * 0.5307027145f + (-0.7265760135f); q = q * t + 0.7107068705f; q = q * t + (-0.142248368f); q = q * t + 0.127414796f; q = q * t;
    const f32x2 s = (v * v) * (-0.72134752044f);
    f32x2 e; e.x = __builtin_amdgcn_exp2f(s.x); e.y = __builtin_amdgcn_exp2f(s.y);
    const f32x2 m = v * (q * e), r = v - m;
    f32x2 o; o.x = v.x < 0.f ? m.x : r.x; o.y = v.y < 0.f ? m.y : r.y; return o;
}

template <int ACT  > struct EpiBf16 {
    static constexpr bool PERM = true, AFTER_DRAIN = false; static_assert(ACT == 0 || ACT == 1, "EpiBf16: ACT is 0 (none) or 1 (gelu_pk)");
    bf16_t* O; int ldc; const float* bias; int split_cols; size_t split_stride; float scale0;
    __device__ __forceinline__ void operator()(const f32x4 (&acc)[2][2][4][2], const Unit& u, int wr, int wc, int fr, int fq) const {
        const int row0 = u.pm * BM + wr * 64 + fr; int colt = u.pn * BM; bf16_t* base = O;
        float sc = 1.f; if (split_cols) { const int t = colt / split_cols; base += (size_t)t * split_stride; colt -= t * split_cols; if (t == 0) sc = scale0; }
        const int col0 = colt + wc * 32 + 8 * fq, bcol0 = u.pn * BM + wc * 32 + 8 * fq;
        f32x4 bv[2][2];
#pragma unroll
        for (int bj = 0; bj < 2; ++bj)
#pragma unroll
            for (int n = 0; n < 2; ++n) bv[bj][n] = bias ? *(const f32x4*)(bias + bcol0 + bj * HALF + 4 * n) : (f32x4){0.f, 0.f, 0.f, 0.f};
#pragma unroll
        for (int ai = 0; ai < 2; ++ai)
#pragma unroll
            for (int m = 0; m < 4; ++m) { bf16_t* rowp = base + (size_t)(row0 + ai * HALF + m * 16) * ldc + col0;
#pragma unroll
                for (int bj = 0; bj < 2; ++bj) { f32x4 v0 = acc[ai][bj][m][0] + bv[bj][0], v1 = acc[ai][bj][m][1] + bv[bj][1];
                    if (ACT == 1) { f32x2 a = gelu_pk((f32x2){v0[0], v0[1]}), b = gelu_pk((f32x2){v0[2], v0[3]}), c = gelu_pk((f32x2){v1[0], v1[1]}), d = gelu_pk((f32x2){v1[2], v1[3]});
                        v0 = (f32x4){a.x, a.y, b.x, b.y}; v1 = (f32x4){c.x, c.y, d.x, d.y}; }
                    v0 = v0 * sc; v1 = v1 * sc; u32x4 w; w.x = cvt_pk_bf16(v0[0], v0[1]); w.y = cvt_pk_bf16(v0[2], v0[3]); w.z = cvt_pk_bf16(v1[0], v1[1]); w.w = cvt_pk_bf16(v1[2], v1[3]);
                    *(u32x4*)(rowp + bj * HALF) = w; } }
    }
};

struct PanelStats {
    unsigned* xbuf;
    unsigned* cnt;
    unsigned* tmo;
    int ntn; float eps;
    unsigned code;
    __device__ __forceinline__ bool run(const f32x4 (&v)[2][2][4][2], const Unit& u, int wr, int wc, int fr, int fq, PG8_LAS unsigned char* lds, int wid, int lane) const {
        typedef float f32x2v __attribute__((ext_vector_type(2)));
        PG8_LAS f32x2v* P = (PG8_LAS f32x2v*)lds;
        PG8_LAS f32x2v* S = (PG8_LAS f32x2v*)(lds + 8192);
        PG8_LAS unsigned* flag = (PG8_LAS unsigned*)(lds + 8192 + 2048);
#pragma unroll
        for (int ai = 0; ai < 2; ++ai)
#pragma unroll
            for (int m = 0; m < 4; ++m) {
                float s = 0.f;
#pragma unroll
                for (int bj = 0; bj < 2; ++bj)
#pragma unroll
                    for (int n = 0; n < 2; ++n) { const f32x4 x = v[ai][bj][m][n]; s += (x[0] + x[1]) + (x[2] + x[3]); }
                s += __shfl_xor(s, 16); s += __shfl_xor(s, 32);
                const float mw = s * (1.0f / 64.0f); float q = 0.f;
#pragma unroll
                for (int bj = 0; bj < 2; ++bj)
#pragma unroll
                    for (int n = 0; n < 2; ++n) { const f32x4 d = v[ai][bj][m][n] - mw; q += (d[0] * d[0] + d[1] * d[1]) + (d[2] * d[2] + d[3] * d[3]); }
                q += __shfl_xor(q, 16); q += __shfl_xor(q, 32);
                if (fq == 0) P[(ai * HALF + wr * 64 + m * 16 + fr) * 4 + wc] = (f32x2v){mw, q};
            }
        asm volatile("s_waitcnt lgkmcnt(0)" ::: "memory"); __builtin_amdgcn_s_barrier(); asm volatile("" ::: "memory");
#if defined(BROKEN_EXCHANGE_NO_WAIT)
#warning BROKEN CONTROL BUILD: the row-statistics exchange does not wait; results are wrong by design
        if (blockIdx.x >= 64) { const long long t0_ = clock64(); while (clock64() - t0_ < 60000) __builtin_amdgcn_s_sleep(8); }
#endif
        const int row = wid * 32 + (lane & 31);
        if (lane < 32) {
            const f32x2v a = P[row * 4 + 0], b = P[row * 4 + 1], c = P[row * 4 + 2], d = P[row * 4 + 3];
            const float mt = (a.x + b.x + c.x + d.x) * 0.25f;
            const float da = a.x - mt, db = b.x - mt, dc = c.x - mt, dd = d.x - mt;
            const float m2 = (a.y + b.y) + (c.y + d.y) + 64.0f * ((da * da + db * db) + (dc * dc + dd * dd));
            unsigned long long* slot = (unsigned long long*)xbuf + ((size_t)(u.pm * BM + row) * 4 + u.pn);
            __hip_atomic_store(slot, ((unsigned long long)__float_as_uint(m2) << 32) | __float_as_uint(mt), __ATOMIC_RELAXED, __HIP_MEMORY_SCOPE_AGENT);
        }
        asm volatile("s_waitcnt vmcnt(0)" ::: "memory");
        if (lane == 0) __hip_atomic_fetch_add(cnt + 64 * u.pm, 1u, __ATOMIC_RELAXED, __HIP_MEMORY_SCOPE_AGENT);
        if (wid == 0) {
            bool dead = false; const unsigned long long t0 = __builtin_amdgcn_s_memrealtime(); const unsigned want = 8u * (unsigned)ntn;
            for (;;) {
#if defined(BROKEN_EXCHANGE_NO_WAIT)
                break;
#endif
                if ((unsigned)__builtin_amdgcn_readfirstlane(__hip_atomic_load(cnt + 64 * u.pm, __ATOMIC_RELAXED, __HIP_MEMORY_SCOPE_AGENT)) >= want) break;
                if (__builtin_amdgcn_s_memrealtime() - t0 > 2000000ull) {
                    if (lane == 0) { unsigned expect = 0u; __hip_atomic_compare_exchange_strong(tmo + 1, &expect, code | (unsigned)(u.pm & 0xff), __ATOMIC_RELAXED, __ATOMIC_RELAXED, __HIP_MEMORY_SCOPE_AGENT);
                                     __hip_atomic_store(tmo, 1u, __ATOMIC_RELAXED, __HIP_MEMORY_SCOPE_AGENT); }
                    dead = true; break; }
                __builtin_amdgcn_s_sleep(2);
            }
            __builtin_amdgcn_fence(__ATOMIC_ACQUIRE, "agent");
            if (lane == 0) flag[0] = dead ? 1u : 0u;
        }
        asm volatile("s_waitcnt vmcnt(0) lgkmcnt(0)" ::: "memory"); __builtin_amdgcn_s_barrier(); asm volatile("" ::: "memory");
        const bool bad = flag[0] != 0u;
        if (lane < 32) {
            const unsigned long long* slot = (const unsigned long long*)xbuf + (size_t)(u.pm * BM + row) * 4; float mt[4], m2[4]; float ms = 0.f;
#pragma unroll
            for (int t = 0; t < 4; ++t) { if (t < ntn) { const unsigned long long w = __hip_atomic_load(slot + t, __ATOMIC_RELAXED, __HIP_MEMORY_SCOPE_AGENT); mt[t] = __uint_as_float((unsigned)w); m2[t] = __uint_as_float((unsigned)(w >> 32)); } else { mt[t] = 0.f; m2[t] = 0.f; } ms += mt[t]; }
            const float mean = ms / (float)ntn; float q = 0.f;
#pragma unroll
            for (int t = 0; t < 4; ++t) if (t < ntn) { const float dm = mt[t] - mean; q += m2[t] + 256.0f * dm * dm; }
            S[row] = (f32x2v){mean, 1.0f / sqrtf(q / (256.0f * (float)ntn) + eps)};
        }
        asm volatile("s_waitcnt lgkmcnt(0)" ::: "memory"); __builtin_amdgcn_s_barrier(); asm volatile("" ::: "memory");
        return bad;
    }
};
struct EpiLnRes {
    static constexpr bool PERM = false, AFTER_DRAIN = true;
    const float* base; float* out; int ldc; const float* bias; PanelStats st; unsigned poison;
    __device__ __forceinline__ void fused(f32x4 (&acc)[2][2][4][2], const Unit& u, int wr, int wc, int fr, int fq, PG8_LAS unsigned char* lds, int wid, int lane) const {
        typedef float f32x2v __attribute__((ext_vector_type(2)));
        const PG8_LAS f32x2v* S = (const PG8_LAS f32x2v*)(lds + 8192);
        const int col0 = u.pn * BM + wc * 32 + 4 * fq;
#pragma unroll
        for (int bj = 0; bj < 2; ++bj)
#pragma unroll
            for (int n = 0; n < 2; ++n) { const f32x4 bv = bias ? *(const f32x4*)(bias + col0 + bj * HALF + n * 16) : (f32x4){0.f, 0.f, 0.f, 0.f};
#pragma unroll
                for (int ai = 0; ai < 2; ++ai)
#pragma unroll
                    for (int m = 0; m < 4; ++m) acc[ai][bj][m][n] += bv; }
        f32x4 pre[4][2][2];
#pragma unroll
        for (int m = 0; m < 4; ++m) { const size_t off = (size_t)(u.pm * BM + wr * 64 + m * 16 + fr) * ldc + col0;
#pragma unroll
            for (int bj = 0; bj < 2; ++bj)
#pragma unroll
                for (int n = 0; n < 2; ++n) pre[m][bj][n] = *(const f32x4*)(base + off + bj * HALF + n * 16); }
        const bool bad = st.run(acc, u, wr, wc, fr, fq, lds, wid, lane) || poison != 0u;
        const float qnan = __builtin_nanf("");
#pragma unroll
        for (int ai = 0; ai < 2; ++ai)
#pragma unroll
            for (int m = 0; m < 4; ++m) { const int r = ai * HALF + wr * 64 + m * 16 + fr; const f32x2v sr = S[r]; const size_t off = (size_t)(u.pm * BM + r) * ldc + col0;
#pragma unroll
                for (int bj = 0; bj < 2; ++bj)
#pragma unroll
                    for (int n = 0; n < 2; ++n) { const f32x4 bs = ai == 0 ? pre[m][bj][n] : *(const f32x4*)(base + off + bj * HALF + n * 16); f32x4 o = bs + (acc[ai][bj][m][n] - sr.x) * sr.y;
                        if (bad) o = (f32x4){qnan, qnan, qnan, qnan}; *(f32x4*)(out + off + bj * HALF + n * 16) = o; }
                if (m & 1) asm volatile("" ::: "memory"); }
    }
};
struct EpiLnResLn {
    static constexpr bool PERM = false, AFTER_DRAIN = true;
    const float* base; float* out; bf16_t* xn; int ldc; const float* bias; PanelStats st1, st2; unsigned poison;
    __device__ __forceinline__ void fused(f32x4 (&acc)[2][2][4][2], const Unit& u, int wr, int wc, int fr, int fq, PG8_LAS unsigned char* lds, int wid, int lane) const {
        typedef float f32x2v __attribute__((ext_vector_type(2))); typedef unsigned u32x2v __attribute__((ext_vector_type(2)));
        const PG8_LAS f32x2v* S = (const PG8_LAS f32x2v*)(lds + 8192);
        const int col0 = u.pn * BM + wc * 32 + 4 * fq;
#pragma unroll
        for (int bj = 0; bj < 2; ++bj)
#pragma unroll
            for (int n = 0; n < 2; ++n) { const f32x4 bv = bias ? *(const f32x4*)(bias + col0 + bj * HALF + n * 16) : (f32x4){0.f, 0.f, 0.f, 0.f};
#pragma unroll
                for (int ai = 0; ai < 2; ++ai)
#pragma unroll
                    for (int m = 0; m < 4; ++m) acc[ai][bj][m][n] += bv; }
        bool bad = st1.run(acc, u, wr, wc, fr, fq, lds, wid, lane) || poison != 0u;
        const float qnan = __builtin_nanf("");
#pragma unroll
        for (int ai = 0; ai < 2; ++ai)
#pragma unroll
            for (int m = 0; m < 4; ++m) { const int r = ai * HALF + wr * 64 + m * 16 + fr; const f32x2v sr = S[r]; const size_t off = (size_t)(u.pm * BM + r) * ldc + col0;
#pragma unroll
                for (int bj = 0; bj < 2; ++bj)
#pragma unroll
                    for (int n = 0; n < 2; ++n) { const f32x4 bs = *(const f32x4*)(base + off + bj * HALF + n * 16); acc[ai][bj][m][n] = bs + (acc[ai][bj][m][n] - sr.x) * sr.y; }
                asm volatile("" : "+v"(acc[ai][0][m][0]), "+v"(acc[ai][0][m][1]), "+v"(acc[ai][1][m][0]), "+v"(acc[ai][1][m][1]));
                if (m & 1) asm volatile("" ::: "memory"); }
        const bool bad1 = bad;
        bad = st2.run(acc, u, wr, wc, fr, fq, lds, wid, lane) || bad;
#pragma unroll
        for (int ai = 0; ai < 2; ++ai)
#pragma unroll
            for (int m = 0; m < 4; ++m) { const int r = ai * HALF + wr * 64 + m * 16 + fr; const f32x2v sr = S[r]; const size_t off = (size_t)(u.pm * BM + r) * ldc + col0;
#pragma unroll
                for (int bj = 0; bj < 2; ++bj)
#pragma unroll
                    for (int n = 0; n < 2; ++n) { const f32x4 x1 = acc[ai][bj][m][n]; *(f32x4*)(out + off + bj * HALF + n * 16) = bad1 ? (f32x4){qnan, qnan, qnan, qnan} : x1;
                        const f32x4 o = (x1 - sr.x) * sr.y; u32x2v w; w.x = cvt_pk_bf16(o[0], o[1]); w.y = cvt_pk_bf16(o[2], o[3]);
                        if (bad) { w.x = 0x7fc07fc0u; w.y = 0x7fc07fc0u; } *(u32x2v*)(xn + off + bj * HALF + n * 16) = w; }
                asm volatile("" ::: "memory"); }
    }
};

template <class Epi, class Sched, bool ALIGN_EPI = false, bool SP2 = false>
__device__ __forceinline__ void gemm_phase(PG8_LAS unsigned char* lds, const Gemm g, const Sched& S, const Epi& E) {
    int tid = threadIdx.x; asm volatile("" : "+v"(tid));
    const int wid = __builtin_amdgcn_readfirstlane(tid >> 6), lane = tid & 63, wr = wid >> 2, wc = wid & 3, fr = lane & 15, fq = lane >> 4;
    const int K = g.K, nt = K / BK;
    unsigned voffA[2], voffB[2];
#pragma unroll
    for (int i = 0; i < 2; ++i) { int R, C; stage_rc(tid * 16 + i * 8192, R, C); const int Rb = Epi::PERM ? ((R & ~31) + perm32(R & 31)) : R;
        voffA[i] = (unsigned)(R * K + C) * 2u; voffB[i] = (unsigned)(Rb * K + C) * 2u; }
    const size_t kstep = (size_t)(BK * 2);
    const size_t hstep = (size_t)HALF * K * 2;
    const size_t tstep = 2 * hstep;
    const unsigned ldsw = (unsigned)wid * 1024u;
    const int aoff = lds_byte(wr * 64 + fr, fq * 8), boff = lds_byte(wc * 32 + fr, fq * 8);
#define PG8_SA(b, h) (((b) * 2 + (h)) * HTB)
#define PG8_SB(b, h) ((4 + (b) * 2 + (h)) * HTB)
#define PG8_STAGE(bufoff, gbase, voff) do { _Pragma("unroll") for (int _i = 0; _i < 2; ++_i) \
        __builtin_amdgcn_global_load_lds((const unsigned*)((const char*)(gbase) + (voff)[_i]), (PG8_LAS unsigned*)(lds + (bufoff) + ldsw + _i * 8192), 16, 0, 0); } while (0)
#define PG8_LDA(dst, b, h) do { _Pragma("unroll") for (int m = 0; m < 4; ++m) _Pragma("unroll") for (int k = 0; k < 2; ++k) dst[m][k] = *(const PG8_LAS bf16x8*)(lds + PG8_SA(b, h) + aoff + m * 2048 + k * 1024); } while (0)
#define PG8_LDB(dst, b, h) do { _Pragma("unroll") for (int n = 0; n < 2; ++n) _Pragma("unroll") for (int k = 0; k < 2; ++k) dst[n][k] = *(const PG8_LAS bf16x8*)(lds + PG8_SB(b, h) + boff + n * 2048 + k * 1024); } while (0)
#define PG8_MMA(ai, bj, At, Bt) do { __builtin_amdgcn_s_setprio(1); _Pragma("unroll") for (int m = 0; m < 4; ++m) _Pragma("unroll") for (int n = 0; n < 2; ++n) _Pragma("unroll") for (int k = 0; k < 2; ++k) \
        acc[ai][bj][m][n] = __builtin_amdgcn_mfma_f32_16x16x32_bf16(Bt[n][k], At[m][k], acc[ai][bj][m][n], 0, 0, 0); __builtin_amdgcn_s_setprio(0); } while (0)
#define PG8_WAIT_V(n) asm volatile("s_waitcnt vmcnt(" #n ")" ::: "memory")
#define PG8_WAIT_L(n) asm volatile("s_waitcnt lgkmcnt(" #n ")" ::: "memory")
#define PG8_BAR __builtin_amdgcn_s_barrier()
#define PG8_SCHED __builtin_amdgcn_sched_barrier(0)
    Unit cur, nxt; int ui = 0;
    if (!S.next(0, cur)) return;
    f32x4 acc[2][2][4][2];
#pragma unroll
    for (int a = 0; a < 2; ++a)
#pragma unroll
        for (int b = 0; b < 2; ++b)
#pragma unroll
            for (int m = 0; m < 4; ++m)
#pragma unroll
                for (int n = 0; n < 2; ++n) acc[a][b][m][n] = (f32x4){0.f, 0.f, 0.f, 0.f};
    bf16x8 At[4][2], B0[2][2], B1[2][2];
    const char* cA = (const char*)g.A + (size_t)S.arow(cur) * (size_t)(K * 2); const char* cB = (const char*)g.Bt + (size_t)cur.pn * tstep;
    S.a_ready(cur);
    if constexpr (SP2) {
        PG8_STAGE(PG8_SB(0, 0), cB, voffB); PG8_STAGE(PG8_SB(0, 1), cB + hstep, voffB); PG8_STAGE(PG8_SA(0, 0), cA, voffA); PG8_STAGE(PG8_SA(0, 1), cA + hstep, voffA);
        if (wr == 1) PG8_BAR;
        PG8_WAIT_V(2); PG8_BAR;
        PG8_STAGE(PG8_SB(1, 0), cB + kstep, voffB); PG8_STAGE(PG8_SA(1, 0), cA + kstep, voffA); PG8_STAGE(PG8_SB(1, 1), cB + hstep + kstep, voffB);
        PG8_WAIT_V(6); PG8_BAR;
    } else {
        PG8_STAGE(PG8_SB(0, 0), cB, voffB); PG8_STAGE(PG8_SA(0, 0), cA, voffA); PG8_STAGE(PG8_SB(0, 1), cB + hstep, voffB); PG8_STAGE(PG8_SA(0, 1), cA + hstep, voffA);
        if (wr == 1) PG8_BAR;
        PG8_WAIT_V(4); PG8_BAR;
        PG8_STAGE(PG8_SB(1, 0), cB + kstep, voffB); PG8_STAGE(PG8_SA(1, 0), cA + kstep, voffA); PG8_STAGE(PG8_SB(1, 1), cB + hstep + kstep, voffB);
        PG8_WAIT_V(6); PG8_BAR;
    }
    for (;;) {
        const bool has_next = S.next(ui + 1, nxt);
        const char* nA = has_next ? (const char*)g.A + (size_t)S.arow(nxt) * (size_t)(K * 2) : cA; const char* nB = has_next ? (const char*)g.Bt + (size_t)nxt.pn * tstep : cB;
        for (int t = 0; t < nt; t += 2) {
            const bool last = (t == nt - 2);
            const char* a1 = cA + (size_t)(t + 1) * kstep;
            const char* a2 = last ? nA : cA + (size_t)(t + 2) * kstep; const char* b2 = last ? nB : cB + (size_t)(t + 2) * kstep;
            const char* a3 = a2 + kstep; const char* b3 = b2 + kstep;
            if (last && has_next) S.a_ready(nxt);
            if constexpr (SP2) {
            PG8_LDB(B0, 0, 0); PG8_LDB(B1, 0, 1); PG8_SCHED; PG8_LDA(At, 0, 0); PG8_STAGE(PG8_SA(1, 1), a1 + hstep, voffA);
            PG8_WAIT_V(8); PG8_WAIT_L(0); PG8_BAR; PG8_MMA(0, 0, At, B0); PG8_MMA(0, 1, At, B1); PG8_BAR; PG8_SCHED;
            PG8_LDA(At, 0, 1); PG8_STAGE(PG8_SB(0, 0), b2, voffB); PG8_STAGE(PG8_SB(0, 1), b2 + hstep, voffB); PG8_STAGE(PG8_SA(0, 0), a2, voffA);
            PG8_WAIT_V(8); PG8_WAIT_L(0); PG8_BAR; PG8_MMA(1, 0, At, B0); PG8_MMA(1, 1, At, B1); PG8_BAR; PG8_SCHED;
            PG8_LDB(B0, 1, 0); PG8_LDB(B1, 1, 1); PG8_SCHED; PG8_LDA(At, 1, 0); PG8_STAGE(PG8_SA(0, 1), a2 + hstep, voffA);
            PG8_WAIT_V(8); PG8_WAIT_L(0); PG8_BAR; PG8_MMA(0, 0, At, B0); PG8_MMA(0, 1, At, B1); PG8_BAR; PG8_SCHED;
            PG8_LDA(At, 1, 1); PG8_STAGE(PG8_SB(1, 0), b3, voffB); PG8_STAGE(PG8_SB(1, 1), b3 + hstep, voffB); PG8_STAGE(PG8_SA(1, 0), a3, voffA);
            PG8_WAIT_V(8); PG8_WAIT_L(0); PG8_BAR; PG8_MMA(1, 0, At, B0); PG8_MMA(1, 1, At, B1); PG8_BAR; PG8_SCHED;
            } else {
            PG8_LDB(B0, 0, 0); PG8_SCHED; PG8_LDA(At, 0, 0); PG8_STAGE(PG8_SA(1, 1), a1 + hstep, voffA);
            PG8_WAIT_L(8); PG8_BAR; PG8_WAIT_L(0); PG8_MMA(0, 0, At, B0); PG8_BAR; PG8_SCHED;
            PG8_LDB(B1, 0, 1); PG8_STAGE(PG8_SB(0, 0), b2, voffB);
            PG8_BAR; PG8_WAIT_L(0); PG8_MMA(0, 1, At, B1); PG8_BAR;
            PG8_LDA(At, 0, 1); PG8_STAGE(PG8_SA(0, 0), a2, voffA);
            PG8_BAR; PG8_WAIT_L(0); PG8_MMA(1, 0, At, B0); PG8_BAR; PG8_SCHED;
            PG8_STAGE(PG8_SB(0, 1), b2 + hstep, voffB);
            PG8_WAIT_V(6); PG8_BAR; PG8_MMA(1, 1, At, B1); PG8_BAR;
            PG8_LDB(B0, 1, 0); PG8_SCHED; PG8_LDA(At, 1, 0); PG8_STAGE(PG8_SA(0, 1), a2 + hstep, voffA);
            PG8_WAIT_L(8); PG8_BAR; PG8_WAIT_L(0); PG8_MMA(0, 0, At, B0); PG8_BAR; PG8_SCHED;
            PG8_LDB(B1, 1, 1); PG8_STAGE(PG8_SB(1, 0), b3, voffB);
            PG8_BAR; PG8_WAIT_L(0); PG8_MMA(0, 1, At, B1); PG8_BAR;
            PG8_LDA(At, 1, 1); PG8_STAGE(PG8_SA(1, 0), a3, voffA);
            PG8_BAR; PG8_WAIT_L(0); PG8_MMA(1, 0, At, B0); PG8_BAR; PG8_SCHED;
            PG8_STAGE(PG8_SB(1, 1), b3 + hstep, voffB);
            PG8_WAIT_V(6); PG8_BAR; PG8_MMA(1, 1, At, B1); PG8_BAR;
            }
        }
        if constexpr (ALIGN_EPI) { if (wr == 0) PG8_BAR; }
        if constexpr (!Epi::AFTER_DRAIN) { E(acc, cur, wr, wc, fr, fq); S.done(cur); }
        if (!has_next) break;
#pragma unroll
        for (int a = 0; a < 2; ++a)
#pragma unroll
            for (int b = 0; b < 2; ++b)
#pragma unroll
                for (int m = 0; m < 4; ++m)
#pragma unroll
                    for (int n = 0; n < 2; ++n) acc[a][b][m][n] = (f32x4){0.f, 0.f, 0.f, 0.f};
        cur = nxt; cA = nA; cB = nB; ++ui;
        if constexpr (ALIGN_EPI) { if (wr == 1) PG8_BAR; }
    }
    PG8_WAIT_V(0);
    if constexpr (!ALIGN_EPI) { if (wr == 0) PG8_BAR; }
    PG8_BAR;
    if constexpr (Epi::AFTER_DRAIN) { E.fused(acc, cur, wr, wc, fr, fq, lds, wid, lane); S.done(cur); }
#undef PG8_SA
#undef PG8_SB
#undef PG8_STAGE
#undef PG8_LDA
#undef PG8_LDB
#undef PG8_MMA
#undef PG8_WAIT_V
#undef PG8_WAIT_L
#undef PG8_BAR
#undef PG8_SCHED
}
}

#define DEV __device__ __forceinline__
#define LAS __attribute__((address_space(3)))
#define GAS __attribute__((address_space(1)))
typedef unsigned short bf16_t;
typedef short bf16x8 __attribute__((ext_vector_type(8)));
typedef short s16x4 __attribute__((ext_vector_type(4)));
typedef float f32x4 __attribute__((ext_vector_type(4)));
typedef float f32x2 __attribute__((ext_vector_type(2)));
typedef float f32x16 __attribute__((ext_vector_type(16)));
typedef unsigned u32x4 __attribute__((ext_vector_type(4)));
typedef unsigned u32x2 __attribute__((ext_vector_type(2)));
typedef __bf16 bf16x2_t __attribute__((ext_vector_type(2)));

constexpr int DM = 1024, NCTX = 8192, NLAT = 16384, MTOT = 24576;
constexpr int INP = 2304, INC = 2144, DFF = 2816, UPC = 5632;
constexpr int NLAYER = 4;
constexpr float EPS = 1e-6f;
constexpr size_t MiB = 1u << 20;
constexpr size_t WS_CTL = 0;
constexpr size_t WS_MOD = 1 * MiB;
constexpr size_t WS_BIN = 2 * MiB;
constexpr size_t WS_BUP = 3 * MiB;
constexpr size_t WS_SSQ = 4 * MiB;
constexpr size_t WS_WIN = 5 * MiB;
constexpr size_t WS_WUKV = WS_WIN + 4718592;
constexpr size_t WS_WOUT = 10 * MiB;
constexpr size_t WS_WUP = 12 * MiB;
constexpr size_t WS_WDN = 23 * MiB;
constexpr size_t WS_TLAT = 29 * MiB;
constexpr size_t WS_TCTX = 45 * MiB;
constexpr size_t WS_CS64 = WS_TCTX + 512 * 1024;
constexpr size_t WS_XS = 46 * MiB;
constexpr size_t WS_R = 94 * MiB;
constexpr size_t WS_P = WS_R;
constexpr size_t WS_OB = WS_P + 108 * MiB;
constexpr size_t WS_KML = WS_OB + 48 * MiB;
constexpr size_t WS_KMC = WS_KML + 23592960;
constexpr size_t WS_VML = WS_KMC + 9 * MiB;
constexpr size_t WS_VMC = WS_VML + 15 * MiB;
constexpr size_t WS_KDL = WS_VMC + 6 * MiB;
constexpr size_t WS_KDC = WS_KDL + 15 * MiB;
constexpr size_t WS_VDL = WS_KDC + 6 * MiB;
constexpr size_t WS_VDC = WS_VDL + 15 * MiB;
constexpr size_t WS_QMR = WS_VDC + 6 * MiB;
constexpr size_t WS_QDR = WS_QMR + 18 * MiB;
constexpr size_t WS_FBL = WS_QDR + 12 * MiB;
constexpr size_t WS_FBC = WS_FBL + 16 * MiB;
constexpr size_t WS_END = WS_FBC + 8 * MiB;
constexpr size_t WS_U = WS_R;
constexpr size_t WS_ACT = WS_R + 176 * MiB;
static_assert(WS_ACT + 88 * MiB <= WS_END, "overlay fits");
constexpr size_t OUT_CKV = 25165824, OUT_KROPE = OUT_CKV + 4194304, OUT_DK = OUT_KROPE + 1048576, OUT_DV = OUT_DK + 12582912;
constexpr int LDS_BYTES = 147456;
constexpr int RING_BYTES = 131072;
constexpr int LDS_MISC = RING_BYTES;

struct Args { const float* in[26]; float* out; unsigned char* ws; int ph_lo, ph_hi; };
enum { I_XP = 0, I_XS, I_C, I_CCKV, I_CKROPE, I_CDK, I_CDV, I_CCTX, I_WADA, I_BADA, I_GMIX, I_GFFN, I_WIN, I_GKV, I_WUK, I_WUV,
       I_LQ1, I_LK1, I_LQ2, I_LK2, I_GSUB, I_WOUT, I_WUP, I_WCONV, I_WDOWN, I_GFINAL };

DEV float bf2f(unsigned b) { return __uint_as_float(b << 16); }
DEV unsigned pk2(float lo, float hi) { f32x2 v = {lo, hi}; bf16x2_t b = __builtin_convertvector(v, bf16x2_t); return __builtin_bit_cast(unsigned, b); }
DEV bf16_t f2bf(float f) { return (bf16_t)(pk2(f, 0.f) & 0xffffu); }
DEV float wave_sum(float v) {
#pragma unroll
    for (int o = 1; o < 64; o <<= 1) v += __shfl_xor(v, o);
    return v;
}
DEV f32x4 mfma16(bf16x8 a, bf16x8 b, f32x4 c) { return __builtin_amdgcn_mfma_f32_16x16x32_bf16(a, b, c, 0, 0, 0); }
DEV f32x16 mfma32(bf16x8 a, bf16x8 b, f32x16 c) { return __builtin_amdgcn_mfma_f32_32x32x16_bf16(a, b, c, 0, 0, 0); }
DEV int row_b9(int row0) { return row0 < NCTX ? 0 : 1 + ((row0 - NCTX) >> 11); }

struct EpiA {
    static constexpr bool PERM = true, AFTER_DRAIN = false;
    bf16_t* O; int ldc; const float* ssq; const float* bias; int ldb; int row_off;
    DEV void operator()(const f32x4 (&acc)[2][2][4][2], const pg8::Unit& u, int wr, int wc, int fr, int fq) const {
        const int lrow0 = u.pm * 256, b9 = row_b9(row_off + lrow0);
        const int col0 = u.pn * 256 + wc * 32 + 8 * fq;
        f32x4 bv[2][2];
#pragma unroll
        for (int bj = 0; bj < 2; ++bj)
#pragma unroll
            for (int n = 0; n < 2; ++n) bv[bj][n] = *(const GAS f32x4*)(bias + (size_t)b9 * ldb + col0 + bj * 128 + 4 * n);
#pragma unroll
        for (int ai = 0; ai < 2; ++ai)
#pragma unroll
            for (int m = 0; m < 4; ++m) {
                const int lr = lrow0 + ai * 128 + wr * 64 + m * 16 + fr;
                const float rs = rsqrtf(((const GAS float*)ssq)[row_off + lr] * (1.0f / 1024.0f) + EPS);
                GAS bf16_t* rowp = (GAS bf16_t*)O + (size_t)lr * ldc + col0;
#pragma unroll
                for (int bj = 0; bj < 2; ++bj) {
                    const f32x4 v0 = acc[ai][bj][m][0] * rs + bv[bj][0], v1 = acc[ai][bj][m][1] * rs + bv[bj][1];
                    u32x4 w; w.x = pk2(v0[0], v0[1]); w.y = pk2(v0[2], v0[3]); w.z = pk2(v1[0], v1[1]); w.w = pk2(v1[2], v1[3]);
                    *(GAS u32x4*)(rowp + bj * 128) = w;
                }
            }
    }
};
struct EpiRes {
    static constexpr bool PERM = false, AFTER_DRAIN = false;
    const float* xold_c; const float* xold_l;
    float* X;
    const float* gate;
    const float* g; const float* scale;
    bf16_t* XS; float* ssq; int row_off;
    DEV void operator()(const f32x4 (&acc)[2][2][4][2], const pg8::Unit& u, int wr, int wc, int fr, int fq) const {
        const int row0 = row_off + u.pm * 256, b9 = row_b9(row0);
        const int col0 = u.pn * 256 + wc * 32 + 4 * fq;
        f32x4 gv[2][2], gs[2][2];
#pragma unroll
        for (int bj = 0; bj < 2; ++bj)
#pragma unroll
            for (int n = 0; n < 2; ++n) {
                const int c = col0 + bj * 128 + n * 16;
                gv[bj][n] = *(const GAS f32x4*)(gate + (size_t)b9 * 6144 + c);
                if (g) { const f32x4 gg = *(const GAS f32x4*)(g + c), sc = *(const GAS f32x4*)(scale + (size_t)b9 * 6144 + c); gs[bj][n] = gg * (sc + 1.0f); }
                else gs[bj][n] = (f32x4){0.f, 0.f, 0.f, 0.f};
            }
        const float* xo = (row0 < NCTX) ? xold_c : (xold_l - (size_t)NCTX * DM);
#pragma unroll
        for (int ai = 0; ai < 2; ++ai)
#pragma unroll
            for (int m = 0; m < 4; ++m) {
                const int r = row0 + ai * 128 + wr * 64 + m * 16 + fr;
                float ss = 0.f;
#pragma unroll
                for (int bj = 0; bj < 2; ++bj)
#pragma unroll
                    for (int n = 0; n < 2; ++n) {
                        const size_t off = (size_t)r * DM + col0 + bj * 128 + n * 16;
                        const f32x4 xv = *(const GAS f32x4*)(xo + off);
                        const f32x4 xn = xv + gv[bj][n] * acc[ai][bj][m][n];
                        *(GAS f32x4*)(X + off) = xn;
                        ss += (xn[0] * xn[0] + xn[1] * xn[1]) + (xn[2] * xn[2] + xn[3] * xn[3]);
                        if (g) { const f32x4 y = xn * gs[bj][n]; u32x2 w; w.x = pk2(y[0], y[1]); w.y = pk2(y[2], y[3]); *(GAS u32x2*)(XS + off) = w; }
                    }
                ss += __shfl_xor(ss, 16); ss += __shfl_xor(ss, 32);
                if (fq == 0) unsafeAtomicAdd(ssq + r, ss);
            }
    }
};
struct EpiF {
    static constexpr bool PERM = true, AFTER_DRAIN = false;
    bf16_t* OB; int rowbase; int nseq;
    DEV void operator()(const f32x4 (&acc)[2][2][4][2], const pg8::Unit& u, int wr, int wc, int fr, int fq) const {
        const int col0 = 768 + wc * 32 + 8 * fq;
#pragma unroll
        for (int ai = 0; ai < 2; ++ai)
#pragma unroll
            for (int m = 0; m < 4; ++m) {
                const int np = u.pm * 256 + ai * 128 + wr * 64 + m * 16 + fr;
                GAS bf16_t* rowp = (GAS bf16_t*)OB + (size_t)(rowbase + u.pn * nseq + np) * DM + col0;
#pragma unroll
                for (int bj = 0; bj < 2; ++bj) {
                    const f32x4 v0 = acc[ai][bj][m][0], v1 = acc[ai][bj][m][1];
                    u32x4 w; w.x = pk2(v0[0], v0[1]); w.y = pk2(v0[2], v0[3]); w.z = pk2(v1[0], v1[1]); w.w = pk2(v1[2], v1[3]);
                    *(GAS u32x4*)(rowp + bj * 128) = w;
                }
            }
    }
};


struct FfnOrder {
    pg8::StaticOrder S;
    __device__ void init(int G, int c) { S.init(104 * 256, UPC, G, c); }
    __device__ bool next(int i, pg8::Unit& u) const { return S.next(i, u); }
    DEV int arow(const pg8::Unit& u) const { if (u.pm < 32) return u.pm * 256; const int t = u.pm - 32, b = t / 9, j = t - 9 * b; return NCTX + 2048 * b + (j < 8 ? 254 * j : 1792); }
    DEV void a_ready(const pg8::Unit&) const {}
    DEV void done(const pg8::Unit&) const {}
};
DEV float dpp_ror1(float x) { const int xi = __builtin_bit_cast(int, x); return __builtin_bit_cast(float, __builtin_amdgcn_update_dpp(xi, xi, 0x121, 0xF, 0xF, false)); }
DEV float dpp_rol1(float x) { const int xi = __builtin_bit_cast(int, x); return __builtin_bit_cast(float, __builtin_amdgcn_update_dpp(xi, xi, 0x12F, 0xF, 0xF, false)); }
constexpr int LDS_HALO = LDS_MISC + 1024;
constexpr int LDS_WCV = LDS_HALO + 8192;
struct EpiFfn {
    static constexpr bool PERM = true, AFTER_DRAIN = false;
    bf16_t* ACT; const float* ssq; const float* bias; const float* wconv; LAS unsigned char* lds;
    DEV void operator()(const f32x4 (&acc)[2][2][4][2], const pg8::Unit& un, int wr, int wc, int fr_, int fq_) const {
        int tl_ = threadIdx.x; asm volatile("" : "+v"(tl_));
        const int fr = tl_ & 15, fq = (tl_ >> 4) & 3; (void)fr_; (void)fq_;
        int arow, lo, hi;
        if (un.pm < 32) { arow = un.pm * 256; lo = 0; hi = 255; }
        else { const int t = un.pm - 32, b = t / 9, j = t - 9 * b; arow = NCTX + 2048 * b + (j < 8 ? 254 * j : 1792);
               lo = (j == 0) ? 0 : (j < 8 ? 1 : 241); hi = (j < 8) ? 254 : 255; }
        const int b9 = row_b9(arow);
        const int cw = wc * 32 + 8 * fq;
        LAS unsigned char* hb = lds + LDS_HALO + wr * 2048 + cw * 4;
        LAS unsigned char* wb = lds + LDS_WCV + cw * 4;
        { const int tl = (wr * 4 + wc) * 64 + fq * 16 + fr;
          if (tl < 256) { const int tap = tl >> 6, r = tl & 63, bj = r >> 5, c4 = (r & 31) * 4;
              const GAS float* src = (tap < 3) ? ((const GAS float*)wconv + (size_t)tap * UPC) : ((const GAS float*)bias + (size_t)b9 * UPC);
              *(LAS f32x4*)(lds + LDS_WCV + tap * 1024 + bj * 512 + c4 * 4) = *(const GAS f32x4*)(src + (bj ? DFF : 0) + un.pn * 128 + c4); } }
        f32x4 u[2][2][4][2];
#pragma unroll
        for (int ai = 0; ai < 2; ++ai)
#pragma unroll
            for (int m = 0; m < 4; ++m) {
                const int R = ai * 128 + wr * 64 + m * 16 + fr;
                const float rs = __builtin_amdgcn_rsqf(((const GAS float*)ssq)[arow + R] * (1.0f / 1024.0f) + EPS);
#pragma unroll
                for (int bj = 0; bj < 2; ++bj)
#pragma unroll
                    for (int n = 0; n < 2; ++n) u[ai][bj][m][n] = acc[ai][bj][m][n] * rs;
            }
        if (fr == 0) {
#pragma unroll
            for (int ai = 0; ai < 2; ++ai)
#pragma unroll
                for (int bj = 0; bj < 2; ++bj)
#pragma unroll
                    for (int n = 0; n < 2; ++n) *(LAS f32x4*)(hb + ai * 4096 + bj * 512 + n * 16) = u[ai][bj][0][n];
        }
        if (fr == 15) {
#pragma unroll
            for (int ai = 0; ai < 2; ++ai)
#pragma unroll
                for (int bj = 0; bj < 2; ++bj)
#pragma unroll
                    for (int n = 0; n < 2; ++n) *(LAS f32x4*)(hb + ai * 4096 + 1024 + bj * 512 + n * 16) = u[ai][bj][3][n];
        }
        asm volatile("s_waitcnt lgkmcnt(0)\n\ts_barrier" ::: "memory");
        __builtin_amdgcn_sched_barrier(0);
        const bool f15 = (fr == 15), f0 = (fr == 0);
#pragma unroll
        for (int ai = 0; ai < 2; ++ai)
#pragma unroll
            for (int n = 0; n < 2; ++n) {
                const int q = 2 * ai + wr;
                f32x4 cg[4], cv[4];
#pragma unroll
                for (int bj = 0; bj < 2; ++bj) {
                    const f32x4 w0 = *(const LAS f32x4*)(wb + bj * 512 + n * 16), w1 = *(const LAS f32x4*)(wb + 1024 + bj * 512 + n * 16), w2 = *(const LAS f32x4*)(wb + 2048 + bj * 512 + n * 16);
                    const f32x4 bb = *(const LAS f32x4*)(wb + 3072 + bj * 512 + n * 16);
                    f32x4 hup = *(const LAS f32x4*)(hb + ai * 4096 + (q > 0 ? -1024 : 0) + bj * 512 + n * 16);
                    f32x4 hdn = *(const LAS f32x4*)(hb + ai * 4096 + (q < 3 ? 2048 : 0) + bj * 512 + n * 16);
                    hup = (q > 0) ? (hup + bb) : (f32x4){0.f, 0.f, 0.f, 0.f};
                    hdn = (q < 3) ? (hdn + bb) : (f32x4){0.f, 0.f, 0.f, 0.f};
                    f32x4 ub[4];
#pragma unroll
                    for (int m = 0; m < 4; ++m) ub[m] = u[ai][bj][m][n] + bb;
#pragma unroll
                    for (int m = 0; m < 4; ++m)
#pragma unroll
                        for (int e = 0; e < 4; ++e) {
                            const float cur = ub[m][e];
                            const float pu = (m == 0) ? hup[e] : ub[m == 0 ? 0 : m - 1][e];
                            const float pd = (m == 3) ? hdn[e] : ub[m == 3 ? 3 : m + 1][e];
                            const float up = dpp_ror1(f15 ? pu : cur), dn = dpp_rol1(f0 ? pd : cur);
                            const float r = w0[e] * up + w1[e] * cur + w2[e] * dn;
                            if (bj == 0) cg[m][e] = r; else cv[m][e] = r;
                        }
                }
                int tl2 = tl_; asm volatile("" : "+v"(tl2));
                GAS bf16_t* ap = (GAS bf16_t*)ACT + (size_t)(arow + wr * 64 + (tl2 & 15)) * DFF + un.pn * 128 + wc * 32 + 8 * ((tl2 >> 4) & 3);
#pragma unroll
                for (int m = 0; m < 4; ++m) {
                    const int R = ai * 128 + wr * 64 + m * 16 + fr;
                    float o[4];
#pragma unroll
                    for (int e = 0; e < 4; ++e) { const float g = cg[m][e]; o[e] = g * __builtin_amdgcn_rcpf(1.0f + __expf(-g)) * cv[m][e]; }
                    u32x2 w; w.x = pk2(o[0], o[1]); w.y = pk2(o[2], o[3]);
                    if (R >= lo && R <= hi) *(GAS u32x2*)(ap + (size_t)(ai * 128 + m * 16) * DFF + 4 * n) = w;
                }
                __builtin_amdgcn_sched_barrier(0);
            }
    }
};

DEV void transpose_item(const float* W, int K, int N, bf16_t* WT, int row_off, LAS float* scr, int item, int lane, bool perm_up = false) {
    const int nblk = N / 32, kb = item / nblk, nb = item % nblk, k0 = 64 * kb, n0 = 32 * nb;
    const int d0 = perm_up ? (((n0 % DFF) >> 7) * 256 + ((n0 >= DFF) ? 128 : 0) + ((n0 % DFF) & 127)) : (row_off + n0);
#pragma unroll 8
    for (int i = 0; i < 32; ++i) { const int kk = 2 * i + (lane >> 5); scr[kk * 33 + (lane & 31)] = W[(size_t)(k0 + kk) * N + n0 + (lane & 31)]; }
    asm volatile("s_waitcnt lgkmcnt(0)" ::: "memory");
    const int c = lane & 7;
#pragma unroll
    for (int j = 0; j < 4; ++j) { const int n = (lane >> 3) + 8 * j; const LAS float* s = scr + (8 * c) * 33 + n;
        u32x4 o; o.x = pk2(s[0 * 33], s[1 * 33]); o.y = pk2(s[2 * 33], s[3 * 33]); o.z = pk2(s[4 * 33], s[5 * 33]); o.w = pk2(s[6 * 33], s[7 * 33]);
        *(u32x4*)(WT + (size_t)(d0 + n) * K + k0 + 8 * c) = o; }
    asm volatile("s_waitcnt lgkmcnt(0)" ::: "memory");
}
DEV void convert_weights(const Args& a, LAS unsigned char* lds, int l, int mask, int gw, int NGW, int wave, int lane) {
    LAS float* scr = (LAS float*)(lds + wave * 16384);
    unsigned char* ws = a.ws;
    const int n_in = (mask & 1) ? 16 * 67 : 0, n_uk = (mask & 2) ? 2 * 12 : 0, n_out = (mask & 4) ? 16 * 32 : 0, n_up = (mask & 8) ? 16 * 176 : 0, n_dn = (mask & 16) ? 44 * 32 : 0;
    const int total = n_in + 2 * n_uk + n_out + n_up + n_dn;
    for (int it = gw; it < total; it += NGW) {
        int r = it;
        if (r < n_in) { transpose_item(a.in[I_WIN] + (size_t)l * DM * INC, DM, INC, (bf16_t*)(ws + WS_WIN), 0, scr, r, lane); continue; } r -= n_in;
        if (r < n_uk) { transpose_item(a.in[I_WUK] + (size_t)l * 128 * 384, 128, 384, (bf16_t*)(ws + WS_WUKV), 0, scr, r, lane); continue; } r -= n_uk;
        if (r < n_uk) { transpose_item(a.in[I_WUV] + (size_t)l * 128 * 384, 128, 384, (bf16_t*)(ws + WS_WUKV), 384, scr, r, lane); continue; } r -= n_uk;
        if (r < n_out) { transpose_item(a.in[I_WOUT] + (size_t)l * DM * DM, DM, DM, (bf16_t*)(ws + WS_WOUT), 0, scr, r, lane); continue; } r -= n_out;
        if (r < n_up) { transpose_item(a.in[I_WUP] + (size_t)l * DM * UPC, DM, UPC, (bf16_t*)(ws + WS_WUP), 0, scr, r, lane, true); continue; } r -= n_up;
        transpose_item(a.in[I_WDOWN] + (size_t)l * DFF * DM, DFF, DM, (bf16_t*)(ws + WS_WDN), 0, scr, r, lane);
    }
}
DEV void gemv9_item(LAS float* vec, LAS float* red, const float* W, int N, int ldw, const float* bias, float* out, int ldo, int n0, int tid) {
    const int w = tid >> 6, lane = tid & 63; const int n = n0 + lane; const bool valid = n < N;
    float acc0 = 0.f, acc1 = 0.f, acc2 = 0.f, acc3 = 0.f, acc4 = 0.f, acc5 = 0.f, acc6 = 0.f, acc7 = 0.f, acc8 = 0.f;
    const float* wp = W + (size_t)(128 * w) * ldw + (valid ? n : 0);
    const LAS float* vp = vec + 128 * w;
#pragma unroll 4
    for (int k = 0; k < 128; ++k) {
        const float wv = valid ? wp[(size_t)k * ldw] : 0.f;
        acc0 += vp[k] * wv; acc1 += vp[1024 + k] * wv; acc2 += vp[2048 + k] * wv; acc3 += vp[3072 + k] * wv; acc4 += vp[4096 + k] * wv;
        acc5 += vp[5120 + k] * wv; acc6 += vp[6144 + k] * wv; acc7 += vp[7168 + k] * wv; acc8 += vp[8192 + k] * wv;
    }
    LAS float* rp = red + (w * 9) * 64 + lane;
    rp[0] = acc0; rp[64] = acc1; rp[128] = acc2; rp[192] = acc3; rp[256] = acc4; rp[320] = acc5; rp[384] = acc6; rp[448] = acc7; rp[512] = acc8;
    __syncthreads();
    for (int idx = tid; idx < 576; idx += 512) {
        const int v = idx >> 6, ln = idx & 63; float s = 0.f;
#pragma unroll
        for (int ww = 0; ww < 8; ++ww) s += red[(ww * 9 + v) * 64 + ln];
        const int nn = n0 + ln;
        out[(size_t)v * ldo + nn] = s + ((bias && nn < N) ? bias[nn] : 0.f);
    }
    __syncthreads();
}
#define XB_TMO      128
#define XB_XCNT(j)  (256  + 64 * (j))
#define XB_XSUB(j)  (1280 + 64 * (j))
#define XB_XGEN(j)  (2304 + 64 * (j))
#define XB_TOP      3328
#define XB_TOPGEN   3392
#define XCD_BAR_WORDS 3456
#define XB_SPIN_CAP (1u << 18)

__device__ __forceinline__ unsigned xb_ld(unsigned* p)              { return __hip_atomic_load(p, __ATOMIC_RELAXED, __HIP_MEMORY_SCOPE_AGENT); }
__device__ __forceinline__ unsigned xb_add(unsigned* p, unsigned v) { return __hip_atomic_fetch_add(p, v, __ATOMIC_RELAXED, __HIP_MEMORY_SCOPE_AGENT); }
__device__ __forceinline__ unsigned xb_xcc_id() { return (unsigned)__builtin_amdgcn_s_getreg((3 << 11) | 20) & 0xFu; }
#define XB_SPIN(cond, bar) do { unsigned _sp = 0; while (cond) { __builtin_amdgcn_s_sleep(1); \
    if ((++_sp & 255u) == 0u) { if (xb_ld(&(bar)[XB_TMO])) break; if (_sp > XB_SPIN_CAP) { atomicAdd(&(bar)[XB_TMO], 1u); break; } } } } while (0)

struct XcdBarrier {
    unsigned* bar; unsigned x;
    volatile LAS unsigned* st;
};

__device__ __forceinline__ XcdBarrier xcd_barrier_post(unsigned* bar, volatile LAS unsigned* st) {
    XcdBarrier b; b.bar = bar; b.x = xb_xcc_id(); b.st = st;
    if (threadIdx.x == 0) (void)xb_add(&bar[XB_XCNT(b.x)], 1u);
    return b;
}
__device__ __forceinline__ void xcd_barrier_complete(unsigned* bar, unsigned x, unsigned& nloc, unsigned& nx) {
    const unsigned G = gridDim.x * gridDim.y * gridDim.z;
    unsigned sum, cnt, mine, sp = 0u;
    for (;;) {
        sum = 0u; cnt = 0u; mine = 0u;
#pragma unroll
        for (unsigned j = 0; j < 16; ++j) { const unsigned c = xb_ld(&bar[XB_XCNT(j)]); sum += c; cnt += (c > 0u) ? 1u : 0u; mine = (j == x) ? c : mine; }
        if (sum == G) break;
        __builtin_amdgcn_s_sleep(1);
        if ((++sp & 255u) == 0u) { if (xb_ld(&bar[XB_TMO])) break; if (sp > XB_SPIN_CAP) { atomicAdd(&bar[XB_TMO], 1u); break; } }
    }
    nloc = mine > 0u ? mine : 1u; nx = cnt > 0u ? cnt : 1u;
}

__device__ __forceinline__ void xcd_barrier(const XcdBarrier& b) {
    asm volatile("s_waitcnt vmcnt(0)" ::: "memory");
    __syncthreads();
    if (threadIdx.x == 0) {
        unsigned* bar = b.bar;
        __builtin_amdgcn_s_waitcnt(0);
        unsigned nloc = b.st[0], nx = b.st[1];
        if (nloc == 0u) { xcd_barrier_complete(bar, b.x, nloc, nx); b.st[0] = nloc; b.st[1] = nx; }
        const unsigned old = xb_add(&bar[XB_XSUB(b.x)], 1u);
        const unsigned gen = old / nloc;
        if (old + 1u == (gen + 1u) * nloc) {
            __builtin_amdgcn_fence(__ATOMIC_RELEASE, "agent");
            asm volatile("s_waitcnt vmcnt(0)" ::: "memory");
            const unsigned og = xb_add(&bar[XB_TOP], 1u);
            const unsigned tg = og / nx;
            if (og + 1u == (tg + 1u) * nx) xb_add(&bar[XB_TOPGEN], 1u);
            else XB_SPIN(xb_ld(&bar[XB_TOPGEN]) == tg, bar);
            __builtin_amdgcn_fence(__ATOMIC_ACQUIRE, "agent");
            xb_add(&bar[XB_XGEN(b.x)], 1u);
            asm volatile("s_waitcnt vmcnt(0)" ::: "memory");
        } else {
            XB_SPIN(xb_ld(&bar[XB_XGEN(b.x)]) == gen, bar);
            __builtin_amdgcn_fence(__ATOMIC_ACQUIRE, "agent");
            asm volatile("s_waitcnt vmcnt(0)" ::: "memory");
        }
    }
    __syncthreads();
}

constexpr int B_AROW = 272, B_VROW = 772, B_UROW = 528;
constexpr int B_LDS_A = 0, B_LDS_V = 64 * B_AROW, B_LDS_U = B_LDS_V + 64 * B_VROW, B_LDS_TAB = B_LDS_U + 64 * B_UROW;
static_assert(B_LDS_TAB + 4096 <= RING_BYTES, "phase B LDS");

DEV float rope1(float x, int dd, int t, const LAS f32x2* tab) {
    const float xp = __shfl_xor(x, 8);
    const int pos = (dd < 16) ? (t >> 6) : (t & 63);
    const f32x2 cs = tab[pos * 8 + (dd & 7)];
    return (dd & 8) ? (x * cs.x + xp * cs.y) : (x * cs.x - xp * cs.y);
}

DEV void phase_b(const Args& a, LAS unsigned char* lds, int l, int tid, int mode, int blk_start, int blk_stride) {
    unsigned char* ws = a.ws;
    const int wave = __builtin_amdgcn_readfirstlane(tid >> 6), lane = tid & 63, fr = lane & 15, fq = lane >> 4;
    const GAS bf16_t* P = (const GAS bf16_t*)(ws + WS_P);
    const GAS bf16_t* WUKV = (const GAS bf16_t*)(ws + WS_WUKV);
    const GAS bf16_t* CS64 = (const GAS bf16_t*)(ws + WS_CS64);
    GAS float* outg = (GAS float*)a.out;
    LAS f32x2* tab = (LAS f32x2*)(lds + B_LDS_TAB);
    {
        const int pos = tid >> 3, f = tid & 7;
        const float inv = __builtin_amdgcn_exp2f(-(float)f * (13.287712379549449f / 8.0f));
        const float ang = (float)pos * inv;
        tab[tid] = (f32x2){cosf(ang), sinf(ang)};
    }
    __syncthreads();
    const GAS float* gkv = (const GAS float*)a.in[I_GKV] + l * 128;
    for (int blk = blk_start; blk < (mode == 0 ? 384 : 448); blk += blk_stride) {
        int kind, r0 = 0, bidx, t0;
        if (blk < 128) { kind = 0; r0 = blk * 64; bidx = r0 >> 8; t0 = r0 & 255; }
        else if (blk < 384) { kind = 1; r0 = NCTX + (blk - 128) * 64; bidx = (r0 - NCTX) >> 11; t0 = (r0 - NCTX) & 2047; }
        else { kind = 2; const int cb = blk - 384; bidx = cb >> 3; t0 = 2048 + 64 * (cb & 7); }
        GAS bf16_t* KM; GAS bf16_t* KD; GAS bf16_t* VMt; GAS bf16_t* VDt; int vt_ld;
        if (kind == 0) { KM = (GAS bf16_t*)(ws + WS_KMC) + (size_t)(bidx * 256 + t0) * 576; KD = (GAS bf16_t*)(ws + WS_KDC) + (size_t)(bidx * 256 + t0) * 384;
                         VMt = (GAS bf16_t*)(ws + WS_VMC) + (size_t)bidx * 6 * 64 * 256 + t0; VDt = (GAS bf16_t*)(ws + WS_VDC) + (size_t)bidx * 6 * 64 * 256 + t0; vt_ld = 256; }
        else { KM = (GAS bf16_t*)(ws + WS_KML) + (size_t)(bidx * 2560 + t0) * 576; KD = (GAS bf16_t*)(ws + WS_KDL) + (size_t)(bidx * 2560 + t0) * 384;
               VMt = (GAS bf16_t*)(ws + WS_VML) + (size_t)bidx * 6 * 64 * 2560 + t0; VDt = (GAS bf16_t*)(ws + WS_VDL) + (size_t)bidx * 6 * 64 * 2560 + t0; vt_ld = 2560; }
        if (mode == 0) {
            for (int c = tid; c < 64 * 32; c += 512) { const int rr = c >> 5, e = c & 31;
                *(LAS u32x4*)(lds + B_LDS_U + rr * B_UROW + e * 16) = *(const GAS u32x4*)(P + (size_t)(r0 + rr) * INP + 1888 + 8 * e); }
            __syncthreads();
        } else {
        if (kind == 2) {
            for (int i = 0; i < 8; ++i) {
                const int rr = wave * 8 + i;
                const int j = (t0 - 2048) + rr;
                const size_t crow = ((size_t)(bidx * 4 + l)) * 512 + j;
                const f32x2 cv = *(const f32x2*)(a.in[I_CCKV] + crow * 128 + 2 * lane);
                *(LAS unsigned*)(lds + B_LDS_A + rr * B_AROW + lane * 4) = pk2(cv.x, cv.y);
                const float kr = a.in[I_CKROPE][crow * 32 + (lane & 31)];
                const bf16_t krb = f2bf(kr);
                { const int hb = (lane >> 5) * 3;
#pragma unroll
                  for (int h = 0; h < 3; ++h) KM[(size_t)rr * 576 + (hb + h) * 96 + 64 + (lane & 31)] = krb; }
#pragma unroll
                for (int q = 0; q < 6; ++q) {
                    KD[(size_t)rr * 384 + 64 * q + lane] = f2bf(a.in[I_CDK][crow * 384 + 64 * q + lane]);
                    *(LAS bf16_t*)(lds + B_LDS_V + rr * B_VROW + (64 * q + lane) * 2) = f2bf(a.in[I_CDV][crow * 384 + 64 * q + lane]);
                }
            }
        } else {
            const size_t obase = ((size_t)(bidx * 4 + l)) * 256 + t0;
#pragma unroll
            for (int it = 0; it < 2; ++it) {
                const int rr = (tid >> 4) + 32 * it, cj = tid & 15;
                const u32x4 w = *(const GAS u32x4*)(P + (size_t)(r0 + rr) * INP + 576 + 8 * cj);
                float x[8]; x[0] = bf2f(w.x & 0xffffu); x[1] = bf2f(w.x >> 16); x[2] = bf2f(w.y & 0xffffu); x[3] = bf2f(w.y >> 16);
                x[4] = bf2f(w.z & 0xffffu); x[5] = bf2f(w.z >> 16); x[6] = bf2f(w.w & 0xffffu); x[7] = bf2f(w.w >> 16);
                float ss = 0.f;
#pragma unroll
                for (int j = 0; j < 8; ++j) ss += x[j] * x[j];
                ss += __shfl_xor(ss, 1); ss += __shfl_xor(ss, 2); ss += __shfl_xor(ss, 4); ss += __shfl_xor(ss, 8);
                const float rs = rsqrtf(ss * (1.0f / 128.0f) + EPS);
                const f32x4 ga = *(const GAS f32x4*)(gkv + 8 * cj), gb = *(const GAS f32x4*)(gkv + 8 * cj + 4);
                x[0] *= rs * ga[0]; x[1] *= rs * ga[1]; x[2] *= rs * ga[2]; x[3] *= rs * ga[3]; x[4] *= rs * gb[0]; x[5] *= rs * gb[1]; x[6] *= rs * gb[2]; x[7] *= rs * gb[3];
                u32x4 o; o.x = pk2(x[0], x[1]); o.y = pk2(x[2], x[3]); o.z = pk2(x[4], x[5]); o.w = pk2(x[6], x[7]);
                *(LAS u32x4*)(lds + B_LDS_A + rr * B_AROW + cj * 16) = o;
                if (kind == 0) { GAS float* op = outg + OUT_CKV + (obase + rr) * 128 + 8 * cj; *(GAS f32x4*)op = (f32x4){x[0], x[1], x[2], x[3]}; *(GAS f32x4*)(op + 4) = (f32x4){x[4], x[5], x[6], x[7]}; }
            }
#pragma unroll 1
            for (int cb = 0; cb < 35; cb += 7) {
              u32x4 wv[7];
#pragma unroll
              for (int i = 0; i < 7; ++i) {
                const int c = tid + 512 * (cb + i); const int rr = c / 268, ch = c - rr * 268;
                const bool need = (c < 64 * 268) && (ch < 236) && !(ch >= 72 && ch < 88) && !(kind == 0 && (ch < 72 || (ch >= 92 && ch < 140)));
                wv[i] = (u32x4){0u, 0u, 0u, 0u};
                if (need) wv[i] = *(const GAS u32x4*)(P + (size_t)(r0 + rr) * INP + 8 * ch);
              }
#pragma unroll
              for (int i = 0; i < 7; ++i) {
                const int c = tid + 512 * (cb + i); const int rr = c / 268, ch = c - rr * 268;
                const bool need = (c < 64 * 268) && (ch < 236) && !(ch >= 72 && ch < 88) && !(kind == 0 && (ch < 72 || (ch >= 92 && ch < 140)));
                if (!need) continue;
                const int r = r0 + rr, t = t0 + rr;
                u32x4 w = wv[i];
                const bool ropeable = (ch < 72) ? ((ch % 12) >= 8) : (ch < 188);
                if (kind == 1 && ropeable) {
                    const int j = ch & 3;
                    const int pos = (j < 2) ? (t >> 6) : (t & 63);
                    float x[8]; x[0] = bf2f(w.x & 0xffffu); x[1] = bf2f(w.x >> 16); x[2] = bf2f(w.y & 0xffffu); x[3] = bf2f(w.y >> 16);
                    x[4] = bf2f(w.z & 0xffffu); x[5] = bf2f(w.z >> 16); x[6] = bf2f(w.w & 0xffffu); x[7] = bf2f(w.w >> 16);
                    const float sgn = (j & 1) ? 1.0f : -1.0f;
#pragma unroll
                    for (int i = 0; i < 8; ++i) {
                        const float xp = __builtin_bit_cast(float, __builtin_amdgcn_update_dpp(0, __builtin_bit_cast(int, x[i]), 0xB1, 0xF, 0xF, true));
                        const f32x2 cs = tab[pos * 8 + i];
                        x[i] = x[i] * cs.x + sgn * (xp * cs.y);
                    }
                    w.x = pk2(x[0], x[1]); w.y = pk2(x[2], x[3]); w.z = pk2(x[4], x[5]); w.w = pk2(x[6], x[7]);
                }
                if (ch < 72) { *(GAS u32x4*)((GAS bf16_t*)(ws + WS_QMR) + (size_t)(r - NCTX) * 576 + 8 * ch) = w; }
                else if (ch < 92) { const int j = ch - 88;
#pragma unroll
                    for (int h = 0; h < 6; ++h) *(GAS u32x4*)(KM + (size_t)rr * 576 + h * 96 + 64 + 8 * j) = w;
                    if (kind == 0) { GAS float* op = outg + OUT_KROPE + (obase + rr) * 32 + 8 * j;
                        *(GAS f32x4*)op = (f32x4){bf2f(w.x & 0xffffu), bf2f(w.x >> 16), bf2f(w.y & 0xffffu), bf2f(w.y >> 16)}; *(GAS f32x4*)(op + 4) = (f32x4){bf2f(w.z & 0xffffu), bf2f(w.z >> 16), bf2f(w.w & 0xffffu), bf2f(w.w >> 16)}; } }
                else if (ch < 140) { *(GAS u32x4*)((GAS bf16_t*)(ws + WS_QDR) + (size_t)(r - NCTX) * 384 + 8 * (ch - 92)) = w; }
                else if (ch < 188) { const int e = ch - 140; *(GAS u32x4*)(KD + (size_t)rr * 384 + 8 * e) = w;
                    if (kind == 0) { GAS float* op = outg + OUT_DK + (obase + rr) * 384 + 8 * e;
                        *(GAS f32x4*)op = (f32x4){bf2f(w.x & 0xffffu), bf2f(w.x >> 16), bf2f(w.y & 0xffffu), bf2f(w.y >> 16)}; *(GAS f32x4*)(op + 4) = (f32x4){bf2f(w.z & 0xffffu), bf2f(w.z >> 16), bf2f(w.w & 0xffffu), bf2f(w.w >> 16)}; } }
                else if (ch < 236) { const int e = ch - 188; LAS unsigned* vp = (LAS unsigned*)(lds + B_LDS_V + rr * B_VROW + e * 16); vp[0] = w.x; vp[1] = w.y; vp[2] = w.z; vp[3] = w.w;
                    if (kind == 0) { GAS float* op = outg + OUT_DV + (obase + rr) * 384 + 8 * e;
                        *(GAS f32x4*)op = (f32x4){bf2f(w.x & 0xffffu), bf2f(w.x >> 16), bf2f(w.y & 0xffffu), bf2f(w.y >> 16)}; *(GAS f32x4*)(op + 4) = (f32x4){bf2f(w.z & 0xffffu), bf2f(w.z >> 16), bf2f(w.w & 0xffffu), bf2f(w.w >> 16)}; } }
                else { *(LAS u32x4*)(lds + B_LDS_U + rr * B_UROW + (ch - 236) * 16) = w; }
              }
            }
        }
        bf16x8 bwa[6][4];
#pragma unroll
        for (int nt = 0; nt < 6; ++nt)
#pragma unroll
            for (int kk = 0; kk < 4; ++kk) bwa[nt][kk] = *(const GAS bf16x8*)(WUKV + (size_t)(96 * wave + 16 * nt + fr) * 128 + 32 * kk + 8 * fq);
        __syncthreads();
#pragma unroll
        for (int nt = 0; nt < 6; ++nt) {
            const int c0 = 96 * wave + 16 * nt;
            bf16x8 bw[4];
#pragma unroll
            for (int kk = 0; kk < 4; ++kk) bw[kk] = bwa[nt][kk];
#pragma unroll
            for (int mt = 0; mt < 4; ++mt) {
                f32x4 acc = {0.f, 0.f, 0.f, 0.f};
#pragma unroll
                for (int kk = 0; kk < 4; ++kk) {
                    const bf16x8 af = *(const LAS bf16x8*)(lds + B_LDS_A + (16 * mt + fr) * B_AROW + (32 * kk + 8 * fq) * 2);
                    acc = (wave < 4) ? mfma16(bw[kk], af, acc) : mfma16(af, bw[kk], acc);
                }
                u32x2 w; w.x = pk2(acc[0], acc[1]); w.y = pk2(acc[2], acc[3]);
                if (wave < 4) { const int h = c0 >> 6, d = (c0 & 63) + 4 * fq; *(GAS u32x2*)(KM + (size_t)(16 * mt + fr) * 576 + h * 96 + d) = w; }
                else { const int col = c0 - 384 + fr, h = col >> 6, dv = col & 63; *(GAS u32x2*)(VMt + (size_t)(h * 64 + dv) * vt_ld + 16 * mt + 4 * fq) = w; }
            }
        }
        }
        if (mode == 0) {
            const int g = wave >> 1, nseq = (kind == 0) ? 256 : 2048, ldk = 2 * nseq;
            GAS bf16_t* FB = (kind == 0) ? (GAS bf16_t*)(ws + WS_FBC) : (GAS bf16_t*)(ws + WS_FBL);
#pragma unroll 1
            for (int nt = 0; nt < 4; ++nt) {
                const int cc0 = 16 * ((wave & 1) * 4 + nt);
                bf16x8 bw[2];
#pragma unroll
                for (int kk = 0; kk < 2; ++kk) bw[kk] = *(const GAS bf16x8*)(CS64 + (size_t)(cc0 + fr) * 64 + 32 * kk + 8 * fq);
                const int cc = cc0 + fr, cp = cc & 63, koff = (cc >= 64) ? nseq : 0;
                GAS bf16_t* dst = FB + (size_t)(bidx * 256 + g * 64 + cp) * ldk + koff + (t0 & (nseq - 1));
#pragma unroll
                for (int mt = 0; mt < 4; ++mt) {
                    f32x4 acc = {0.f, 0.f, 0.f, 0.f};
#pragma unroll
                    for (int kk = 0; kk < 2; ++kk) {
                        const bf16x8 af = *(const LAS bf16x8*)(lds + B_LDS_U + (16 * mt + fr) * B_UROW + (64 * g + 32 * kk + 8 * fq) * 2);
                        acc = mfma16(af, bw[kk], acc);
                    }
                    u32x2 w; w.x = pk2(acc[0], acc[1]); w.y = pk2(acc[2], acc[3]);
                    *(GAS u32x2*)(dst + 16 * mt + 4 * fq) = w;
                }
            }
        }
        if (mode == 1)
#pragma unroll 4
        for (int q = 0; q < 48; ++q) {
            const int cr = 48 * wave + q;
            const bf16_t v = *(const LAS bf16_t*)(lds + B_LDS_V + lane * B_VROW + cr * 2);
            VDt[(size_t)cr * vt_ld + lane] = v;
        }
        __syncthreads();
    }
}

constexpr int AT_VROW = 136;
template <bool DIFF> struct AttnCfg {
    static constexpr int ND = DIFF ? 4 : 6;
    static constexpr int NM = DIFF ? 2 : 1;
    static constexpr int NDM = DIFF ? 2 : 6;
    static constexpr int KROW = DIFF ? 144 : 208;
    static constexpr int KT = 64 * KROW;
    static constexpr int CPR = 2 * ND;
    static constexpr int NKC = 64 * CPR;
};
constexpr int AT_LDS_K = 0, AT_LDS_V = 2 * 64 * 208, AT_LDS_SCR = AT_LDS_V + 2 * 64 * AT_VROW;
static_assert(AT_LDS_SCR + 2048 <= RING_BYTES, "attention LDS");

DEV float vmax3(float a, float b, float c) { float r; asm("v_max3_f32 %0, %1, %2, %3" : "=v"(r) : "v"(a), "v"(b), "v"(c)); return r; }
template <bool DIFF>
DEV void attn_unit(LAS unsigned char* lds, const bf16_t* Qa, int qa_ld, const bf16_t* Qb, int qb_ld, const bf16_t* Kp, int k_ld,
                   const bf16_t* Vt, int vt_ld, int nt_main, int nt_total, bf16_t* Oout, float cscale, float lam, const float* gsub, float subscale, int tid) {
    typedef AttnCfg<DIFF> C;
    const int wave = __builtin_amdgcn_readfirstlane(tid >> 6), lane = tid & 63, l31 = lane & 31, hi = lane >> 5;
    LAS float* scr = (LAS float*)(lds + AT_LDS_SCR) + wave * 64;
    const int kkey0 = tid / C::CPR, kpart0 = tid % C::CPR;
    const int kc1 = tid + 512; const bool has1 = kc1 < C::NKC; const int kkey1 = kc1 / C::CPR, kpart1 = kc1 % C::CPR;
    const int vdv = tid >> 3, vpart = tid & 7;
    const GAS bf16_t* kg0 = (const GAS bf16_t*)Kp + (size_t)kkey0 * k_ld + kpart0 * 8;
    const GAS bf16_t* kg1 = (const GAS bf16_t*)Kp + (size_t)kkey1 * k_ld + kpart1 * 8;
    const GAS bf16_t* vg = (const GAS bf16_t*)Vt + (size_t)vdv * vt_ld + vpart * 8;
    const int kl0 = kkey0 * C::KROW + kpart0 * 16, kl1 = kkey1 * C::KROW + kpart1 * 16, vl = vdv * AT_VROW + vpart * 16;
    u32x4 kr0, kr1 = {0, 0, 0, 0}, vr;
    bf16x8 qf[C::ND];
    { const GAS bf16_t* qp = (const GAS bf16_t*)Qa + (size_t)(32 * wave + l31) * qa_ld + 8 * hi;
#pragma unroll
      for (int d = 0; d < C::ND; ++d) qf[d] = *(const GAS bf16x8*)(qp + 16 * d); }
    kr0 = *(const GAS u32x4*)kg0; if (has1) kr1 = *(const GAS u32x4*)kg1; vr = *(const GAS u32x4*)vg;
    *(LAS u32x4*)(lds + AT_LDS_K + kl0) = kr0; if (has1) *(LAS u32x4*)(lds + AT_LDS_K + kl1) = kr1;
    *(LAS u32x2*)(lds + AT_LDS_V + vl) = (u32x2){vr.x, vr.y}; *(LAS u32x2*)(lds + AT_LDS_V + vl + 8) = (u32x2){vr.z, vr.w};
    __syncthreads();
    f32x16 O[C::NM][2];
    float mref[C::NM], lsum[C::NM];
#pragma unroll
    for (int mp = 0; mp < C::NM; ++mp) { mref[mp] = 0.f; lsum[mp] = 0.f;
#pragma unroll
        for (int r = 0; r < 16; ++r) { O[mp][0][r] = 0.f; O[mp][1][r] = 0.f; } }
#pragma unroll 1
    for (int t = 0; t < nt_total; ++t) {
        const int cur = t & 1;
        const bool more = (t + 1) < nt_total;
        if (more) {
            const size_t ko = (size_t)(t + 1) * 64 * k_ld;
            kr0 = *(const GAS u32x4*)(kg0 + ko); if (has1) kr1 = *(const GAS u32x4*)(kg1 + ko);
            vr = *(const GAS u32x4*)(vg + (t + 1) * 64);
        }
        if (t == nt_main) {
            const GAS bf16_t* qp = (const GAS bf16_t*)Qb + (size_t)(32 * wave + l31) * qb_ld + 8 * hi;
#pragma unroll
            for (int d = 0; d < C::ND; ++d) qf[d] = *(const GAS bf16x8*)(qp + 16 * d);
        }
        const LAS unsigned char* Kb = lds + AT_LDS_K + cur * C::KT;
        const LAS unsigned char* Vb = lds + AT_LDS_V + cur * (64 * AT_VROW);
        bf16x8 kf[2][C::NDM];
#pragma unroll
        for (int dd = 0; dd < C::NDM; ++dd) {
            kf[0][dd] = *(const LAS bf16x8*)(Kb + l31 * C::KROW + dd * 32 + hi * 16);
            kf[1][dd] = *(const LAS bf16x8*)(Kb + (32 + l31) * C::KROW + dd * 32 + hi * 16);
        }
        __builtin_amdgcn_sched_barrier(0);
        bf16x8 vf[4][2];
#pragma unroll
        for (int mp = 0; mp < C::NM; ++mp) {
            f32x16 s0, s1;
#pragma unroll
            for (int r = 0; r < 16; ++r) { s0[r] = 0.f; s1[r] = 0.f; }
#pragma unroll
            for (int dd = 0; dd < C::NDM; ++dd) {
                s0 = mfma32(kf[0][dd], qf[mp * C::NDM + dd], s0); s1 = mfma32(kf[1][dd], qf[mp * C::NDM + dd], s1);
            }
            __builtin_amdgcn_sched_barrier(0);
            if (mp == 0) {
#pragma unroll
                for (int j = 0; j < 4; ++j)
#pragma unroll
                    for (int db = 0; db < 2; ++db) {
                        const LAS unsigned char* vp = Vb + (32 * db + l31) * AT_VROW + (32 * (j >> 1) + 16 * (j & 1) + 4 * hi) * 2;
                        const s16x4 lo = *(const LAS s16x4*)vp, hh = *(const LAS s16x4*)(vp + 16);
                        vf[j][db] = (bf16x8){lo[0], lo[1], lo[2], lo[3], hh[0], hh[1], hh[2], hh[3]};
                    }
                if (C::NM > 1) {
#pragma unroll
                    for (int dd = 0; dd < C::NDM; ++dd) {
                        kf[0][dd] = *(const LAS bf16x8*)(Kb + l31 * C::KROW + (C::NDM + dd) * 32 + hi * 16);
                        kf[1][dd] = *(const LAS bf16x8*)(Kb + (32 + l31) * C::KROW + (C::NDM + dd) * 32 + hi * 16);
                    }
                }
                __builtin_amdgcn_sched_barrier(0);
            }
            float ma = vmax3(s0[0], s0[1], s1[0]), mb = vmax3(s0[2], s0[3], s1[1]); ma = vmax3(ma, s1[2], s1[3]);
#pragma unroll
            for (int r = 4; r < 16; r += 4) { ma = vmax3(ma, s0[r], s0[r + 1]); mb = vmax3(mb, s0[r + 2], s0[r + 3]); ma = vmax3(ma, s1[r], s1[r + 1]); mb = vmax3(mb, s1[r + 2], s1[r + 3]); }
            float mx = vmax3(ma, mb, mb);
            mx = vmax3(mx, __shfl_xor(mx, 32), mx);
            const float rm = mx * cscale;
            if (t == 0) mref[mp] = rm;
            else if (__any(rm > mref[mp] + 8.0f)) {
                const float mnew = vmax3(mref[mp], rm, rm);
                const float alpha = __builtin_amdgcn_exp2f(mref[mp] - mnew);
                lsum[mp] *= alpha; mref[mp] = mnew;
                if (hi == 0) scr[l31] = alpha;
                asm volatile("s_waitcnt lgkmcnt(0)" ::: "memory");
#pragma unroll
                for (int g4 = 0; g4 < 4; ++g4) { const f32x4 a4 = *(const LAS f32x4*)(scr + 8 * g4 + 4 * hi);
#pragma unroll
                    for (int j = 0; j < 4; ++j) { O[mp][0][4 * g4 + j] *= a4[j]; O[mp][1][4 * g4 + j] *= a4[j]; } }
                asm volatile("s_waitcnt lgkmcnt(0)" ::: "memory");
            }
            const float nm = -mref[mp];
            float ls = 0.f;
#pragma unroll
            for (int r = 0; r < 16; ++r) { s0[r] = __builtin_amdgcn_exp2f(fmaf(s0[r], cscale, nm)); s1[r] = __builtin_amdgcn_exp2f(fmaf(s1[r], cscale, nm)); ls += s0[r] + s1[r]; }
            lsum[mp] += ls;
            bf16x8 pa[4];
#pragma unroll
            for (int j = 0; j < 4; ++j) {
                u32x4 w;
                if (j < 2) { w.x = pk2(s0[8 * j], s0[8 * j + 1]); w.y = pk2(s0[8 * j + 2], s0[8 * j + 3]); w.z = pk2(s0[8 * j + 4], s0[8 * j + 5]); w.w = pk2(s0[8 * j + 6], s0[8 * j + 7]); }
                else { const int jj = j - 2; w.x = pk2(s1[8 * jj], s1[8 * jj + 1]); w.y = pk2(s1[8 * jj + 2], s1[8 * jj + 3]); w.z = pk2(s1[8 * jj + 4], s1[8 * jj + 5]); w.w = pk2(s1[8 * jj + 6], s1[8 * jj + 7]); }
                pa[j] = __builtin_bit_cast(bf16x8, w);
            }
#pragma unroll
            for (int j = 0; j < 4; ++j)
#pragma unroll
                for (int db = 0; db < 2; ++db) O[mp][db] = mfma32(pa[j], vf[j][db], O[mp][db]);
        }
        if (more) {
            const int nb = cur ^ 1;
            *(LAS u32x4*)(lds + AT_LDS_K + nb * C::KT + kl0) = kr0; if (has1) *(LAS u32x4*)(lds + AT_LDS_K + nb * C::KT + kl1) = kr1;
            *(LAS u32x2*)(lds + AT_LDS_V + nb * (64 * AT_VROW) + vl) = (u32x2){vr.x, vr.y}; *(LAS u32x2*)(lds + AT_LDS_V + nb * (64 * AT_VROW) + vl + 8) = (u32x2){vr.z, vr.w};
        }
        __syncthreads();
    }
    float inv[C::NM][16];
#pragma unroll
    for (int mp = 0; mp < C::NM; ++mp) {
        float lt = lsum[mp]; lt += __shfl_xor(lt, 32);
        if (hi == 0) scr[l31] = 1.0f / lt;
        asm volatile("s_waitcnt lgkmcnt(0)" ::: "memory");
#pragma unroll
        for (int g4 = 0; g4 < 4; ++g4) { const f32x4 a4 = *(const LAS f32x4*)(scr + 8 * g4 + 4 * hi);
#pragma unroll
            for (int j = 0; j < 4; ++j) inv[mp][4 * g4 + j] = a4[j]; }
        asm volatile("s_waitcnt lgkmcnt(0)" ::: "memory");
    }
    GAS bf16_t* ow = (GAS bf16_t*)Oout + (size_t)(32 * wave) * DM;
    if constexpr (!DIFF) {
#pragma unroll
        for (int r = 0; r < 16; ++r) { const int q = (r & 3) + 8 * (r >> 2) + 4 * hi;
#pragma unroll
            for (int db = 0; db < 2; ++db) ow[(size_t)q * DM + 32 * db + l31] = f2bf(O[0][db][r] * inv[0][r]); }
    } else {
        const float gs0 = ((const GAS float*)gsub)[l31] * subscale, gs1 = ((const GAS float*)gsub)[32 + l31] * subscale;
#pragma unroll
        for (int r = 0; r < 16; ++r) { const int q = (r & 3) + 8 * (r >> 2) + 4 * hi;
            const float o0 = O[0][0][r] * inv[0][r] - lam * (O[1][0][r] * inv[1][r]);
            const float o1 = O[0][1][r] * inv[0][r] - lam * (O[1][1][r] * inv[1][r]);
            float ss = o0 * o0 + o1 * o1;
#pragma unroll
            for (int o = 1; o < 32; o <<= 1) ss += __shfl_xor(ss, o);
            const float rs = rsqrtf(ss * (1.0f / 64.0f) + EPS);
            ow[(size_t)q * DM + l31] = f2bf(o0 * rs * gs0); ow[(size_t)q * DM + 32 + l31] = f2bf(o1 * rs * gs1); }
    }
}

DEV void load8(const GAS bf16_t* p, float (&v)[8]) {
    const u32x4 w = *(const GAS u32x4*)p;
    v[0] = bf2f(w.x & 0xffffu); v[1] = bf2f(w.x >> 16); v[2] = bf2f(w.y & 0xffffu); v[3] = bf2f(w.y >> 16);
    v[4] = bf2f(w.z & 0xffffu); v[5] = bf2f(w.z >> 16); v[6] = bf2f(w.w & 0xffffu); v[7] = bf2f(w.w >> 16);
}
DEV void phase_f(const Args& a, int l, int nrows, int seqlen, int tid) {
    const GAS bf16_t* U = (const GAS bf16_t*)(a.ws + WS_U);
    GAS bf16_t* ACT = (GAS bf16_t*)(a.ws + WS_ACT);
    const GAS float* wc = (const GAS float*)a.in[I_WCONV] + (size_t)l * 3 * UPC;
    const int nitems = (nrows / 8) * 352;
    for (int it = blockIdx.x * 512 + tid; it < nitems; it += gridDim.x * 512) {
        const int rb = it / 352, j8 = it - rb * 352, r0 = rb * 8, c0 = j8 * 8;
        float wg[3][8], wv[3][8];
#pragma unroll
        for (int k = 0; k < 3; ++k) {
            const f32x4 g0 = *(const GAS f32x4*)(wc + k * UPC + c0), g1 = *(const GAS f32x4*)(wc + k * UPC + c0 + 4);
            const f32x4 v0 = *(const GAS f32x4*)(wc + k * UPC + DFF + c0), v1 = *(const GAS f32x4*)(wc + k * UPC + DFF + c0 + 4);
#pragma unroll
            for (int j = 0; j < 4; ++j) { wg[k][j] = g0[j]; wg[k][4 + j] = g1[j]; wv[k][j] = v0[j]; wv[k][4 + j] = v1[j]; }
        }
        float pg[8], pv[8], cg_[8], cv[8], ng[8], nv[8];
        const bool hasp = (r0 % seqlen) != 0, hasn = ((r0 + 8) % seqlen) != 0;
        if (hasp) { load8(U + (size_t)(r0 - 1) * UPC + c0, pg); load8(U + (size_t)(r0 - 1) * UPC + DFF + c0, pv); }
        else {
#pragma unroll
            for (int j = 0; j < 8; ++j) { pg[j] = 0.f; pv[j] = 0.f; } }
        load8(U + (size_t)r0 * UPC + c0, cg_); load8(U + (size_t)r0 * UPC + DFF + c0, cv);
#pragma unroll
        for (int i = 0; i < 8; ++i) {
            const int r = r0 + i;
            if (i < 7 || hasn) { load8(U + (size_t)(r + 1) * UPC + c0, ng); load8(U + (size_t)(r + 1) * UPC + DFF + c0, nv); }
            else {
#pragma unroll
                for (int j = 0; j < 8; ++j) { ng[j] = 0.f; nv[j] = 0.f; } }
            float o[8];
#pragma unroll
            for (int j = 0; j < 8; ++j) {
                const float gt = wg[0][j] * pg[j] + wg[1][j] * cg_[j] + wg[2][j] * ng[j];
                const float vl = wv[0][j] * pv[j] + wv[1][j] * cv[j] + wv[2][j] * nv[j];
                const float sg = gt * __builtin_amdgcn_rcpf(1.0f + __expf(-gt));
                o[j] = sg * vl;
            }
            u32x4 w; w.x = pk2(o[0], o[1]); w.y = pk2(o[2], o[3]); w.z = pk2(o[4], o[5]); w.w = pk2(o[6], o[7]);
            *(GAS u32x4*)(ACT + (size_t)r * DFF + c0) = w;
#pragma unroll
            for (int j = 0; j < 8; ++j) { pg[j] = cg_[j]; pv[j] = cv[j]; cg_[j] = ng[j]; cv[j] = nv[j]; }
        }
    }
}

struct ShiftOrder {
    pg8::StaticOrder S;
    __device__ void init(int M, int N, int G, int c) { S.init(M, N, G, c); }
    __device__ bool next(int i, pg8::Unit& u) const { return S.next(i, u); }
    DEV void a_ready(const pg8::Unit&) const {}
    DEV void done(const pg8::Unit&) const {}
};

#ifndef NREP_SYNC
#define NREP_SYNC 1
#endif
#ifndef NREP_P
#define NREP_P 1
#endif
#ifndef NREP_A
#define NREP_A 1
#endif
#ifndef NREP_B1
#define NREP_B1 1
#endif
#ifndef NREP_B
#define NREP_B 1
#endif
#ifndef NREP_C
#define NREP_C 1
#endif
#ifndef NREP_E
#define NREP_E 1
#endif
#ifndef NREP_F
#define NREP_F 1
#endif
__global__ void __launch_bounds__(512, 2) mega_fwd(Args a) {
    extern __shared__ __attribute__((aligned(16))) unsigned char lds_raw[];
    LAS unsigned char* lds = (LAS unsigned char*)lds_raw;
    cg::grid_group grid = cg::this_grid();
    const int G = gridDim.x, bid = blockIdx.x;
#define PH_LOCALS \
    unsigned char* ws = a.ws; asm volatile("" : "+s"(ws)); \
    int tid = threadIdx.x; asm volatile("" : "+v"(tid)); \
    const int lane = tid & 63, wave = __builtin_amdgcn_readfirstlane(tid >> 6); \
    const int gw = bid * 8 + wave, NGW = G * 8, gt = bid * 512 + tid, NGT = G * 512; \
    float* MOD = (float*)(ws + WS_MOD); float* BIN = (float*)(ws + WS_BIN); float* BUP = (float*)(ws + WS_BUP); float* SSQ = (float*)(ws + WS_SSQ); \
    bf16_t* XS = (bf16_t*)(ws + WS_XS); bf16_t* Pb = (bf16_t*)(ws + WS_P); bf16_t* OB = (bf16_t*)(ws + WS_OB); \
    unsigned* CTL = (unsigned*)(ws + WS_CTL); \
    (void)lane; (void)wave; (void)gw; (void)NGW; (void)gt; (void)NGT; (void)MOD; (void)BIN; (void)BUP; (void)SSQ; (void)XS; (void)Pb; (void)OB; (void)CTL;
    const bool one = (a.ph_hi - a.ph_lo) > 1;
    for (int i = threadIdx.x; i < 4096; i += 512) ((LAS unsigned*)(lds + LDS_MISC))[i] = 0u;
    __syncthreads();
    XcdBarrier xbar; xbar.bar = (unsigned*)(a.ws + WS_CTL) + 16384; xbar.x = 0; xbar.st = nullptr;
    if (one) xbar = xcd_barrier_post((unsigned*)(a.ws + WS_CTL) + 16384, (volatile LAS unsigned*)(lds + LDS_MISC + 32));
    int ph = 0;
#define PH_BEGIN if (ph >= a.ph_lo && ph < a.ph_hi) { PH_LOCALS
#define PH_END   if (one && ph + 1 < a.ph_hi) { if (ph == 0) grid.sync(); else { for (int rs_ = 0; rs_ < NREP_SYNC; ++rs_) xcd_barrier(xbar); } } } ++ph;

    PH_BEGIN
#ifndef SKIP_P0
    for (int rep = 0; rep < NREP_P; ++rep) {
        LAS float* vec = (LAS float*)lds; LAS float* red = (LAS float*)(lds + 36864);
        for (int i = tid; i < 9216; i += 512) { const int v = i >> 10, k = i & 1023; const float x = (v == 0) ? a.in[I_CCTX][k] : a.in[I_C][(v - 1) * 1024 + k]; vec[i] = x / (1.0f + __expf(-x)); }
        __syncthreads();
        for (int it = bid; it < 4 * 96; it += G) { const int l = it / 96, nb = it % 96;
            gemv9_item(vec, red, a.in[I_WADA] + (size_t)l * DM * 6144, 6144, 6144, a.in[I_BADA] + l * 6144, MOD + (size_t)l * 9 * 6144, 6144, nb * 64, tid); }
        __syncthreads();
        convert_weights(a, lds, 0, 31, gw, NGW, wave, lane);
        for (int i = gt; i < 9 * MTOT; i += NGT) SSQ[i] = 0.f;
        for (int i = gt; i < 1024; i += NGT) CTL[i] = 0u;
        { unsigned* padp = (unsigned*)(ws + WS_WIN + (size_t)INC * DM * 2); for (int i = gt; i < (INP - INC) * DM / 2; i += NGT) padp[i] = 0u; }
        { bf16_t* T = (bf16_t*)(ws + WS_TLAT);
          for (int i = gt; i < 2048 * 4096; i += NGT) { const int np = i >> 12, k = i & 4095, n = k & 2047; const int m = (np * n) & 2047; const float x = (float)m * (1.0f / 1024.0f);
              const float v = (k < 2048) ? cospif(x) : -sinpif(x); T[i] = f2bf(v * 0.02209708691207961f); } }
        { bf16_t* T = (bf16_t*)(ws + WS_TCTX);
          for (int i = gt; i < 256 * 512; i += NGT) { const int np = i >> 9, k = i & 511, n = k & 255; const int m = (np * n) & 255; const float x = (float)m * (1.0f / 128.0f);
              const float v = (k < 256) ? cospif(x) : -sinpif(x); T[i] = f2bf(v * 0.0625f); } }
        { bf16_t* T = (bf16_t*)(ws + WS_CS64);
          for (int i = gt; i < 128 * 64; i += NGT) { const int cc = i >> 6, c = i & 63, cp = cc & 63; const int m = (cp * c) & 63; const float x = (float)m * (1.0f / 32.0f);
              const float v = (cc < 64) ? cospif(x) : sinpif(x); T[i] = f2bf(v * 0.125f); } }
    }
#endif
    PH_END
    PH_BEGIN
#ifndef SKIP_P1
    for (int rep = 0; rep < NREP_P; ++rep) {
        LAS float* vec = (LAS float*)lds; LAS float* red = (LAS float*)(lds + 36864);
        for (int it = bid; it < 4 * 124; it += G) { const int l = it / 124, j = it % 124; const bool up = j >= 36; const int chunk = up ? 3 : 0;
            for (int i = tid; i < 9216; i += 512) { const int v = i >> 10, k = i & 1023; vec[i] = MOD[((size_t)l * 9 + v) * 6144 + chunk * 1024 + k]; }
            __syncthreads();
            if (!up) gemv9_item(vec, red, a.in[I_WIN] + (size_t)l * DM * INC, INC, INC, nullptr, BIN + (size_t)l * 9 * INP, INP, j * 64, tid);
            else gemv9_item(vec, red, a.in[I_WUP] + (size_t)l * DM * UPC, UPC, UPC, nullptr, BUP + (size_t)l * 9 * UPC, UPC, (j - 36) * 64, tid);
        }
        for (int r = gw; r < MTOT; r += NGW) {
            const float* xr = (r < NCTX) ? a.in[I_XP] + (size_t)r * DM : a.in[I_XS] + (size_t)(r - NCTX) * DM;
            const int b9 = row_b9(r);
            const float* sc = MOD + (size_t)b9 * 6144 + 1024; const float* gm = a.in[I_GMIX];
            float ss = 0.f;
#pragma unroll
            for (int j = 0; j < 4; ++j) { const int c = 4 * lane + 256 * j; const f32x4 x = *(const f32x4*)(xr + c); const f32x4 g = *(const f32x4*)(gm + c), s = *(const f32x4*)(sc + c);
                ss += (x[0] * x[0] + x[1] * x[1]) + (x[2] * x[2] + x[3] * x[3]); const f32x4 y = x * g * (s + 1.0f);
                u32x2 w; w.x = pk2(y[0], y[1]); w.y = pk2(y[2], y[3]); *(u32x2*)(XS + (size_t)r * DM + c) = w; }
            ss = wave_sum(ss);
            if (lane == 0) SSQ[r] = ss;
        }
    }
#endif
    PH_END

#pragma unroll 1
    for (int l = 0; l < NLAYER; ++l) {
        PH_BEGIN
#ifndef SKIP_A
        {
            pg8::Gemm g{XS, (const bf16_t*)(ws + WS_WIN), MTOT, INP, DM}; pg8::StaticOrder S; S.init(MTOT, INP, G, bid);
            EpiA E{Pb, INP, SSQ + (size_t)(2 * l) * MTOT, BIN + (size_t)l * 9 * INP, INP, 0};
            for (int rep = 0; rep < NREP_A; ++rep) pg8::gemm_phase<EpiA, pg8::StaticOrder, true, true>(lds, g, S, E);
        }
#endif
        PH_END
        PH_BEGIN
#ifndef SKIP_B
        {
            for (int rep = 0; rep < NREP_B1; ++rep) phase_b(a, lds, l, tid, 0, bid, G);
        }
#endif
        PH_END
        PH_BEGIN
#ifndef SKIP_B
#pragma unroll 1
        for (int repb = 0; repb < NREP_B; ++repb) {
            if (bid < 96 && G > 128) {
#pragma unroll 1
                for (int f = 0; f < 2; ++f) {
                    pg8::Gemm g = (f == 0) ? pg8::Gemm{(const bf16_t*)(ws + WS_TLAT), (const bf16_t*)(ws + WS_FBL), 2048, 2048, 4096}
                                           : pg8::Gemm{(const bf16_t*)(ws + WS_TCTX), (const bf16_t*)(ws + WS_FBC), 256, 8192, 512};
                    pg8::StaticOrder S; S.init(g.M, g.N, G, (f == 0) ? bid : (bid + G - 64) % G);
                    EpiF E{OB, (f == 0) ? NCTX : 0, (f == 0) ? 2048 : 256};
                    pg8::gemm_phase<EpiF, pg8::StaticOrder, true, true>(lds, g, S, E);
                }
            } else {
                phase_b(a, lds, l, tid, 1, bid - 96, G - 96);
            }
        }
#endif
        PH_END
        PH_BEGIN
#ifndef SKIP_C
#pragma unroll 1
        for (int rep = 0; rep < NREP_C; ++rep) {
            int tid2 = threadIdx.x; asm volatile("" : "+v"(tid2));
            unsigned char* ws2 = a.ws; asm volatile("" : "+s"(ws2));
            float lam, lam_init;
            { const float p1 = ((tid2 & 63) < 32) ? a.in[I_LQ1][l * 32 + (tid2 & 63)] * a.in[I_LK1][l * 32 + (tid2 & 63)] : 0.f, p2 = ((tid2 & 63) < 32) ? a.in[I_LQ2][l * 32 + (tid2 & 63)] * a.in[I_LK2][l * 32 + (tid2 & 63)] : 0.f;
              lam_init = 0.8f - 0.6f * expf(-0.3f * (float)l); lam = expf(wave_sum(p1)) - expf(wave_sum(p2)) + lam_init; }
            const float cm = 0.10206207261596575f * 1.4426950408889634f, cd = 0.17677669529663687f * 1.4426950408889634f;
            LAS int* qslot = (LAS int*)(lds + LDS_MISC);
            unsigned* qctr = (unsigned*)(ws2 + WS_CTL) + 64 * (1 + l + 8 * rep);
            for (;;) {
                __syncthreads();
                if (tid2 == 0) *qslot = (int)atomicAdd(qctr, 1u);
                __syncthreads();
                const int idx = *qslot;
                if (idx >= 1152) break;
                const bool lat = idx < 768;
                const bool diff = lat ? (idx < 384) : (idx < 960);
                int q0, vt_ld, nt_main, nt_total, qa_ld; size_t qa_off, k_off, vt_off; size_t qa_base, k_base, vt_base;
                int h;
                if (lat) { const int j = diff ? idx : idx - 384; const int bh = j >> 3, qb = j & 7, b = bh / 6; h = bh % 6;
                    const int lr0 = b * 2048 + qb * 256; q0 = NCTX + lr0; vt_ld = 2560; nt_main = 32; nt_total = 40;
                    qa_base = diff ? WS_QDR : WS_QMR; qa_ld = diff ? 384 : 576; qa_off = (size_t)lr0 * qa_ld + (diff ? 64 : 96) * h;
                    k_base = diff ? WS_KDL : WS_KML; k_off = (size_t)b * 2560 * (diff ? 384 : 576) + (diff ? 64 : 96) * h;
                    vt_base = diff ? WS_VDL : WS_VML; vt_off = (size_t)(b * 6 + h) * 64 * 2560; }
                else { const int j = diff ? idx - 768 : idx - 960; const int i = j / 6; h = j % 6; q0 = i * 256; vt_ld = 256; nt_main = 4; nt_total = 4;
                    qa_base = WS_P; qa_ld = INP; qa_off = (size_t)q0 * INP + (diff ? 736 + 64 * h : 96 * h);
                    k_base = diff ? WS_KDC : WS_KMC; k_off = (size_t)q0 * (diff ? 384 : 576) + (diff ? 64 : 96) * h;
                    vt_base = diff ? WS_VDC : WS_VMC; vt_off = (size_t)(i * 6 + h) * 64 * 256; }
                const bf16_t* Qa = (const bf16_t*)(ws2 + qa_base) + qa_off;
                const bf16_t* Qb = (const bf16_t*)(ws2 + WS_P) + (size_t)q0 * INP + (diff ? 736 + 64 * h : 96 * h);
                const bf16_t* Kp = (const bf16_t*)(ws2 + k_base) + k_off;
                const bf16_t* Vt = (const bf16_t*)(ws2 + vt_base) + vt_off;
                bf16_t* Oo = (bf16_t*)(ws2 + WS_OB) + (size_t)q0 * DM + (diff ? 384 : 0) + 64 * h;
                if (diff) { int tt = threadIdx.x; asm volatile("" : "+v"(tt)); attn_unit<true>(lds, Qa, qa_ld, Qb, INP, Kp, 384, Vt, vt_ld, nt_main, nt_total, Oo, cd, lam, a.in[I_GSUB] + l * 64, 1.0f - lam_init, tt); }
                else { int tt = threadIdx.x; asm volatile("" : "+v"(tt)); attn_unit<false>(lds, Qa, qa_ld, Qb, INP, Kp, 576, Vt, vt_ld, nt_main, nt_total, Oo, cm, 0.f, nullptr, 0.f, tt); }
            }
        }
#endif
        PH_END
        PH_BEGIN
#ifndef SKIP_D
        {
            if (l > 0 && bid >= 128) { convert_weights(a, lds, l, 16, gw - 128 * 8, NGW - 128 * 8, wave, lane); __syncthreads(); }
            pg8::Gemm g{OB, (const bf16_t*)(ws + WS_WOUT), MTOT, DM, DM}; pg8::StaticOrder S; S.init(MTOT, DM, G, bid);
            EpiRes E{(l == 0) ? a.in[I_XP] : a.out, (l == 0) ? a.in[I_XS] : a.out + (size_t)NCTX * DM, a.out, (MOD + (size_t)l * 9 * 6144) + 2 * 1024,
                     a.in[I_GFFN] + l * DM, (MOD + (size_t)l * 9 * 6144) + 4 * 1024, XS, SSQ + (size_t)(2 * l + 1) * MTOT, 0};
            pg8::gemm_phase<EpiRes, pg8::StaticOrder, true, true>(lds, g, S, E);
        }
#endif
        PH_END
        PH_BEGIN
#ifndef SKIP_E
        {
            pg8::Gemm g{XS, (const bf16_t*)(ws + WS_WUP), 104 * 256, UPC, DM}; FfnOrder S; S.init(G, bid);
            EpiFfn E{(bf16_t*)(ws + WS_R), SSQ + (size_t)(2 * l + 1) * MTOT, BUP + (size_t)l * 9 * UPC, a.in[I_WCONV] + (size_t)l * 3 * UPC, lds};
            for (int rep = 0; rep < NREP_E; ++rep) pg8::gemm_phase<EpiFfn, FfnOrder, true, true>(lds, g, S, E);
        }
#endif
        PH_END
        PH_BEGIN
#ifndef SKIP_G
        {
            if (l + 1 < NLAYER && bid >= 128) { convert_weights(a, lds, l + 1, 15, gw - 128 * 8, NGW - 128 * 8, wave, lane); __syncthreads(); }
            const bool nxt = (l + 1 < NLAYER);
            pg8::Gemm g{(const bf16_t*)(ws + WS_R), (const bf16_t*)(ws + WS_WDN), MTOT, DM, DFF}; pg8::StaticOrder S; S.init(MTOT, DM, G, bid);
            EpiRes E{a.out, a.out + (size_t)NCTX * DM, a.out, (MOD + (size_t)l * 9 * 6144) + 5 * 1024,
                     nxt ? a.in[I_GMIX] + (l + 1) * DM : nullptr, (MOD + (size_t)l * 9 * 6144) + 9 * 6144 + 1 * 1024, XS, SSQ + (size_t)(nxt ? 2 * l + 2 : 8) * MTOT, 0};
            pg8::gemm_phase<EpiRes, pg8::StaticOrder, true, true>(lds, g, S, E);
        }
#endif
        PH_END
    }
    PH_BEGIN
#ifndef SKIP_FIN
    {
        const float* gf = a.in[I_GFINAL];
        for (int r = gw; r < MTOT; r += NGW) {
            float* xr = a.out + (size_t)r * DM;
            f32x4 x[4]; float ss = 0.f;
#pragma unroll
            for (int j = 0; j < 4; ++j) { x[j] = *(const f32x4*)(xr + 4 * lane + 256 * j); ss += (x[j][0] * x[j][0] + x[j][1] * x[j][1]) + (x[j][2] * x[j][2] + x[j][3] * x[j][3]); }
            ss = wave_sum(ss);
            const float rs = rsqrtf(ss * (1.0f / 1024.0f) + EPS);
#pragma unroll
            for (int j = 0; j < 4; ++j) { const f32x4 g = *(const f32x4*)(gf + 4 * lane + 256 * j); *(f32x4*)(xr + 4 * lane + 256 * j) = x[j] * rs * g; }
        }
    }
#endif
    PH_END
#undef PH_BEGIN
#undef PH_END
}
constexpr int N_PHASES = 2 + NLAYER * 7 + 1;

#ifndef MK_ONE_LAUNCH
#define MK_ONE_LAUNCH 1
#endif
extern "C" void kernel_launch(void* const* d_in, const int* in_sizes, int n_in, void* d_out, int out_size, void* d_ws, size_t ws_size, hipStream_t stream) {
    static int grid = 0;
    if (grid == 0) {
        if (n_in != 26 || ws_size < WS_END) { fprintf(stderr, "kernel_launch: unexpected inputs (n_in %d, ws %zu < %zu)\n", n_in, ws_size, (size_t)WS_END); grid = -1; return; }
        int dev = 0, cus = 0, per_cu = 0;
        hipGetDevice(&dev); hipDeviceGetAttribute(&cus, hipDeviceAttributeMultiprocessorCount, dev);
        if (hipFuncSetAttribute((const void*)mega_fwd, hipFuncAttributeMaxDynamicSharedMemorySize, LDS_BYTES) != hipSuccess) { fprintf(stderr, "kernel_launch: hipFuncSetAttribute failed\n"); grid = -1; return; }
        if (hipOccupancyMaxActiveBlocksPerMultiprocessor(&per_cu, (const void*)mega_fwd, 512, LDS_BYTES) != hipSuccess || per_cu < 1) { fprintf(stderr, "kernel_launch: occupancy query gave %d\n", per_cu); per_cu = 1; }
        (void)hipGetLastError();
        grid = cus * 1;
    }
    if (grid < 0) return;
    if (hipMemsetAsync((char*)d_ws + WS_CTL, 0, 1 << 20, stream) != hipSuccess) { fprintf(stderr, "kernel_launch: memset failed\n"); return; }
    Args a{};
    for (int i = 0; i < 26; ++i) a.in[i] = (const float*)d_in[i];
    a.out = (float*)d_out; a.ws = (unsigned char*)d_ws;
#if MK_ONE_LAUNCH
    a.ph_lo = 0; a.ph_hi = N_PHASES;
    void* args[] = {&a};
    hipError_t e = hipLaunchCooperativeKernel((const void*)mega_fwd, dim3(grid), dim3(512), args, LDS_BYTES, stream);
    if (e != hipSuccess) fprintf(stderr, "cooperative launch failed: %s (grid %d)\n", hipGetErrorString(e), grid);
#else
    for (int p = 0; p < N_PHASES; ++p) { a.ph_lo = p; a.ph_hi = p + 1; hipLaunchKernelGGL(mega_fwd, dim3(grid), dim3(512), LDS_BYTES, stream, a); }
#endif
}
```

```cpp
#include <hip/hip_runtime.h>
#include <hip/hip_cooperative_groups.h>
#include <cstdio>
#include <cstdint>
namespace cg = cooperative_groups;
namespace pg8 {
#define PG8_LAS __attribute__((address_space(3)))
typedef unsigned short bf16_t;
typedef short bf16x8 __attribute__((ext_vector_type(8)));
typedef float f32x4 __attribute__((ext_vector_type(4)));
typedef unsigned u32x4 __attribute__((ext_vector_type(4)));
constexpr int BM = 256, BK = 64, HALF = 128, HTB = HALF * BK * 2  , STAGE_BYTES = 8 * HTB, NXCD = 8, WGM = 8;

__host__ __device__ __forceinline__ int lds_byte(int r, int c) { const int st = (r >> 4) * 2 + (c >> 5), rr = r & 15, cc = c & 31, ob = rr * 64 + cc * 2; return st * 1024 + (ob ^ (((ob >> 9) & 1) << 5)); }
__host__ __device__ __forceinline__ void stage_rc(int b, int& R, int& C) { const int st = b / 1024, sb = b % 1024, swz = sb ^ (((sb >> 9) & 1) << 5); R = (st >> 1) * 16 + swz / 64; C = (st & 1) * 32 + (swz % 64) / 2; }
__host__ __device__ __forceinline__ int perm32(int rho) { const int n = rho >> 4, i = rho & 15; return 8 * (i >> 2) + 4 * n + (i & 3); }

struct Unit { int pm, pn; };
struct Gemm { const bf16_t* A; const bf16_t* Bt; int M, N, K; };

struct StaticOrder {
    int nM, nN, nwg, G, c;
    __host__ __device__ void init(int M, int N, int G_, int c_) { nM = M / BM; nN = N / BM; nwg = nM * nN; G = G_; c = c_; }
    __host__ __device__ bool next(int i, Unit& u) const {
        const long L = (long)i * G + c; if (L >= nwg) return false;
        int wgid = (int)L; { const int q = nwg / NXCD, r = nwg % NXCD, xcd = wgid % NXCD, off = wgid / NXCD; wgid = (xcd < r ? xcd * (q + 1) : r * (q + 1) + (xcd - r) * q) + off; }
        const int nig = WGM * nN, gid = wgid / nig, fm = gid * WGM, gsz = (nM - fm) < WGM ? (nM - fm) : WGM;
        u.pm = fm + ((wgid % nig) % gsz); u.pn = (wgid % nig) / gsz; return true;
    }
    __device__ __forceinline__ int arow(const Unit& u) const { return u.pm * BM; }
    __device__ __forceinline__ void a_ready(const Unit&) const {}
    __device__ __forceinline__ void done(const Unit&) const {}
};

__device__ __forceinline__ unsigned cvt_pk_bf16(float lo, float hi) { unsigned r; asm volatile("v_cvt_pk_bf16_f32 %0, %1, %2" : "=v"(r) : "v"(lo), "v"(hi)); return r; }
typedef float f32x2 __attribute__((ext_vector_type(2)));
__device__ __forceinline__ f32x2 gelu_pk(f32x2 v) {
    const f32x2 av = __builtin_elementwise_abs(v), d = av * 0.2316418882f + 1.0f;
    f32x2 t; t.x = __builtin_amdgcn_rcpf(d.x); t.y = __builtin_amdgcn_rcpf(d.y);
    f32x2 q = t * 0.5307027145f + (-0.7265760135f); q = q * t + 0.7107068705f; q = q * t + (-0.142248368f); q = q * t + 0.127414796f; q = q * t;
    const f32x2 s = (v * v) * (-0.72134752044f);
    f32x2 e; e.x = __builtin_amdgcn_exp2f(s.x); e.y = __builtin_amdgcn_exp2f(s.y);
    const f32x2 m = v * (q * e), r = v - m;
    f32x2 o; o.x = v.x < 0.f ? m.x : r.x; o.y = v.y < 0.f ? m.y : r.y; return o;
}

template <int ACT  > struct EpiBf16 {
    static constexpr bool PERM = true, AFTER_DRAIN = false; static_assert(ACT == 0 || ACT == 1, "EpiBf16: ACT is 0 (none) or 1 (gelu_pk)");
    bf16_t* O; int ldc; const float* bias; int split_cols; size_t split_stride; float scale0;
    __device__ __forceinline__ void operator()(const f32x4 (&acc)[2][2][4][2], const Unit& u, int wr, int wc, int fr, int fq) const {
        const int row0 = u.pm * BM + wr * 64 + fr; int colt = u.pn * BM; bf16_t* base = O;
        float sc = 1.f; if (split_cols) { const int t = colt / split_cols; base += (size_t)t * split_stride; colt -= t * split_cols; if (t == 0) sc = scale0; }
        const int col0 = colt + wc * 32 + 8 * fq, bcol0 = u.pn * BM + wc * 32 + 8 * fq;
        f32x4 bv[2][2];
#pragma unroll
        for (int bj = 0; bj < 2; ++bj)
#pragma unroll
            for (int n = 0; n < 2; ++n) bv[bj][n] = bias ? *(const f32x4*)(bias + bcol0 + bj * HALF + 4 * n) : (f32x4){0.f, 0.f, 0.f, 0.f};
#pragma unroll
        for (int ai = 0; ai < 2; ++ai)
#pragma unroll
            for (int m = 0; m < 4; ++m) { bf16_t* rowp = base + (size_t)(row0 + ai * HALF + m * 16) * ldc + col0;
#pragma unroll
                for (int bj = 0; bj < 2; ++bj) { f32x4 v0 = acc[ai][bj][m][0] + bv[bj][0], v1 = acc[ai][bj][m][1] + bv[bj][1];
                    if (ACT == 1) { f32x2 a = gelu_pk((f32x2){v0[0], v0[1]}), b = gelu_pk((f32x2){v0[2], v0[3]}), c = gelu_pk((f32x2){v1[0], v1[1]}), d = gelu_pk((f32x2){v1[2], v1[3]});
                        v0 = (f32x4){a.x, a.y, b.x, b.y}; v1 = (f32x4){c.x, c.y, d.x, d.y}; }
                    v0 = v0 * sc; v1 = v1 * sc; u32x4 w; w.x = cvt_pk_bf16(v0[0], v0[1]); w.y = cvt_pk_bf16(v0[2], v0[3]); w.z = cvt_pk_bf16(v1[0], v1[1]); w.w = cvt_pk_bf16(v1[2], v1[3]);
                    *(u32x4*)(rowp + bj * HALF) = w; } }
    }
};

struct PanelStats {
    unsigned* xbuf;
    unsigned* cnt;
    unsigned* tmo;
    int ntn; float eps;
    unsigned code;
    __device__ __forceinline__ bool run(const f32x4 (&v)[2][2][4][2], const Unit& u, int wr, int wc, int fr, int fq, PG8_LAS unsigned char* lds, int wid, int lane) const {
        typedef float f32x2v __attribute__((ext_vector_type(2)));
        PG8_LAS f32x2v* P = (PG8_LAS f32x2v*)lds;
        PG8_LAS f32x2v* S = (PG8_LAS f32x2v*)(lds + 8192);
        PG8_LAS unsigned* flag = (PG8_LAS unsigned*)(lds + 8192 + 2048);
#pragma unroll
        for (int ai = 0; ai < 2; ++ai)
#pragma unroll
            for (int m = 0; m < 4; ++m) {
                float s = 0.f;
#pragma unroll
                for (int bj = 0; bj < 2; ++bj)
#pragma unroll
                    for (int n = 0; n < 2; ++n) { const f32x4 x = v[ai][bj][m][n]; s += (x[0] + x[1]) + (x[2] + x[3]); }
                s += __shfl_xor(s, 16); s += __shfl_xor(s, 32);
                const float mw = s * (1.0f / 64.0f); float q = 0.f;
#pragma unroll
                for (int bj = 0; bj < 2; ++bj)
#pragma unroll
                    for (int n = 0; n < 2; ++n) { const f32x4 d = v[ai][bj][m][n] - mw; q += (d[0] * d[0] + d[1] * d[1]) + (d[2] * d[2] + d[3] * d[3]); }
                q += __shfl_xor(q, 16); q += __shfl_xor(q, 32);
                if (fq == 0) P[(ai * HALF + wr * 64 + m * 16 + fr) * 4 + wc] = (f32x2v){mw, q};
            }
        asm volatile("s_waitcnt lgkmcnt(0)" ::: "memory"); __builtin_amdgcn_s_barrier(); asm volatile("" ::: "memory");
#if defined(BROKEN_EXCHANGE_NO_WAIT)
#warning BROKEN CONTROL BUILD: the row-statistics exchange does not wait; results are wrong by design
        if (blockIdx.x >= 64) { const long long t0_ = clock64(); while (clock64() - t0_ < 60000) __builtin_amdgcn_s_sleep(8); }
#endif
        const int row = wid * 32 + (lane & 31);
        if (lane < 32) {
            const f32x2v a = P[row * 4 + 0], b = P[row * 4 + 1], c = P[row * 4 + 2], d = P[row * 4 + 3];
            const float mt = (a.x + b.x + c.x + d.x) * 0.25f;
            const float da = a.x - mt, db = b.x - mt, dc = c.x - mt, dd = d.x - mt;
            const float m2 = (a.y + b.y) + (c.y + d.y) + 64.0f * ((da * da + db * db) + (dc * dc + dd * dd));
            unsigned long long* slot = (unsigned long long*)xbuf + ((size_t)(u.pm * BM + row) * 4 + u.pn);
            __hip_atomic_store(slot, ((unsigned long long)__float_as_uint(m2) << 32) | __float_as_uint(mt), __ATOMIC_RELAXED, __HIP_MEMORY_SCOPE_AGENT);
        }
        asm volatile("s_waitcnt vmcnt(0)" ::: "memory");
        if (lane == 0) __hip_atomic_fetch_add(cnt + 64 * u.pm, 1u, __ATOMIC_RELAXED, __HIP_MEMORY_SCOPE_AGENT);
        if (wid == 0) {
            bool dead = false; const unsigned long long t0 = __builtin_amdgcn_s_memrealtime(); const unsigned want = 8u * (unsigned)ntn;
            for (;;) {
#if defined(BROKEN_EXCHANGE_NO_WAIT)
                break;
#endif
                if ((unsigned)__builtin_amdgcn_readfirstlane(__hip_atomic_load(cnt + 64 * u.pm, __ATOMIC_RELAXED, __HIP_MEMORY_SCOPE_AGENT)) >= want) break;
                if (__builtin_amdgcn_s_memrealtime() - t0 > 2000000ull) {
                    if (lane == 0) { unsigned expect = 0u; __hip_atomic_compare_exchange_strong(tmo + 1, &expect, code | (unsigned)(u.pm & 0xff), __ATOMIC_RELAXED, __ATOMIC_RELAXED, __HIP_MEMORY_SCOPE_AGENT);
                                     __hip_atomic_store(tmo, 1u, __ATOMIC_RELAXED, __HIP_MEMORY_SCOPE_AGENT); }
                    dead = true; break; }
                __builtin_amdgcn_s_sleep(2);
            }
            __builtin_amdgcn_fence(__ATOMIC_ACQUIRE, "agent");
            if (lane == 0) flag[0] = dead ? 1u : 0u;
        }
        asm volatile("s_waitcnt vmcnt(0) lgkmcnt(0)" ::: "memory"); __builtin_amdgcn_s_barrier(); asm volatile("" ::: "memory");
        const bool bad = flag[0] != 0u;
        if (lane < 32) {
            const unsigned long long* slot = (const unsigned long long*)xbuf + (size_t)(u.pm * BM + row) * 4; float mt[4], m2[4]; float ms = 0.f;
#pragma unroll
            for (int t = 0; t < 4; ++t) { if (t < ntn) { const unsigned long long w = __hip_atomic_load(slot + t, __ATOMIC_RELAXED, __HIP_MEMORY_SCOPE_AGENT); mt[t] = __uint_as_float((unsigned)w); m2[t] = __uint_as_float((unsigned)(w >> 32)); } else { mt[t] = 0.f; m2[t] = 0.f; } ms += mt[t]; }
            const float mean = ms / (float)ntn; float q = 0.f;
#pragma unroll
            for (int t = 0; t < 4; ++t) if (t < ntn) { const float dm = mt[t] - mean; q += m2[t] + 256.0f * dm * dm; }
            S[row] = (f32x2v){mean, 1.0f / sqrtf(q / (256.0f * (float)ntn) + eps)};
        }
        asm volatile("s_waitcnt lgkmcnt(0)" ::: "memory"); __builtin_amdgcn_s_barrier(); asm volatile("" ::: "memory");
        return bad;
    }
};
struct EpiLnRes {
    static constexpr bool PERM = false, AFTER_DRAIN = true;
    const float* base; float* out; int ldc; const float* bias; PanelStats st; unsigned poison;
    __device__ __forceinline__ void fused(f32x4 (&acc)[2][2][4][2], const Unit& u, int wr, int wc, int fr, int fq, PG8_LAS unsigned char* lds, int wid, int lane) const {
        typedef float f32x2v __attribute__((ext_vector_type(2)));
        const PG8_LAS f32x2v* S = (const PG8_LAS f32x2v*)(lds + 8192);
        const int col0 = u.pn * BM + wc * 32 + 4 * fq;
#pragma unroll
        for (int bj = 0; bj < 2; ++bj)
#pragma unroll
            for (int n = 0; n < 2; ++n) { const f32x4 bv = bias ? *(const f32x4*)(bias + col0 + bj * HALF + n * 16) : (f32x4){0.f, 0.f, 0.f, 0.f};
#pragma unroll
                for (int ai = 0; ai < 2; ++ai)
#pragma unroll
                    for (int m = 0; m < 4; ++m) acc[ai][bj][m][n] += bv; }
        f32x4 pre[4][2][2];
#pragma unroll
        for (int m = 0; m < 4; ++m) { const size_t off = (size_t)(u.pm * BM + wr * 64 + m * 16 + fr) * ldc + col0;
#pragma unroll
            for (int bj = 0; bj < 2; ++bj)
#pragma unroll
                for (int n = 0; n < 2; ++n) pre[m][bj][n] = *(const f32x4*)(base + off + bj * HALF + n * 16); }
        const bool bad = st.run(acc, u, wr, wc, fr, fq, lds, wid, lane) || poison != 0u;
        const float qnan = __builtin_nanf("");
#pragma unroll
        for (int ai = 0; ai < 2; ++ai)
#pragma unroll
            for (int m = 0; m < 4; ++m) { const int r = ai * HALF + wr * 64 + m * 16 + fr; const f32x2v sr = S[r]; const size_t off = (size_t)(u.pm * BM + r) * ldc + col0;
#pragma unroll
                for (int bj = 0; bj < 2; ++bj)
#pragma unroll
                    for (int n = 0; n < 2; ++n) { const f32x4 bs = ai == 0 ? pre[m][bj][n] : *(const f32x4*)(base + off + bj * HALF + n * 16); f32x4 o = bs + (acc[ai][bj][m][n] - sr.x) * sr.y;
                        if (bad) o = (f32x4){qnan, qnan, qnan, qnan}; *(f32x4*)(out + off + bj * HALF + n * 16) = o; }
                if (m & 1) asm volatile("" ::: "memory"); }
    }
};
struct EpiLnResLn {
    static constexpr bool PERM = false, AFTER_DRAIN = true;
    const float* base; float* out; bf16_t* xn; int ldc; const float* bias; PanelStats st1, st2; unsigned poison;
    __device__ __forceinline__ void fused(f32x4 (&acc)[2][2][4][2], const Unit& u, int wr, int wc, int fr, int fq, PG8_LAS unsigned char* lds, int wid, int lane) const {
        typedef float f32x2v __attribute__((ext_vector_type(2))); typedef unsigned u32x2v __attribute__((ext_vector_type(2)));
        const PG8_LAS f32x2v* S = (const PG8_LAS f32x2v*)(lds + 8192);
        const int col0 = u.pn * BM + wc * 32 + 4 * fq;
#pragma unroll
        for (int bj = 0; bj < 2; ++bj)
#pragma unroll
            for (int n = 0; n < 2; ++n) { const f32x4 bv = bias ? *(const f32x4*)(bias + col0 + bj * HALF + n * 16) : (f32x4){0.f, 0.f, 0.f, 0.f};
#pragma unroll
                for (int ai = 0; ai < 2; ++ai)
#pragma unroll
                    for (int m = 0; m < 4; ++m) acc[ai][bj][m][n] += bv; }
        bool bad = st1.run(acc, u, wr, wc, fr, fq, lds, wid, lane) || poison != 0u;
        const float qnan = __builtin_nanf("");
#pragma unroll
        for (int ai = 0; ai < 2; ++ai)
#pragma unroll
            for (int m = 0; m < 4; ++m) { const int r = ai * HALF + wr * 64 + m * 16 + fr; const f32x2v sr = S[r]; const size_t off = (size_t)(u.pm * BM + r) * ldc + col0;
#pragma unroll
                for (int bj = 0; bj < 2; ++bj)
#pragma unroll
                    for (int n = 0; n < 2; ++n) { const f32x4 bs = *(const f32x4*)(base + off + bj * HALF + n * 16); acc[ai][bj][m][n] = bs + (acc[ai][bj][m][n] - sr.x) * sr.y; }
                asm volatile("" : "+v"(acc[ai][0][m][0]), "+v"(acc[ai][0][m][1]), "+v"(acc[ai][1][m][0]), "+v"(acc[ai][1][m][1]));
                if (m & 1) asm volatile("" ::: "memory"); }
        const bool bad1 = bad;
        bad = st2.run(acc, u, wr, wc, fr, fq, lds, wid, lane) || bad;
#pragma unroll
        for (int ai = 0; ai < 2; ++ai)
#pragma unroll
            for (int m = 0; m < 4; ++m) { const int r = ai * HALF + wr * 64 + m * 16 + fr; const f32x2v sr = S[r]; const size_t off = (size_t)(u.pm * BM + r) * ldc + col0;
#pragma unroll
                for (int bj = 0; bj < 2; ++bj)
#pragma unroll
                    for (int n = 0; n < 2; ++n) { const f32x4 x1 = acc[ai][bj][m][n]; *(f32x4*)(out + off + bj * HALF + n * 16) = bad1 ? (f32x4){qnan, qnan, qnan, qnan} : x1;
                        const f32x4 o = (x1 - sr.x) * sr.y; u32x2v w; w.x = cvt_pk_bf16(o[0], o[1]); w.y = cvt_pk_bf16(o[2], o[3]);
                        if (bad) { w.x = 0x7fc07fc0u; w.y = 0x7fc07fc0u; } *(u32x2v*)(xn + off + bj * HALF + n * 16) = w; }
                asm volatile("" ::: "memory"); }
    }
};

template <class Epi, class Sched, bool ALIGN_EPI = false, bool SP2 = false>
__device__ __forceinline__ void gemm_phase(PG8_LAS unsigned char* lds, const Gemm g, const Sched& S, const Epi& E) {
    int tid = threadIdx.x; asm volatile("" : "+v"(tid));
    const int wid = __builtin_amdgcn_readfirstlane(tid >> 6), lane = tid & 63, wr = wid >> 2, wc = wid & 3, fr = lane & 15, fq = lane >> 4;
    const int K = g.K, nt = K / BK;
    unsigned voffA[2], voffB[2];
#pragma unroll
    for (int i = 0; i < 2; ++i) { int R, C; stage_rc(tid * 16 + i * 8192, R, C); const int Rb = Epi::PERM ? ((R & ~31) + perm32(R & 31)) : R;
        voffA[i] = (unsigned)(R * K + C) * 2u; voffB[i] = (unsigned)(Rb * K + C) * 2u; }
    const size_t kstep = (size_t)(BK * 2);
    const size_t hstep = (size_t)HALF * K * 2;
    const size_t tstep = 2 * hstep;
    const unsigned ldsw = (unsigned)wid * 1024u;
    const int aoff = lds_byte(wr * 64 + fr, fq * 8), boff = lds_byte(wc * 32 + fr, fq * 8);
#define PG8_SA(b, h) (((b) * 2 + (h)) * HTB)
#define PG8_SB(b, h) ((4 + (b) * 2 + (h)) * HTB)
#define PG8_STAGE(bufoff, gbase, voff) do { _Pragma("unroll") for (int _i = 0; _i < 2; ++_i) \
        __builtin_amdgcn_global_load_lds((const unsigned*)((const char*)(gbase) + (voff)[_i]), (PG8_LAS unsigned*)(lds + (bufoff) + ldsw + _i * 8192), 16, 0, 0); } while (0)
#define PG8_LDA(dst, b, h) do { _Pragma("unroll") for (int m = 0; m < 4; ++m) _Pragma("unroll") for (int k = 0; k < 2; ++k) dst[m][k] = *(const PG8_LAS bf16x8*)(lds + PG8_SA(b, h) + aoff + m * 2048 + k * 1024); } while (0)
#define PG8_LDB(dst, b, h) do { _Pragma("unroll") for (int n = 0; n < 2; ++n) _Pragma("unroll") for (int k = 0; k < 2; ++k) dst[n][k] = *(const PG8_LAS bf16x8*)(lds + PG8_SB(b, h) + boff + n * 2048 + k * 1024); } while (0)
#define PG8_MMA(ai, bj, At, Bt) do { __builtin_amdgcn_s_setprio(1); _Pragma("unroll") for (int m = 0; m < 4; ++m) _Pragma("unroll") for (int n = 0; n < 2; ++n) _Pragma("unroll") for (int k = 0; k < 2; ++k) \
        acc[ai][bj][m][n] = __builtin_amdgcn_mfma_f32_16x16x32_bf16(Bt[n][k], At[m][k], acc[ai][bj][m][n], 0, 0, 0); __builtin_amdgcn_s_setprio(0); } while (0)
#define PG8_WAIT_V(n) asm volatile("s_waitcnt vmcnt(" #n ")" ::: "memory")
#define PG8_WAIT_L(n) asm volatile("s_waitcnt lgkmcnt(" #n ")" ::: "memory")
#define PG8_BAR __builtin_amdgcn_s_barrier()
#define PG8_SCHED __builtin_amdgcn_sched_barrier(0)
    Unit cur, nxt; int ui = 0;
    if (!S.next(0, cur)) return;
    f32x4 acc[2][2][4][2];
#pragma unroll
    for (int a = 0; a < 2; ++a)
#pragma unroll
        for (int b = 0; b < 2; ++b)
#pragma unroll
            for (int m = 0; m < 4; ++m)
#pragma unroll
                for (int n = 0; n < 2; ++n) acc[a][b][m][n] = (f32x4){0.f, 0.f, 0.f, 0.f};
    bf16x8 At[4][2], B0[2][2], B1[2][2];
    const char* cA = (const char*)g.A + (size_t)S.arow(cur) * (size_t)(K * 2); const char* cB = (const char*)g.Bt + (size_t)cur.pn * tstep;
    S.a_ready(cur);
    if constexpr (SP2) {
        PG8_STAGE(PG8_SB(0, 0), cB, voffB); PG8_STAGE(PG8_SB(0, 1), cB + hstep, voffB); PG8_STAGE(PG8_SA(0, 0), cA, voffA); PG8_STAGE(PG8_SA(0, 1), cA + hstep, voffA);
        if (wr == 1) PG8_BAR;
        PG8_WAIT_V(2); PG8_BAR;
        PG8_STAGE(PG8_SB(1, 0), cB + kstep, voffB); PG8_STAGE(PG8_SA(1, 0), cA + kstep, voffA); PG8_STAGE(PG8_SB(1, 1), cB + hstep + kstep, voffB);
        PG8_WAIT_V(6); PG8_BAR;
    } else {
        PG8_STAGE(PG8_SB(0, 0), cB, voffB); PG8_STAGE(PG8_SA(0, 0), cA, voffA); PG8_STAGE(PG8_SB(0, 1), cB + hstep, voffB); PG8_STAGE(PG8_SA(0, 1), cA + hstep, voffA);
        if (wr == 1) PG8_BAR;
        PG8_WAIT_V(4); PG8_BAR;
        PG8_STAGE(PG8_SB(1, 0), cB + kstep, voffB); PG8_STAGE(PG8_SA(1, 0), cA + kstep, voffA); PG8_STAGE(PG8_SB(1, 1), cB + hstep + kstep, voffB);
        PG8_WAIT_V(6); PG8_BAR;
    }
    for (;;) {
        const bool has_next = S.next(ui + 1, nxt);
        const char* nA = has_next ? (const char*)g.A + (size_t)S.arow(nxt) * (size_t)(K * 2) : cA; const char* nB = has_next ? (const char*)g.Bt + (size_t)nxt.pn * tstep : cB;
        for (int t = 0; t < nt; t += 2) {
            const bool last = (t == nt - 2);
            const char* a1 = cA + (size_t)(t + 1) * kstep;
            const char* a2 = last ? nA : cA + (size_t)(t + 2) * kstep; const char* b2 = last ? nB : cB + (size_t)(t + 2) * kstep;
            const char* a3 = a2 + kstep; const char* b3 = b2 + kstep;
            if (last && has_next) S.a_ready(nxt);
            if constexpr (SP2) {
            PG8_LDB(B0, 0, 0); PG8_LDB(B1, 0, 1); PG8_SCHED; PG8_LDA(At, 0, 0); PG8_STAGE(PG8_SA(1, 1), a1 + hstep, voffA);
            PG8_WAIT_V(8); PG8_WAIT_L(0); PG8_BAR; PG8_MMA(0, 0, At, B0); PG8_MMA(0, 1, At, B1); PG8_BAR; PG8_SCHED;
            PG8_LDA(At, 0, 1); PG8_STAGE(PG8_SB(0, 0), b2, voffB); PG8_STAGE(PG8_SB(0, 1), b2 + hstep, voffB); PG8_STAGE(PG8_SA(0, 0), a2, voffA);
            PG8_WAIT_V(8); PG8_WAIT_L(0); PG8_BAR; PG8_MMA(1, 0, At, B0); PG8_MMA(1, 1, At, B1); PG8_BAR; PG8_SCHED;
            PG8_LDB(B0, 1, 0); PG8_LDB(B1, 1, 1); PG8_SCHED; PG8_LDA(At, 1, 0); PG8_STAGE(PG8_SA(0, 1), a2 + hstep, voffA);
            PG8_WAIT_V(8); PG8_WAIT_L(0); PG8_BAR; PG8_MMA(0, 0, At, B0); PG8_MMA(0, 1, At, B1); PG8_BAR; PG8_SCHED;
            PG8_LDA(At, 1, 1); PG8_STAGE(PG8_SB(1, 0), b3, voffB); PG8_STAGE(PG8_SB(1, 1), b3 + hstep, voffB); PG8_STAGE(PG8_SA(1, 0), a3, voffA);
            PG8_WAIT_V(8); PG8_WAIT_L(0); PG8_BAR; PG8_MMA(1, 0, At, B0); PG8_MMA(1, 1, At, B1); PG8_BAR; PG8_SCHED;
            } else {
            PG8_LDB(B0, 0, 0); PG8_SCHED; PG8_LDA(At, 0, 0); PG8_STAGE(PG8_SA(1, 1), a1 + hstep, voffA);
            PG8_WAIT_L(8); PG8_BAR; PG8_WAIT_L(0); PG8_MMA(0, 0, At, B0); PG8_BAR; PG8_SCHED;
            PG8_LDB(B1, 0, 1); PG8_STAGE(PG8_SB(0, 0), b2, voffB);
            PG8_BAR; PG8_WAIT_L(0); PG8_MMA(0, 1, At, B1); PG8_BAR;
            PG8_LDA(At, 0, 1); PG8_STAGE(PG8_SA(0, 0), a2, voffA);
            PG8_BAR; PG8_WAIT_L(0); PG8_MMA(1, 0, At, B0); PG8_BAR; PG8_SCHED;
            PG8_STAGE(PG8_SB(0, 1), b2 + hstep, voffB);
            PG8_WAIT_V(6); PG8_BAR; PG8_MMA(1, 1, At, B1); PG8_BAR;
            PG8_LDB(B0, 1, 0); PG8_SCHED; PG8_LDA(At, 1, 0); PG8_STAGE(PG8_SA(0, 1), a2 + hstep, voffA);
            PG8_WAIT_L(8); PG8_BAR; PG8_WAIT_L(0); PG8_MMA(0, 0, At, B0); PG8_BAR; PG8_SCHED;
            PG8_LDB(B1, 1, 1); PG8_STAGE(PG8_SB(1, 0), b3, voffB);
            PG8_BAR; PG8_WAIT_L(0); PG8_MMA(0, 1, At, B1); PG8_BAR;
            PG8_LDA(At, 1, 1); PG8_STAGE(PG8_SA(1, 0), a3, voffA);
            PG8_BAR; PG8_WAIT_L(0); PG8_MMA(1, 0, At, B0); PG8_BAR; PG8_SCHED;
            PG8_STAGE(PG8_SB(1, 1), b3 + hstep, voffB);
            PG8_WAIT_V(6); PG8_BAR; PG8_MMA(1, 1, At, B1); PG8_BAR;
            }
        }
        if constexpr (ALIGN_EPI) { if (wr == 0) PG8_BAR; }
        if constexpr (!Epi::AFTER_DRAIN) { E(acc, cur, wr, wc, fr, fq); S.done(cur); }
        if (!has_next) break;
#pragma unroll
        for (int a = 0; a < 2; ++a)
#pragma unroll
            for (int b = 0; b < 2; ++b)
#pragma unroll
                for (int m = 0; m < 4; ++m)
#pragma unroll
                    for (int n = 0; n < 2; ++n) acc[a][b][m][n] = (f32x4){0.f, 0.f, 0.f, 0.f};
        cur = nxt; cA = nA; cB = nB; ++ui;
        if constexpr (ALIGN_EPI) { if (wr == 1) PG8_BAR; }
    }
    PG8_WAIT_V(0);
    if constexpr (!ALIGN_EPI) { if (wr == 0) PG8_BAR; }
    PG8_BAR;
    if constexpr (Epi::AFTER_DRAIN) { E.fused(acc, cur, wr, wc, fr, fq, lds, wid, lane); S.done(cur); }
#undef PG8_SA
#undef PG8_SB
#undef PG8_STAGE
#undef PG8_LDA
#undef PG8_LDB
#undef PG8_MMA
#undef PG8_WAIT_V
#undef PG8_WAIT_L
#undef PG8_BAR
#undef PG8_SCHED
}
}

#define DEV __device__ __forceinline__
#define LAS __attribute__((address_space(3)))
#define GAS __attribute__((address_space(1)))
typedef unsigned short bf16_t;
typedef short bf16x8 __attribute__((ext_vector_type(8)));
typedef short s16x4 __attribute__((ext_vector_type(4)));
typedef float f32x4 __attribute__((ext_vector_type(4)));
typedef float f32x2 __attribute__((ext_vector_type(2)));
typedef float f32x16 __attribute__((ext_vector_type(16)));
typedef unsigned u32x4 __attribute__((ext_vector_type(4)));
typedef unsigned u32x2 __attribute__((ext_vector_type(2)));
typedef __bf16 bf16x2_t __attribute__((ext_vector_type(2)));

constexpr int DM = 1024, NCTX = 8192, NLAT = 16384, MTOT = 24576;
constexpr int INP = 2304, INC = 2144, DFF = 2816, UPC = 5632;
constexpr int NLAYER = 4;
constexpr float EPS = 1e-6f;
constexpr size_t MiB = 1u << 20;
constexpr size_t WS_CTL = 0;
constexpr size_t WS_MOD = 1 * MiB;
constexpr size_t WS_BIN = 2 * MiB;
constexpr size_t WS_BUP = 3 * MiB;
constexpr size_t WS_SSQ = 4 * MiB;
constexpr size_t WS_WIN = 5 * MiB;
constexpr size_t WS_WUKV = WS_WIN + 4718592;
constexpr size_t WS_WOUT = 10 * MiB;
constexpr size_t WS_WUP = 12 * MiB;
constexpr size_t WS_WDN = 23 * MiB;
constexpr size_t WS_TLAT = 29 * MiB;
constexpr size_t WS_TCTX = 45 * MiB;
constexpr size_t WS_CS64 = WS_TCTX + 512 * 1024;
constexpr size_t WS_XS = 46 * MiB;
constexpr size_t WS_R = 94 * MiB;
constexpr size_t WS_P = WS_R;
constexpr size_t WS_OB = WS_P + 108 * MiB;
constexpr size_t WS_KML = WS_OB + 48 * MiB;
constexpr size_t WS_KMC = WS_KML + 23592960;
constexpr size_t WS_VML = WS_KMC + 9 * MiB;
constexpr size_t WS_VMC = WS_VML + 15 * MiB;
constexpr size_t WS_KDL = WS_VMC + 6 * MiB;
constexpr size_t WS_KDC = WS_KDL + 15 * MiB;
constexpr size_t WS_VDL = WS_KDC + 6 * MiB;
constexpr size_t WS_VDC = WS_VDL + 15 * MiB;
constexpr size_t WS_QMR = WS_VDC + 6 * MiB;
constexpr size_t WS_QDR = WS_QMR + 18 * MiB;
constexpr size_t WS_FBL = WS_QDR + 12 * MiB;
constexpr size_t WS_FBC = WS_FBL + 16 * MiB;
constexpr size_t WS_END = WS_FBC + 8 * MiB;
constexpr size_t WS_U = WS_R;
constexpr size_t WS_ACT = WS_R + 176 * MiB;
static_assert(WS_ACT + 88 * MiB <= WS_END, "overlay fits");
constexpr size_t OUT_CKV = 25165824, OUT_KROPE = OUT_CKV + 4194304, OUT_DK = OUT_KROPE + 1048576, OUT_DV = OUT_DK + 12582912;
constexpr int LDS_BYTES = 147456;
constexpr int RING_BYTES = 131072;
constexpr int LDS_MISC = RING_BYTES;

struct Args { const float* in[26]; float* out; unsigned char* ws; int ph_lo, ph_hi; };
enum { I_XP = 0, I_XS, I_C, I_CCKV, I_CKROPE, I_CDK, I_CDV, I_CCTX, I_WADA, I_BADA, I_GMIX, I_GFFN, I_WIN, I_GKV, I_WUK, I_WUV,
       I_LQ1, I_LK1, I_LQ2, I_LK2, I_GSUB, I_WOUT, I_WUP, I_WCONV, I_WDOWN, I_GFINAL };

DEV float bf2f(unsigned b) { return __uint_as_float(b << 16); }
DEV unsigned pk2(float lo, float hi) { f32x2 v = {lo, hi}; bf16x2_t b = __builtin_convertvector(v, bf16x2_t); return __builtin_bit_cast(unsigned, b); }
DEV bf16_t f2bf(float f) { return (bf16_t)(pk2(f, 0.f) & 0xffffu); }
DEV float wave_sum(float v) {
#pragma unroll
    for (int o = 1; o < 64; o <<= 1) v += __shfl_xor(v, o);
    return v;
}
DEV f32x4 mfma16(bf16x8 a, bf16x8 b, f32x4 c) { return __builtin_amdgcn_mfma_f32_16x16x32_bf16(a, b, c, 0, 0, 0); }
DEV f32x16 mfma32(bf16x8 a, bf16x8 b, f32x16 c) { return __builtin_amdgcn_mfma_f32_32x32x16_bf16(a, b, c, 0, 0, 0); }
DEV int row_b9(int row0) { return row0 < NCTX ? 0 : 1 + ((row0 - NCTX) >> 11); }

struct EpiA {
    static constexpr bool PERM = true, AFTER_DRAIN = false;
    bf16_t* O; int ldc; const float* ssq; const float* bias; int ldb; int row_off;
    DEV void operator()(const f32x4 (&acc)[2][2][4][2], const pg8::Unit& u, int wr, int wc, int fr, int fq) const {
        const int lrow0 = u.pm * 256, b9 = row_b9(row_off + lrow0);
        const int col0 = u.pn * 256 + wc * 32 + 8 * fq;
        f32x4 bv[2][2];
#pragma unroll
        for (int bj = 0; bj < 2; ++bj)
#pragma unroll
            for (int n = 0; n < 2; ++n) bv[bj][n] = *(const GAS f32x4*)(bias + (size_t)b9 * ldb + col0 + bj * 128 + 4 * n);
#pragma unroll
        for (int ai = 0; ai < 2; ++ai)
#pragma unroll
            for (int m = 0; m < 4; ++m) {
                const int lr = lrow0 + ai * 128 + wr * 64 + m * 16 + fr;
                const float rs = rsqrtf(((const GAS float*)ssq)[row_off + lr] * (1.0f / 1024.0f) + EPS);
                GAS bf16_t* rowp = (GAS bf16_t*)O + (size_t)lr * ldc + col0;
#pragma unroll
                for (int bj = 0; bj < 2; ++bj) {
                    const f32x4 v0 = acc[ai][bj][m][0] * rs + bv[bj][0], v1 = acc[ai][bj][m][1] * rs + bv[bj][1];
                    u32x4 w; w.x = pk2(v0[0], v0[1]); w.y = pk2(v0[2], v0[3]); w.z = pk2(v1[0], v1[1]); w.w = pk2(v1[2], v1[3]);
                    *(GAS u32x4*)(rowp + bj * 128) = w;
                }
            }
    }
};
struct EpiRes {
    static constexpr bool PERM = false, AFTER_DRAIN = false;
    const float* xold_c; const float* xold_l;
    float* X;
    const float* gate;
    const float* g; const float* scale;
    bf16_t* XS; float* ssq; int row_off;
    DEV void operator()(const f32x4 (&acc)[2][2][4][2], const pg8::Unit& u, int wr, int wc, int fr, int fq) const {
        const int row0 = row_off + u.pm * 256, b9 = row_b9(row0);
        const int col0 = u.pn * 256 + wc * 32 + 4 * fq;
        f32x4 gv[2][2], gs[2][2];
#pragma unroll
        for (int bj = 0; bj < 2; ++bj)
#pragma unroll
            for (int n = 0; n < 2; ++n) {
                const int c = col0 + bj * 128 + n * 16;
                gv[bj][n] = *(const GAS f32x4*)(gate + (size_t)b9 * 6144 + c);
                if (g) { const f32x4 gg = *(const GAS f32x4*)(g + c), sc = *(const GAS f32x4*)(scale + (size_t)b9 * 6144 + c); gs[bj][n] = gg * (sc + 1.0f); }
                else gs[bj][n] = (f32x4){0.f, 0.f, 0.f, 0.f};
            }
        const float* xo = (row0 < NCTX) ? xold_c : (xold_l - (size_t)NCTX * DM);
#pragma unroll
        for (int ai = 0; ai < 2; ++ai)
#pragma unroll
            for (int m = 0; m < 4; ++m) {
                const int r = row0 + ai * 128 + wr * 64 + m * 16 + fr;
                float ss = 0.f;
#pragma unroll
                for (int bj = 0; bj < 2; ++bj)
#pragma unroll
                    for (int n = 0; n < 2; ++n) {
                        const size_t off = (size_t)r * DM + col0 + bj * 128 + n * 16;
                        const f32x4 xv = *(const GAS f32x4*)(xo + off);
                        const f32x4 xn = xv + gv[bj][n] * acc[ai][bj][m][n];
                        *(GAS f32x4*)(X + off) = xn;
                        ss += (xn[0] * xn[0] + xn[1] * xn[1]) + (xn[2] * xn[2] + xn[3] * xn[3]);
                        if (g) { const f32x4 y = xn * gs[bj][n]; u32x2 w; w.x = pk2(y[0], y[1]); w.y = pk2(y[2], y[3]); *(GAS u32x2*)(XS + off) = w; }
                    }
                ss += __shfl_xor(ss, 16); ss += __shfl_xor(ss, 32);
                if (fq == 0) unsafeAtomicAdd(ssq + r, ss);
            }
    }
};
struct EpiF {
    static constexpr bool PERM = true, AFTER_DRAIN = false;
    bf16_t* OB; int rowbase; int nseq;
    DEV void operator()(const f32x4 (&acc)[2][2][4][2], const pg8::Unit& u, int wr, int wc, int fr, int fq) const {
        const int col0 = 768 + wc * 32 + 8 * fq;
#pragma unroll
        for (int ai = 0; ai < 2; ++ai)
#pragma unroll
            for (int m = 0; m < 4; ++m) {
                const int np = u.pm * 256 + ai * 128 + wr * 64 + m * 16 + fr;
                GAS bf16_t* rowp = (GAS bf16_t*)OB + (size_t)(rowbase + u.pn * nseq + np) * DM + col0;
#pragma unroll
                for (int bj = 0; bj < 2; ++bj) {
                    const f32x4 v0 = acc[ai][bj][m][0], v1 = acc[ai][bj][m][1];
                    u32x4 w; w.x = pk2(v0[0], v0[1]); w.y = pk2(v0[2], v0[3]); w.z = pk2(v1[0], v1[1]); w.w = pk2(v1[2], v1[3]);
                    *(GAS u32x4*)(rowp + bj * 128) = w;
                }
            }
    }
};


struct FfnOrder {
    pg8::StaticOrder S;
    __device__ void init(int G, int c) { S.init(104 * 256, UPC, G, c); }
    __device__ bool next(int i, pg8::Unit& u) const { return S.next(i, u); }
    DEV int arow(const pg8::Unit& u) const { if (u.pm < 32) return u.pm * 256; const int t = u.pm - 32, b = t / 9, j = t - 9 * b; return NCTX + 2048 * b + (j < 8 ? 254 * j : 1792); }
    DEV void a_ready(const pg8::Unit&) const {}
    DEV void done(const pg8::Unit&) const {}
};
DEV float dpp_ror1(float x) { const int xi = __builtin_bit_cast(int, x); return __builtin_bit_cast(float, __builtin_amdgcn_update_dpp(xi, xi, 0x121, 0xF, 0xF, false)); }
DEV float dpp_rol1(float x) { const int xi = __builtin_bit_cast(int, x); return __builtin_bit_cast(float, __builtin_amdgcn_update_dpp(xi, xi, 0x12F, 0xF, 0xF, false)); }
constexpr int LDS_HALO = LDS_MISC + 1024;
constexpr int LDS_WCV = LDS_HALO + 8192;
struct EpiFfn {
    static constexpr bool PERM = true, AFTER_DRAIN = false;
    bf16_t* ACT; const float* ssq; const float* bias; const float* wconv; LAS unsigned char* lds;
    DEV void operator()(const f32x4 (&acc)[2][2][4][2], const pg8::Unit& un, int wr, int wc, int fr_, int fq_) const {
        int tl_ = threadIdx.x; asm volatile("" : "+v"(tl_));
        const int fr = tl_ & 15, fq = (tl_ >> 4) & 3; (void)fr_; (void)fq_;
        int arow, lo, hi;
        if (un.pm < 32) { arow = un.pm * 256; lo = 0; hi = 255; }
        else { const int t = un.pm - 32, b = t / 9, j = t - 9 * b; arow = NCTX + 2048 * b + (j < 8 ? 254 * j : 1792);
               lo = (j == 0) ? 0 : (j < 8 ? 1 : 241); hi = (j < 8) ? 254 : 255; }
        const int b9 = row_b9(arow);
        const int cw = wc * 32 + 8 * fq;
        LAS unsigned char* hb = lds + LDS_HALO + wr * 2048 + cw * 4;
        LAS unsigned char* wb = lds + LDS_WCV + cw * 4;
        { const int tl = (wr * 4 + wc) * 64 + fq * 16 + fr;
          if (tl < 256) { const int tap = tl >> 6, r = tl & 63, bj = r >> 5, c4 = (r & 31) * 4;
              const GAS float* src = (tap < 3) ? ((const GAS float*)wconv + (size_t)tap * UPC) : ((const GAS float*)bias + (size_t)b9 * UPC);
              *(LAS f32x4*)(lds + LDS_WCV + tap * 1024 + bj * 512 + c4 * 4) = *(const GAS f32x4*)(src + (bj ? DFF : 0) + un.pn * 128 + c4); } }
        f32x4 u[2][2][4][2];
#pragma unroll
        for (int ai = 0; ai < 2; ++ai)
#pragma unroll
            for (int m = 0; m < 4; ++m) {
                const int R = ai * 128 + wr * 64 + m * 16 + fr;
                const float rs = __builtin_amdgcn_rsqf(((const GAS float*)ssq)[arow + R] * (1.0f / 1024.0f) + EPS);
#pragma unroll
                for (int bj = 0; bj < 2; ++bj)
#pragma unroll
                    for (int n = 0; n < 2; ++n) u[ai][bj][m][n] = acc[ai][bj][m][n] * rs;
            }
        if (fr == 0) {
#pragma unroll
            for (int ai = 0; ai < 2; ++ai)
#pragma unroll
                for (int bj = 0; bj < 2; ++bj)
#pragma unroll
                    for (int n = 0; n < 2; ++n) *(LAS f32x4*)(hb + ai * 4096 + bj * 512 + n * 16) = u[ai][bj][0][n];
        }
        if (fr == 15) {
#pragma unroll
            for (int ai = 0; ai < 2; ++ai)
#pragma unroll
                for (int bj = 0; bj < 2; ++bj)
#pragma unroll
                    for (int n = 0; n < 2; ++n) *(LAS f32x4*)(hb + ai * 4096 + 1024 + bj * 512 + n * 16) = u[ai][bj][3][n];
        }
        asm volatile("s_waitcnt lgkmcnt(0)\n\ts_barrier" ::: "memory");
        __builtin_amdgcn_sched_barrier(0);
        const bool f15 = (fr == 15), f0 = (fr == 0);
#pragma unroll
        for (int ai = 0; ai < 2; ++ai)
#pragma unroll
            for (int n = 0; n < 2; ++n) {
                const int q = 2 * ai + wr;
                f32x4 cg[4], cv[4];
#pragma unroll
                for (int bj = 0; bj < 2; ++bj) {
                    const f32x4 w0 = *(const LAS f32x4*)(wb + bj * 512 + n * 16), w1 = *(const LAS f32x4*)(wb + 1024 + bj * 512 + n * 16), w2 = *(const LAS f32x4*)(wb + 2048 + bj * 512 + n * 16);
                    const f32x4 bb = *(const LAS f32x4*)(wb + 3072 + bj * 512 + n * 16);
                    f32x4 hup = *(const LAS f32x4*)(hb + ai * 4096 + (q > 0 ? -1024 : 0) + bj * 512 + n * 16);
                    f32x4 hdn = *(const LAS f32x4*)(hb + ai * 4096 + (q < 3 ? 2048 : 0) + bj * 512 + n * 16);
                    hup = (q > 0) ? (hup + bb) : (f32x4){0.f, 0.f, 0.f, 0.f};
                    hdn = (q < 3) ? (hdn + bb) : (f32x4){0.f, 0.f, 0.f, 0.f};
                    f32x4 ub[4];
#pragma unroll
                    for (int m = 0; m < 4; ++m) ub[m] = u[ai][bj][m][n] + bb;
#pragma unroll
                    for (int m = 0; m < 4; ++m)
#pragma unroll
                        for (int e = 0; e < 4; ++e) {
                            const float cur = ub[m][e];
                            const float pu = (m == 0) ? hup[e] : ub[m == 0 ? 0 : m - 1][e];
                            const float pd = (m == 3) ? hdn[e] : ub[m == 3 ? 3 : m + 1][e];
                            const float up = dpp_ror1(f15 ? pu : cur), dn = dpp_rol1(f0 ? pd : cur);
                            const float r = w0[e] * up + w1[e] * cur + w2[e] * dn;
                            if (bj == 0) cg[m][e] = r; else cv[m][e] = r;
                        }
                }
                int tl2 = tl_; asm volatile("" : "+v"(tl2));
                GAS bf16_t* ap = (GAS bf16_t*)ACT + (size_t)(arow + wr * 64 + (tl2 & 15)) * DFF + un.pn * 128 + wc * 32 + 8 * ((tl2 >> 4) & 3);
#pragma unroll
                for (int m = 0; m < 4; ++m) {
                    const int R = ai * 128 + wr * 64 + m * 16 + fr;
                    float o[4];
#pragma unroll
                    for (int e = 0; e < 4; ++e) { const float g = cg[m][e]; o[e] = g * __builtin_amdgcn_rcpf(1.0f + __expf(-g)) * cv[m][e]; }
                    u32x2 w; w.x = pk2(o[0], o[1]); w.y = pk2(o[2], o[3]);
                    if (R >= lo && R <= hi) *(GAS u32x2*)(ap + (size_t)(ai * 128 + m * 16) * DFF + 4 * n) = w;
                }
                __builtin_amdgcn_sched_barrier(0);
            }
    }
};

DEV void transpose_item(const float* W, int K, int N, bf16_t* WT, int row_off, LAS float* scr, int item, int lane, bool perm_up = false) {
    const int nblk = N / 32, kb = item / nblk, nb = item % nblk, k0 = 64 * kb, n0 = 32 * nb;
    const int d0 = perm_up ? (((n0 % DFF) >> 7) * 256 + ((n0 >= DFF) ? 128 : 0) + ((n0 % DFF) & 127)) : (row_off + n0);
#pragma unroll 8
    for (int i = 0; i < 32; ++i) { const int kk = 2 * i + (lane >> 5); scr[kk * 33 + (lane & 31)] = W[(size_t)(k0 + kk) * N + n0 + (lane & 31)]; }
    asm volatile("s_waitcnt lgkmcnt(0)" ::: "memory");
    const int c = lane & 7;
#pragma unroll
    for (int j = 0; j < 4; ++j) { const int n = (lane >> 3) + 8 * j; const LAS float* s = scr + (8 * c) * 33 + n;
        u32x4 o; o.x = pk2(s[0 * 33], s[1 * 33]); o.y = pk2(s[2 * 33], s[3 * 33]); o.z = pk2(s[4 * 33], s[5 * 33]); o.w = pk2(s[6 * 33], s[7 * 33]);
        *(u32x4*)(WT + (size_t)(d0 + n) * K + k0 + 8 * c) = o; }
    asm volatile("s_waitcnt lgkmcnt(0)" ::: "memory");
}
DEV void convert_weights(const Args& a, LAS unsigned char* lds, int l, int mask, int gw, int NGW, int wave, int lane) {
    LAS float* scr = (LAS float*)(lds + wave * 16384);
    unsigned char* ws = a.ws;
    const int n_in = (mask & 1) ? 16 * 67 : 0, n_uk = (mask & 2) ? 2 * 12 : 0, n_out = (mask & 4) ? 16 * 32 : 0, n_up = (mask & 8) ? 16 * 176 : 0, n_dn = (mask & 16) ? 44 * 32 : 0;
    const int total = n_in + 2 * n_uk + n_out + n_up + n_dn;
    for (int it = gw; it < total; it += NGW) {
        int r = it;
        if (r < n_in) { transpose_item(a.in[I_WIN] + (size_t)l * DM * INC, DM, INC, (bf16_t*)(ws + WS_WIN), 0, scr, r, lane); continue; } r -= n_in;
        if (r < n_uk) { transpose_item(a.in[I_WUK] + (size_t)l * 128 * 384, 128, 384, (bf16_t*)(ws + WS_WUKV), 0, scr, r, lane); continue; } r -= n_uk;
        if (r < n_uk) { transpose_item(a.in[I_WUV] + (size_t)l * 128 * 384, 128, 384, (bf16_t*)(ws + WS_WUKV), 384, scr, r, lane); continue; } r -= n_uk;
        if (r < n_out) { transpose_item(a.in[I_WOUT] + (size_t)l * DM * DM, DM, DM, (bf16_t*)(ws + WS_WOUT), 0, scr, r, lane); continue; } r -= n_out;
        if (r < n_up) { transpose_item(a.in[I_WUP] + (size_t)l * DM * UPC, DM, UPC, (bf16_t*)(ws + WS_WUP), 0, scr, r, lane, true); continue; } r -= n_up;
        transpose_item(a.in[I_WDOWN] + (size_t)l * DFF * DM, DFF, DM, (bf16_t*)(ws + WS_WDN), 0, scr, r, lane);
    }
}
DEV void gemv9_item(LAS float* vec, LAS float* red, const float* W, int N, int ldw, const float* bias, float* out, int ldo, int n0, int tid) {
    const int w = tid >> 6, lane = tid & 63; const int n = n0 + lane; const bool valid = n < N;
    float acc0 = 0.f, acc1 = 0.f, acc2 = 0.f, acc3 = 0.f, acc4 = 0.f, acc5 = 0.f, acc6 = 0.f, acc7 = 0.f, acc8 = 0.f;
    const float* wp = W + (size_t)(128 * w) * ldw + (valid ? n : 0);
    const LAS float* vp = vec + 128 * w;
#pragma unroll 16
    for (int k = 0; k < 128; ++k) {
        const float wv = valid ? wp[(size_t)k * ldw] : 0.f;
        acc0 += vp[k] * wv; acc1 += vp[1024 + k] * wv; acc2 += vp[2048 + k] * wv; acc3 += vp[3072 + k] * wv; acc4 += vp[4096 + k] * wv;
        acc5 += vp[5120 + k] * wv; acc6 += vp[6144 + k] * wv; acc7 += vp[7168 + k] * wv; acc8 += vp[8192 + k] * wv;
    }
    LAS float* rp = red + (w * 9) * 64 + lane;
    rp[0] = acc0; rp[64] = acc1; rp[128] = acc2; rp[192] = acc3; rp[256] = acc4; rp[320] = acc5; rp[384] = acc6; rp[448] = acc7; rp[512] = acc8;
    __syncthreads();
    for (int idx = tid; idx < 576; idx += 512) {
        const int v = idx >> 6, ln = idx & 63; float s = 0.f;
#pragma unroll
        for (int ww = 0; ww < 8; ++ww) s += red[(ww * 9 + v) * 64 + ln];
        const int nn = n0 + ln;
        out[(size_t)v * ldo + nn] = s + ((bias && nn < N) ? bias[nn] : 0.f);
    }
    __syncthreads();
}
#define XB_TMO      128
#define XB_XCNT(j)  (256  + 64 * (j))
#define XB_XSUB(j)  (1280 + 64 * (j))
#define XB_XGEN(j)  (2304 + 64 * (j))
#define XB_TOP      3328
#define XB_TOPGEN   3392
#define XCD_BAR_WORDS 3456
#define XB_SPIN_CAP (1u << 18)

__device__ __forceinline__ unsigned xb_ld(unsigned* p)              { return __hip_atomic_load(p, __ATOMIC_RELAXED, __HIP_MEMORY_SCOPE_AGENT); }
__device__ __forceinline__ unsigned xb_add(unsigned* p, unsigned v) { return __hip_atomic_fetch_add(p, v, __ATOMIC_RELAXED, __HIP_MEMORY_SCOPE_AGENT); }
__device__ __forceinline__ unsigned xb_xcc_id() { return (unsigned)__builtin_amdgcn_s_getreg((3 << 11) | 20) & 0xFu; }
#define XB_SPIN(cond, bar) do { unsigned _sp = 0; while (cond) { __builtin_amdgcn_s_sleep(1); \
    if ((++_sp & 255u) == 0u) { if (xb_ld(&(bar)[XB_TMO])) break; if (_sp > XB_SPIN_CAP) { atomicAdd(&(bar)[XB_TMO], 1u); break; } } } } while (0)

struct XcdBarrier {
    unsigned* bar; unsigned x;
    volatile LAS unsigned* st;
};

__device__ __forceinline__ XcdBarrier xcd_barrier_post(unsigned* bar, volatile LAS unsigned* st) {
    XcdBarrier b; b.bar = bar; b.x = xb_xcc_id(); b.st = st;
    if (threadIdx.x == 0) (void)xb_add(&bar[XB_XCNT(b.x)], 1u);
    return b;
}
__device__ __forceinline__ void xcd_barrier_complete(unsigned* bar, unsigned x, unsigned& nloc, unsigned& nx) {
    const unsigned G = gridDim.x * gridDim.y * gridDim.z;
    unsigned sum, cnt, mine, sp = 0u;
    for (;;) {
        sum = 0u; cnt = 0u; mine = 0u;
#pragma unroll
        for (unsigned j = 0; j < 16; ++j) { const unsigned c = xb_ld(&bar[XB_XCNT(j)]); sum += c; cnt += (c > 0u) ? 1u : 0u; mine = (j == x) ? c : mine; }
        if (sum == G) break;
        __builtin_amdgcn_s_sleep(1);
        if ((++sp & 255u) == 0u) { if (xb_ld(&bar[XB_TMO])) break; if (sp > XB_SPIN_CAP) { atomicAdd(&bar[XB_TMO], 1u); break; } }
    }
    nloc = mine > 0u ? mine : 1u; nx = cnt > 0u ? cnt : 1u;
}

__device__ __forceinline__ void xcd_barrier(const XcdBarrier& b) {
    asm volatile("s_waitcnt vmcnt(0)" ::: "memory");
    __syncthreads();
    if (threadIdx.x == 0) {
        unsigned* bar = b.bar;
        __builtin_amdgcn_s_waitcnt(0);
        unsigned nloc = b.st[0], nx = b.st[1];
        if (nloc == 0u) { xcd_barrier_complete(bar, b.x, nloc, nx); b.st[0] = nloc; b.st[1] = nx; }
        const unsigned old = xb_add(&bar[XB_XSUB(b.x)], 1u);
        const unsigned gen = old / nloc;
        if (old + 1u == (gen + 1u) * nloc) {
            __builtin_amdgcn_fence(__ATOMIC_RELEASE, "agent");
            asm volatile("s_waitcnt vmcnt(0)" ::: "memory");
            const unsigned og = xb_add(&bar[XB_TOP], 1u);
            const unsigned tg = og / nx;
            if (og + 1u == (tg + 1u) * nx) xb_add(&bar[XB_TOPGEN], 1u);
            else XB_SPIN(xb_ld(&bar[XB_TOPGEN]) == tg, bar);
            __builtin_amdgcn_fence(__ATOMIC_ACQUIRE, "agent");
            xb_add(&bar[XB_XGEN(b.x)], 1u);
            asm volatile("s_waitcnt vmcnt(0)" ::: "memory");
        } else {
            XB_SPIN(xb_ld(&bar[XB_XGEN(b.x)]) == gen, bar);
            __builtin_amdgcn_fence(__ATOMIC_ACQUIRE, "agent");
            asm volatile("s_waitcnt vmcnt(0)" ::: "memory");
        }
    }
    __syncthreads();
}

constexpr int B_AROW = 272, B_VROW = 772, B_UROW = 528;
constexpr int B_LDS_A = 0, B_LDS_V = 64 * B_AROW, B_LDS_U = B_LDS_V + 64 * B_VROW, B_LDS_TAB = B_LDS_U + 64 * B_UROW;
static_assert(B_LDS_TAB + 4096 <= RING_BYTES, "phase B LDS");

DEV float rope1(float x, int dd, int t, const LAS f32x2* tab) {
    const float xp = __shfl_xor(x, 8);
    const int pos = (dd < 16) ? (t >> 6) : (t & 63);
    const f32x2 cs = tab[pos * 8 + (dd & 7)];
    return (dd & 8) ? (x * cs.x + xp * cs.y) : (x * cs.x - xp * cs.y);
}

DEV void phase_b(const Args& a, LAS unsigned char* lds, int l, int tid, int mode, int blk_start, int blk_stride, unsigned* qctr = nullptr) {
    unsigned char* ws = a.ws;
    const int wave = __builtin_amdgcn_readfirstlane(tid >> 6), lane = tid & 63, fr = lane & 15, fq = lane >> 4;
    const GAS bf16_t* P = (const GAS bf16_t*)(ws + WS_P);
    const GAS bf16_t* WUKV = (const GAS bf16_t*)(ws + WS_WUKV);
    const GAS bf16_t* CS64 = (const GAS bf16_t*)(ws + WS_CS64);
    GAS float* outg = (GAS float*)a.out;
    LAS f32x2* tab = (LAS f32x2*)(lds + B_LDS_TAB);
    {
        const int pos = tid >> 3, f = tid & 7;
        const float inv = __builtin_amdgcn_exp2f(-(float)f * (13.287712379549449f / 8.0f));
        const float ang = (float)pos * inv;
        tab[tid] = (f32x2){cosf(ang), sinf(ang)};
    }
    __syncthreads();
    const GAS float* gkv = (const GAS float*)a.in[I_GKV] + l * 128;
    LAS int* bslot = (LAS int*)(lds + LDS_MISC + 4);
    for (int blk = blk_start;; blk += blk_stride) {
        if (qctr) { if (tid == 0) *bslot = (int)atomicAdd(qctr, 1u); __syncthreads(); blk = *bslot; }
        if (blk >= (mode == 0 ? 384 : 448)) break;
        int kind, r0 = 0, bidx, t0;
        if (blk < 128) { kind = 0; r0 = blk * 64; bidx = r0 >> 8; t0 = r0 & 255; }
        else if (blk < 384) { kind = 1; r0 = NCTX + (blk - 128) * 64; bidx = (r0 - NCTX) >> 11; t0 = (r0 - NCTX) & 2047; }
        else { kind = 2; const int cb = blk - 384; bidx = cb >> 3; t0 = 2048 + 64 * (cb & 7); }
        GAS bf16_t* KM; GAS bf16_t* KD; GAS bf16_t* VMt; GAS bf16_t* VDt; int vt_ld;
        if (kind == 0) { KM = (GAS bf16_t*)(ws + WS_KMC) + (size_t)(bidx * 256 + t0) * 576; KD = (GAS bf16_t*)(ws + WS_KDC) + (size_t)(bidx * 256 + t0) * 384;
                         VMt = (GAS bf16_t*)(ws + WS_VMC) + (size_t)bidx * 6 * 64 * 256 + t0; VDt = (GAS bf16_t*)(ws + WS_VDC) + (size_t)bidx * 6 * 64 * 256 + t0; vt_ld = 256; }
        else { KM = (GAS bf16_t*)(ws + WS_KML) + (size_t)(bidx * 2560 + t0) * 576; KD = (GAS bf16_t*)(ws + WS_KDL) + (size_t)(bidx * 2560 + t0) * 384;
               VMt = (GAS bf16_t*)(ws + WS_VML) + (size_t)bidx * 6 * 64 * 2560 + t0; VDt = (GAS bf16_t*)(ws + WS_VDL) + (size_t)bidx * 6 * 64 * 2560 + t0; vt_ld = 2560; }
        if (mode == 0) {
            for (int c = tid; c < 64 * 32; c += 512) { const int rr = c >> 5, e = c & 31;
                *(LAS u32x4*)(lds + B_LDS_U + rr * B_UROW + e * 16) = *(const GAS u32x4*)(P + (size_t)(r0 + rr) * INP + 1888 + 8 * e); }
            __syncthreads();
        } else {
        if (kind == 2) {
            for (int i = 0; i < 8; ++i) {
                const int rr = wave * 8 + i;
                const int j = (t0 - 2048) + rr;
                const size_t crow = ((size_t)(bidx * 4 + l)) * 512 + j;
                const f32x2 cv = *(const f32x2*)(a.in[I_CCKV] + crow * 128 + 2 * lane);
                *(LAS unsigned*)(lds + B_LDS_A + rr * B_AROW + lane * 4) = pk2(cv.x, cv.y);
                const float kr = a.in[I_CKROPE][crow * 32 + (lane & 31)];
                const bf16_t krb = f2bf(kr);
                { const int hb = (lane >> 5) * 3;
#pragma unroll
                  for (int h = 0; h < 3; ++h) KM[(size_t)rr * 576 + (hb + h) * 96 + 64 + (lane & 31)] = krb; }
#pragma unroll
                for (int q = 0; q < 6; ++q) {
                    KD[(size_t)rr * 384 + 64 * q + lane] = f2bf(a.in[I_CDK][crow * 384 + 64 * q + lane]);
                    *(LAS bf16_t*)(lds + B_LDS_V + rr * B_VROW + (64 * q + lane) * 2) = f2bf(a.in[I_CDV][crow * 384 + 64 * q + lane]);
                }
            }
        } else {
            const size_t obase = ((size_t)(bidx * 4 + l)) * 256 + t0;
#pragma unroll
            for (int it = 0; it < 2; ++it) {
                const int rr = (tid >> 4) + 32 * it, cj = tid & 15;
                const u32x4 w = *(const GAS u32x4*)(P + (size_t)(r0 + rr) * INP + 576 + 8 * cj);
                float x[8]; x[0] = bf2f(w.x & 0xffffu); x[1] = bf2f(w.x >> 16); x[2] = bf2f(w.y & 0xffffu); x[3] = bf2f(w.y >> 16);
                x[4] = bf2f(w.z & 0xffffu); x[5] = bf2f(w.z >> 16); x[6] = bf2f(w.w & 0xffffu); x[7] = bf2f(w.w >> 16);
                float ss = 0.f;
#pragma unroll
                for (int j = 0; j < 8; ++j) ss += x[j] * x[j];
                ss += __shfl_xor(ss, 1); ss += __shfl_xor(ss, 2); ss += __shfl_xor(ss, 4); ss += __shfl_xor(ss, 8);
                const float rs = rsqrtf(ss * (1.0f / 128.0f) + EPS);
                const f32x4 ga = *(const GAS f32x4*)(gkv + 8 * cj), gb = *(const GAS f32x4*)(gkv + 8 * cj + 4);
                x[0] *= rs * ga[0]; x[1] *= rs * ga[1]; x[2] *= rs * ga[2]; x[3] *= rs * ga[3]; x[4] *= rs * gb[0]; x[5] *= rs * gb[1]; x[6] *= rs * gb[2]; x[7] *= rs * gb[3];
                u32x4 o; o.x = pk2(x[0], x[1]); o.y = pk2(x[2], x[3]); o.z = pk2(x[4], x[5]); o.w = pk2(x[6], x[7]);
                *(LAS u32x4*)(lds + B_LDS_A + rr * B_AROW + cj * 16) = o;
                if (kind == 0) { GAS float* op = outg + OUT_CKV + (obase + rr) * 128 + 8 * cj; *(GAS f32x4*)op = (f32x4){x[0], x[1], x[2], x[3]}; *(GAS f32x4*)(op + 4) = (f32x4){x[4], x[5], x[6], x[7]}; }
            }
#pragma unroll 1
            for (int cb = 0; cb < 35; cb += 7) {
              u32x4 wv[7];
#pragma unroll
              for (int i = 0; i < 7; ++i) {
                const int c = tid + 512 * (cb + i); const int rr = c / 268, ch = c - rr * 268;
                const bool need = (c < 64 * 268) && (ch < 236) && !(ch >= 72 && ch < 88) && !(kind == 0 && (ch < 72 || (ch >= 92 && ch < 140)));
                wv[i] = (u32x4){0u, 0u, 0u, 0u};
                if (need) wv[i] = *(const GAS u32x4*)(P + (size_t)(r0 + rr) * INP + 8 * ch);
              }
#pragma unroll
              for (int i = 0; i < 7; ++i) {
                const int c = tid + 512 * (cb + i); const int rr = c / 268, ch = c - rr * 268;
                const bool need = (c < 64 * 268) && (ch < 236) && !(ch >= 72 && ch < 88) && !(kind == 0 && (ch < 72 || (ch >= 92 && ch < 140)));
                if (!need) continue;
                const int r = r0 + rr, t = t0 + rr;
                u32x4 w = wv[i];
                const bool ropeable = (ch < 72) ? ((ch % 12) >= 8) : (ch < 188);
                if (kind == 1 && ropeable) {
                    const int j = ch & 3;
                    const int pos = (j < 2) ? (t >> 6) : (t & 63);
                    float x[8]; x[0] = bf2f(w.x & 0xffffu); x[1] = bf2f(w.x >> 16); x[2] = bf2f(w.y & 0xffffu); x[3] = bf2f(w.y >> 16);
                    x[4] = bf2f(w.z & 0xffffu); x[5] = bf2f(w.z >> 16); x[6] = bf2f(w.w & 0xffffu); x[7] = bf2f(w.w >> 16);
                    const float sgn = (j & 1) ? 1.0f : -1.0f;
#pragma unroll
                    for (int i = 0; i < 8; ++i) {
                        const float xp = __builtin_bit_cast(float, __builtin_amdgcn_update_dpp(0, __builtin_bit_cast(int, x[i]), 0xB1, 0xF, 0xF, true));
                        const f32x2 cs = tab[pos * 8 + i];
                        x[i] = x[i] * cs.x + sgn * (xp * cs.y);
                    }
                    w.x = pk2(x[0], x[1]); w.y = pk2(x[2], x[3]); w.z = pk2(x[4], x[5]); w.w = pk2(x[6], x[7]);
                }
                if (ch < 72) { *(GAS u32x4*)((GAS bf16_t*)(ws + WS_QMR) + (size_t)(r - NCTX) * 576 + 8 * ch) = w; }
                else if (ch < 92) { const int j = ch - 88;
#pragma unroll
                    for (int h = 0; h < 6; ++h) *(GAS u32x4*)(KM + (size_t)rr * 576 + h * 96 + 64 + 8 * j) = w;
                    if (kind == 0) { GAS float* op = outg + OUT_KROPE + (obase + rr) * 32 + 8 * j;
                        *(GAS f32x4*)op = (f32x4){bf2f(w.x & 0xffffu), bf2f(w.x >> 16), bf2f(w.y & 0xffffu), bf2f(w.y >> 16)}; *(GAS f32x4*)(op + 4) = (f32x4){bf2f(w.z & 0xffffu), bf2f(w.z >> 16), bf2f(w.w & 0xffffu), bf2f(w.w >> 16)}; } }
                else if (ch < 140) { *(GAS u32x4*)((GAS bf16_t*)(ws + WS_QDR) + (size_t)(r - NCTX) * 384 + 8 * (ch - 92)) = w; }
                else if (ch < 188) { const int e = ch - 140; *(GAS u32x4*)(KD + (size_t)rr * 384 + 8 * e) = w;
                    if (kind == 0) { GAS float* op = outg + OUT_DK + (obase + rr) * 384 + 8 * e;
                        *(GAS f32x4*)op = (f32x4){bf2f(w.x & 0xffffu), bf2f(w.x >> 16), bf2f(w.y & 0xffffu), bf2f(w.y >> 16)}; *(GAS f32x4*)(op + 4) = (f32x4){bf2f(w.z & 0xffffu), bf2f(w.z >> 16), bf2f(w.w & 0xffffu), bf2f(w.w >> 16)}; } }
                else if (ch < 236) { const int e = ch - 188; LAS unsigned* vp = (LAS unsigned*)(lds + B_LDS_V + rr * B_VROW + e * 16); vp[0] = w.x; vp[1] = w.y; vp[2] = w.z; vp[3] = w.w;
                    if (kind == 0) { GAS float* op = outg + OUT_DV + (obase + rr) * 384 + 8 * e;
                        *(GAS f32x4*)op = (f32x4){bf2f(w.x & 0xffffu), bf2f(w.x >> 16), bf2f(w.y & 0xffffu), bf2f(w.y >> 16)}; *(GAS f32x4*)(op + 4) = (f32x4){bf2f(w.z & 0xffffu), bf2f(w.z >> 16), bf2f(w.w & 0xffffu), bf2f(w.w >> 16)}; } }
                else { *(LAS u32x4*)(lds + B_LDS_U + rr * B_UROW + (ch - 236) * 16) = w; }
              }
            }
        }
        bf16x8 bwa[6][4];
#pragma unroll
        for (int nt = 0; nt < 6; ++nt)
#pragma unroll
            for (int kk = 0; kk < 4; ++kk) bwa[nt][kk] = *(const GAS bf16x8*)(WUKV + (size_t)(96 * wave + 16 * nt + fr) * 128 + 32 * kk + 8 * fq);
        __syncthreads();
#pragma unroll
        for (int nt = 0; nt < 6; ++nt) {
            const int c0 = 96 * wave + 16 * nt;
            bf16x8 bw[4];
#pragma unroll
            for (int kk = 0; kk < 4; ++kk) bw[kk] = bwa[nt][kk];
#pragma unroll
            for (int mt = 0; mt < 4; ++mt) {
                f32x4 acc = {0.f, 0.f, 0.f, 0.f};
#pragma unroll
                for (int kk = 0; kk < 4; ++kk) {
                    const bf16x8 af = *(const LAS bf16x8*)(lds + B_LDS_A + (16 * mt + fr) * B_AROW + (32 * kk + 8 * fq) * 2);
                    acc = (wave < 4) ? mfma16(bw[kk], af, acc) : mfma16(af, bw[kk], acc);
                }
                u32x2 w; w.x = pk2(acc[0], acc[1]); w.y = pk2(acc[2], acc[3]);
                if (wave < 4) { const int h = c0 >> 6, d = (c0 & 63) + 4 * fq; *(GAS u32x2*)(KM + (size_t)(16 * mt + fr) * 576 + h * 96 + d) = w; }
                else { const int col = c0 - 384 + fr, h = col >> 6, dv = col & 63; *(GAS u32x2*)(VMt + (size_t)(h * 64 + dv) * vt_ld + 16 * mt + 4 * fq) = w; }
            }
        }
        }
        if (mode == 0) {
            const int g = wave >> 1, nseq = (kind == 0) ? 256 : 2048, ldk = 2 * nseq;
            GAS bf16_t* FB = (kind == 0) ? (GAS bf16_t*)(ws + WS_FBC) : (GAS bf16_t*)(ws + WS_FBL);
#pragma unroll 1
            for (int nt = 0; nt < 4; ++nt) {
                const int cc0 = 16 * ((wave & 1) * 4 + nt);
                bf16x8 bw[2];
#pragma unroll
                for (int kk = 0; kk < 2; ++kk) bw[kk] = *(const GAS bf16x8*)(CS64 + (size_t)(cc0 + fr) * 64 + 32 * kk + 8 * fq);
                const int cc = cc0 + fr, cp = cc & 63, koff = (cc >= 64) ? nseq : 0;
                GAS bf16_t* dst = FB + (size_t)(bidx * 256 + g * 64 + cp) * ldk + koff + (t0 & (nseq - 1));
#pragma unroll
                for (int mt = 0; mt < 4; ++mt) {
                    f32x4 acc = {0.f, 0.f, 0.f, 0.f};
#pragma unroll
                    for (int kk = 0; kk < 2; ++kk) {
                        const bf16x8 af = *(const LAS bf16x8*)(lds + B_LDS_U + (16 * mt + fr) * B_UROW + (64 * g + 32 * kk + 8 * fq) * 2);
                        acc = mfma16(af, bw[kk], acc);
                    }
                    u32x2 w; w.x = pk2(acc[0], acc[1]); w.y = pk2(acc[2], acc[3]);
                    *(GAS u32x2*)(dst + 16 * mt + 4 * fq) = w;
                }
            }
        }
        if (mode == 1)
#pragma unroll 4
        for (int q = 0; q < 48; ++q) {
            const int cr = 48 * wave + q;
            const bf16_t v = *(const LAS bf16_t*)(lds + B_LDS_V + lane * B_VROW + cr * 2);
            VDt[(size_t)cr * vt_ld + lane] = v;
        }
        __syncthreads();
    }
}

constexpr int AT_VROW = 136;
template <bool DIFF> struct AttnCfg {
    static constexpr int ND = DIFF ? 4 : 6;
    static constexpr int NM = DIFF ? 2 : 1;
    static constexpr int NDM = DIFF ? 2 : 6;
    static constexpr int KROW = DIFF ? 144 : 208;
    static constexpr int KT = 64 * KROW;
    static constexpr int CPR = 2 * ND;
    static constexpr int NKC = 64 * CPR;
};
constexpr int AT_LDS_K = 0, AT_LDS_V = 2 * 64 * 208, AT_LDS_SCR = AT_LDS_V + 2 * 64 * AT_VROW;
static_assert(AT_LDS_SCR + 2048 <= RING_BYTES, "attention LDS");

DEV float vmax3(float a, float b, float c) { float r; asm("v_max3_f32 %0, %1, %2, %3" : "=v"(r) : "v"(a), "v"(b), "v"(c)); return r; }
template <bool DIFF>
DEV void attn_unit(LAS unsigned char* lds, const bf16_t* Qa, int qa_ld, const bf16_t* Qb, int qb_ld, const bf16_t* Kp, int k_ld,
                   const bf16_t* Vt, int vt_ld, int nt_main, int nt_total, bf16_t* Oout, float cscale, float lam, const float* gsub, float subscale, int tid) {
    typedef AttnCfg<DIFF> C;
    const int wave = __builtin_amdgcn_readfirstlane(tid >> 6), lane = tid & 63, l31 = lane & 31, hi = lane >> 5;
    LAS float* scr = (LAS float*)(lds + AT_LDS_SCR) + wave * 64;
    const int kkey0 = tid / C::CPR, kpart0 = tid % C::CPR;
    const int kc1 = tid + 512; const bool has1 = kc1 < C::NKC; const int kkey1 = kc1 / C::CPR, kpart1 = kc1 % C::CPR;
    const int vdv = tid >> 3, vpart = tid & 7;
    const GAS bf16_t* kg0 = (const GAS bf16_t*)Kp + (size_t)kkey0 * k_ld + kpart0 * 8;
    const GAS bf16_t* kg1 = (const GAS bf16_t*)Kp + (size_t)kkey1 * k_ld + kpart1 * 8;
    const GAS bf16_t* vg = (const GAS bf16_t*)Vt + (size_t)vdv * vt_ld + vpart * 8;
    const int kl0 = kkey0 * C::KROW + kpart0 * 16, kl1 = kkey1 * C::KROW + kpart1 * 16, vl = vdv * AT_VROW + vpart * 16;
    u32x4 kr0, kr1 = {0, 0, 0, 0}, vr;
    bf16x8 qf[C::ND];
    { const GAS bf16_t* qp = (const GAS bf16_t*)Qa + (size_t)(32 * wave + l31) * qa_ld + 8 * hi;
#pragma unroll
      for (int d = 0; d < C::ND; ++d) qf[d] = *(const GAS bf16x8*)(qp + 16 * d); }
    kr0 = *(const GAS u32x4*)kg0; if (has1) kr1 = *(const GAS u32x4*)kg1; vr = *(const GAS u32x4*)vg;
    *(LAS u32x4*)(lds + AT_LDS_K + kl0) = kr0; if (has1) *(LAS u32x4*)(lds + AT_LDS_K + kl1) = kr1;
    *(LAS u32x2*)(lds + AT_LDS_V + vl) = (u32x2){vr.x, vr.y}; *(LAS u32x2*)(lds + AT_LDS_V + vl + 8) = (u32x2){vr.z, vr.w};
    __syncthreads();
    f32x16 O[C::NM][2];
    float mref[C::NM], lsum[C::NM];
#pragma unroll
    for (int mp = 0; mp < C::NM; ++mp) { mref[mp] = 0.f; lsum[mp] = 0.f;
#pragma unroll
        for (int r = 0; r < 16; ++r) { O[mp][0][r] = 0.f; O[mp][1][r] = 0.f; } }
#pragma unroll 1
    for (int t = 0; t < nt_total; ++t) {
        const int cur = t & 1;
        const bool more = (t + 1) < nt_total;
        if (more) {
            const size_t ko = (size_t)(t + 1) * 64 * k_ld;
            kr0 = *(const GAS u32x4*)(kg0 + ko); if (has1) kr1 = *(const GAS u32x4*)(kg1 + ko);
            vr = *(const GAS u32x4*)(vg + (t + 1) * 64);
        }
        if (t == nt_main) {
            const GAS bf16_t* qp = (const GAS bf16_t*)Qb + (size_t)(32 * wave + l31) * qb_ld + 8 * hi;
#pragma unroll
            for (int d = 0; d < C::ND; ++d) qf[d] = *(const GAS bf16x8*)(qp + 16 * d);
        }
        const LAS unsigned char* Kb = lds + AT_LDS_K + cur * C::KT;
        const LAS unsigned char* Vb = lds + AT_LDS_V + cur * (64 * AT_VROW);
        bf16x8 kf[2][C::NDM];
#pragma unroll
        for (int dd = 0; dd < C::NDM; ++dd) {
            kf[0][dd] = *(const LAS bf16x8*)(Kb + l31 * C::KROW + dd * 32 + hi * 16);
            kf[1][dd] = *(const LAS bf16x8*)(Kb + (32 + l31) * C::KROW + dd * 32 + hi * 16);
        }
        __builtin_amdgcn_sched_barrier(0);
        bf16x8 vf[4][2];
#pragma unroll
        for (int mp = 0; mp < C::NM; ++mp) {
            f32x16 s0, s1;
#pragma unroll
            for (int r = 0; r < 16; ++r) { s0[r] = 0.f; s1[r] = 0.f; }
#pragma unroll
            for (int dd = 0; dd < C::NDM; ++dd) {
                s0 = mfma32(kf[0][dd], qf[mp * C::NDM + dd], s0); s1 = mfma32(kf[1][dd], qf[mp * C::NDM + dd], s1);
            }
            __builtin_amdgcn_sched_barrier(0);
            if (mp == 0) {
#pragma unroll
                for (int j = 0; j < 4; ++j)
#pragma unroll
                    for (int db = 0; db < 2; ++db) {
                        const LAS unsigned char* vp = Vb + (32 * db + l31) * AT_VROW + (32 * (j >> 1) + 16 * (j & 1) + 4 * hi) * 2;
                        const s16x4 lo = *(const LAS s16x4*)vp, hh = *(const LAS s16x4*)(vp + 16);
                        vf[j][db] = (bf16x8){lo[0], lo[1], lo[2], lo[3], hh[0], hh[1], hh[2], hh[3]};
                    }
                if (C::NM > 1) {
#pragma unroll
                    for (int dd = 0; dd < C::NDM; ++dd) {
                        kf[0][dd] = *(const LAS bf16x8*)(Kb + l31 * C::KROW + (C::NDM + dd) * 32 + hi * 16);
                        kf[1][dd] = *(const LAS bf16x8*)(Kb + (32 + l31) * C::KROW + (C::NDM + dd) * 32 + hi * 16);
                    }
                }
                __builtin_amdgcn_sched_barrier(0);
            }
            float ma = vmax3(s0[0], s0[1], s1[0]), mb = vmax3(s0[2], s0[3], s1[1]); ma = vmax3(ma, s1[2], s1[3]);
#pragma unroll
            for (int r = 4; r < 16; r += 4) { ma = vmax3(ma, s0[r], s0[r + 1]); mb = vmax3(mb, s0[r + 2], s0[r + 3]); ma = vmax3(ma, s1[r], s1[r + 1]); mb = vmax3(mb, s1[r + 2], s1[r + 3]); }
            float mx = vmax3(ma, mb, mb);
            mx = vmax3(mx, __shfl_xor(mx, 32), mx);
            const float rm = mx * cscale;
            if (t == 0) mref[mp] = rm;
            else if (__any(rm > mref[mp] + 8.0f)) {
                const float mnew = vmax3(mref[mp], rm, rm);
                const float alpha = __builtin_amdgcn_exp2f(mref[mp] - mnew);
                lsum[mp] *= alpha; mref[mp] = mnew;
                if (hi == 0) scr[l31] = alpha;
                asm volatile("s_waitcnt lgkmcnt(0)" ::: "memory");
#pragma unroll
                for (int g4 = 0; g4 < 4; ++g4) { const f32x4 a4 = *(const LAS f32x4*)(scr + 8 * g4 + 4 * hi);
#pragma unroll
                    for (int j = 0; j < 4; ++j) { O[mp][0][4 * g4 + j] *= a4[j]; O[mp][1][4 * g4 + j] *= a4[j]; } }
                asm volatile("s_waitcnt lgkmcnt(0)" ::: "memory");
            }
            const float nm = -mref[mp];
            float ls = 0.f;
#pragma unroll
            for (int r = 0; r < 16; ++r) { s0[r] = __builtin_amdgcn_exp2f(fmaf(s0[r], cscale, nm)); s1[r] = __builtin_amdgcn_exp2f(fmaf(s1[r], cscale, nm)); ls += s0[r] + s1[r]; }
            lsum[mp] += ls;
            bf16x8 pa[4];
#pragma unroll
            for (int j = 0; j < 4; ++j) {
                u32x4 w;
                if (j < 2) { w.x = pk2(s0[8 * j], s0[8 * j + 1]); w.y = pk2(s0[8 * j + 2], s0[8 * j + 3]); w.z = pk2(s0[8 * j + 4], s0[8 * j + 5]); w.w = pk2(s0[8 * j + 6], s0[8 * j + 7]); }
                else { const int jj = j - 2; w.x = pk2(s1[8 * jj], s1[8 * jj + 1]); w.y = pk2(s1[8 * jj + 2], s1[8 * jj + 3]); w.z = pk2(s1[8 * jj + 4], s1[8 * jj + 5]); w.w = pk2(s1[8 * jj + 6], s1[8 * jj + 7]); }
                pa[j] = __builtin_bit_cast(bf16x8, w);
            }
#pragma unroll
            for (int j = 0; j < 4; ++j)
#pragma unroll
                for (int db = 0; db < 2; ++db) O[mp][db] = mfma32(pa[j], vf[j][db], O[mp][db]);
        }
        if (more) {
            const int nb = cur ^ 1;
            *(LAS u32x4*)(lds + AT_LDS_K + nb * C::KT + kl0) = kr0; if (has1) *(LAS u32x4*)(lds + AT_LDS_K + nb * C::KT + kl1) = kr1;
            *(LAS u32x2*)(lds + AT_LDS_V + nb * (64 * AT_VROW) + vl) = (u32x2){vr.x, vr.y}; *(LAS u32x2*)(lds + AT_LDS_V + nb * (64 * AT_VROW) + vl + 8) = (u32x2){vr.z, vr.w};
        }
        __syncthreads();
    }
    float inv[C::NM][16];
#pragma unroll
    for (int mp = 0; mp < C::NM; ++mp) {
        float lt = lsum[mp]; lt += __shfl_xor(lt, 32);
        if (hi == 0) scr[l31] = 1.0f / lt;
        asm volatile("s_waitcnt lgkmcnt(0)" ::: "memory");
#pragma unroll
        for (int g4 = 0; g4 < 4; ++g4) { const f32x4 a4 = *(const LAS f32x4*)(scr + 8 * g4 + 4 * hi);
#pragma unroll
            for (int j = 0; j < 4; ++j) inv[mp][4 * g4 + j] = a4[j]; }
        asm volatile("s_waitcnt lgkmcnt(0)" ::: "memory");
    }
    GAS bf16_t* ow = (GAS bf16_t*)Oout + (size_t)(32 * wave) * DM;
    if constexpr (!DIFF) {
#pragma unroll
        for (int r = 0; r < 16; ++r) { const int q = (r & 3) + 8 * (r >> 2) + 4 * hi;
#pragma unroll
            for (int db = 0; db < 2; ++db) ow[(size_t)q * DM + 32 * db + l31] = f2bf(O[0][db][r] * inv[0][r]); }
    } else {
        const float gs0 = ((const GAS float*)gsub)[l31] * subscale, gs1 = ((const GAS float*)gsub)[32 + l31] * subscale;
#pragma unroll
        for (int r = 0; r < 16; ++r) { const int q = (r & 3) + 8 * (r >> 2) + 4 * hi;
            const float o0 = O[0][0][r] * inv[0][r] - lam * (O[1][0][r] * inv[1][r]);
            const float o1 = O[0][1][r] * inv[0][r] - lam * (O[1][1][r] * inv[1][r]);
            float ss = o0 * o0 + o1 * o1;
#pragma unroll
            for (int o = 1; o < 32; o <<= 1) ss += __shfl_xor(ss, o);
            const float rs = rsqrtf(ss * (1.0f / 64.0f) + EPS);
            ow[(size_t)q * DM + l31] = f2bf(o0 * rs * gs0); ow[(size_t)q * DM + 32 + l31] = f2bf(o1 * rs * gs1); }
    }
}

DEV void load8(const GAS bf16_t* p, float (&v)[8]) {
    const u32x4 w = *(const GAS u32x4*)p;
    v[0] = bf2f(w.x & 0xffffu); v[1] = bf2f(w.x >> 16); v[2] = bf2f(w.y & 0xffffu); v[3] = bf2f(w.y >> 16);
    v[4] = bf2f(w.z & 0xffffu); v[5] = bf2f(w.z >> 16); v[6] = bf2f(w.w & 0xffffu); v[7] = bf2f(w.w >> 16);
}
DEV void phase_f(const Args& a, int l, int nrows, int seqlen, int tid) {
    const GAS bf16_t* U = (const GAS bf16_t*)(a.ws + WS_U);
    GAS bf16_t* ACT = (GAS bf16_t*)(a.ws + WS_ACT);
    const GAS float* wc = (const GAS float*)a.in[I_WCONV] + (size_t)l * 3 * UPC;
    const int nitems = (nrows / 8) * 352;
    for (int it = blockIdx.x * 512 + tid; it < nitems; it += gridDim.x * 512) {
        const int rb = it / 352, j8 = it - rb * 352, r0 = rb * 8, c0 = j8 * 8;
        float wg[3][8], wv[3][8];
#pragma unroll
        for (int k = 0; k < 3; ++k) {
            const f32x4 g0 = *(const GAS f32x4*)(wc + k * UPC + c0), g1 = *(const GAS f32x4*)(wc + k * UPC + c0 + 4);
            const f32x4 v0 = *(const GAS f32x4*)(wc + k * UPC + DFF + c0), v1 = *(const GAS f32x4*)(wc + k * UPC + DFF + c0 + 4);
#pragma unroll
            for (int j = 0; j < 4; ++j) { wg[k][j] = g0[j]; wg[k][4 + j] = g1[j]; wv[k][j] = v0[j]; wv[k][4 + j] = v1[j]; }
        }
        float pg[8], pv[8], cg_[8], cv[8], ng[8], nv[8];
        const bool hasp = (r0 % seqlen) != 0, hasn = ((r0 + 8) % seqlen) != 0;
        if (hasp) { load8(U + (size_t)(r0 - 1) * UPC + c0, pg); load8(U + (size_t)(r0 - 1) * UPC + DFF + c0, pv); }
        else {
#pragma unroll
            for (int j = 0; j < 8; ++j) { pg[j] = 0.f; pv[j] = 0.f; } }
        load8(U + (size_t)r0 * UPC + c0, cg_); load8(U + (size_t)r0 * UPC + DFF + c0, cv);
#pragma unroll
        for (int i = 0; i < 8; ++i) {
            const int r = r0 + i;
            if (i < 7 || hasn) { load8(U + (size_t)(r + 1) * UPC + c0, ng); load8(U + (size_t)(r + 1) * UPC + DFF + c0, nv); }
            else {
#pragma unroll
                for (int j = 0; j < 8; ++j) { ng[j] = 0.f; nv[j] = 0.f; } }
            float o[8];
#pragma unroll
            for (int j = 0; j < 8; ++j) {
                const float gt = wg[0][j] * pg[j] + wg[1][j] * cg_[j] + wg[2][j] * ng[j];
                const float vl = wv[0][j] * pv[j] + wv[1][j] * cv[j] + wv[2][j] * nv[j];
                const float sg = gt * __builtin_amdgcn_rcpf(1.0f + __expf(-gt));
                o[j] = sg * vl;
            }
            u32x4 w; w.x = pk2(o[0], o[1]); w.y = pk2(o[2], o[3]); w.z = pk2(o[4], o[5]); w.w = pk2(o[6], o[7]);
            *(GAS u32x4*)(ACT + (size_t)r * DFF + c0) = w;
#pragma unroll
            for (int j = 0; j < 8; ++j) { pg[j] = cg_[j]; pv[j] = cv[j]; cg_[j] = ng[j]; cv[j] = nv[j]; }
        }
    }
}

struct ShiftOrder {
    pg8::StaticOrder S;
    __device__ void init(int M, int N, int G, int c) { S.init(M, N, G, c); }
    __device__ bool next(int i, pg8::Unit& u) const { return S.next(i, u); }
    DEV void a_ready(const pg8::Unit&) const {}
    DEV void done(const pg8::Unit&) const {}
};

#ifndef NREP_SYNC
#define NREP_SYNC 1
#endif
#ifndef NREP_P
#define NREP_P 1
#endif
#ifndef NREP_A
#define NREP_A 1
#endif
#ifndef NREP_B1
#define NREP_B1 1
#endif
#ifndef NREP_B
#define NREP_B 1
#endif
#ifndef NREP_C
#define NREP_C 1
#endif
#ifndef NREP_E
#define NREP_E 1
#endif
#ifndef NREP_F
#define NREP_F 1
#endif
__global__ void __launch_bounds__(512, 2) mega_fwd(Args a) {
    extern __shared__ __attribute__((aligned(16))) unsigned char lds_raw[];
    LAS unsigned char* lds = (LAS unsigned char*)lds_raw;
    cg::grid_group grid = cg::this_grid();
    const int G = gridDim.x, bid = blockIdx.x;
#define PH_LOCALS \
    unsigned char* ws = a.ws; asm volatile("" : "+s"(ws)); \
    int tid = threadIdx.x; asm volatile("" : "+v"(tid)); \
    const int lane = tid & 63, wave = __builtin_amdgcn_readfirstlane(tid >> 6); \
    const int gw = bid * 8 + wave, NGW = G * 8, gt = bid * 512 + tid, NGT = G * 512; \
    float* MOD = (float*)(ws + WS_MOD); float* BIN = (float*)(ws + WS_BIN); float* BUP = (float*)(ws + WS_BUP); float* SSQ = (float*)(ws + WS_SSQ); \
    bf16_t* XS = (bf16_t*)(ws + WS_XS); bf16_t* Pb = (bf16_t*)(ws + WS_P); bf16_t* OB = (bf16_t*)(ws + WS_OB); \
    unsigned* CTL = (unsigned*)(ws + WS_CTL); \
    (void)lane; (void)wave; (void)gw; (void)NGW; (void)gt; (void)NGT; (void)MOD; (void)BIN; (void)BUP; (void)SSQ; (void)XS; (void)Pb; (void)OB; (void)CTL;
    const bool one = (a.ph_hi - a.ph_lo) > 1;
    for (int i = threadIdx.x; i < 4096; i += 512) ((LAS unsigned*)(lds + LDS_MISC))[i] = 0u;
    __syncthreads();
    XcdBarrier xbar; xbar.bar = (unsigned*)(a.ws + WS_CTL) + 16384; xbar.x = 0; xbar.st = nullptr;
    if (one) xbar = xcd_barrier_post((unsigned*)(a.ws + WS_CTL) + 16384, (volatile LAS unsigned*)(lds + LDS_MISC + 32));
    int ph = 0;
#define PH_BEGIN if (ph >= a.ph_lo && ph < a.ph_hi) { PH_LOCALS
#define PH_END   if (one && ph + 1 < a.ph_hi) { if (ph == 0) grid.sync(); else { for (int rs_ = 0; rs_ < NREP_SYNC; ++rs_) xcd_barrier(xbar); } } } ++ph;

    PH_BEGIN
#ifndef SKIP_P0
    for (int rep = 0; rep < NREP_P; ++rep) {
        LAS float* vec = (LAS float*)lds; LAS float* red = (LAS float*)(lds + 36864);
        for (int i = tid; i < 9216; i += 512) { const int v = i >> 10, k = i & 1023; const float x = (v == 0) ? a.in[I_CCTX][k] : a.in[I_C][(v - 1) * 1024 + k]; vec[i] = x / (1.0f + __expf(-x)); }
        __syncthreads();
        for (int it = bid; it < 4 * 96; it += G) { const int l = it / 96, nb = it % 96;
            gemv9_item(vec, red, a.in[I_WADA] + (size_t)l * DM * 6144, 6144, 6144, a.in[I_BADA] + l * 6144, MOD + (size_t)l * 9 * 6144, 6144, nb * 64, tid); }
        __syncthreads();
        convert_weights(a, lds, 0, 31, gw, NGW, wave, lane);
        for (int i = gt; i < 9 * MTOT; i += NGT) SSQ[i] = 0.f;
        for (int i = gt; i < 1024; i += NGT) CTL[i] = 0u;
        { unsigned* padp = (unsigned*)(ws + WS_WIN + (size_t)INC * DM * 2); for (int i = gt; i < (INP - INC) * DM / 2; i += NGT) padp[i] = 0u; }
        { bf16_t* T = (bf16_t*)(ws + WS_TLAT);
          for (int i = gt; i < 2048 * 4096; i += NGT) { const int np = i >> 12, k = i & 4095, n = k & 2047; const int m = (np * n) & 2047; const float x = (float)m * (1.0f / 1024.0f);
              const float v = (k < 2048) ? cospif(x) : -sinpif(x); T[i] = f2bf(v * 0.02209708691207961f); } }
        { bf16_t* T = (bf16_t*)(ws + WS_TCTX);
          for (int i = gt; i < 256 * 512; i += NGT) { const int np = i >> 9, k = i & 511, n = k & 255; const int m = (np * n) & 255; const float x = (float)m * (1.0f / 128.0f);
              const float v = (k < 256) ? cospif(x) : -sinpif(x); T[i] = f2bf(v * 0.0625f); } }
        { bf16_t* T = (bf16_t*)(ws + WS_CS64);
          for (int i = gt; i < 128 * 64; i += NGT) { const int cc = i >> 6, c = i & 63, cp = cc & 63; const int m = (cp * c) & 63; const float x = (float)m * (1.0f / 32.0f);
              const float v = (cc < 64) ? cospif(x) : sinpif(x); T[i] = f2bf(v * 0.125f); } }
    }
#endif
    PH_END
    PH_BEGIN
#ifndef SKIP_P1
    for (int rep = 0; rep < NREP_P; ++rep) {
        LAS float* vec = (LAS float*)lds; LAS float* red = (LAS float*)(lds + 36864);
        for (int it = bid; it < 4 * 124; it += G) { const int l = it / 124, j = it % 124; const bool up = j >= 36; const int chunk = up ? 3 : 0;
            for (int i = tid; i < 9216; i += 512) { const int v = i >> 10, k = i & 1023; vec[i] = MOD[((size_t)l * 9 + v) * 6144 + chunk * 1024 + k]; }
            __syncthreads();
            if (!up) gemv9_item(vec, red, a.in[I_WIN] + (size_t)l * DM * INC, INC, INC, nullptr, BIN + (size_t)l * 9 * INP, INP, j * 64, tid);
            else gemv9_item(vec, red, a.in[I_WUP] + (size_t)l * DM * UPC, UPC, UPC, nullptr, BUP + (size_t)l * 9 * UPC, UPC, (j - 36) * 64, tid);
        }
        for (int r = gw; r < MTOT; r += NGW) {
            const float* xr = (r < NCTX) ? a.in[I_XP] + (size_t)r * DM : a.in[I_XS] + (size_t)(r - NCTX) * DM;
            const int b9 = row_b9(r);
            const float* sc = MOD + (size_t)b9 * 6144 + 1024; const float* gm = a.in[I_GMIX];
            float ss = 0.f;
#pragma unroll
            for (int j = 0; j < 4; ++j) { const int c = 4 * lane + 256 * j; const f32x4 x = *(const f32x4*)(xr + c); const f32x4 g = *(const f32x4*)(gm + c), s = *(const f32x4*)(sc + c);
                ss += (x[0] * x[0] + x[1] * x[1]) + (x[2] * x[2] + x[3] * x[3]); const f32x4 y = x * g * (s + 1.0f);
                u32x2 w; w.x = pk2(y[0], y[1]); w.y = pk2(y[2], y[3]); *(u32x2*)(XS + (size_t)r * DM + c) = w; }
            ss = wave_sum(ss);
            if (lane == 0) SSQ[r] = ss;
        }
    }
#endif
    PH_END

#pragma unroll 1
    for (int l = 0; l < NLAYER; ++l) {
        PH_BEGIN
#ifndef SKIP_A
        {
            pg8::Gemm g{XS, (const bf16_t*)(ws + WS_WIN), MTOT, INP, DM}; pg8::StaticOrder S; S.init(MTOT, INP, G, bid);
            EpiA E{Pb, INP, SSQ + (size_t)(2 * l) * MTOT, BIN + (size_t)l * 9 * INP, INP, 0};
            for (int rep = 0; rep < NREP_A; ++rep) pg8::gemm_phase<EpiA, pg8::StaticOrder, true, true>(lds, g, S, E);
        }
#endif
        PH_END
        PH_BEGIN
#ifndef SKIP_B
        {
            for (int rep = 0; rep < NREP_B1; ++rep) phase_b(a, lds, l, tid, 0, bid, G);
        }
#endif
        PH_END
        PH_BEGIN
#ifndef SKIP_B
#pragma unroll 1
        for (int repb = 0; repb < NREP_B; ++repb) {
            if (bid < 96 && G > 128) {
#pragma unroll 1
                for (int f = 0; f < 2; ++f) {
                    pg8::Gemm g = (f == 0) ? pg8::Gemm{(const bf16_t*)(ws + WS_TLAT), (const bf16_t*)(ws + WS_FBL), 2048, 2048, 4096}
                                           : pg8::Gemm{(const bf16_t*)(ws + WS_TCTX), (const bf16_t*)(ws + WS_FBC), 256, 8192, 512};
                    pg8::StaticOrder S; S.init(g.M, g.N, G, (f == 0) ? bid : (bid + G - 64) % G);
                    EpiF E{OB, (f == 0) ? NCTX : 0, (f == 0) ? 2048 : 256};
                    pg8::gemm_phase<EpiF, pg8::StaticOrder, true, true>(lds, g, S, E);
                }
            }
            { int tidq = threadIdx.x; asm volatile("" : "+v"(tidq));
              phase_b(a, lds, l, tidq, 1, 0, 1, CTL + 64 * (16 + l + 8 * repb)); }
        }
#endif
        PH_END
        PH_BEGIN
#ifndef SKIP_C
#pragma unroll 1
        for (int rep = 0; rep < NREP_C; ++rep) {
            int tid2 = threadIdx.x; asm volatile("" : "+v"(tid2));
            unsigned char* ws2 = a.ws; asm volatile("" : "+s"(ws2));
            float lam, lam_init;
            { const float p1 = ((tid2 & 63) < 32) ? a.in[I_LQ1][l * 32 + (tid2 & 63)] * a.in[I_LK1][l * 32 + (tid2 & 63)] : 0.f, p2 = ((tid2 & 63) < 32) ? a.in[I_LQ2][l * 32 + (tid2 & 63)] * a.in[I_LK2][l * 32 + (tid2 & 63)] : 0.f;
              lam_init = 0.8f - 0.6f * expf(-0.3f * (float)l); lam = expf(wave_sum(p1)) - expf(wave_sum(p2)) + lam_init; }
            const float cm = 0.10206207261596575f * 1.4426950408889634f, cd = 0.17677669529663687f * 1.4426950408889634f;
            LAS int* qslot = (LAS int*)(lds + LDS_MISC);
            unsigned* qctr = (unsigned*)(ws2 + WS_CTL) + 64 * (1 + l + 8 * rep);
            for (;;) {
                __syncthreads();
                if (tid2 == 0) *qslot = (int)atomicAdd(qctr, 1u);
                __syncthreads();
                const int idx = *qslot;
                if (idx >= 1152) break;
                const bool lat = idx < 768;
                const bool diff = lat ? (idx < 384) : (idx < 960);
                int q0, vt_ld, nt_main, nt_total, qa_ld; size_t qa_off, k_off, vt_off; size_t qa_base, k_base, vt_base;
                int h;
                if (lat) { const int j = diff ? idx : idx - 384; const int bh = j >> 3, qb = j & 7, b = bh / 6; h = bh % 6;
                    const int lr0 = b * 2048 + qb * 256; q0 = NCTX + lr0; vt_ld = 2560; nt_main = 32; nt_total = 40;
                    qa_base = diff ? WS_QDR : WS_QMR; qa_ld = diff ? 384 : 576; qa_off = (size_t)lr0 * qa_ld + (diff ? 64 : 96) * h;
                    k_base = diff ? WS_KDL : WS_KML; k_off = (size_t)b * 2560 * (diff ? 384 : 576) + (diff ? 64 : 96) * h;
                    vt_base = diff ? WS_VDL : WS_VML; vt_off = (size_t)(b * 6 + h) * 64 * 2560; }
                else { const int j = diff ? idx - 768 : idx - 960; const int i = j / 6; h = j % 6; q0 = i * 256; vt_ld = 256; nt_main = 4; nt_total = 4;
                    qa_base = WS_P; qa_ld = INP; qa_off = (size_t)q0 * INP + (diff ? 736 + 64 * h : 96 * h);
                    k_base = diff ? WS_KDC : WS_KMC; k_off = (size_t)q0 * (diff ? 384 : 576) + (diff ? 64 : 96) * h;
                    vt_base = diff ? WS_VDC : WS_VMC; vt_off = (size_t)(i * 6 + h) * 64 * 256; }
                const bf16_t* Qa = (const bf16_t*)(ws2 + qa_base) + qa_off;
                const bf16_t* Qb = (const bf16_t*)(ws2 + WS_P) + (size_t)q0 * INP + (diff ? 736 + 64 * h : 96 * h);
                const bf16_t* Kp = (const bf16_t*)(ws2 + k_base) + k_off;
                const bf16_t* Vt = (const bf16_t*)(ws2 + vt_base) + vt_off;
                bf16_t* Oo = (bf16_t*)(ws2 + WS_OB) + (size_t)q0 * DM + (diff ? 384 : 0) + 64 * h;
                if (diff) { int tt = threadIdx.x; asm volatile("" : "+v"(tt)); attn_unit<true>(lds, Qa, qa_ld, Qb, INP, Kp, 384, Vt, vt_ld, nt_main, nt_total, Oo, cd, lam, a.in[I_GSUB] + l * 64, 1.0f - lam_init, tt); }
                else { int tt = threadIdx.x; asm volatile("" : "+v"(tt)); attn_unit<false>(lds, Qa, qa_ld, Qb, INP, Kp, 576, Vt, vt_ld, nt_main, nt_total, Oo, cm, 0.f, nullptr, 0.f, tt); }
            }
        }
#endif
        PH_END
        PH_BEGIN
#ifndef SKIP_D
        {
            if (l > 0 && bid >= 128) { convert_weights(a, lds, l, 16, gw - 128 * 8, NGW - 128 * 8, wave, lane); __syncthreads(); }
            pg8::Gemm g{OB, (const bf16_t*)(ws + WS_WOUT), MTOT, DM, DM}; pg8::StaticOrder S; S.init(MTOT, DM, G, bid);
            EpiRes E{(l == 0) ? a.in[I_XP] : a.out, (l == 0) ? a.in[I_XS] : a.out + (size_t)NCTX * DM, a.out, (MOD + (size_t)l * 9 * 6144) + 2 * 1024,
                     a.in[I_GFFN] + l * DM, (MOD + (size_t)l * 9 * 6144) + 4 * 1024, XS, SSQ + (size_t)(2 * l + 1) * MTOT, 0};
            pg8::gemm_phase<EpiRes, pg8::StaticOrder, true, true>(lds, g, S, E);
        }
#endif
        PH_END
        PH_BEGIN
#ifndef SKIP_E
        {
            pg8::Gemm g{XS, (const bf16_t*)(ws + WS_WUP), 104 * 256, UPC, DM}; FfnOrder S; S.init(G, bid);
            EpiFfn E{(bf16_t*)(ws + WS_R), SSQ + (size_t)(2 * l + 1) * MTOT, BUP + (size_t)l * 9 * UPC, a.in[I_WCONV] + (size_t)l * 3 * UPC, lds};
            for (int rep = 0; rep < NREP_E; ++rep) pg8::gemm_phase<EpiFfn, FfnOrder, true, true>(lds, g, S, E);
        }
#endif
        PH_END
        PH_BEGIN
#ifndef SKIP_G
        {
            if (l + 1 < NLAYER && bid >= 128) { convert_weights(a, lds, l + 1, 15, gw - 128 * 8, NGW - 128 * 8, wave, lane); __syncthreads(); }
            const bool nxt = (l + 1 < NLAYER);
            pg8::Gemm g{(const bf16_t*)(ws + WS_R), (const bf16_t*)(ws + WS_WDN), MTOT, DM, DFF}; pg8::StaticOrder S; S.init(MTOT, DM, G, bid);
            EpiRes E{a.out, a.out + (size_t)NCTX * DM, a.out, (MOD + (size_t)l * 9 * 6144) + 5 * 1024,
                     nxt ? a.in[I_GMIX] + (l + 1) * DM : nullptr, (MOD + (size_t)l * 9 * 6144) + 9 * 6144 + 1 * 1024, XS, SSQ + (size_t)(nxt ? 2 * l + 2 : 8) * MTOT, 0};
            pg8::gemm_phase<EpiRes, pg8::StaticOrder, true, true>(lds, g, S, E);
        }
#endif
        PH_END
    }
    PH_BEGIN
#ifndef SKIP_FIN
    {
        const float* gf = a.in[I_GFINAL];
        for (int r = gw; r < MTOT; r += NGW) {
            float* xr = a.out + (size_t)r * DM;
            f32x4 x[4]; float ss = 0.f;
#pragma unroll
            for (int j = 0; j < 4; ++j) { x[j] = *(const f32x4*)(xr + 4 * lane + 256 * j); ss += (x[j][0] * x[j][0] + x[j][1] * x[j][1]) + (x[j][2] * x[j][2] + x[j][3] * x[j][3]); }
            ss = wave_sum(ss);
            const float rs = rsqrtf(ss * (1.0f / 1024.0f) + EPS);
#pragma unroll
            for (int j = 0; j < 4; ++j) { const f32x4 g = *(const f32x4*)(gf + 4 * lane + 256 * j); *(f32x4*)(xr + 4 * lane + 256 * j) = x[j] * rs * g; }
        }
    }
#endif
    PH_END
#undef PH_BEGIN
#undef PH_END
}
constexpr int N_PHASES = 2 + NLAYER * 7 + 1;

#ifndef MK_ONE_LAUNCH
#define MK_ONE_LAUNCH 1
#endif
extern "C" void kernel_launch(void* const* d_in, const int* in_sizes, int n_in, void* d_out, int out_size, void* d_ws, size_t ws_size, hipStream_t stream) {
    static int grid = 0;
    if (grid == 0) {
        if (n_in != 26 || ws_size < WS_END) { fprintf(stderr, "kernel_launch: unexpected inputs (n_in %d, ws %zu < %zu)\n", n_in, ws_size, (size_t)WS_END); grid = -1; return; }
        int dev = 0, cus = 0, per_cu = 0;
        hipGetDevice(&dev); hipDeviceGetAttribute(&cus, hipDeviceAttributeMultiprocessorCount, dev);
        if (hipFuncSetAttribute((const void*)mega_fwd, hipFuncAttributeMaxDynamicSharedMemorySize, LDS_BYTES) != hipSuccess) { fprintf(stderr, "kernel_launch: hipFuncSetAttribute failed\n"); grid = -1; return; }
        if (hipOccupancyMaxActiveBlocksPerMultiprocessor(&per_cu, (const void*)mega_fwd, 512, LDS_BYTES) != hipSuccess || per_cu < 1) { fprintf(stderr, "kernel_launch: occupancy query gave %d\n", per_cu); per_cu = 1; }
        (void)hipGetLastError();
        grid = cus * 1;
    }
    if (grid < 0) return;
    if (hipMemsetAsync((char*)d_ws + WS_CTL, 0, 1 << 20, stream) != hipSuccess) { fprintf(stderr, "kernel_launch: memset failed\n"); return; }
    Args a{};
    for (int i = 0; i < 26; ++i) a.in[i] = (const float*)d_in[i];
    a.out = (float*)d_out; a.ws = (unsigned char*)d_ws;
#if MK_ONE_LAUNCH
    a.ph_lo = 0; a.ph_hi = N_PHASES;
    void* args[] = {&a};
    hipError_t e = hipLaunchCooperativeKernel((const void*)mega_fwd, dim3(grid), dim3(512), args, LDS_BYTES, stream);
    if (e != hipSuccess) fprintf(stderr, "cooperative launch failed: %s (grid %d)\n", hipGetErrorString(e), grid);
#else
    for (int p = 0; p < N_PHASES; ++p) { a.ph_lo = p; a.ph_hi = p + 1; hipLaunchKernelGGL(mega_fwd, dim3(grid), dim3(512), LDS_BYTES, stream, a); }
#endif
}
```

```cpp
#include <hip/hip_runtime.h>
#include <hip/hip_cooperative_groups.h>
#include <cstdio>
#include <cstdint>
namespace cg = cooperative_groups;
namespace pg8 {
#define PG8_LAS __attribute__((address_space(3)))
typedef unsigned short bf16_t;
typedef short bf16x8 __attribute__((ext_vector_type(8)));
typedef float f32x4 __attribute__((ext_vector_type(4)));
typedef unsigned u32x4 __attribute__((ext_vector_type(4)));
constexpr int BM = 256, BK = 64, HALF = 128, HTB = HALF * BK * 2  , STAGE_BYTES = 8 * HTB, NXCD = 8, WGM = 8;

__host__ __device__ __forceinline__ int lds_byte(int r, int c) { const int st = (r >> 4) * 2 + (c >> 5), rr = r & 15, cc = c & 31, ob = rr * 64 + cc * 2; return st * 1024 + (ob ^ (((ob >> 9) & 1) << 5)); }
__host__ __device__ __forceinline__ void stage_rc(int b, int& R, int& C) { const int st = b / 1024, sb = b % 1024, swz = sb ^ (((sb >> 9) & 1) << 5); R = (st >> 1) * 16 + swz / 64; C = (st & 1) * 32 + (swz % 64) / 2; }
__host__ __device__ __forceinline__ int perm32(int rho) { const int n = rho >> 4, i = rho & 15; return 8 * (i >> 2) + 4 * n + (i & 3); }

struct Unit { int pm, pn; };
struct Gemm { const bf16_t* A; const bf16_t* Bt; int M, N, K; };

struct StaticOrder {
    int nM, nN, nwg, G, c;
    __host__ __device__ void init(int M, int N, int G_, int c_) { nM = M / BM; nN = N / BM; nwg = nM * nN; G = G_; c = c_; }
    __host__ __device__ bool next(int i, Unit& u) const {
        const long L = (long)i * G + c; if (L >= nwg) return false;
        int wgid = (int)L; { const int q = nwg / NXCD, r = nwg % NXCD, xcd = wgid % NXCD, off = wgid / NXCD; wgid = (xcd < r ? xcd * (q + 1) : r * (q + 1) + (xcd - r) * q) + off; }
        const int nig = WGM * nN, gid = wgid / nig, fm = gid * WGM, gsz = (nM - fm) < WGM ? (nM - fm) : WGM;
        u.pm = fm + ((wgid % nig) % gsz); u.pn = (wgid % nig) / gsz; return true;
    }
    __device__ __forceinline__ int arow(const Unit& u) const { return u.pm * BM; }
    __device__ __forceinline__ void a_ready(const Unit&) const {}
    __device__ __forceinline__ void done(const Unit&) const {}
};

__device__ __forceinline__ unsigned cvt_pk_bf16(float lo, float hi) { unsigned r; asm volatile("v_cvt_pk_bf16_f32 %0, %1, %2" : "=v"(r) : "v"(lo), "v"(hi)); return r; }
typedef float f32x2 __attribute__((ext_vector_type(2)));
__device__ __forceinline__ f32x2 gelu_pk(f32x2 v) {
    const f32x2 av = __builtin_elementwise_abs(v), d = av * 0.2316418882f + 1.0f;
    f32x2 t; t.x = __builtin_amdgcn_rcpf(d.x); t.y = __builtin_amdgcn_rcpf(d.y);
    f32x2 q = t * 0.5307027145f + (-0.7265760135f); q = q * t + 0.7107068705f; q = q * t + (-0.142248368f); q = q * t + 0.127414796f; q = q * t;
    const f32x2 s = (v * v) * (-0.72134752044f);
    f32x2 e; e.x = __builtin_amdgcn_exp2f(s.x); e.y = __builtin_amdgcn_exp2f(s.y);
    const f32x2 m = v * (q * e), r = v - m;
    f32x2 o; o.x = v.x < 0.f ? m.x : r.x; o.y = v.y < 0.f ? m.y : r.y; return o;
}

template <int ACT  > struct EpiBf16 {
    static constexpr bool PERM = true, AFTER_DRAIN = false; static_assert(ACT == 0 || ACT == 1, "EpiBf16: ACT is 0 (none) or 1 (gelu_pk)");
    bf16_t* O; int ldc; const float* bias; int split_cols; size_t split_stride; float scale0;
    __device__ __forceinline__ void operator()(const f32x4 (&acc)[2][2][4][2], const Unit& u, int wr, int wc, int fr, int fq) const {
        const int row0 = u.pm * BM + wr * 64 + fr; int colt = u.pn * BM; bf16_t* base = O;
        float sc = 1.f; if (split_cols) { const int t = colt / split_cols; base += (size_t)t * split_stride; colt -= t * split_cols; if (t == 0) sc = scale0; }
        const int col0 = colt + wc * 32 + 8 * fq, bcol0 = u.pn * BM + wc * 32 + 8 * fq;
        f32x4 bv[2][2];
#pragma unroll
        for (int bj = 0; bj < 2; ++bj)
#pragma unroll
            for (int n = 0; n < 2; ++n) bv[bj][n] = bias ? *(const f32x4*)(bias + bcol0 + bj * HALF + 4 * n) : (f32x4){0.f, 0.f, 0.f, 0.f};
#pragma unroll
        for (int ai = 0; ai < 2; ++ai)
#pragma unroll
            for (int m = 0; m < 4; ++m) { bf16_t* rowp = base + (size_t)(row0 + ai * HALF + m * 16) * ldc + col0;
#pragma unroll
                for (int bj = 0; bj < 2; ++bj) { f32x4 v0 = acc[ai][bj][m][0] + bv[bj][0], v1 = acc[ai][bj][m][1] + bv[bj][1];
                    if (ACT == 1) { f32x2 a = gelu_pk((f32x2){v0[0], v0[1]}), b = gelu_pk((f32x2){v0[2], v0[3]}), c = gelu_pk((f32x2){v1[0], v1[1]}), d = gelu_pk((f32x2){v1[2], v1[3]});
                        v0 = (f32x4){a.x, a.y, b.x, b.y}; v1 = (f32x4){c.x, c.y, d.x, d.y}; }
                    v0 = v0 * sc; v1 = v1 * sc; u32x4 w; w.x = cvt_pk_bf16(v0[0], v0[1]); w.y = cvt_pk_bf16(v0[2], v0[3]); w.z = cvt_pk_bf16(v1[0], v1[1]); w.w = cvt_pk_bf16(v1[2], v1[3]);
                    *(u32x4*)(rowp + bj * HALF) = w; } }
    }
};

struct PanelStats {
    unsigned* xbuf;
    unsigned* cnt;
    unsigned* tmo;
    int ntn; float eps;
    unsigned code;
    __device__ __forceinline__ bool run(const f32x4 (&v)[2][2][4][2], const Unit& u, int wr, int wc, int fr, int fq, PG8_LAS unsigned char* lds, int wid, int lane) const {
        typedef float f32x2v __attribute__((ext_vector_type(2)));
        PG8_LAS f32x2v* P = (PG8_LAS f32x2v*)lds;
        PG8_LAS f32x2v* S = (PG8_LAS f32x2v*)(lds + 8192);
        PG8_LAS unsigned* flag = (PG8_LAS unsigned*)(lds + 8192 + 2048);
#pragma unroll
        for (int ai = 0; ai < 2; ++ai)
#pragma unroll
            for (int m = 0; m < 4; ++m) {
                float s = 0.f;
#pragma unroll
                for (int bj = 0; bj < 2; ++bj)
#pragma unroll
                    for (int n = 0; n < 2; ++n) { const f32x4 x = v[ai][bj][m][n]; s += (x[0] + x[1]) + (x[2] + x[3]); }
                s += __shfl_xor(s, 16); s += __shfl_xor(s, 32);
                const float mw = s * (1.0f / 64.0f); float q = 0.f;
#pragma unroll
                for (int bj = 0; bj < 2; ++bj)
#pragma unroll
                    for (int n = 0; n < 2; ++n) { const f32x4 d = v[ai][bj][m][n] - mw; q += (d[0] * d[0] + d[1] * d[1]) + (d[2] * d[2] + d[3] * d[3]); }
                q += __shfl_xor(q, 16); q += __shfl_xor(q, 32);
                if (fq == 0) P[(ai * HALF + wr * 64 + m * 16 + fr) * 4 + wc] = (f32x2v){mw, q};
            }
        asm volatile("s_waitcnt lgkmcnt(0)" ::: "memory"); __builtin_amdgcn_s_barrier(); asm volatile("" ::: "memory");
#if defined(BROKEN_EXCHANGE_NO_WAIT)
#warning BROKEN CONTROL BUILD: the row-statistics exchange does not wait; results are wrong by design
        if (blockIdx.x >= 64) { const long long t0_ = clock64(); while (clock64() - t0_ < 60000) __builtin_amdgcn_s_sleep(8); }
#endif
        const int row = wid * 32 + (lane & 31);
        if (lane < 32) {
            const f32x2v a = P[row * 4 + 0], b = P[row * 4 + 1], c = P[row * 4 + 2], d = P[row * 4 + 3];
            const float mt = (a.x + b.x + c.x + d.x) * 0.25f;
            const float da = a.x - mt, db = b.x - mt, dc = c.x - mt, dd = d.x - mt;
            const float m2 = (a.y + b.y) + (c.y + d.y) + 64.0f * ((da * da + db * db) + (dc * dc + dd * dd));
            unsigned long long* slot = (unsigned long long*)xbuf + ((size_t)(u.pm * BM + row) * 4 + u.pn);
            __hip_atomic_store(slot, ((unsigned long long)__float_as_uint(m2) << 32) | __float_as_uint(mt), __ATOMIC_RELAXED, __HIP_MEMORY_SCOPE_AGENT);
        }
        asm volatile("s_waitcnt vmcnt(0)" ::: "memory");
        if (lane == 0) __hip_atomic_fetch_add(cnt + 64 * u.pm, 1u, __ATOMIC_RELAXED, __HIP_MEMORY_SCOPE_AGENT);
        if (wid == 0) {
            bool dead = false; const unsigned long long t0 = __builtin_amdgcn_s_memrealtime(); const unsigned want = 8u * (unsigned)ntn;
            for (;;) {
#if defined(BROKEN_EXCHANGE_NO_WAIT)
                break;
#endif
                if ((unsigned)__builtin_amdgcn_readfirstlane(__hip_atomic_load(cnt + 64 * u.pm, __ATOMIC_RELAXED, __HIP_MEMORY_SCOPE_AGENT)) >= want) break;
                if (__builtin_amdgcn_s_memrealtime() - t0 > 2000000ull) {
                    if (lane == 0) { unsigned expect = 0u; __hip_atomic_compare_exchange_strong(tmo + 1, &expect, code | (unsigned)(u.pm & 0xff), __ATOMIC_RELAXED, __ATOMIC_RELAXED, __HIP_MEMORY_SCOPE_AGENT);
                                     __hip_atomic_store(tmo, 1u, __ATOMIC_RELAXED, __HIP_MEMORY_SCOPE_AGENT); }
                    dead = true; break; }
                __builtin_amdgcn_s_sleep(2);
            }
            __builtin_amdgcn_fence(__ATOMIC_ACQUIRE, "agent");
            if (lane == 0) flag[0] = dead ? 1u : 0u;
        }
        asm volatile("s_waitcnt vmcnt(0) lgkmcnt(0)" ::: "memory"); __builtin_amdgcn_s_barrier(); asm volatile("" ::: "memory");
        const bool bad = flag[0] != 0u;
        if (lane < 32) {
            const unsigned long long* slot = (const unsigned long long*)xbuf + (size_t)(u.pm * BM + row) * 4; float mt[4], m2[4]; float ms = 0.f;
#pragma unroll
            for (int t = 0; t < 4; ++t) { if (t < ntn) { const unsigned long long w = __hip_atomic_load(slot + t, __ATOMIC_RELAXED, __HIP_MEMORY_SCOPE_AGENT); mt[t] = __uint_as_float((unsigned)w); m2[t] = __uint_as_float((unsigned)(w >> 32)); } else { mt[t] = 0.f; m2[t] = 0.f; } ms += mt[t]; }
            const float mean = ms / (float)ntn; float q = 0.f;
#pragma unroll
            for (int t = 0; t < 4; ++t) if (t < ntn) { const float dm = mt[t] - mean; q += m2[t] + 256.0f * dm * dm; }
            S[row] = (f32x2v){mean, 1.0f / sqrtf(q / (256.0f * (float)ntn) + eps)};
        }
        asm volatile("s_waitcnt lgkmcnt(0)" ::: "memory"); __builtin_amdgcn_s_barrier(); asm volatile("" ::: "memory");
        return bad;
    }
};
struct EpiLnRes {
    static constexpr bool PERM = false, AFTER_DRAIN = true;
    const float* base; float* out; int ldc; const float* bias; PanelStats st; unsigned poison;
    __device__ __forceinline__ void fused(f32x4 (&acc)[2][2][4][2], const Unit& u, int wr, int wc, int fr, int fq, PG8_LAS unsigned char* lds, int wid, int lane) const {
        typedef float f32x2v __attribute__((ext_vector_type(2)));
        const PG8_LAS f32x2v* S = (const PG8_LAS f32x2v*)(lds + 8192);
        const int col0 = u.pn * BM + wc * 32 + 4 * fq;
#pragma unroll
        for (int bj = 0; bj < 2; ++bj)
#pragma unroll
            for (int n = 0; n < 2; ++n) { const f32x4 bv = bias ? *(const f32x4*)(bias + col0 + bj * HALF + n * 16) : (f32x4){0.f, 0.f, 0.f, 0.f};
#pragma unroll
                for (int ai = 0; ai < 2; ++ai)
#pragma unroll
                    for (int m = 0; m < 4; ++m) acc[ai][bj][m][n] += bv; }
        f32x4 pre[4][2][2];
#pragma unroll
        for (int m = 0; m < 4; ++m) { const size_t off = (size_t)(u.pm * BM + wr * 64 + m * 16 + fr) * ldc + col0;
#pragma unroll
            for (int bj = 0; bj < 2; ++bj)
#pragma unroll
                for (int n = 0; n < 2; ++n) pre[m][bj][n] = *(const f32x4*)(base + off + bj * HALF + n * 16); }
        const bool bad = st.run(acc, u, wr, wc, fr, fq, lds, wid, lane) || poison != 0u;
        const float qnan = __builtin_nanf("");
#pragma unroll
        for (int ai = 0; ai < 2; ++ai)
#pragma unroll
            for (int m = 0; m < 4; ++m) { const int r = ai * HALF + wr * 64 + m * 16 + fr; const f32x2v sr = S[r]; const size_t off = (size_t)(u.pm * BM + r) * ldc + col0;
#pragma unroll
                for (int bj = 0; bj < 2; ++bj)
#pragma unroll
                    for (int n = 0; n < 2; ++n) { const f32x4 bs = ai == 0 ? pre[m][bj][n] : *(const f32x4*)(base + off + bj * HALF + n * 16); f32x4 o = bs + (acc[ai][bj][m][n] - sr.x) * sr.y;
                        if (bad) o = (f32x4){qnan, qnan, qnan, qnan}; *(f32x4*)(out + off + bj * HALF + n * 16) = o; }
                if (m & 1) asm volatile("" ::: "memory"); }
    }
};
struct EpiLnResLn {
    static constexpr bool PERM = false, AFTER_DRAIN = true;
    const float* base; float* out; bf16_t* xn; int ldc; const float* bias; PanelStats st1, st2; unsigned poison;
    __device__ __forceinline__ void fused(f32x4 (&acc)[2][2][4][2], const Unit& u, int wr, int wc, int fr, int fq, PG8_LAS unsigned char* lds, int wid, int lane) const {
        typedef float f32x2v __attribute__((ext_vector_type(2))); typedef unsigned u32x2v __attribute__((ext_vector_type(2)));
        const PG8_LAS f32x2v* S = (const PG8_LAS f32x2v*)(lds + 8192);
        const int col0 = u.pn * BM + wc * 32 + 4 * fq;
#pragma unroll
        for (int bj = 0; bj < 2; ++bj)
#pragma unroll
            for (int n = 0; n < 2; ++n) { const f32x4 bv = bias ? *(const f32x4*)(bias + col0 + bj * HALF + n * 16) : (f32x4){0.f, 0.f, 0.f, 0.f};
#pragma unroll
                for (int ai = 0; ai < 2; ++ai)
#pragma unroll
                    for (int m = 0; m < 4; ++m) acc[ai][bj][m][n] += bv; }
        bool bad = st1.run(acc, u, wr, wc, fr, fq, lds, wid, lane) || poison != 0u;
        const float qnan = __builtin_nanf("");
#pragma unroll
        for (int ai = 0; ai < 2; ++ai)
#pragma unroll
            for (int m = 0; m < 4; ++m) { const int r = ai * HALF + wr * 64 + m * 16 + fr; const f32x2v sr = S[r]; const size_t off = (size_t)(u.pm * BM + r) * ldc + col0;
#pragma unroll
                for (int bj = 0; bj < 2; ++bj)
#pragma unroll
                    for (int n = 0; n < 2; ++n) { const f32x4 bs = *(const f32x4*)(base + off + bj * HALF + n * 16); acc[ai][bj][m][n] = bs + (acc[ai][bj][m][n] - sr.x) * sr.y; }
                asm volatile("" : "+v"(acc[ai][0][m][0]), "+v"(acc[ai][0][m][1]), "+v"(acc[ai][1][m][0]), "+v"(acc[ai][1][m][1]));
                if (m & 1) asm volatile("" ::: "memory"); }
        const bool bad1 = bad;
        bad = st2.run(acc, u, wr, wc, fr, fq, lds, wid, lane) || bad;
#pragma unroll
        for (int ai = 0; ai < 2; ++ai)
#pragma unroll
            for (int m = 0; m < 4; ++m) { const int r = ai * HALF + wr * 64 + m * 16 + fr; const f32x2v sr = S[r]; const size_t off = (size_t)(u.pm * BM + r) * ldc + col0;
#pragma unroll
                for (int bj = 0; bj < 2; ++bj)
#pragma unroll
                    for (int n = 0; n < 2; ++n) { const f32x4 x1 = acc[ai][bj][m][n]; *(f32x4*)(out + off + bj * HALF + n * 16) = bad1 ? (f32x4){qnan, qnan, qnan, qnan} : x1;
                        const f32x4 o = (x1 - sr.x) * sr.y; u32x2v w; w.x = cvt_pk_bf16(o[0], o[1]); w.y = cvt_pk_bf16(o[2], o[3]);
                        if (bad) { w.x = 0x7fc07fc0u; w.y = 0x7fc07fc0u; } *(u32x2v*)(xn + off + bj * HALF + n * 16) = w; }
                asm volatile("" ::: "memory"); }
    }
};

template <class Epi, class Sched, bool ALIGN_EPI = false, bool SP2 = false>
__device__ __forceinline__ void gemm_phase(PG8_LAS unsigned char* lds, const Gemm g, const Sched& S, const Epi& E) {
    int tid = threadIdx.x; asm volatile("" : "+v"(tid));
    const int wid = __builtin_amdgcn_readfirstlane(tid >> 6), lane = tid & 63, wr = wid >> 2, wc = wid & 3, fr = lane & 15, fq = lane >> 4;
    const int K = g.K, nt = K / BK;
    unsigned voffA[2], voffB[2];
#pragma unroll
    for (int i = 0; i < 2; ++i) { int R, C; stage_rc(tid * 16 + i * 8192, R, C); const int Rb = Epi::PERM ? ((R & ~31) + perm32(R & 31)) : R;
        voffA[i] = (unsigned)(R * K + C) * 2u; voffB[i] = (unsigned)(Rb * K + C) * 2u; }
    const size_t kstep = (size_t)(BK * 2);
    const size_t hstep = (size_t)HALF * K * 2;
    const size_t tstep = 2 * hstep;
    const unsigned ldsw = (unsigned)wid * 1024u;
    const int aoff = lds_byte(wr * 64 + fr, fq * 8), boff = lds_byte(wc * 32 + fr, fq * 8);
#define PG8_SA(b, h) (((b) * 2 + (h)) * HTB)
#define PG8_SB(b, h) ((4 + (b) * 2 + (h)) * HTB)
#define PG8_STAGE(bufoff, gbase, voff) do { _Pragma("unroll") for (int _i = 0; _i < 2; ++_i) \
        __builtin_amdgcn_global_load_lds((const unsigned*)((const char*)(gbase) + (voff)[_i]), (PG8_LAS unsigned*)(lds + (bufoff) + ldsw + _i * 8192), 16, 0, 0); } while (0)
#define PG8_LDA(dst, b, h) do { _Pragma("unroll") for (int m = 0; m < 4; ++m) _Pragma("unroll") for (int k = 0; k < 2; ++k) dst[m][k] = *(const PG8_LAS bf16x8*)(lds + PG8_SA(b, h) + aoff + m * 2048 + k * 1024); } while (0)
#define PG8_LDB(dst, b, h) do { _Pragma("unroll") for (int n = 0; n < 2; ++n) _Pragma("unroll") for (int k = 0; k < 2; ++k) dst[n][k] = *(const PG8_LAS bf16x8*)(lds + PG8_SB(b, h) + boff + n * 2048 + k * 1024); } while (0)
#define PG8_MMA(ai, bj, At, Bt) do { __builtin_amdgcn_s_setprio(1); _Pragma("unroll") for (int m = 0; m < 4; ++m) _Pragma("unroll") for (int n = 0; n < 2; ++n) _Pragma("unroll") for (int k = 0; k < 2; ++k) \
        acc[ai][bj][m][n] = __builtin_amdgcn_mfma_f32_16x16x32_bf16(Bt[n][k], At[m][k], acc[ai][bj][m][n], 0, 0, 0); __builtin_amdgcn_s_setprio(0); } while (0)
#define PG8_WAIT_V(n) asm volatile("s_waitcnt vmcnt(" #n ")" ::: "memory")
#define PG8_WAIT_L(n) asm volatile("s_waitcnt lgkmcnt(" #n ")" ::: "memory")
#define PG8_BAR __builtin_amdgcn_s_barrier()
#define PG8_SCHED __builtin_amdgcn_sched_barrier(0)
    Unit cur, nxt; int ui = 0;
    if (!S.next(0, cur)) return;
    f32x4 acc[2][2][4][2];
#pragma unroll
    for (int a = 0; a < 2; ++a)
#pragma unroll
        for (int b = 0; b < 2; ++b)
#pragma unroll
            for (int m = 0; m < 4; ++m)
#pragma unroll
                for (int n = 0; n < 2; ++n) acc[a][b][m][n] = (f32x4){0.f, 0.f, 0.f, 0.f};
    bf16x8 At[4][2], B0[2][2], B1[2][2];
    const char* cA = (const char*)g.A + (size_t)S.arow(cur) * (size_t)(K * 2); const char* cB = (const char*)g.Bt + (size_t)cur.pn * tstep;
    S.a_ready(cur);
    if constexpr (SP2) {
        PG8_STAGE(PG8_SB(0, 0), cB, voffB); PG8_STAGE(PG8_SB(0, 1), cB + hstep, voffB); PG8_STAGE(PG8_SA(0, 0), cA, voffA); PG8_STAGE(PG8_SA(0, 1), cA + hstep, voffA);
        if (wr == 1) PG8_BAR;
        PG8_WAIT_V(2); PG8_BAR;
        PG8_STAGE(PG8_SB(1, 0), cB + kstep, voffB); PG8_STAGE(PG8_SA(1, 0), cA + kstep, voffA); PG8_STAGE(PG8_SB(1, 1), cB + hstep + kstep, voffB);
        PG8_WAIT_V(6); PG8_BAR;
    } else {
        PG8_STAGE(PG8_SB(0, 0), cB, voffB); PG8_STAGE(PG8_SA(0, 0), cA, voffA); PG8_STAGE(PG8_SB(0, 1), cB + hstep, voffB); PG8_STAGE(PG8_SA(0, 1), cA + hstep, voffA);
        if (wr == 1) PG8_BAR;
        PG8_WAIT_V(4); PG8_BAR;
        PG8_STAGE(PG8_SB(1, 0), cB + kstep, voffB); PG8_STAGE(PG8_SA(1, 0), cA + kstep, voffA); PG8_STAGE(PG8_SB(1, 1), cB + hstep + kstep, voffB);
        PG8_WAIT_V(6); PG8_BAR;
    }
    for (;;) {
        const bool has_next = S.next(ui + 1, nxt);
        const char* nA = has_next ? (const char*)g.A + (size_t)S.arow(nxt) * (size_t)(K * 2) : cA; const char* nB = has_next ? (const char*)g.Bt + (size_t)nxt.pn * tstep : cB;
        for (int t = 0; t < nt; t += 2) {
            const bool last = (t == nt - 2);
            const char* a1 = cA + (size_t)(t + 1) * kstep;
            const char* a2 = last ? nA : cA + (size_t)(t + 2) * kstep; const char* b2 = last ? nB : cB + (size_t)(t + 2) * kstep;
            const char* a3 = a2 + kstep; const char* b3 = b2 + kstep;
            if (last && has_next) S.a_ready(nxt);
            if constexpr (SP2) {
            PG8_LDB(B0, 0, 0); PG8_LDB(B1, 0, 1); PG8_SCHED; PG8_LDA(At, 0, 0); PG8_STAGE(PG8_SA(1, 1), a1 + hstep, voffA);
            PG8_WAIT_V(8); PG8_WAIT_L(0); PG8_BAR; PG8_MMA(0, 0, At, B0); PG8_MMA(0, 1, At, B1); PG8_BAR; PG8_SCHED;
            PG8_LDA(At, 0, 1); PG8_STAGE(PG8_SB(0, 0), b2, voffB); PG8_STAGE(PG8_SB(0, 1), b2 + hstep, voffB); PG8_STAGE(PG8_SA(0, 0), a2, voffA);
            PG8_WAIT_V(8); PG8_WAIT_L(0); PG8_BAR; PG8_MMA(1, 0, At, B0); PG8_MMA(1, 1, At, B1); PG8_BAR; PG8_SCHED;
            PG8_LDB(B0, 1, 0); PG8_LDB(B1, 1, 1); PG8_SCHED; PG8_LDA(At, 1, 0); PG8_STAGE(PG8_SA(0, 1), a2 + hstep, voffA);
            PG8_WAIT_V(8); PG8_WAIT_L(0); PG8_BAR; PG8_MMA(0, 0, At, B0); PG8_MMA(0, 1, At, B1); PG8_BAR; PG8_SCHED;
            PG8_LDA(At, 1, 1); PG8_STAGE(PG8_SB(1, 0), b3, voffB); PG8_STAGE(PG8_SB(1, 1), b3 + hstep, voffB); PG8_STAGE(PG8_SA(1, 0), a3, voffA);
            PG8_WAIT_V(8); PG8_WAIT_L(0); PG8_BAR; PG8_MMA(1, 0, At, B0); PG8_MMA(1, 1, At, B1); PG8_BAR; PG8_SCHED;
            } else {
            PG8_LDB(B0, 0, 0); PG8_SCHED; PG8_LDA(At, 0, 0); PG8_STAGE(PG8_SA(1, 1), a1 + hstep, voffA);
            PG8_WAIT_L(8); PG8_BAR; PG8_WAIT_L(0); PG8_MMA(0, 0, At, B0); PG8_BAR; PG8_SCHED;
            PG8_LDB(B1, 0, 1); PG8_STAGE(PG8_SB(0, 0), b2, voffB);
            PG8_BAR; PG8_WAIT_L(0); PG8_MMA(0, 1, At, B1); PG8_BAR;
            PG8_LDA(At, 0, 1); PG8_STAGE(PG8_SA(0, 0), a2, voffA);
            PG8_BAR; PG8_WAIT_L(0); PG8_MMA(1, 0, At, B0); PG8_BAR; PG8_SCHED;
            PG8_STAGE(PG8_SB(0, 1), b2 + hstep, voffB);
            PG8_WAIT_V(6); PG8_BAR; PG8_MMA(1, 1, At, B1); PG8_BAR;
            PG8_LDB(B0, 1, 0); PG8_SCHED; PG8_LDA(At, 1, 0); PG8_STAGE(PG8_SA(0, 1), a2 + hstep, voffA);
            PG8_WAIT_L(8); PG8_BAR; PG8_WAIT_L(0); PG8_MMA(0, 0, At, B0); PG8_BAR; PG8_SCHED;
            PG8_LDB(B1, 1, 1); PG8_STAGE(PG8_SB(1, 0), b3, voffB);
            PG8_BAR; PG8_WAIT_L(0); PG8_MMA(0, 1, At, B1); PG8_BAR;
            PG8_LDA(At, 1, 1); PG8_STAGE(PG8_SA(1, 0), a3, voffA);
            PG8_BAR; PG8_WAIT_L(0); PG8_MMA(1, 0, At, B0); PG8_BAR; PG8_SCHED;
            PG8_STAGE(PG8_SB(1, 1), b3 + hstep, voffB);
            PG8_WAIT_V(6); PG8_BAR; PG8_MMA(1, 1, At, B1); PG8_BAR;
            }
        }
        if constexpr (ALIGN_EPI) { if (wr == 0) PG8_BAR; }
        if constexpr (!Epi::AFTER_DRAIN) { E(acc, cur, wr, wc, fr, fq); S.done(cur); }
        if (!has_next) break;
#pragma unroll
        for (int a = 0; a < 2; ++a)
#pragma unroll
            for (int b = 0; b < 2; ++b)
#pragma unroll
                for (int m = 0; m < 4; ++m)
#pragma unroll
                    for (int n = 0; n < 2; ++n) acc[a][b][m][n] = (f32x4){0.f, 0.f, 0.f, 0.f};
        cur = nxt; cA = nA; cB = nB; ++ui;
        if constexpr (ALIGN_EPI) { if (wr == 1) PG8_BAR; }
    }
    PG8_WAIT_V(0);
    if constexpr (!ALIGN_EPI) { if (wr == 0) PG8_BAR; }
    PG8_BAR;
    if constexpr (Epi::AFTER_DRAIN) { E.fused(acc, cur, wr, wc, fr, fq, lds, wid, lane); S.done(cur); }
#undef PG8_SA
#undef PG8_SB
#undef PG8_STAGE
#undef PG8_LDA
#undef PG8_LDB
#undef PG8_MMA
#undef PG8_WAIT_V
#undef PG8_WAIT_L
#undef PG8_BAR
#undef PG8_SCHED
}
}

#define DEV __device__ __forceinline__
#define LAS __attribute__((address_space(3)))
#define GAS __attribute__((address_space(1)))
typedef unsigned short bf16_t;
typedef short bf16x8 __attribute__((ext_vector_type(8)));
typedef short s16x4 __attribute__((ext_vector_type(4)));
typedef float f32x4 __attribute__((ext_vector_type(4)));
typedef float f32x2 __attribute__((ext_vector_type(2)));
typedef float f32x16 __attribute__((ext_vector_type(16)));
typedef unsigned u32x4 __attribute__((ext_vector_type(4)));
typedef unsigned u32x2 __attribute__((ext_vector_type(2)));
typedef __bf16 bf16x2_t __attribute__((ext_vector_type(2)));

constexpr int DM = 1024, NCTX = 8192, NLAT = 16384, MTOT = 24576;
constexpr int INP = 2304, INC = 2144, DFF = 2816, UPC = 5632;
constexpr int NLAYER = 4;
constexpr float EPS = 1e-6f;
constexpr size_t MiB = 1u << 20;
constexpr size_t WS_CTL = 0;
constexpr size_t WS_MOD = 1 * MiB;
constexpr size_t WS_BIN = 2 * MiB;
constexpr size_t WS_BUP = 3 * MiB;
constexpr size_t WS_SSQ = 4 * MiB;
constexpr size_t WS_WIN = 5 * MiB;
constexpr size_t WS_WUKV = WS_WIN + 4718592;
constexpr size_t WS_WOUT = 10 * MiB;
constexpr size_t WS_WUP = 12 * MiB;
constexpr size_t WS_WDN = 23 * MiB;
constexpr size_t WS_TLAT = 29 * MiB;
constexpr size_t WS_TCTX = 45 * MiB;
constexpr size_t WS_CS64 = WS_TCTX + 512 * 1024;
constexpr size_t WS_XS = 46 * MiB;
constexpr size_t WS_R = 94 * MiB;
constexpr size_t WS_P = WS_R;
constexpr size_t WS_OB = WS_P + 108 * MiB;
constexpr size_t WS_KML = WS_OB + 48 * MiB;
constexpr size_t WS_KMC = WS_KML + 23592960;
constexpr size_t WS_VML = WS_KMC + 9 * MiB;
constexpr size_t WS_VMC = WS_VML + 15 * MiB;
constexpr size_t WS_KDL = WS_VMC + 6 * MiB;
constexpr size_t WS_KDC = WS_KDL + 15 * MiB;
constexpr size_t WS_VDL = WS_KDC + 6 * MiB;
constexpr size_t WS_VDC = WS_VDL + 15 * MiB;
constexpr size_t WS_QMR = WS_VDC + 6 * MiB;
constexpr size_t WS_QDR = WS_QMR + 18 * MiB;
constexpr size_t WS_FBL = WS_QDR + 12 * MiB;
constexpr size_t WS_FBC = WS_FBL + 16 * MiB;
constexpr size_t WS_END = WS_FBC + 8 * MiB;
constexpr size_t WS_U = WS_R;
constexpr size_t WS_ACT = WS_R + 176 * MiB;
static_assert(WS_ACT + 88 * MiB <= WS_END, "overlay fits");
constexpr size_t OUT_CKV = 25165824, OUT_KROPE = OUT_CKV + 4194304, OUT_DK = OUT_KROPE + 1048576, OUT_DV = OUT_DK + 12582912;
constexpr int LDS_BYTES = 147456;
constexpr int RING_BYTES = 131072;
constexpr int LDS_MISC = RING_BYTES;

struct Args { const float* in[26]; float* out; unsigned char* ws; int ph_lo, ph_hi; };
enum { I_XP = 0, I_XS, I_C, I_CCKV, I_CKROPE, I_CDK, I_CDV, I_CCTX, I_WADA, I_BADA, I_GMIX, I_GFFN, I_WIN, I_GKV, I_WUK, I_WUV,
       I_LQ1, I_LK1, I_LQ2, I_LK2, I_GSUB, I_WOUT, I_WUP, I_WCONV, I_WDOWN, I_GFINAL };

DEV float bf2f(unsigned b) { return __uint_as_float(b << 16); }
DEV unsigned pk2(float lo, float hi) { f32x2 v = {lo, hi}; bf16x2_t b = __builtin_convertvector(v, bf16x2_t); return __builtin_bit_cast(unsigned, b); }
DEV bf16_t f2bf(float f) { return (bf16_t)(pk2(f, 0.f) & 0xffffu); }
DEV float wave_sum(float v) {
#pragma unroll
    for (int o = 1; o < 64; o <<= 1) v += __shfl_xor(v, o);
    return v;
}
DEV f32x4 mfma16(bf16x8 a, bf16x8 b, f32x4 c) { return __builtin_amdgcn_mfma_f32_16x16x32_bf16(a, b, c, 0, 0, 0); }
DEV f32x16 mfma32(bf16x8 a, bf16x8 b, f32x16 c) { return __builtin_amdgcn_mfma_f32_32x32x16_bf16(a, b, c, 0, 0, 0); }
DEV int row_b9(int row0) { return row0 < NCTX ? 0 : 1 + ((row0 - NCTX) >> 11); }

struct EpiA {
    static constexpr bool PERM = true, AFTER_DRAIN = false;
    bf16_t* O; int ldc; const float* ssq; const float* bias; int ldb; int row_off;
    DEV void operator()(const f32x4 (&acc)[2][2][4][2], const pg8::Unit& u, int wr, int wc, int fr, int fq) const {
        const int lrow0 = u.pm * 256, b9 = row_b9(row_off + lrow0);
        const int col0 = u.pn * 256 + wc * 32 + 8 * fq;
        f32x4 bv[2][2];
#pragma unroll
        for (int bj = 0; bj < 2; ++bj)
#pragma unroll
            for (int n = 0; n < 2; ++n) bv[bj][n] = *(const GAS f32x4*)(bias + (size_t)b9 * ldb + col0 + bj * 128 + 4 * n);
#pragma unroll
        for (int ai = 0; ai < 2; ++ai)
#pragma unroll
            for (int m = 0; m < 4; ++m) {
                const int lr = lrow0 + ai * 128 + wr * 64 + m * 16 + fr;
                const float rs = rsqrtf(((const GAS float*)ssq)[row_off + lr] * (1.0f / 1024.0f) + EPS);
                GAS bf16_t* rowp = (GAS bf16_t*)O + (size_t)lr * ldc + col0;
#pragma unroll
                for (int bj = 0; bj < 2; ++bj) {
                    const f32x4 v0 = acc[ai][bj][m][0] * rs + bv[bj][0], v1 = acc[ai][bj][m][1] * rs + bv[bj][1];
                    u32x4 w; w.x = pk2(v0[0], v0[1]); w.y = pk2(v0[2], v0[3]); w.z = pk2(v1[0], v1[1]); w.w = pk2(v1[2], v1[3]);
                    *(GAS u32x4*)(rowp + bj * 128) = w;
                }
            }
    }
};
struct EpiRes {
    static constexpr bool PERM = false, AFTER_DRAIN = false;
    const float* xold_c; const float* xold_l;
    float* X;
    const float* gate;
    const float* g; const float* scale;
    bf16_t* XS; float* ssq; int row_off;
    DEV void operator()(const f32x4 (&acc)[2][2][4][2], const pg8::Unit& u, int wr, int wc, int fr, int fq) const {
        const int row0 = row_off + u.pm * 256, b9 = row_b9(row0);
        const int col0 = u.pn * 256 + wc * 32 + 4 * fq;
        f32x4 gv[2][2], gs[2][2];
#pragma unroll
        for (int bj = 0; bj < 2; ++bj)
#pragma unroll
            for (int n = 0; n < 2; ++n) {
                const int c = col0 + bj * 128 + n * 16;
                gv[bj][n] = *(const GAS f32x4*)(gate + (size_t)b9 * 6144 + c);
                if (g) { const f32x4 gg = *(const GAS f32x4*)(g + c), sc = *(const GAS f32x4*)(scale + (size_t)b9 * 6144 + c); gs[bj][n] = gg * (sc + 1.0f); }
                else gs[bj][n] = (f32x4){0.f, 0.f, 0.f, 0.f};
            }
        const float* xo = (row0 < NCTX) ? xold_c : (xold_l - (size_t)NCTX * DM);
#pragma unroll
        for (int ai = 0; ai < 2; ++ai)
#pragma unroll
            for (int m = 0; m < 4; ++m) {
                const int r = row0 + ai * 128 + wr * 64 + m * 16 + fr;
                float ss = 0.f;
#pragma unroll
                for (int bj = 0; bj < 2; ++bj)
#pragma unroll
                    for (int n = 0; n < 2; ++n) {
                        const size_t off = (size_t)r * DM + col0 + bj * 128 + n * 16;
                        const f32x4 xv = *(const GAS f32x4*)(xo + off);
                        const f32x4 xn = xv + gv[bj][n] * acc[ai][bj][m][n];
                        *(GAS f32x4*)(X + off) = xn;
                        ss += (xn[0] * xn[0] + xn[1] * xn[1]) + (xn[2] * xn[2] + xn[3] * xn[3]);
                        if (g) { const f32x4 y = xn * gs[bj][n]; u32x2 w; w.x = pk2(y[0], y[1]); w.y = pk2(y[2], y[3]); *(GAS u32x2*)(XS + off) = w; }
                    }
                ss += __shfl_xor(ss, 16); ss += __shfl_xor(ss, 32);
                if (fq == 0) unsafeAtomicAdd(ssq + r, ss);
            }
    }
};
struct EpiF {
    static constexpr bool PERM = true, AFTER_DRAIN = false;
    bf16_t* OB; int rowbase; int nseq;
    DEV void operator()(const f32x4 (&acc)[2][2][4][2], const pg8::Unit& u, int wr, int wc, int fr, int fq) const {
        const int col0 = 768 + wc * 32 + 8 * fq;
#pragma unroll
        for (int ai = 0; ai < 2; ++ai)
#pragma unroll
            for (int m = 0; m < 4; ++m) {
                const int np = u.pm * 256 + ai * 128 + wr * 64 + m * 16 + fr;
                GAS bf16_t* rowp = (GAS bf16_t*)OB + (size_t)(rowbase + u.pn * nseq + np) * DM + col0;
#pragma unroll
                for (int bj = 0; bj < 2; ++bj) {
                    const f32x4 v0 = acc[ai][bj][m][0], v1 = acc[ai][bj][m][1];
                    u32x4 w; w.x = pk2(v0[0], v0[1]); w.y = pk2(v0[2], v0[3]); w.z = pk2(v1[0], v1[1]); w.w = pk2(v1[2], v1[3]);
                    *(GAS u32x4*)(rowp + bj * 128) = w;
                }
            }
    }
};


struct FfnOrder {
    pg8::StaticOrder S;
    __device__ void init(int G, int c) { S.init(104 * 256, UPC, G, c); }
    __device__ bool next(int i, pg8::Unit& u) const { return S.next(i, u); }
    DEV int arow(const pg8::Unit& u) const { if (u.pm < 32) return u.pm * 256; const int t = u.pm - 32, b = t / 9, j = t - 9 * b; return NCTX + 2048 * b + (j < 8 ? 254 * j : 1792); }
    DEV void a_ready(const pg8::Unit&) const {}
    DEV void done(const pg8::Unit&) const {}
};
DEV float dpp_ror1(float x) { const int xi = __builtin_bit_cast(int, x); return __builtin_bit_cast(float, __builtin_amdgcn_update_dpp(xi, xi, 0x121, 0xF, 0xF, false)); }
DEV float dpp_rol1(float x) { const int xi = __builtin_bit_cast(int, x); return __builtin_bit_cast(float, __builtin_amdgcn_update_dpp(xi, xi, 0x12F, 0xF, 0xF, false)); }
constexpr int LDS_HALO = LDS_MISC + 1024;
constexpr int LDS_WCV = LDS_HALO + 8192;
struct EpiFfn {
    static constexpr bool PERM = true, AFTER_DRAIN = false;
    bf16_t* ACT; const float* ssq; const float* bias; const float* wconv; LAS unsigned char* lds;
    DEV void operator()(const f32x4 (&acc)[2][2][4][2], const pg8::Unit& un, int wr, int wc, int fr_, int fq_) const {
        int tl_ = threadIdx.x; asm volatile("" : "+v"(tl_));
        const int fr = tl_ & 15, fq = (tl_ >> 4) & 3; (void)fr_; (void)fq_;
        int arow, lo, hi;
        if (un.pm < 32) { arow = un.pm * 256; lo = 0; hi = 255; }
        else { const int t = un.pm - 32, b = t / 9, j = t - 9 * b; arow = NCTX + 2048 * b + (j < 8 ? 254 * j : 1792);
               lo = (j == 0) ? 0 : (j < 8 ? 1 : 241); hi = (j < 8) ? 254 : 255; }
        const int b9 = row_b9(arow);
        const int cw = wc * 32 + 8 * fq;
        LAS unsigned char* hb = lds + LDS_HALO + wr * 2048 + cw * 4;
        LAS unsigned char* wb = lds + LDS_WCV + cw * 4;
        { const int tl = (wr * 4 + wc) * 64 + fq * 16 + fr;
          if (tl < 256) { const int tap = tl >> 6, r = tl & 63, bj = r >> 5, c4 = (r & 31) * 4;
              const GAS float* src = (tap < 3) ? ((const GAS float*)wconv + (size_t)tap * UPC) : ((const GAS float*)bias + (size_t)b9 * UPC);
              *(LAS f32x4*)(lds + LDS_WCV + tap * 1024 + bj * 512 + c4 * 4) = *(const GAS f32x4*)(src + (bj ? DFF : 0) + un.pn * 128 + c4); } }
        f32x4 u[2][2][4][2];
#pragma unroll
        for (int ai = 0; ai < 2; ++ai)
#pragma unroll
            for (int m = 0; m < 4; ++m) {
                const int R = ai * 128 + wr * 64 + m * 16 + fr;
                const float rs = __builtin_amdgcn_rsqf(((const GAS float*)ssq)[arow + R] * (1.0f / 1024.0f) + EPS);
#pragma unroll
                for (int bj = 0; bj < 2; ++bj)
#pragma unroll
                    for (int n = 0; n < 2; ++n) u[ai][bj][m][n] = acc[ai][bj][m][n] * rs;
            }
        if (fr == 0) {
#pragma unroll
            for (int ai = 0; ai < 2; ++ai)
#pragma unroll
                for (int bj = 0; bj < 2; ++bj)
#pragma unroll
                    for (int n = 0; n < 2; ++n) *(LAS f32x4*)(hb + ai * 4096 + bj * 512 + n * 16) = u[ai][bj][0][n];
        }
        if (fr == 15) {
#pragma unroll
            for (int ai = 0; ai < 2; ++ai)
#pragma unroll
                for (int bj = 0; bj < 2; ++bj)
#pragma unroll
                    for (int n = 0; n < 2; ++n) *(LAS f32x4*)(hb + ai * 4096 + 1024 + bj * 512 + n * 16) = u[ai][bj][3][n];
        }
        asm volatile("s_waitcnt lgkmcnt(0)\n\ts_barrier" ::: "memory");
        __builtin_amdgcn_sched_barrier(0);
        const bool f15 = (fr == 15), f0 = (fr == 0);
#pragma unroll
        for (int ai = 0; ai < 2; ++ai)
#pragma unroll
            for (int n = 0; n < 2; ++n) {
                const int q = 2 * ai + wr;
                f32x4 cg[4], cv[4];
#pragma unroll
                for (int bj = 0; bj < 2; ++bj) {
                    const f32x4 w0 = *(const LAS f32x4*)(wb + bj * 512 + n * 16), w1 = *(const LAS f32x4*)(wb + 1024 + bj * 512 + n * 16), w2 = *(const LAS f32x4*)(wb + 2048 + bj * 512 + n * 16);
                    const f32x4 bb = *(const LAS f32x4*)(wb + 3072 + bj * 512 + n * 16);
                    f32x4 hup = *(const LAS f32x4*)(hb + ai * 4096 + (q > 0 ? -1024 : 0) + bj * 512 + n * 16);
                    f32x4 hdn = *(const LAS f32x4*)(hb + ai * 4096 + (q < 3 ? 2048 : 0) + bj * 512 + n * 16);
                    hup = (q > 0) ? (hup + bb) : (f32x4){0.f, 0.f, 0.f, 0.f};
                    hdn = (q < 3) ? (hdn + bb) : (f32x4){0.f, 0.f, 0.f, 0.f};
                    f32x4 ub[4];
#pragma unroll
                    for (int m = 0; m < 4; ++m) ub[m] = u[ai][bj][m][n] + bb;
#pragma unroll
                    for (int m = 0; m < 4; ++m)
#pragma unroll
                        for (int e = 0; e < 4; ++e) {
                            const float cur = ub[m][e];
                            const float pu = (m == 0) ? hup[e] : ub[m == 0 ? 0 : m - 1][e];
                            const float pd = (m == 3) ? hdn[e] : ub[m == 3 ? 3 : m + 1][e];
                            const float up = dpp_ror1(f15 ? pu : cur), dn = dpp_rol1(f0 ? pd : cur);
                            const float r = w0[e] * up + w1[e] * cur + w2[e] * dn;
                            if (bj == 0) cg[m][e] = r; else cv[m][e] = r;
                        }
                }
                int tl2 = tl_; asm volatile("" : "+v"(tl2));
                GAS bf16_t* ap = (GAS bf16_t*)ACT + (size_t)(arow + wr * 64 + (tl2 & 15)) * DFF + un.pn * 128 + wc * 32 + 8 * ((tl2 >> 4) & 3);
#pragma unroll
                for (int m = 0; m < 4; ++m) {
                    const int R = ai * 128 + wr * 64 + m * 16 + fr;
                    float o[4];
#pragma unroll
                    for (int e = 0; e < 4; ++e) { const float g = cg[m][e]; o[e] = g * __builtin_amdgcn_rcpf(1.0f + __expf(-g)) * cv[m][e]; }
                    u32x2 w; w.x = pk2(o[0], o[1]); w.y = pk2(o[2], o[3]);
                    if (R >= lo && R <= hi) *(GAS u32x2*)(ap + (size_t)(ai * 128 + m * 16) * DFF + 4 * n) = w;
                }
                __builtin_amdgcn_sched_barrier(0);
            }
    }
};

DEV void transpose_item(const float* W, int K, int N, bf16_t* WT, int row_off, LAS float* scr, int item, int lane, bool perm_up = false) {
    const int nblk = N / 32, kb = item / nblk, nb = item % nblk, k0 = 64 * kb, n0 = 32 * nb;
    const int d0 = perm_up ? (((n0 % DFF) >> 7) * 256 + ((n0 >= DFF) ? 128 : 0) + ((n0 % DFF) & 127)) : (row_off + n0);
#pragma unroll 8
    for (int i = 0; i < 32; ++i) { const int kk = 2 * i + (lane >> 5); scr[kk * 33 + (lane & 31)] = W[(size_t)(k0 + kk) * N + n0 + (lane & 31)]; }
    asm volatile("s_waitcnt lgkmcnt(0)" ::: "memory");
    const int c = lane & 7;
#pragma unroll
    for (int j = 0; j < 4; ++j) { const int n = (lane >> 3) + 8 * j; const LAS float* s = scr + (8 * c) * 33 + n;
        u32x4 o; o.x = pk2(s[0 * 33], s[1 * 33]); o.y = pk2(s[2 * 33], s[3 * 33]); o.z = pk2(s[4 * 33], s[5 * 33]); o.w = pk2(s[6 * 33], s[7 * 33]);
        *(u32x4*)(WT + (size_t)(d0 + n) * K + k0 + 8 * c) = o; }
    asm volatile("s_waitcnt lgkmcnt(0)" ::: "memory");
}
DEV void convert_weights(const Args& a, LAS unsigned char* lds, int l, int mask, int gw, int NGW, int wave, int lane) {
    LAS float* scr = (LAS float*)(lds + wave * 16384);
    unsigned char* ws = a.ws;
    const int n_in = (mask & 1) ? 16 * 67 : 0, n_uk = (mask & 2) ? 2 * 12 : 0, n_out = (mask & 4) ? 16 * 32 : 0, n_up = (mask & 8) ? 16 * 176 : 0, n_dn = (mask & 16) ? 44 * 32 : 0;
    const int total = n_in + 2 * n_uk + n_out + n_up + n_dn;
    for (int it = gw; it < total; it += NGW) {
        int r = it;
        if (r < n_in) { transpose_item(a.in[I_WIN] + (size_t)l * DM * INC, DM, INC, (bf16_t*)(ws + WS_WIN), 0, scr, r, lane); continue; } r -= n_in;
        if (r < n_uk) { transpose_item(a.in[I_WUK] + (size_t)l * 128 * 384, 128, 384, (bf16_t*)(ws + WS_WUKV), 0, scr, r, lane); continue; } r -= n_uk;
        if (r < n_uk) { transpose_item(a.in[I_WUV] + (size_t)l * 128 * 384, 128, 384, (bf16_t*)(ws + WS_WUKV), 384, scr, r, lane); continue; } r -= n_uk;
        if (r < n_out) { transpose_item(a.in[I_WOUT] + (size_t)l * DM * DM, DM, DM, (bf16_t*)(ws + WS_WOUT), 0, scr, r, lane); continue; } r -= n_out;
        if (r < n_up) { transpose_item(a.in[I_WUP] + (size_t)l * DM * UPC, DM, UPC, (bf16_t*)(ws + WS_WUP), 0, scr, r, lane, true); continue; } r -= n_up;
        transpose_item(a.in[I_WDOWN] + (size_t)l * DFF * DM, DFF, DM, (bf16_t*)(ws + WS_WDN), 0, scr, r, lane);
    }
}
DEV void gemv9_item(LAS float* vec, LAS float* red, const float* W, int N, int ldw, const float* bias, float* out, int ldo, int n0, int tid) {
    const int w = tid >> 6, lane = tid & 63; const int n = n0 + lane; const bool valid = n < N;
    float acc0 = 0.f, acc1 = 0.f, acc2 = 0.f, acc3 = 0.f, acc4 = 0.f, acc5 = 0.f, acc6 = 0.f, acc7 = 0.f, acc8 = 0.f;
    const float* wp = W + (size_t)(128 * w) * ldw + (valid ? n : 0);
    const LAS float* vp = vec + 128 * w;
#pragma unroll 16
    for (int k = 0; k < 128; ++k) {
        const float wv = valid ? wp[(size_t)k * ldw] : 0.f;
        acc0 += vp[k] * wv; acc1 += vp[1024 + k] * wv; acc2 += vp[2048 + k] * wv; acc3 += vp[3072 + k] * wv; acc4 += vp[4096 + k] * wv;
        acc5 += vp[5120 + k] * wv; acc6 += vp[6144 + k] * wv; acc7 += vp[7168 + k] * wv; acc8 += vp[8192 + k] * wv;
    }
    LAS float* rp = red + (w * 9) * 64 + lane;
    rp[0] = acc0; rp[64] = acc1; rp[128] = acc2; rp[192] = acc3; rp[256] = acc4; rp[320] = acc5; rp[384] = acc6; rp[448] = acc7; rp[512] = acc8;
    __syncthreads();
    for (int idx = tid; idx < 576; idx += 512) {
        const int v = idx >> 6, ln = idx & 63; float s = 0.f;
#pragma unroll
        for (int ww = 0; ww < 8; ++ww) s += red[(ww * 9 + v) * 64 + ln];
        const int nn = n0 + ln;
        out[(size_t)v * ldo + nn] = s + ((bias && nn < N) ? bias[nn] : 0.f);
    }
    __syncthreads();
}
#define XB_TMO      128
#define XB_XCNT(j)  (256  + 64 * (j))
#define XB_XSUB(j)  (1280 + 64 * (j))
#define XB_XGEN(j)  (2304 + 64 * (j))
#define XB_TOP      3328
#define XB_TOPGEN   3392
#define XCD_BAR_WORDS 3456
#define XB_SPIN_CAP (1u << 18)

__device__ __forceinline__ unsigned xb_ld(unsigned* p)              { return __hip_atomic_load(p, __ATOMIC_RELAXED, __HIP_MEMORY_SCOPE_AGENT); }
__device__ __forceinline__ unsigned xb_add(unsigned* p, unsigned v) { return __hip_atomic_fetch_add(p, v, __ATOMIC_RELAXED, __HIP_MEMORY_SCOPE_AGENT); }
__device__ __forceinline__ unsigned xb_xcc_id() { return (unsigned)__builtin_amdgcn_s_getreg((3 << 11) | 20) & 0xFu; }
#define XB_SPIN(cond, bar) do { unsigned _sp = 0; while (cond) { __builtin_amdgcn_s_sleep(1); \
    if ((++_sp & 255u) == 0u) { if (xb_ld(&(bar)[XB_TMO])) break; if (_sp > XB_SPIN_CAP) { atomicAdd(&(bar)[XB_TMO], 1u); break; } } } } while (0)

struct XcdBarrier {
    unsigned* bar; unsigned x;
    volatile LAS unsigned* st;
};

__device__ __forceinline__ XcdBarrier xcd_barrier_post(unsigned* bar, volatile LAS unsigned* st) {
    XcdBarrier b; b.bar = bar; b.x = xb_xcc_id(); b.st = st;
    if (threadIdx.x == 0) (void)xb_add(&bar[XB_XCNT(b.x)], 1u);
    return b;
}
__device__ __forceinline__ void xcd_barrier_complete(unsigned* bar, unsigned x, unsigned& nloc, unsigned& nx) {
    const unsigned G = gridDim.x * gridDim.y * gridDim.z;
    unsigned sum, cnt, mine, sp = 0u;
    for (;;) {
        sum = 0u; cnt = 0u; mine = 0u;
#pragma unroll
        for (unsigned j = 0; j < 16; ++j) { const unsigned c = xb_ld(&bar[XB_XCNT(j)]); sum += c; cnt += (c > 0u) ? 1u : 0u; mine = (j == x) ? c : mine; }
        if (sum == G) break;
        __builtin_amdgcn_s_sleep(1);
        if ((++sp & 255u) == 0u) { if (xb_ld(&bar[XB_TMO])) break; if (sp > XB_SPIN_CAP) { atomicAdd(&bar[XB_TMO], 1u); break; } }
    }
    nloc = mine > 0u ? mine : 1u; nx = cnt > 0u ? cnt : 1u;
}

__device__ __forceinline__ void xcd_barrier(const XcdBarrier& b) {
    asm volatile("s_waitcnt vmcnt(0)" ::: "memory");
    __syncthreads();
    if (threadIdx.x == 0) {
        unsigned* bar = b.bar;
        __builtin_amdgcn_s_waitcnt(0);
        unsigned nloc = b.st[0], nx = b.st[1];
        if (nloc == 0u) { xcd_barrier_complete(bar, b.x, nloc, nx); b.st[0] = nloc; b.st[1] = nx; }
        const unsigned old = xb_add(&bar[XB_XSUB(b.x)], 1u);
        const unsigned gen = old / nloc;
        if (old + 1u == (gen + 1u) * nloc) {
            __builtin_amdgcn_fence(__ATOMIC_RELEASE, "agent");
            asm volatile("s_waitcnt vmcnt(0)" ::: "memory");
            const unsigned og = xb_add(&bar[XB_TOP], 1u);
            const unsigned tg = og / nx;
            if (og + 1u == (tg + 1u) * nx) xb_add(&bar[XB_TOPGEN], 1u);
            else XB_SPIN(xb_ld(&bar[XB_TOPGEN]) == tg, bar);
            __builtin_amdgcn_fence(__ATOMIC_ACQUIRE, "agent");
            xb_add(&bar[XB_XGEN(b.x)], 1u);
            asm volatile("s_waitcnt vmcnt(0)" ::: "memory");
        } else {
            XB_SPIN(xb_ld(&bar[XB_XGEN(b.x)]) == gen, bar);
            __builtin_amdgcn_fence(__ATOMIC_ACQUIRE, "agent");
            asm volatile("s_waitcnt vmcnt(0)" ::: "memory");
        }
    }
    __syncthreads();
}

constexpr int B_AROW = 272, B_VROW = 772, B_UROW = 528;
constexpr int B_LDS_A = 0, B_LDS_V = 64 * B_AROW, B_LDS_U = B_LDS_V + 64 * B_VROW, B_LDS_TAB = B_LDS_U + 64 * B_UROW;
static_assert(B_LDS_TAB + 4096 <= RING_BYTES, "phase B LDS");

DEV float rope1(float x, int dd, int t, const LAS f32x2* tab) {
    const float xp = __shfl_xor(x, 8);
    const int pos = (dd < 16) ? (t >> 6) : (t & 63);
    const f32x2 cs = tab[pos * 8 + (dd & 7)];
    return (dd & 8) ? (x * cs.x + xp * cs.y) : (x * cs.x - xp * cs.y);
}

DEV void phase_b(const Args& a, LAS unsigned char* lds, int l, int tid, int mode, int blk_start, int blk_stride, unsigned* qctr = nullptr) {
    unsigned char* ws = a.ws;
    const int wave = __builtin_amdgcn_readfirstlane(tid >> 6), lane = tid & 63, fr = lane & 15, fq = lane >> 4;
    const GAS bf16_t* P = (const GAS bf16_t*)(ws + WS_P);
    const GAS bf16_t* WUKV = (const GAS bf16_t*)(ws + WS_WUKV);
    const GAS bf16_t* CS64 = (const GAS bf16_t*)(ws + WS_CS64);
    GAS float* outg = (GAS float*)a.out;
    LAS f32x2* tab = (LAS f32x2*)(lds + B_LDS_TAB);
    {
        const int pos = tid >> 3, f = tid & 7;
        const float inv = __builtin_amdgcn_exp2f(-(float)f * (13.287712379549449f / 8.0f));
        const float ang = (float)pos * inv;
        tab[tid] = (f32x2){cosf(ang), sinf(ang)};
    }
    __syncthreads();
    const GAS float* gkv = (const GAS float*)a.in[I_GKV] + l * 128;
    LAS int* bslot = (LAS int*)(lds + LDS_MISC + 4);
    for (int blk = blk_start;; blk += blk_stride) {
        if (qctr) { if (tid == 0) *bslot = (int)atomicAdd(qctr, 1u); __syncthreads(); blk = *bslot; if (blk < 448) blk = (blk < 64) ? 384 + blk : blk - 64; }
        if (blk >= (mode == 0 ? 384 : 448)) break;
        int kind, r0 = 0, bidx, t0;
        if (blk < 128) { kind = 0; r0 = blk * 64; bidx = r0 >> 8; t0 = r0 & 255; }
        else if (blk < 384) { kind = 1; r0 = NCTX + (blk - 128) * 64; bidx = (r0 - NCTX) >> 11; t0 = (r0 - NCTX) & 2047; }
        else { kind = 2; const int cb = blk - 384; bidx = cb >> 3; t0 = 2048 + 64 * (cb & 7); }
        GAS bf16_t* KM; GAS bf16_t* KD; GAS bf16_t* VMt; GAS bf16_t* VDt; int vt_ld;
        if (kind == 0) { KM = (GAS bf16_t*)(ws + WS_KMC) + (size_t)(bidx * 256 + t0) * 576; KD = (GAS bf16_t*)(ws + WS_KDC) + (size_t)(bidx * 256 + t0) * 384;
                         VMt = (GAS bf16_t*)(ws + WS_VMC) + (size_t)bidx * 6 * 64 * 256 + t0; VDt = (GAS bf16_t*)(ws + WS_VDC) + (size_t)bidx * 6 * 64 * 256 + t0; vt_ld = 256; }
        else { KM = (GAS bf16_t*)(ws + WS_KML) + (size_t)(bidx * 2560 + t0) * 576; KD = (GAS bf16_t*)(ws + WS_KDL) + (size_t)(bidx * 2560 + t0) * 384;
               VMt = (GAS bf16_t*)(ws + WS_VML) + (size_t)bidx * 6 * 64 * 2560 + t0; VDt = (GAS bf16_t*)(ws + WS_VDL) + (size_t)bidx * 6 * 64 * 2560 + t0; vt_ld = 2560; }
        if (mode == 0) {
            for (int c = tid; c < 64 * 32; c += 512) { const int rr = c >> 5, e = c & 31;
                *(LAS u32x4*)(lds + B_LDS_U + rr * B_UROW + e * 16) = *(const GAS u32x4*)(P + (size_t)(r0 + rr) * INP + 1888 + 8 * e); }
            __syncthreads();
        } else {
        if (kind == 2) {
            for (int i = 0; i < 8; ++i) {
                const int rr = wave * 8 + i;
                const int j = (t0 - 2048) + rr;
                const size_t crow = ((size_t)(bidx * 4 + l)) * 512 + j;
                const f32x2 cv = *(const f32x2*)(a.in[I_CCKV] + crow * 128 + 2 * lane);
                *(LAS unsigned*)(lds + B_LDS_A + rr * B_AROW + lane * 4) = pk2(cv.x, cv.y);
                const float kr = a.in[I_CKROPE][crow * 32 + (lane & 31)];
                const bf16_t krb = f2bf(kr);
                { const int hb = (lane >> 5) * 3;
#pragma unroll
                  for (int h = 0; h < 3; ++h) KM[(size_t)rr * 576 + (hb + h) * 96 + 64 + (lane & 31)] = krb; }
#pragma unroll
                for (int q = 0; q < 6; ++q) {
                    KD[(size_t)rr * 384 + 64 * q + lane] = f2bf(a.in[I_CDK][crow * 384 + 64 * q + lane]);
                    *(LAS bf16_t*)(lds + B_LDS_V + rr * B_VROW + (64 * q + lane) * 2) = f2bf(a.in[I_CDV][crow * 384 + 64 * q + lane]);
                }
            }
        } else {
            const size_t obase = ((size_t)(bidx * 4 + l)) * 256 + t0;
#pragma unroll
            for (int it = 0; it < 2; ++it) {
                const int rr = (tid >> 4) + 32 * it, cj = tid & 15;
                const u32x4 w = *(const GAS u32x4*)(P + (size_t)(r0 + rr) * INP + 576 + 8 * cj);
                float x[8]; x[0] = bf2f(w.x & 0xffffu); x[1] = bf2f(w.x >> 16); x[2] = bf2f(w.y & 0xffffu); x[3] = bf2f(w.y >> 16);
                x[4] = bf2f(w.z & 0xffffu); x[5] = bf2f(w.z >> 16); x[6] = bf2f(w.w & 0xffffu); x[7] = bf2f(w.w >> 16);
                float ss = 0.f;
#pragma unroll
                for (int j = 0; j < 8; ++j) ss += x[j] * x[j];
                ss += __shfl_xor(ss, 1); ss += __shfl_xor(ss, 2); ss += __shfl_xor(ss, 4); ss += __shfl_xor(ss, 8);
                const float rs = rsqrtf(ss * (1.0f / 128.0f) + EPS);
                const f32x4 ga = *(const GAS f32x4*)(gkv + 8 * cj), gb = *(const GAS f32x4*)(gkv + 8 * cj + 4);
                x[0] *= rs * ga[0]; x[1] *= rs * ga[1]; x[2] *= rs * ga[2]; x[3] *= rs * ga[3]; x[4] *= rs * gb[0]; x[5] *= rs * gb[1]; x[6] *= rs * gb[2]; x[7] *= rs * gb[3];
                u32x4 o; o.x = pk2(x[0], x[1]); o.y = pk2(x[2], x[3]); o.z = pk2(x[4], x[5]); o.w = pk2(x[6], x[7]);
                *(LAS u32x4*)(lds + B_LDS_A + rr * B_AROW + cj * 16) = o;
                if (kind == 0) { GAS float* op = outg + OUT_CKV + (obase + rr) * 128 + 8 * cj; *(GAS f32x4*)op = (f32x4){x[0], x[1], x[2], x[3]}; *(GAS f32x4*)(op + 4) = (f32x4){x[4], x[5], x[6], x[7]}; }
            }
#pragma unroll 1
            for (int cb = 0; cb < 35; cb += 7) {
              u32x4 wv[7];
#pragma unroll
              for (int i = 0; i < 7; ++i) {
                const int c = tid + 512 * (cb + i); const int rr = c / 268, ch = c - rr * 268;
                const bool need = (c < 64 * 268) && (ch < 236) && !(ch >= 72 && ch < 88) && !(kind == 0 && (ch < 72 || (ch >= 92 && ch < 140)));
                wv[i] = (u32x4){0u, 0u, 0u, 0u};
                if (need) wv[i] = *(const GAS u32x4*)(P + (size_t)(r0 + rr) * INP + 8 * ch);
              }
#pragma unroll
              for (int i = 0; i < 7; ++i) {
                const int c = tid + 512 * (cb + i); const int rr = c / 268, ch = c - rr * 268;
                const bool need = (c < 64 * 268) && (ch < 236) && !(ch >= 72 && ch < 88) && !(kind == 0 && (ch < 72 || (ch >= 92 && ch < 140)));
                if (!need) continue;
                const int r = r0 + rr, t = t0 + rr;
                u32x4 w = wv[i];
                const bool ropeable = (ch < 72) ? ((ch % 12) >= 8) : (ch < 188);
                if (kind == 1 && ropeable) {
                    const int j = ch & 3;
                    const int pos = (j < 2) ? (t >> 6) : (t & 63);
                    float x[8]; x[0] = bf2f(w.x & 0xffffu); x[1] = bf2f(w.x >> 16); x[2] = bf2f(w.y & 0xffffu); x[3] = bf2f(w.y >> 16);
                    x[4] = bf2f(w.z & 0xffffu); x[5] = bf2f(w.z >> 16); x[6] = bf2f(w.w & 0xffffu); x[7] = bf2f(w.w >> 16);
                    const float sgn = (j & 1) ? 1.0f : -1.0f;
#pragma unroll
                    for (int i = 0; i < 8; ++i) {
                        const float xp = __builtin_bit_cast(float, __builtin_amdgcn_update_dpp(0, __builtin_bit_cast(int, x[i]), 0xB1, 0xF, 0xF, true));
                        const f32x2 cs = tab[pos * 8 + i];
                        x[i] = x[i] * cs.x + sgn * (xp * cs.y);
                    }
                    w.x = pk2(x[0], x[1]); w.y = pk2(x[2], x[3]); w.z = pk2(x[4], x[5]); w.w = pk2(x[6], x[7]);
                }
                if (ch < 72) { *(GAS u32x4*)((GAS bf16_t*)(ws + WS_QMR) + (size_t)(r - NCTX) * 576 + 8 * ch) = w; }
                else if (ch < 92) { const int j = ch - 88;
#pragma unroll
                    for (int h = 0; h < 6; ++h) *(GAS u32x4*)(KM + (size_t)rr * 576 + h * 96 + 64 + 8 * j) = w;
                    if (kind == 0) { GAS float* op = outg + OUT_KROPE + (obase + rr) * 32 + 8 * j;
                        *(GAS f32x4*)op = (f32x4){bf2f(w.x & 0xffffu), bf2f(w.x >> 16), bf2f(w.y & 0xffffu), bf2f(w.y >> 16)}; *(GAS f32x4*)(op + 4) = (f32x4){bf2f(w.z & 0xffffu), bf2f(w.z >> 16), bf2f(w.w & 0xffffu), bf2f(w.w >> 16)}; } }
                else if (ch < 140) { *(GAS u32x4*)((GAS bf16_t*)(ws + WS_QDR) + (size_t)(r - NCTX) * 384 + 8 * (ch - 92)) = w; }
                else if (ch < 188) { const int e = ch - 140; *(GAS u32x4*)(KD + (size_t)rr * 384 + 8 * e) = w;
                    if (kind == 0) { GAS float* op = outg + OUT_DK + (obase + rr) * 384 + 8 * e;
                        *(GAS f32x4*)op = (f32x4){bf2f(w.x & 0xffffu), bf2f(w.x >> 16), bf2f(w.y & 0xffffu), bf2f(w.y >> 16)}; *(GAS f32x4*)(op + 4) = (f32x4){bf2f(w.z & 0xffffu), bf2f(w.z >> 16), bf2f(w.w & 0xffffu), bf2f(w.w >> 16)}; } }
                else if (ch < 236) { const int e = ch - 188; LAS unsigned* vp = (LAS unsigned*)(lds + B_LDS_V + rr * B_VROW + e * 16); vp[0] = w.x; vp[1] = w.y; vp[2] = w.z; vp[3] = w.w;
                    if (kind == 0) { GAS float* op = outg + OUT_DV + (obase + rr) * 384 + 8 * e;
                        *(GAS f32x4*)op = (f32x4){bf2f(w.x & 0xffffu), bf2f(w.x >> 16), bf2f(w.y & 0xffffu), bf2f(w.y >> 16)}; *(GAS f32x4*)(op + 4) = (f32x4){bf2f(w.z & 0xffffu), bf2f(w.z >> 16), bf2f(w.w & 0xffffu), bf2f(w.w >> 16)}; } }
                else { *(LAS u32x4*)(lds + B_LDS_U + rr * B_UROW + (ch - 236) * 16) = w; }
              }
            }
        }
        bf16x8 bwa[6][4];
#pragma unroll
        for (int nt = 0; nt < 6; ++nt)
#pragma unroll
            for (int kk = 0; kk < 4; ++kk) bwa[nt][kk] = *(const GAS bf16x8*)(WUKV + (size_t)(96 * wave + 16 * nt + fr) * 128 + 32 * kk + 8 * fq);
        __syncthreads();
#pragma unroll
        for (int nt = 0; nt < 6; ++nt) {
            const int c0 = 96 * wave + 16 * nt;
            bf16x8 bw[4];
#pragma unroll
            for (int kk = 0; kk < 4; ++kk) bw[kk] = bwa[nt][kk];
#pragma unroll
            for (int mt = 0; mt < 4; ++mt) {
                f32x4 acc = {0.f, 0.f, 0.f, 0.f};
#pragma unroll
                for (int kk = 0; kk < 4; ++kk) {
                    const bf16x8 af = *(const LAS bf16x8*)(lds + B_LDS_A + (16 * mt + fr) * B_AROW + (32 * kk + 8 * fq) * 2);
                    acc = (wave < 4) ? mfma16(bw[kk], af, acc) : mfma16(af, bw[kk], acc);
                }
                u32x2 w; w.x = pk2(acc[0], acc[1]); w.y = pk2(acc[2], acc[3]);
                if (wave < 4) { const int h = c0 >> 6, d = (c0 & 63) + 4 * fq; *(GAS u32x2*)(KM + (size_t)(16 * mt + fr) * 576 + h * 96 + d) = w; }
                else { const int col = c0 - 384 + fr, h = col >> 6, dv = col & 63; *(GAS u32x2*)(VMt + (size_t)(h * 64 + dv) * vt_ld + 16 * mt + 4 * fq) = w; }
            }
        }
        }
        if (mode == 0) {
            const int g = wave >> 1, nseq = (kind == 0) ? 256 : 2048, ldk = 2 * nseq;
            GAS bf16_t* FB = (kind == 0) ? (GAS bf16_t*)(ws + WS_FBC) : (GAS bf16_t*)(ws + WS_FBL);
#pragma unroll 1
            for (int nt = 0; nt < 4; ++nt) {
                const int cc0 = 16 * ((wave & 1) * 4 + nt);
                bf16x8 bw[2];
#pragma unroll
                for (int kk = 0; kk < 2; ++kk) bw[kk] = *(const GAS bf16x8*)(CS64 + (size_t)(cc0 + fr) * 64 + 32 * kk + 8 * fq);
                const int cc = cc0 + fr, cp = cc & 63, koff = (cc >= 64) ? nseq : 0;
                GAS bf16_t* dst = FB + (size_t)(bidx * 256 + g * 64 + cp) * ldk + koff + (t0 & (nseq - 1));
#pragma unroll
                for (int mt = 0; mt < 4; ++mt) {
                    f32x4 acc = {0.f, 0.f, 0.f, 0.f};
#pragma unroll
                    for (int kk = 0; kk < 2; ++kk) {
                        const bf16x8 af = *(const LAS bf16x8*)(lds + B_LDS_U + (16 * mt + fr) * B_UROW + (64 * g + 32 * kk + 8 * fq) * 2);
                        acc = mfma16(af, bw[kk], acc);
                    }
                    u32x2 w; w.x = pk2(acc[0], acc[1]); w.y = pk2(acc[2], acc[3]);
                    *(GAS u32x2*)(dst + 16 * mt + 4 * fq) = w;
                }
            }
        }
        if (mode == 1)
#pragma unroll 4
        for (int q = 0; q < 48; ++q) {
            const int cr = 48 * wave + q;
            const bf16_t v = *(const LAS bf16_t*)(lds + B_LDS_V + lane * B_VROW + cr * 2);
            VDt[(size_t)cr * vt_ld + lane] = v;
        }
        __syncthreads();
    }
}

constexpr int AT_VROW = 136;
template <bool DIFF> struct AttnCfg {
    static constexpr int ND = DIFF ? 4 : 6;
    static constexpr int NM = DIFF ? 2 : 1;
    static constexpr int NDM = DIFF ? 2 : 6;
    static constexpr int KROW = DIFF ? 144 : 208;
    static constexpr int KT = 64 * KROW;
    static constexpr int CPR = 2 * ND;
    static constexpr int NKC = 64 * CPR;
};
constexpr int AT_LDS_K = 0, AT_LDS_V = 2 * 64 * 208, AT_LDS_SCR = AT_LDS_V + 2 * 64 * AT_VROW;
static_assert(AT_LDS_SCR + 2048 <= RING_BYTES, "attention LDS");

DEV float vmax3(float a, float b, float c) { float r; asm("v_max3_f32 %0, %1, %2, %3" : "=v"(r) : "v"(a), "v"(b), "v"(c)); return r; }
template <bool DIFF>
DEV void attn_unit(LAS unsigned char* lds, const bf16_t* Qa, int qa_ld, const bf16_t* Qb, int qb_ld, const bf16_t* Kp, int k_ld,
                   const bf16_t* Vt, int vt_ld, int nt_main, int nt_total, bf16_t* Oout, float cscale, float lam, const float* gsub, float subscale, int tid) {
    typedef AttnCfg<DIFF> C;
    const int wave = __builtin_amdgcn_readfirstlane(tid >> 6), lane = tid & 63, l31 = lane & 31, hi = lane >> 5;
    LAS float* scr = (LAS float*)(lds + AT_LDS_SCR) + wave * 64;
    const int kkey0 = tid / C::CPR, kpart0 = tid % C::CPR;
    const int kc1 = tid + 512; const bool has1 = kc1 < C::NKC; const int kkey1 = kc1 / C::CPR, kpart1 = kc1 % C::CPR;
    const int vdv = tid >> 3, vpart = tid & 7;
    const GAS bf16_t* kg0 = (const GAS bf16_t*)Kp + (size_t)kkey0 * k_ld + kpart0 * 8;
    const GAS bf16_t* kg1 = (const GAS bf16_t*)Kp + (size_t)kkey1 * k_ld + kpart1 * 8;
    const GAS bf16_t* vg = (const GAS bf16_t*)Vt + (size_t)vdv * vt_ld + vpart * 8;
    const int kl0 = kkey0 * C::KROW + kpart0 * 16, kl1 = kkey1 * C::KROW + kpart1 * 16, vl = vdv * AT_VROW + vpart * 16;
    u32x4 kr0, kr1 = {0, 0, 0, 0}, vr;
    bf16x8 qf[C::ND];
    { const GAS bf16_t* qp = (const GAS bf16_t*)Qa + (size_t)(32 * wave + l31) * qa_ld + 8 * hi;
#pragma unroll
      for (int d = 0; d < C::ND; ++d) qf[d] = *(const GAS bf16x8*)(qp + 16 * d); }
    kr0 = *(const GAS u32x4*)kg0; if (has1) kr1 = *(const GAS u32x4*)kg1; vr = *(const GAS u32x4*)vg;
    *(LAS u32x4*)(lds + AT_LDS_K + kl0) = kr0; if (has1) *(LAS u32x4*)(lds + AT_LDS_K + kl1) = kr1;
    *(LAS u32x2*)(lds + AT_LDS_V + vl) = (u32x2){vr.x, vr.y}; *(LAS u32x2*)(lds + AT_LDS_V + vl + 8) = (u32x2){vr.z, vr.w};
    __syncthreads();
    f32x16 O[C::NM][2];
    float mref[C::NM], lsum[C::NM];
#pragma unroll
    for (int mp = 0; mp < C::NM; ++mp) { mref[mp] = 0.f; lsum[mp] = 0.f;
#pragma unroll
        for (int r = 0; r < 16; ++r) { O[mp][0][r] = 0.f; O[mp][1][r] = 0.f; } }
#pragma unroll 1
    for (int t = 0; t < nt_total; ++t) {
        const int cur = t & 1;
        const bool more = (t + 1) < nt_total;
        if (more) {
            const size_t ko = (size_t)(t + 1) * 64 * k_ld;
            kr0 = *(const GAS u32x4*)(kg0 + ko); if (has1) kr1 = *(const GAS u32x4*)(kg1 + ko);
            vr = *(const GAS u32x4*)(vg + (t + 1) * 64);
        }
        if (t == nt_main) {
            const GAS bf16_t* qp = (const GAS bf16_t*)Qb + (size_t)(32 * wave + l31) * qb_ld + 8 * hi;
#pragma unroll
            for (int d = 0; d < C::ND; ++d) qf[d] = *(const GAS bf16x8*)(qp + 16 * d);
        }
        const LAS unsigned char* Kb = lds + AT_LDS_K + cur * C::KT;
        const LAS unsigned char* Vb = lds + AT_LDS_V + cur * (64 * AT_VROW);
        bf16x8 kf[2][C::NDM];
#pragma unroll
        for (int dd = 0; dd < C::NDM; ++dd) {
            kf[0][dd] = *(const LAS bf16x8*)(Kb + l31 * C::KROW + dd * 32 + hi * 16);
            kf[1][dd] = *(const LAS bf16x8*)(Kb + (32 + l31) * C::KROW + dd * 32 + hi * 16);
        }
        __builtin_amdgcn_sched_barrier(0);
        bf16x8 vf[4][2];
#pragma unroll
        for (int mp = 0; mp < C::NM; ++mp) {
            f32x16 s0, s1;
#pragma unroll
            for (int r = 0; r < 16; ++r) { s0[r] = 0.f; s1[r] = 0.f; }
#pragma unroll
            for (int dd = 0; dd < C::NDM; ++dd) {
                s0 = mfma32(kf[0][dd], qf[mp * C::NDM + dd], s0); s1 = mfma32(kf[1][dd], qf[mp * C::NDM + dd], s1);
            }
            __builtin_amdgcn_sched_barrier(0);
            if (mp == 0) {
#pragma unroll
                for (int j = 0; j < 4; ++j)
#pragma unroll
                    for (int db = 0; db < 2; ++db) {
                        const LAS unsigned char* vp = Vb + (32 * db + l31) * AT_VROW + (32 * (j >> 1) + 16 * (j & 1) + 4 * hi) * 2;
                        const s16x4 lo = *(const LAS s16x4*)vp, hh = *(const LAS s16x4*)(vp + 16);
                        vf[j][db] = (bf16x8){lo[0], lo[1], lo[2], lo[3], hh[0], hh[1], hh[2], hh[3]};
                    }
                if (C::NM > 1) {
#pragma unroll
                    for (int dd = 0; dd < C::NDM; ++dd) {
                        kf[0][dd] = *(const LAS bf16x8*)(Kb + l31 * C::KROW + (C::NDM + dd) * 32 + hi * 16);
                        kf[1][dd] = *(const LAS bf16x8*)(Kb + (32 + l31) * C::KROW + (C::NDM + dd) * 32 + hi * 16);
                    }
                }
                __builtin_amdgcn_sched_barrier(0);
            }
            float ma = vmax3(s0[0], s0[1], s1[0]), mb = vmax3(s0[2], s0[3], s1[1]); ma = vmax3(ma, s1[2], s1[3]);
#pragma unroll
            for (int r = 4; r < 16; r += 4) { ma = vmax3(ma, s0[r], s0[r + 1]); mb = vmax3(mb, s0[r + 2], s0[r + 3]); ma = vmax3(ma, s1[r], s1[r + 1]); mb = vmax3(mb, s1[r + 2], s1[r + 3]); }
            float mx = vmax3(ma, mb, mb);
            mx = vmax3(mx, __shfl_xor(mx, 32), mx);
            const float rm = mx * cscale;
            if (t == 0) mref[mp] = rm;
            else if (__any(rm > mref[mp] + 8.0f)) {
                const float mnew = vmax3(mref[mp], rm, rm);
                const float alpha = __builtin_amdgcn_exp2f(mref[mp] - mnew);
                lsum[mp] *= alpha; mref[mp] = mnew;
                if (hi == 0) scr[l31] = alpha;
                asm volatile("s_waitcnt lgkmcnt(0)" ::: "memory");
#pragma unroll
                for (int g4 = 0; g4 < 4; ++g4) { const f32x4 a4 = *(const LAS f32x4*)(scr + 8 * g4 + 4 * hi);
#pragma unroll
                    for (int j = 0; j < 4; ++j) { O[mp][0][4 * g4 + j] *= a4[j]; O[mp][1][4 * g4 + j] *= a4[j]; } }
                asm volatile("s_waitcnt lgkmcnt(0)" ::: "memory");
            }
            const float nm = -mref[mp];
            float ls = 0.f;
#pragma unroll
            for (int r = 0; r < 16; ++r) { s0[r] = __builtin_amdgcn_exp2f(fmaf(s0[r], cscale, nm)); s1[r] = __builtin_amdgcn_exp2f(fmaf(s1[r], cscale, nm)); ls += s0[r] + s1[r]; }
            lsum[mp] += ls;
            bf16x8 pa[4];
#pragma unroll
            for (int j = 0; j < 4; ++j) {
                u32x4 w;
                if (j < 2) { w.x = pk2(s0[8 * j], s0[8 * j + 1]); w.y = pk2(s0[8 * j + 2], s0[8 * j + 3]); w.z = pk2(s0[8 * j + 4], s0[8 * j + 5]); w.w = pk2(s0[8 * j + 6], s0[8 * j + 7]); }
                else { const int jj = j - 2; w.x = pk2(s1[8 * jj], s1[8 * jj + 1]); w.y = pk2(s1[8 * jj + 2], s1[8 * jj + 3]); w.z = pk2(s1[8 * jj + 4], s1[8 * jj + 5]); w.w = pk2(s1[8 * jj + 6], s1[8 * jj + 7]); }
                pa[j] = __builtin_bit_cast(bf16x8, w);
            }
#pragma unroll
            for (int j = 0; j < 4; ++j)
#pragma unroll
                for (int db = 0; db < 2; ++db) O[mp][db] = mfma32(pa[j], vf[j][db], O[mp][db]);
        }
        if (more) {
            const int nb = cur ^ 1;
            *(LAS u32x4*)(lds + AT_LDS_K + nb * C::KT + kl0) = kr0; if (has1) *(LAS u32x4*)(lds + AT_LDS_K + nb * C::KT + kl1) = kr1;
            *(LAS u32x2*)(lds + AT_LDS_V + nb * (64 * AT_VROW) + vl) = (u32x2){vr.x, vr.y}; *(LAS u32x2*)(lds + AT_LDS_V + nb * (64 * AT_VROW) + vl + 8) = (u32x2){vr.z, vr.w};
        }
        __syncthreads();
    }
    float inv[C::NM][16];
#pragma unroll
    for (int mp = 0; mp < C::NM; ++mp) {
        float lt = lsum[mp]; lt += __shfl_xor(lt, 32);
        if (hi == 0) scr[l31] = 1.0f / lt;
        asm volatile("s_waitcnt lgkmcnt(0)" ::: "memory");
#pragma unroll
        for (int g4 = 0; g4 < 4; ++g4) { const f32x4 a4 = *(const LAS f32x4*)(scr + 8 * g4 + 4 * hi);
#pragma unroll
            for (int j = 0; j < 4; ++j) inv[mp][4 * g4 + j] = a4[j]; }
        asm volatile("s_waitcnt lgkmcnt(0)" ::: "memory");
    }
    GAS bf16_t* ow = (GAS bf16_t*)Oout + (size_t)(32 * wave) * DM;
    if constexpr (!DIFF) {
#pragma unroll
        for (int r = 0; r < 16; ++r) { const int q = (r & 3) + 8 * (r >> 2) + 4 * hi;
#pragma unroll
            for (int db = 0; db < 2; ++db) ow[(size_t)q * DM + 32 * db + l31] = f2bf(O[0][db][r] * inv[0][r]); }
    } else {
        const float gs0 = ((const GAS float*)gsub)[l31] * subscale, gs1 = ((const GAS float*)gsub)[32 + l31] * subscale;
#pragma unroll
        for (int r = 0; r < 16; ++r) { const int q = (r & 3) + 8 * (r >> 2) + 4 * hi;
            const float o0 = O[0][0][r] * inv[0][r] - lam * (O[1][0][r] * inv[1][r]);
            const float o1 = O[0][1][r] * inv[0][r] - lam * (O[1][1][r] * inv[1][r]);
            float ss = o0 * o0 + o1 * o1;
#pragma unroll
            for (int o = 1; o < 32; o <<= 1) ss += __shfl_xor(ss, o);
            const float rs = rsqrtf(ss * (1.0f / 64.0f) + EPS);
            ow[(size_t)q * DM + l31] = f2bf(o0 * rs * gs0); ow[(size_t)q * DM + 32 + l31] = f2bf(o1 * rs * gs1); }
    }
}

DEV void load8(const GAS bf16_t* p, float (&v)[8]) {
    const u32x4 w = *(const GAS u32x4*)p;
    v[0] = bf2f(w.x & 0xffffu); v[1] = bf2f(w.x >> 16); v[2] = bf2f(w.y & 0xffffu); v[3] = bf2f(w.y >> 16);
    v[4] = bf2f(w.z & 0xffffu); v[5] = bf2f(w.z >> 16); v[6] = bf2f(w.w & 0xffffu); v[7] = bf2f(w.w >> 16);
}
DEV void phase_f(const Args& a, int l, int nrows, int seqlen, int tid) {
    const GAS bf16_t* U = (const GAS bf16_t*)(a.ws + WS_U);
    GAS bf16_t* ACT = (GAS bf16_t*)(a.ws + WS_ACT);
    const GAS float* wc = (const GAS float*)a.in[I_WCONV] + (size_t)l * 3 * UPC;
    const int nitems = (nrows / 8) * 352;
    for (int it = blockIdx.x * 512 + tid; it < nitems; it += gridDim.x * 512) {
        const int rb = it / 352, j8 = it - rb * 352, r0 = rb * 8, c0 = j8 * 8;
        float wg[3][8], wv[3][8];
#pragma unroll
        for (int k = 0; k < 3; ++k) {
            const f32x4 g0 = *(const GAS f32x4*)(wc + k * UPC + c0), g1 = *(const GAS f32x4*)(wc + k * UPC + c0 + 4);
            const f32x4 v0 = *(const GAS f32x4*)(wc + k * UPC + DFF + c0), v1 = *(const GAS f32x4*)(wc + k * UPC + DFF + c0 + 4);
#pragma unroll
            for (int j = 0; j < 4; ++j) { wg[k][j] = g0[j]; wg[k][4 + j] = g1[j]; wv[k][j] = v0[j]; wv[k][4 + j] = v1[j]; }
        }
        float pg[8], pv[8], cg_[8], cv[8], ng[8], nv[8];
        const bool hasp = (r0 % seqlen) != 0, hasn = ((r0 + 8) % seqlen) != 0;
        if (hasp) { load8(U + (size_t)(r0 - 1) * UPC + c0, pg); load8(U + (size_t)(r0 - 1) * UPC + DFF + c0, pv); }
        else {
#pragma unroll
            for (int j = 0; j < 8; ++j) { pg[j] = 0.f; pv[j] = 0.f; } }
        load8(U + (size_t)r0 * UPC + c0, cg_); load8(U + (size_t)r0 * UPC + DFF + c0, cv);
#pragma unroll
        for (int i = 0; i < 8; ++i) {
            const int r = r0 + i;
            if (i < 7 || hasn) { load8(U + (size_t)(r + 1) * UPC + c0, ng); load8(U + (size_t)(r + 1) * UPC + DFF + c0, nv); }
            else {
#pragma unroll
                for (int j = 0; j < 8; ++j) { ng[j] = 0.f; nv[j] = 0.f; } }
            float o[8];
#pragma unroll
            for (int j = 0; j < 8; ++j) {
                const float gt = wg[0][j] * pg[j] + wg[1][j] * cg_[j] + wg[2][j] * ng[j];
                const float vl = wv[0][j] * pv[j] + wv[1][j] * cv[j] + wv[2][j] * nv[j];
                const float sg = gt * __builtin_amdgcn_rcpf(1.0f + __expf(-gt));
                o[j] = sg * vl;
            }
            u32x4 w; w.x = pk2(o[0], o[1]); w.y = pk2(o[2], o[3]); w.z = pk2(o[4], o[5]); w.w = pk2(o[6], o[7]);
            *(GAS u32x4*)(ACT + (size_t)r * DFF + c0) = w;
#pragma unroll
            for (int j = 0; j < 8; ++j) { pg[j] = cg_[j]; pv[j] = cv[j]; cg_[j] = ng[j]; cv[j] = nv[j]; }
        }
    }
}

struct ShiftOrder {
    pg8::StaticOrder S;
    __device__ void init(int M, int N, int G, int c) { S.init(M, N, G, c); }
    __device__ bool next(int i, pg8::Unit& u) const { return S.next(i, u); }
    DEV void a_ready(const pg8::Unit&) const {}
    DEV void done(const pg8::Unit&) const {}
};

#ifndef NREP_SYNC
#define NREP_SYNC 1
#endif
#ifndef NREP_P
#define NREP_P 1
#endif
#ifndef NREP_A
#define NREP_A 1
#endif
#ifndef NREP_B1
#define NREP_B1 1
#endif
#ifndef NREP_B
#define NREP_B 1
#endif
#ifndef NREP_C
#define NREP_C 1
#endif
#ifndef NREP_E
#define NREP_E 1
#endif
#ifndef NREP_F
#define NREP_F 1
#endif
__global__ void __launch_bounds__(512, 2) mega_fwd(Args a) {
    extern __shared__ __attribute__((aligned(16))) unsigned char lds_raw[];
    LAS unsigned char* lds = (LAS unsigned char*)lds_raw;
    cg::grid_group grid = cg::this_grid();
    const int G = gridDim.x, bid = blockIdx.x;
#define PH_LOCALS \
    unsigned char* ws = a.ws; asm volatile("" : "+s"(ws)); \
    int tid = threadIdx.x; asm volatile("" : "+v"(tid)); \
    const int lane = tid & 63, wave = __builtin_amdgcn_readfirstlane(tid >> 6); \
    const int gw = bid * 8 + wave, NGW = G * 8, gt = bid * 512 + tid, NGT = G * 512; \
    float* MOD = (float*)(ws + WS_MOD); float* BIN = (float*)(ws + WS_BIN); float* BUP = (float*)(ws + WS_BUP); float* SSQ = (float*)(ws + WS_SSQ); \
    bf16_t* XS = (bf16_t*)(ws + WS_XS); bf16_t* Pb = (bf16_t*)(ws + WS_P); bf16_t* OB = (bf16_t*)(ws + WS_OB); \
    unsigned* CTL = (unsigned*)(ws + WS_CTL); \
    (void)lane; (void)wave; (void)gw; (void)NGW; (void)gt; (void)NGT; (void)MOD; (void)BIN; (void)BUP; (void)SSQ; (void)XS; (void)Pb; (void)OB; (void)CTL;
    const bool one = (a.ph_hi - a.ph_lo) > 1;
    for (int i = threadIdx.x; i < 4096; i += 512) ((LAS unsigned*)(lds + LDS_MISC))[i] = 0u;
    __syncthreads();
    XcdBarrier xbar; xbar.bar = (unsigned*)(a.ws + WS_CTL) + 16384; xbar.x = 0; xbar.st = nullptr;
    if (one) xbar = xcd_barrier_post((unsigned*)(a.ws + WS_CTL) + 16384, (volatile LAS unsigned*)(lds + LDS_MISC + 32));
    int ph = 0;
#define PH_BEGIN if (ph >= a.ph_lo && ph < a.ph_hi) { PH_LOCALS
#define PH_END   if (one && ph + 1 < a.ph_hi) { if (ph == 0) grid.sync(); else { for (int rs_ = 0; rs_ < NREP_SYNC; ++rs_) xcd_barrier(xbar); } } } ++ph;

    PH_BEGIN
#ifndef SKIP_P0
    for (int rep = 0; rep < NREP_P; ++rep) {
        LAS float* vec = (LAS float*)lds; LAS float* red = (LAS float*)(lds + 36864);
        for (int i = tid; i < 9216; i += 512) { const int v = i >> 10, k = i & 1023; const float x = (v == 0) ? a.in[I_CCTX][k] : a.in[I_C][(v - 1) * 1024 + k]; vec[i] = x / (1.0f + __expf(-x)); }
        __syncthreads();
        for (int it = bid; it < 4 * 96; it += G) { const int l = it / 96, nb = it % 96;
            gemv9_item(vec, red, a.in[I_WADA] + (size_t)l * DM * 6144, 6144, 6144, a.in[I_BADA] + l * 6144, MOD + (size_t)l * 9 * 6144, 6144, nb * 64, tid); }
        __syncthreads();
        convert_weights(a, lds, 0, 31, gw, NGW, wave, lane);
        for (int i = gt; i < 9 * MTOT; i += NGT) SSQ[i] = 0.f;
        for (int i = gt; i < 1024; i += NGT) CTL[i] = 0u;
        { unsigned* padp = (unsigned*)(ws + WS_WIN + (size_t)INC * DM * 2); for (int i = gt; i < (INP - INC) * DM / 2; i += NGT) padp[i] = 0u; }
        { bf16_t* T = (bf16_t*)(ws + WS_TLAT);
          for (int i = gt; i < 2048 * 4096; i += NGT) { const int np = i >> 12, k = i & 4095, n = k & 2047; const int m = (np * n) & 2047; const float x = (float)m * (1.0f / 1024.0f);
              const float v = (k < 2048) ? cospif(x) : -sinpif(x); T[i] = f2bf(v * 0.02209708691207961f); } }
        { bf16_t* T = (bf16_t*)(ws + WS_TCTX);
          for (int i = gt; i < 256 * 512; i += NGT) { const int np = i >> 9, k = i & 511, n = k & 255; const int m = (np * n) & 255; const float x = (float)m * (1.0f / 128.0f);
              const float v = (k < 256) ? cospif(x) : -sinpif(x); T[i] = f2bf(v * 0.0625f); } }
        { bf16_t* T = (bf16_t*)(ws + WS_CS64);
          for (int i = gt; i < 128 * 64; i += NGT) { const int cc = i >> 6, c = i & 63, cp = cc & 63; const int m = (cp * c) & 63; const float x = (float)m * (1.0f / 32.0f);
              const float v = (cc < 64) ? cospif(x) : sinpif(x); T[i] = f2bf(v * 0.125f); } }
    }
#endif
    PH_END
    PH_BEGIN
#ifndef SKIP_P1
    for (int rep = 0; rep < NREP_P; ++rep) {
        LAS float* vec = (LAS float*)lds; LAS float* red = (LAS float*)(lds + 36864);
        for (int it = bid; it < 4 * 124; it += G) { const int l = it / 124, j = it % 124; const bool up = j >= 36; const int chunk = up ? 3 : 0;
            for (int i = tid; i < 9216; i += 512) { const int v = i >> 10, k = i & 1023; vec[i] = MOD[((size_t)l * 9 + v) * 6144 + chunk * 1024 + k]; }
            __syncthreads();
            if (!up) gemv9_item(vec, red, a.in[I_WIN] + (size_t)l * DM * INC, INC, INC, nullptr, BIN + (size_t)l * 9 * INP, INP, j * 64, tid);
            else gemv9_item(vec, red, a.in[I_WUP] + (size_t)l * DM * UPC, UPC, UPC, nullptr, BUP + (size_t)l * 9 * UPC, UPC, (j - 36) * 64, tid);
        }
        for (int r = gw; r < MTOT; r += NGW) {
            const float* xr = (r < NCTX) ? a.in[I_XP] + (size_t)r * DM : a.in[I_XS] + (size_t)(r - NCTX) * DM;
            const int b9 = row_b9(r);
            const float* sc = MOD + (size_t)b9 * 6144 + 1024; const float* gm = a.in[I_GMIX];
            float ss = 0.f;
#pragma unroll
            for (int j = 0; j < 4; ++j) { const int c = 4 * lane + 256 * j; const f32x4 x = *(const f32x4*)(xr + c); const f32x4 g = *(const f32x4*)(gm + c), s = *(const f32x4*)(sc + c);
                ss += (x[0] * x[0] + x[1] * x[1]) + (x[2] * x[2] + x[3] * x[3]); const f32x4 y = x * g * (s + 1.0f);
                u32x2 w; w.x = pk2(y[0], y[1]); w.y = pk2(y[2], y[3]); *(u32x2*)(XS + (size_t)r * DM + c) = w; }
            ss = wave_sum(ss);
            if (lane == 0) SSQ[r] = ss;
        }
    }
#endif
    PH_END

#pragma unroll 1
    for (int l = 0; l < NLAYER; ++l) {
        PH_BEGIN
#ifndef SKIP_A
        {
            pg8::Gemm g{XS, (const bf16_t*)(ws + WS_WIN), MTOT, INP, DM}; pg8::StaticOrder S; S.init(MTOT, INP, G, bid);
            EpiA E{Pb, INP, SSQ + (size_t)(2 * l) * MTOT, BIN + (size_t)l * 9 * INP, INP, 0};
            for (int rep = 0; rep < NREP_A; ++rep) pg8::gemm_phase<EpiA, pg8::StaticOrder, true, true>(lds, g, S, E);
        }
#endif
        PH_END
        PH_BEGIN
#ifndef SKIP_B
        {
            for (int rep = 0; rep < NREP_B1; ++rep) phase_b(a, lds, l, tid, 0, bid, G);
        }
#endif
        PH_END
        PH_BEGIN
#ifndef SKIP_B
#pragma unroll 1
        for (int repb = 0; repb < NREP_B; ++repb) {
            if (bid < 96 && G > 128) {
#pragma unroll 1
                for (int f = 0; f < 2; ++f) {
                    pg8::Gemm g = (f == 0) ? pg8::Gemm{(const bf16_t*)(ws + WS_TLAT), (const bf16_t*)(ws + WS_FBL), 2048, 2048, 4096}
                                           : pg8::Gemm{(const bf16_t*)(ws + WS_TCTX), (const bf16_t*)(ws + WS_FBC), 256, 8192, 512};
                    pg8::StaticOrder S; S.init(g.M, g.N, G, (f == 0) ? bid : (bid + G - 64) % G);
                    EpiF E{OB, (f == 0) ? NCTX : 0, (f == 0) ? 2048 : 256};
                    pg8::gemm_phase<EpiF, pg8::StaticOrder, true, true>(lds, g, S, E);
                }
            }
            { int tidq = threadIdx.x; asm volatile("" : "+v"(tidq));
              phase_b(a, lds, l, tidq, 1, 0, 1, CTL + 64 * (16 + l + 8 * repb)); }
        }
#endif
        PH_END
        PH_BEGIN
#ifndef SKIP_C
#pragma unroll 1
        for (int rep = 0; rep < NREP_C; ++rep) {
            int tid2 = threadIdx.x; asm volatile("" : "+v"(tid2));
            unsigned char* ws2 = a.ws; asm volatile("" : "+s"(ws2));
            float lam, lam_init;
            { const float p1 = ((tid2 & 63) < 32) ? a.in[I_LQ1][l * 32 + (tid2 & 63)] * a.in[I_LK1][l * 32 + (tid2 & 63)] : 0.f, p2 = ((tid2 & 63) < 32) ? a.in[I_LQ2][l * 32 + (tid2 & 63)] * a.in[I_LK2][l * 32 + (tid2 & 63)] : 0.f;
              lam_init = 0.8f - 0.6f * expf(-0.3f * (float)l); lam = expf(wave_sum(p1)) - expf(wave_sum(p2)) + lam_init; }
            const float cm = 0.10206207261596575f * 1.4426950408889634f, cd = 0.17677669529663687f * 1.4426950408889634f;
            LAS int* qslot = (LAS int*)(lds + LDS_MISC);
            unsigned* qctr = (unsigned*)(ws2 + WS_CTL) + 64 * (1 + l + 8 * rep);
            for (;;) {
                __syncthreads();
                if (tid2 == 0) *qslot = (int)atomicAdd(qctr, 1u);
                __syncthreads();
                const int idx = *qslot;
                if (idx >= 1152) break;
                const bool lat = idx < 768;
                const bool diff = lat ? (idx < 384) : (idx < 960);
                int q0, vt_ld, nt_main, nt_total, qa_ld; size_t qa_off, k_off, vt_off; size_t qa_base, k_base, vt_base;
                int h;
                if (lat) { const int j = diff ? idx : idx - 384; const int bh = j >> 3, qb = j & 7, b = bh / 6; h = bh % 6;
                    const int lr0 = b * 2048 + qb * 256; q0 = NCTX + lr0; vt_ld = 2560; nt_main = 32; nt_total = 40;
                    qa_base = diff ? WS_QDR : WS_QMR; qa_ld = diff ? 384 : 576; qa_off = (size_t)lr0 * qa_ld + (diff ? 64 : 96) * h;
                    k_base = diff ? WS_KDL : WS_KML; k_off = (size_t)b * 2560 * (diff ? 384 : 576) + (diff ? 64 : 96) * h;
                    vt_base = diff ? WS_VDL : WS_VML; vt_off = (size_t)(b * 6 + h) * 64 * 2560; }
                else { const int j = diff ? idx - 768 : idx - 960; const int i = j / 6; h = j % 6; q0 = i * 256; vt_ld = 256; nt_main = 4; nt_total = 4;
                    qa_base = WS_P; qa_ld = INP; qa_off = (size_t)q0 * INP + (diff ? 736 + 64 * h : 96 * h);
                    k_base = diff ? WS_KDC : WS_KMC; k_off = (size_t)q0 * (diff ? 384 : 576) + (diff ? 64 : 96) * h;
                    vt_base = diff ? WS_VDC : WS_VMC; vt_off = (size_t)(i * 6 + h) * 64 * 256; }
                const bf16_t* Qa = (const bf16_t*)(ws2 + qa_base) + qa_off;
                const bf16_t* Qb = (const bf16_t*)(ws2 + WS_P) + (size_t)q0 * INP + (diff ? 736 + 64 * h : 96 * h);
                const bf16_t* Kp = (const bf16_t*)(ws2 + k_base) + k_off;
                const bf16_t* Vt = (const bf16_t*)(ws2 + vt_base) + vt_off;
                bf16_t* Oo = (bf16_t*)(ws2 + WS_OB) + (size_t)q0 * DM + (diff ? 384 : 0) + 64 * h;
                if (diff) { int tt = threadIdx.x; asm volatile("" : "+v"(tt)); attn_unit<true>(lds, Qa, qa_ld, Qb, INP, Kp, 384, Vt, vt_ld, nt_main, nt_total, Oo, cd, lam, a.in[I_GSUB] + l * 64, 1.0f - lam_init, tt); }
                else { int tt = threadIdx.x; asm volatile("" : "+v"(tt)); attn_unit<false>(lds, Qa, qa_ld, Qb, INP, Kp, 576, Vt, vt_ld, nt_main, nt_total, Oo, cm, 0.f, nullptr, 0.f, tt); }
            }
        }
#endif
        PH_END
        PH_BEGIN
#ifndef SKIP_D
        {
            if (l > 0 && bid >= 128) { convert_weights(a, lds, l, 16, gw - 128 * 8, NGW - 128 * 8, wave, lane); __syncthreads(); }
            pg8::Gemm g{OB, (const bf16_t*)(ws + WS_WOUT), MTOT, DM, DM}; pg8::StaticOrder S; S.init(MTOT, DM, G, bid);
            EpiRes E{(l == 0) ? a.in[I_XP] : a.out, (l == 0) ? a.in[I_XS] : a.out + (size_t)NCTX * DM, a.out, (MOD + (size_t)l * 9 * 6144) + 2 * 1024,
                     a.in[I_GFFN] + l * DM, (MOD + (size_t)l * 9 * 6144) + 4 * 1024, XS, SSQ + (size_t)(2 * l + 1) * MTOT, 0};
            pg8::gemm_phase<EpiRes, pg8::StaticOrder, true, true>(lds, g, S, E);
        }
#endif
        PH_END
        PH_BEGIN
#ifndef SKIP_E
        {
            pg8::Gemm g{XS, (const bf16_t*)(ws + WS_WUP), 104 * 256, UPC, DM}; FfnOrder S; S.init(G, bid);
            EpiFfn E{(bf16_t*)(ws + WS_R), SSQ + (size_t)(2 * l + 1) * MTOT, BUP + (size_t)l * 9 * UPC, a.in[I_WCONV] + (size_t)l * 3 * UPC, lds};
            for (int rep = 0; rep < NREP_E; ++rep) pg8::gemm_phase<EpiFfn, FfnOrder, true, true>(lds, g, S, E);
        }
#endif
        PH_END
        PH_BEGIN
#ifndef SKIP_G
        {
            if (l + 1 < NLAYER && bid >= 128) { convert_weights(a, lds, l + 1, 15, gw - 128 * 8, NGW - 128 * 8, wave, lane); __syncthreads(); }
            const bool nxt = (l + 1 < NLAYER);
            pg8::Gemm g{(const bf16_t*)(ws + WS_R), (const bf16_t*)(ws + WS_WDN), MTOT, DM, DFF}; pg8::StaticOrder S; S.init(MTOT, DM, G, bid);
            EpiRes E{a.out, a.out + (size_t)NCTX * DM, a.out, (MOD + (size_t)l * 9 * 6144) + 5 * 1024,
                     nxt ? a.in[I_GMIX] + (l + 1) * DM : nullptr, (MOD + (size_t)l * 9 * 6144) + 9 * 6144 + 1 * 1024, XS, SSQ + (size_t)(nxt ? 2 * l + 2 : 8) * MTOT, 0};
            pg8::gemm_phase<EpiRes, pg8::StaticOrder, true, true>(lds, g, S, E);
        }
#endif
        PH_END
    }
    PH_BEGIN
#ifndef SKIP_FIN
    {
        const float* gf = a.in[I_GFINAL];
        for (int r = gw; r < MTOT; r += NGW) {
            float* xr = a.out + (size_t)r * DM;
            f32x4 x[4]; float ss = 0.f;
#pragma unroll
            for (int j = 0; j < 4; ++j) { x[j] = *(const f32x4*)(xr + 4 * lane + 256 * j); ss += (x[j][0] * x[j][0] + x[j][1] * x[j][1]) + (x[j][2] * x[j][2] + x[j][3] * x[j][3]); }
            ss = wave_sum(ss);
            const float rs = rsqrtf(ss * (1.0f / 1024.0f) + EPS);
#pragma unroll
            for (int j = 0; j < 4; ++j) { const f32x4 g = *(const f32x4*)(gf + 4 * lane + 256 * j); *(f32x4*)(xr + 4 * lane + 256 * j) = x[j] * rs * g; }
        }
    }
#endif
    PH_END
#undef PH_BEGIN
#undef PH_END
}
constexpr int N_PHASES = 2 + NLAYER * 7 + 1;

#ifndef MK_ONE_LAUNCH
#define MK_ONE_LAUNCH 1
#endif
extern "C" void kernel_launch(void* const* d_in, const int* in_sizes, int n_in, void* d_out, int out_size, void* d_ws, size_t ws_size, hipStream_t stream) {
    static int grid = 0;
    if (grid == 0) {
        if (n_in != 26 || ws_size < WS_END) { fprintf(stderr, "kernel_launch: unexpected inputs (n_in %d, ws %zu < %zu)\n", n_in, ws_size, (size_t)WS_END); grid = -1; return; }
        int dev = 0, cus = 0, per_cu = 0;
        hipGetDevice(&dev); hipDeviceGetAttribute(&cus, hipDeviceAttributeMultiprocessorCount, dev);
        if (hipFuncSetAttribute((const void*)mega_fwd, hipFuncAttributeMaxDynamicSharedMemorySize, LDS_BYTES) != hipSuccess) { fprintf(stderr, "kernel_launch: hipFuncSetAttribute failed\n"); grid = -1; return; }
        if (hipOccupancyMaxActiveBlocksPerMultiprocessor(&per_cu, (const void*)mega_fwd, 512, LDS_BYTES) != hipSuccess || per_cu < 1) { fprintf(stderr, "kernel_launch: occupancy query gave %d\n", per_cu); per_cu = 1; }
        (void)hipGetLastError();
        grid = cus * 1;
    }
    if (grid < 0) return;
    if (hipMemsetAsync((char*)d_ws + WS_CTL, 0, 1 << 20, stream) != hipSuccess) { fprintf(stderr, "kernel_launch: memset failed\n"); return; }
    Args a{};
    for (int i = 0; i < 26; ++i) a.in[i] = (const float*)d_in[i];
    a.out = (float*)d_out; a.ws = (unsigned char*)d_ws;
#if MK_ONE_LAUNCH
    a.ph_lo = 0; a.ph_hi = N_PHASES;
    void* args[] = {&a};
    hipError_t e = hipLaunchCooperativeKernel((const void*)mega_fwd, dim3(grid), dim3(512), args, LDS_BYTES, stream);
    if (e != hipSuccess) fprintf(stderr, "cooperative launch failed: %s (grid %d)\n", hipGetErrorString(e), grid);
#else
    for (int p = 0; p < N_PHASES; ++p) { a.ph_lo = p; a.ph_hi = p + 1; hipLaunchKernelGGL(mega_fwd, dim3(grid), dim3(512), LDS_BYTES, stream, a); }
#endif
}
```

```cpp
#include <hip/hip_runtime.h>
#include <hip/hip_cooperative_groups.h>
#include <cstdio>
#include <cstdint>
namespace cg = cooperative_groups;
namespace pg8 {
#define PG8_LAS __attribute__((address_space(3)))
typedef unsigned short bf16_t;
typedef short bf16x8 __attribute__((ext_vector_type(8)));
typedef float f32x4 __attribute__((ext_vector_type(4)));
typedef unsigned u32x4 __attribute__((ext_vector_type(4)));
constexpr int BM = 256, BK = 64, HALF = 128, HTB = HALF * BK * 2  , STAGE_BYTES = 8 * HTB, NXCD = 8, WGM = 8;

__host__ __device__ __forceinline__ int lds_byte(int r, int c) { const int st = (r >> 4) * 2 + (c >> 5), rr = r & 15, cc = c & 31, ob = rr * 64 + cc * 2; return st * 1024 + (ob ^ (((ob >> 9) & 1) << 5)); }
__host__ __device__ __forceinline__ void stage_rc(int b, int& R, int& C) { const int st = b / 1024, sb = b % 1024, swz = sb ^ (((sb >> 9) & 1) << 5); R = (st >> 1) * 16 + swz / 64; C = (st & 1) * 32 + (swz % 64) / 2; }
__host__ __device__ __forceinline__ int perm32(int rho) { const int n = rho >> 4, i = rho & 15; return 8 * (i >> 2) + 4 * n + (i & 3); }

struct Unit { int pm, pn; };
struct Gemm { const bf16_t* A; const bf16_t* Bt; int M, N, K; };

struct StaticOrder {
    int nM, nN, nwg, G, c;
    __host__ __device__ void init(int M, int N, int G_, int c_) { nM = M / BM; nN = N / BM; nwg = nM * nN; G = G_; c = c_; }
    __host__ __device__ bool next(int i, Unit& u) const {
        const long L = (long)i * G + c; if (L >= nwg) return false;
        int wgid = (int)L; { const int q = nwg / NXCD, r = nwg % NXCD, xcd = wgid % NXCD, off = wgid / NXCD; wgid = (xcd < r ? xcd * (q + 1) : r * (q + 1) + (xcd - r) * q) + off; }
        const int nig = WGM * nN, gid = wgid / nig, fm = gid * WGM, gsz = (nM - fm) < WGM ? (nM - fm) : WGM;
        u.pm = fm + ((wgid % nig) % gsz); u.pn = (wgid % nig) / gsz; return true;
    }
    __device__ __forceinline__ int arow(const Unit& u) const { return u.pm * BM; }
    __device__ __forceinline__ void a_ready(const Unit&) const {}
    __device__ __forceinline__ void done(const Unit&) const {}
};

__device__ __forceinline__ unsigned cvt_pk_bf16(float lo, float hi) { unsigned r; asm volatile("v_cvt_pk_bf16_f32 %0, %1, %2" : "=v"(r) : "v"(lo), "v"(hi)); return r; }
typedef float f32x2 __attribute__((ext_vector_type(2)));
__device__ __forceinline__ f32x2 gelu_pk(f32x2 v) {
    const f32x2 av = __builtin_elementwise_abs(v), d = av * 0.2316418882f + 1.0f;
    f32x2 t; t.x = __builtin_amdgcn_rcpf(d.x); t.y = __builtin_amdgcn_rcpf(d.y);
    f32x2 q = t * 0.5307027145f + (-0.7265760135f); q = q * t + 0.7107068705f; q = q * t + (-0.142248368f); q = q * t + 0.127414796f; q = q * t;
    const f32x2 s = (v * v) * (-0.72134752044f);
    f32x2 e; e.x = __builtin_amdgcn_exp2f(s.x); e.y = __builtin_amdgcn_exp2f(s.y);
    const f32x2 m = v * (q * e), r = v - m;
    f32x2 o; o.x = v.x < 0.f ? m.x : r.x; o.y = v.y < 0.f ? m.y : r.y; return o;
}

template <int ACT  > struct EpiBf16 {
    static constexpr bool PERM = true, AFTER_DRAIN = false; static_assert(ACT == 0 || ACT == 1, "EpiBf16: ACT is 0 (none) or 1 (gelu_pk)");
    bf16_t* O; int ldc; const float* bias; int split_cols; size_t split_stride; float scale0;
    __device__ __forceinline__ void operator()(const f32x4 (&acc)[2][2][4][2], const Unit& u, int wr, int wc, int fr, int fq) const {
        const int row0 = u.pm * BM + wr * 64 + fr; int colt = u.pn * BM; bf16_t* base = O;
        float sc = 1.f; if (split_cols) { const int t = colt / split_cols; base += (size_t)t * split_stride; colt -= t * split_cols; if (t == 0) sc = scale0; }
        const int col0 = colt + wc * 32 + 8 * fq, bcol0 = u.pn * BM + wc * 32 + 8 * fq;
        f32x4 bv[2][2];
#pragma unroll
        for (int bj = 0; bj < 2; ++bj)
#pragma unroll
            for (int n = 0; n < 2; ++n) bv[bj][n] = bias ? *(const f32x4*)(bias + bcol0 + bj * HALF + 4 * n) : (f32x4){0.f, 0.f, 0.f, 0.f};
#pragma unroll
        for (int ai = 0; ai < 2; ++ai)
#pragma unroll
            for (int m = 0; m < 4; ++m) { bf16_t* rowp = base + (size_t)(row0 + ai * HALF + m * 16) * ldc + col0;
#pragma unroll
                for (int bj = 0; bj < 2; ++bj) { f32x4 v0 = acc[ai][bj][m][0] + bv[bj][0], v1 = acc[ai][bj][m][1] + bv[bj][1];
                    if (ACT == 1) { f32x2 a = gelu_pk((f32x2){v0[0], v0[1]}), b = gelu_pk((f32x2){v0[2], v0[3]}), c = gelu_pk((f32x2){v1[0], v1[1]}), d = gelu_pk((f32x2){v1[2], v1[3]});
                        v0 = (f32x4){a.x, a.y, b.x, b.y}; v1 = (f32x4){c.x, c.y, d.x, d.y}; }
                    v0 = v0 * sc; v1 = v1 * sc; u32x4 w; w.x = cvt_pk_bf16(v0[0], v0[1]); w.y = cvt_pk_bf16(v0[2], v0[3]); w.z = cvt_pk_bf16(v1[0], v1[1]); w.w = cvt_pk_bf16(v1[2], v1[3]);
                    *(u32x4*)(rowp + bj * HALF) = w; } }
    }
};

struct PanelStats {
    unsigned* xbuf;
    unsigned* cnt;
    unsigned* tmo;
    int ntn; float eps;
    unsigned code;
    __device__ __forceinline__ bool run(const f32x4 (&v)[2][2][4][2], const Unit& u, int wr, int wc, int fr, int fq, PG8_LAS unsigned char* lds, int wid, int lane) const {
        typedef float f32x2v __attribute__((ext_vector_type(2)));
        PG8_LAS f32x2v* P = (PG8_LAS f32x2v*)lds;
        PG8_LAS f32x2v* S = (PG8_LAS f32x2v*)(lds + 8192);
        PG8_LAS unsigned* flag = (PG8_LAS unsigned*)(lds + 8192 + 2048);
#pragma unroll
        for (int ai = 0; ai < 2; ++ai)
#pragma unroll
            for (int m = 0; m < 4; ++m) {
                float s = 0.f;
#pragma unroll
                for (int bj = 0; bj < 2; ++bj)
#pragma unroll
                    for (int n = 0; n < 2; ++n) { const f32x4 x = v[ai][bj][m][n]; s += (x[0] + x[1]) + (x[2] + x[3]); }
                s += __shfl_xor(s, 16); s += __shfl_xor(s, 32);
                const float mw = s * (1.0f / 64.0f); float q = 0.f;
#pragma unroll
                for (int bj = 0; bj < 2; ++bj)
#pragma unroll
                    for (int n = 0; n < 2; ++n) { const f32x4 d = v[ai][bj][m][n] - mw; q += (d[0] * d[0] + d[1] * d[1]) + (d[2] * d[2] + d[3] * d[3]); }
                q += __shfl_xor(q, 16); q += __shfl_xor(q, 32);
                if (fq == 0) P[(ai * HALF + wr * 64 + m * 16 + fr) * 4 + wc] = (f32x2v){mw, q};
            }
        asm volatile("s_waitcnt lgkmcnt(0)" ::: "memory"); __builtin_amdgcn_s_barrier(); asm volatile("" ::: "memory");
#if defined(BROKEN_EXCHANGE_NO_WAIT)
#warning BROKEN CONTROL BUILD: the row-statistics exchange does not wait; results are wrong by design
        if (blockIdx.x >= 64) { const long long t0_ = clock64(); while (clock64() - t0_ < 60000) __builtin_amdgcn_s_sleep(8); }
#endif
        const int row = wid * 32 + (lane & 31);
        if (lane < 32) {
            const f32x2v a = P[row * 4 + 0], b = P[row * 4 + 1], c = P[row * 4 + 2], d = P[row * 4 + 3];
            const float mt = (a.x + b.x + c.x + d.x) * 0.25f;
            const float da = a.x - mt, db = b.x - mt, dc = c.x - mt, dd = d.x - mt;
            const float m2 = (a.y + b.y) + (c.y + d.y) + 64.0f * ((da * da + db * db) + (dc * dc + dd * dd));
            unsigned long long* slot = (unsigned long long*)xbuf + ((size_t)(u.pm * BM + row) * 4 + u.pn);
            __hip_atomic_store(slot, ((unsigned long long)__float_as_uint(m2) << 32) | __float_as_uint(mt), __ATOMIC_RELAXED, __HIP_MEMORY_SCOPE_AGENT);
        }
        asm volatile("s_waitcnt vmcnt(0)" ::: "memory");
        if (lane == 0) __hip_atomic_fetch_add(cnt + 64 * u.pm, 1u, __ATOMIC_RELAXED, __HIP_MEMORY_SCOPE_AGENT);
        if (wid == 0) {
            bool dead = false; const unsigned long long t0 = __builtin_amdgcn_s_memrealtime(); const unsigned want = 8u * (unsigned)ntn;
            for (;;) {
#if defined(BROKEN_EXCHANGE_NO_WAIT)
                break;
#endif
                if ((unsigned)__builtin_amdgcn_readfirstlane(__hip_atomic_load(cnt + 64 * u.pm, __ATOMIC_RELAXED, __HIP_MEMORY_SCOPE_AGENT)) >= want) break;
                if (__builtin_amdgcn_s_memrealtime() - t0 > 2000000ull) {
                    if (lane == 0) { unsigned expect = 0u; __hip_atomic_compare_exchange_strong(tmo + 1, &expect, code | (unsigned)(u.pm & 0xff), __ATOMIC_RELAXED, __ATOMIC_RELAXED, __HIP_MEMORY_SCOPE_AGENT);
                                     __hip_atomic_store(tmo, 1u, __ATOMIC_RELAXED, __HIP_MEMORY_SCOPE_AGENT); }
                    dead = true; break; }
                __builtin_amdgcn_s_sleep(2);
            }
            __builtin_amdgcn_fence(__ATOMIC_ACQUIRE, "agent");
            if (lane == 0) flag[0] = dead ? 1u : 0u;
        }
        asm volatile("s_waitcnt vmcnt(0) lgkmcnt(0)" ::: "memory"); __builtin_amdgcn_s_barrier(); asm volatile("" ::: "memory");
        const bool bad = flag[0] != 0u;
        if (lane < 32) {
            const unsigned long long* slot = (const unsigned long long*)xbuf + (size_t)(u.pm * BM + row) * 4; float mt[4], m2[4]; float ms = 0.f;
#pragma unroll
            for (int t = 0; t < 4; ++t) { if (t < ntn) { const unsigned long long w = __hip_atomic_load(slot + t, __ATOMIC_RELAXED, __HIP_MEMORY_SCOPE_AGENT); mt[t] = __uint_as_float((unsigned)w); m2[t] = __uint_as_float((unsigned)(w >> 32)); } else { mt[t] = 0.f; m2[t] = 0.f; } ms += mt[t]; }
            const float mean = ms / (float)ntn; float q = 0.f;
#pragma unroll
            for (int t = 0; t < 4; ++t) if (t < ntn) { const float dm = mt[t] - mean; q += m2[t] + 256.0f * dm * dm; }
            S[row] = (f32x2v){mean, 1.0f / sqrtf(q / (256.0f * (float)ntn) + eps)};
        }
        asm volatile("s_waitcnt lgkmcnt(0)" ::: "memory"); __builtin_amdgcn_s_barrier(); asm volatile("" ::: "memory");
        return bad;
    }
};
struct EpiLnRes {
    static constexpr bool PERM = false, AFTER_DRAIN = true;
    const float* base; float* out; int ldc; const float* bias; PanelStats st; unsigned poison;
    __device__ __forceinline__ void fused(f32x4 (&acc)[2][2][4][2], const Unit& u, int wr, int wc, int fr, int fq, PG8_LAS unsigned char* lds, int wid, int lane) const {
        typedef float f32x2v __attribute__((ext_vector_type(2)));
        const PG8_LAS f32x2v* S = (const PG8_LAS f32x2v*)(lds + 8192);
        const int col0 = u.pn * BM + wc * 32 + 4 * fq;
#pragma unroll
        for (int bj = 0; bj < 2; ++bj)
#pragma unroll
            for (int n = 0; n < 2; ++n) { const f32x4 bv = bias ? *(const f32x4*)(bias + col0 + bj * HALF + n * 16) : (f32x4){0.f, 0.f, 0.f, 0.f};
#pragma unroll
                for (int ai = 0; ai < 2; ++ai)
#pragma unroll
                    for (int m = 0; m < 4; ++m) acc[ai][bj][m][n] += bv; }
        f32x4 pre[4][2][2];
#pragma unroll
        for (int m = 0; m < 4; ++m) { const size_t off = (size_t)(u.pm * BM + wr * 64 + m * 16 + fr) * ldc + col0;
#pragma unroll
            for (int bj = 0; bj < 2; ++bj)
#pragma unroll
                for (int n = 0; n < 2; ++n) pre[m][bj][n] = *(const f32x4*)(base + off + bj * HALF + n * 16); }
        const bool bad = st.run(acc, u, wr, wc, fr, fq, lds, wid, lane) || poison != 0u;
        const float qnan = __builtin_nanf("");
#pragma unroll
        for (int ai = 0; ai < 2; ++ai)
#pragma unroll
            for (int m = 0; m < 4; ++m) { const int r = ai * HALF + wr * 64 + m * 16 + fr; const f32x2v sr = S[r]; const size_t off = (size_t)(u.pm * BM + r) * ldc + col0;
#pragma unroll
                for (int bj = 0; bj < 2; ++bj)
#pragma unroll
                    for (int n = 0; n < 2; ++n) { const f32x4 bs = ai == 0 ? pre[m][bj][n] : *(const f32x4*)(base + off + bj * HALF + n * 16); f32x4 o = bs + (acc[ai][bj][m][n] - sr.x) * sr.y;
                        if (bad) o = (f32x4){qnan, qnan, qnan, qnan}; *(f32x4*)(out + off + bj * HALF + n * 16) = o; }
                if (m & 1) asm volatile("" ::: "memory"); }
    }
};
struct EpiLnResLn {
    static constexpr bool PERM = false, AFTER_DRAIN = true;
    const float* base; float* out; bf16_t* xn; int ldc; const float* bias; PanelStats st1, st2; unsigned poison;
    __device__ __forceinline__ void fused(f32x4 (&acc)[2][2][4][2], const Unit& u, int wr, int wc, int fr, int fq, PG8_LAS unsigned char* lds, int wid, int lane) const {
        typedef float f32x2v __attribute__((ext_vector_type(2))); typedef unsigned u32x2v __attribute__((ext_vector_type(2)));
        const PG8_LAS f32x2v* S = (const PG8_LAS f32x2v*)(lds + 8192);
        const int col0 = u.pn * BM + wc * 32 + 4 * fq;
#pragma unroll
        for (int bj = 0; bj < 2; ++bj)
#pragma unroll
            for (int n = 0; n < 2; ++n) { const f32x4 bv = bias ? *(const f32x4*)(bias + col0 + bj * HALF + n * 16) : (f32x4){0.f, 0.f, 0.f, 0.f};
#pragma unroll
                for (int ai = 0; ai < 2; ++ai)
#pragma unroll
                    for (int m = 0; m < 4; ++m) acc[ai][bj][m][n] += bv; }
        bool bad = st1.run(acc, u, wr, wc, fr, fq, lds, wid, lane) || poison != 0u;
        const float qnan = __builtin_nanf("");
#pragma unroll
        for (int ai = 0; ai < 2; ++ai)
#pragma unroll
            for (int m = 0; m < 4; ++m) { const int r = ai * HALF + wr * 64 + m * 16 + fr; const f32x2v sr = S[r]; const size_t off = (size_t)(u.pm * BM + r) * ldc + col0;
#pragma unroll
                for (int bj = 0; bj < 2; ++bj)
#pragma unroll
                    for (int n = 0; n < 2; ++n) { const f32x4 bs = *(const f32x4*)(base + off + bj * HALF + n * 16); acc[ai][bj][m][n] = bs + (acc[ai][bj][m][n] - sr.x) * sr.y; }
                asm volatile("" : "+v"(acc[ai][0][m][0]), "+v"(acc[ai][0][m][1]), "+v"(acc[ai][1][m][0]), "+v"(acc[ai][1][m][1]));
                if (m & 1) asm volatile("" ::: "memory"); }
        const bool bad1 = bad;
        bad = st2.run(acc, u, wr, wc, fr, fq, lds, wid, lane) || bad;
#pragma unroll
        for (int ai = 0; ai < 2; ++ai)
#pragma unroll
            for (int m = 0; m < 4; ++m) { const int r = ai * HALF + wr * 64 + m * 16 + fr; const f32x2v sr = S[r]; const size_t off = (size_t)(u.pm * BM + r) * ldc + col0;
#pragma unroll
                for (int bj = 0; bj < 2; ++bj)
#pragma unroll
                    for (int n = 0; n < 2; ++n) { const f32x4 x1 = acc[ai][bj][m][n]; *(f32x4*)(out + off + bj * HALF + n * 16) = bad1 ? (f32x4){qnan, qnan, qnan, qnan} : x1;
                        const f32x4 o = (x1 - sr.x) * sr.y; u32x2v w; w.x = cvt_pk_bf16(o[0], o[1]); w.y = cvt_pk_bf16(o[2], o[3]);
                        if (bad) { w.x = 0x7fc07fc0u; w.y = 0x7fc07fc0u; } *(u32x2v*)(xn + off + bj * HALF + n * 16) = w; }
                asm volatile("" ::: "memory"); }
    }
};

template <class Epi, class Sched, bool ALIGN_EPI = false, bool SP2 = false>
__device__ __forceinline__ void gemm_phase(PG8_LAS unsigned char* lds, const Gemm g, const Sched& S, const Epi& E) {
    int tid = threadIdx.x; asm volatile("" : "+v"(tid));
    const int wid = __builtin_amdgcn_readfirstlane(tid >> 6), lane = tid & 63, wr = wid >> 2, wc = wid & 3, fr = lane & 15, fq = lane >> 4;
    const int K = g.K, nt = K / BK;
    unsigned voffA[2], voffB[2];
#pragma unroll
    for (int i = 0; i < 2; ++i) { int R, C; stage_rc(tid * 16 + i * 8192, R, C); const int Rb = Epi::PERM ? ((R & ~31) + perm32(R & 31)) : R;
        voffA[i] = (unsigned)(R * K + C) * 2u; voffB[i] = (unsigned)(Rb * K + C) * 2u; }
    const size_t kstep = (size_t)(BK * 2);
    const size_t hstep = (size_t)HALF * K * 2;
    const size_t tstep = 2 * hstep;
    const unsigned ldsw = (unsigned)wid * 1024u;
    const int aoff = lds_byte(wr * 64 + fr, fq * 8), boff = lds_byte(wc * 32 + fr, fq * 8);
#define PG8_SA(b, h) (((b) * 2 + (h)) * HTB)
#define PG8_SB(b, h) ((4 + (b) * 2 + (h)) * HTB)
#define PG8_STAGE(bufoff, gbase, voff) do { _Pragma("unroll") for (int _i = 0; _i < 2; ++_i) \
        __builtin_amdgcn_global_load_lds((const unsigned*)((const char*)(gbase) + (voff)[_i]), (PG8_LAS unsigned*)(lds + (bufoff) + ldsw + _i * 8192), 16, 0, 0); } while (0)
#define PG8_LDA(dst, b, h) do { _Pragma("unroll") for (int m = 0; m < 4; ++m) _Pragma("unroll") for (int k = 0; k < 2; ++k) dst[m][k] = *(const PG8_LAS bf16x8*)(lds + PG8_SA(b, h) + aoff + m * 2048 + k * 1024); } while (0)
#define PG8_LDB(dst, b, h) do { _Pragma("unroll") for (int n = 0; n < 2; ++n) _Pragma("unroll") for (int k = 0; k < 2; ++k) dst[n][k] = *(const PG8_LAS bf16x8*)(lds + PG8_SB(b, h) + boff + n * 2048 + k * 1024); } while (0)
#define PG8_MMA(ai, bj, At, Bt) do { __builtin_amdgcn_s_setprio(1); _Pragma("unroll") for (int m = 0; m < 4; ++m) _Pragma("unroll") for (int n = 0; n < 2; ++n) _Pragma("unroll") for (int k = 0; k < 2; ++k) \
        acc[ai][bj][m][n] = __builtin_amdgcn_mfma_f32_16x16x32_bf16(Bt[n][k], At[m][k], acc[ai][bj][m][n], 0, 0, 0); __builtin_amdgcn_s_setprio(0); } while (0)
#define PG8_WAIT_V(n) asm volatile("s_waitcnt vmcnt(" #n ")" ::: "memory")
#define PG8_WAIT_L(n) asm volatile("s_waitcnt lgkmcnt(" #n ")" ::: "memory")
#define PG8_BAR __builtin_amdgcn_s_barrier()
#define PG8_SCHED __builtin_amdgcn_sched_barrier(0)
    Unit cur, nxt; int ui = 0;
    if (!S.next(0, cur)) return;
    f32x4 acc[2][2][4][2];
#pragma unroll
    for (int a = 0; a < 2; ++a)
#pragma unroll
        for (int b = 0; b < 2; ++b)
#pragma unroll
            for (int m = 0; m < 4; ++m)
#pragma unroll
                for (int n = 0; n < 2; ++n) acc[a][b][m][n] = (f32x4){0.f, 0.f, 0.f, 0.f};
    bf16x8 At[4][2], B0[2][2], B1[2][2];
    const char* cA = (const char*)g.A + (size_t)S.arow(cur) * (size_t)(K * 2); const char* cB = (const char*)g.Bt + (size_t)cur.pn * tstep;
    S.a_ready(cur);
    if constexpr (SP2) {
        PG8_STAGE(PG8_SB(0, 0), cB, voffB); PG8_STAGE(PG8_SB(0, 1), cB + hstep, voffB); PG8_STAGE(PG8_SA(0, 0), cA, voffA); PG8_STAGE(PG8_SA(0, 1), cA + hstep, voffA);
        if (wr == 1) PG8_BAR;
        PG8_WAIT_V(2); PG8_BAR;
        PG8_STAGE(PG8_SB(1, 0), cB + kstep, voffB); PG8_STAGE(PG8_SA(1, 0), cA + kstep, voffA); PG8_STAGE(PG8_SB(1, 1), cB + hstep + kstep, voffB);
        PG8_WAIT_V(6); PG8_BAR;
    } else {
        PG8_STAGE(PG8_SB(0, 0), cB, voffB); PG8_STAGE(PG8_SA(0, 0), cA, voffA); PG8_STAGE(PG8_SB(0, 1), cB + hstep, voffB); PG8_STAGE(PG8_SA(0, 1), cA + hstep, voffA);
        if (wr == 1) PG8_BAR;
        PG8_WAIT_V(4); PG8_BAR;
        PG8_STAGE(PG8_SB(1, 0), cB + kstep, voffB); PG8_STAGE(PG8_SA(1, 0), cA + kstep, voffA); PG8_STAGE(PG8_SB(1, 1), cB + hstep + kstep, voffB);
        PG8_WAIT_V(6); PG8_BAR;
    }
    for (;;) {
        const bool has_next = S.next(ui + 1, nxt);
        const char* nA = has_next ? (const char*)g.A + (size_t)S.arow(nxt) * (size_t)(K * 2) : cA; const char* nB = has_next ? (const char*)g.Bt + (size_t)nxt.pn * tstep : cB;
        for (int t = 0; t < nt; t += 2) {
            const bool last = (t == nt - 2);
            const char* a1 = cA + (size_t)(t + 1) * kstep;
            const char* a2 = last ? nA : cA + (size_t)(t + 2) * kstep; const char* b2 = last ? nB : cB + (size_t)(t + 2) * kstep;
            const char* a3 = a2 + kstep; const char* b3 = b2 + kstep;
            if (last && has_next) S.a_ready(nxt);
            if constexpr (SP2) {
            PG8_LDB(B0, 0, 0); PG8_LDB(B1, 0, 1); PG8_SCHED; PG8_LDA(At, 0, 0); PG8_STAGE(PG8_SA(1, 1), a1 + hstep, voffA);
            PG8_WAIT_V(8); PG8_WAIT_L(0); PG8_BAR; PG8_MMA(0, 0, At, B0); PG8_MMA(0, 1, At, B1); PG8_BAR; PG8_SCHED;
            PG8_LDA(At, 0, 1); PG8_STAGE(PG8_SB(0, 0), b2, voffB); PG8_STAGE(PG8_SB(0, 1), b2 + hstep, voffB); PG8_STAGE(PG8_SA(0, 0), a2, voffA);
            PG8_WAIT_V(8); PG8_WAIT_L(0); PG8_BAR; PG8_MMA(1, 0, At, B0); PG8_MMA(1, 1, At, B1); PG8_BAR; PG8_SCHED;
            PG8_LDB(B0, 1, 0); PG8_LDB(B1, 1, 1); PG8_SCHED; PG8_LDA(At, 1, 0); PG8_STAGE(PG8_SA(0, 1), a2 + hstep, voffA);
            PG8_WAIT_V(8); PG8_WAIT_L(0); PG8_BAR; PG8_MMA(0, 0, At, B0); PG8_MMA(0, 1, At, B1); PG8_BAR; PG8_SCHED;
            PG8_LDA(At, 1, 1); PG8_STAGE(PG8_SB(1, 0), b3, voffB); PG8_STAGE(PG8_SB(1, 1), b3 + hstep, voffB); PG8_STAGE(PG8_SA(1, 0), a3, voffA);
            PG8_WAIT_V(8); PG8_WAIT_L(0); PG8_BAR; PG8_MMA(1, 0, At, B0); PG8_MMA(1, 1, At, B1); PG8_BAR; PG8_SCHED;
            } else {
            PG8_LDB(B0, 0, 0); PG8_SCHED; PG8_LDA(At, 0, 0); PG8_STAGE(PG8_SA(1, 1), a1 + hstep, voffA);
            PG8_WAIT_L(8); PG8_BAR; PG8_WAIT_L(0); PG8_MMA(0, 0, At, B0); PG8_BAR; PG8_SCHED;
            PG8_LDB(B1, 0, 1); PG8_STAGE(PG8_SB(0, 0), b2, voffB);
            PG8_BAR; PG8_WAIT_L(0); PG8_MMA(0, 1, At, B1); PG8_BAR;
            PG8_LDA(At, 0, 1); PG8_STAGE(PG8_SA(0, 0), a2, voffA);
            PG8_BAR; PG8_WAIT_L(0); PG8_MMA(1, 0, At, B0); PG8_BAR; PG8_SCHED;
            PG8_STAGE(PG8_SB(0, 1), b2 + hstep, voffB);
            PG8_WAIT_V(6); PG8_BAR; PG8_MMA(1, 1, At, B1); PG8_BAR;
            PG8_LDB(B0, 1, 0); PG8_SCHED; PG8_LDA(At, 1, 0); PG8_STAGE(PG8_SA(0, 1), a2 + hstep, voffA);
            PG8_WAIT_L(8); PG8_BAR; PG8_WAIT_L(0); PG8_MMA(0, 0, At, B0); PG8_BAR; PG8_SCHED;
            PG8_LDB(B1, 1, 1); PG8_STAGE(PG8_SB(1, 0), b3, voffB);
            PG8_BAR; PG8_WAIT_L(0); PG8_MMA(0, 1, At, B1); PG8_BAR;
            PG8_LDA(At, 1, 1); PG8_STAGE(PG8_SA(1, 0), a3, voffA);
            PG8_BAR; PG8_WAIT_L(0); PG8_MMA(1, 0, At, B0); PG8_BAR; PG8_SCHED;
            PG8_STAGE(PG8_SB(1, 1), b3 + hstep, voffB);
            PG8_WAIT_V(6); PG8_BAR; PG8_MMA(1, 1, At, B1); PG8_BAR;
            }
        }
        if constexpr (ALIGN_EPI) { if (wr == 0) PG8_BAR; }
        if constexpr (!Epi::AFTER_DRAIN) { E(acc, cur, wr, wc, fr, fq); S.done(cur); }
        if (!has_next) break;
#pragma unroll
        for (int a = 0; a < 2; ++a)
#pragma unroll
            for (int b = 0; b < 2; ++b)
#pragma unroll
                for (int m = 0; m < 4; ++m)
#pragma unroll
                    for (int n = 0; n < 2; ++n) acc[a][b][m][n] = (f32x4){0.f, 0.f, 0.f, 0.f};
        cur = nxt; cA = nA; cB = nB; ++ui;
        if constexpr (ALIGN_EPI) { if (wr == 1) PG8_BAR; }
    }
    PG8_WAIT_V(0);
    if constexpr (!ALIGN_EPI) { if (wr == 0) PG8_BAR; }
    PG8_BAR;
    if constexpr (Epi::AFTER_DRAIN) { E.fused(acc, cur, wr, wc, fr, fq, lds, wid, lane); S.done(cur); }
#undef PG8_SA
#undef PG8_SB
#undef PG8_STAGE
#undef PG8_LDA
#undef PG8_LDB
#undef PG8_MMA
#undef PG8_WAIT_V
#undef PG8_WAIT_L
#undef PG8_BAR
#undef PG8_SCHED
}
}

#define DEV __device__ __forceinline__
#define LAS __attribute__((address_space(3)))
#define GAS __attribute__((address_space(1)))
typedef unsigned short bf16_t;
typedef short bf16x8 __attribute__((ext_vector_type(8)));
typedef short s16x4 __attribute__((ext_vector_type(4)));
typedef float f32x4 __attribute__((ext_vector_type(4)));
typedef float f32x2 __attribute__((ext_vector_type(2)));
typedef float f32x16 __attribute__((ext_vector_type(16)));
typedef unsigned u32x4 __attribute__((ext_vector_type(4)));
typedef unsigned u32x2 __attribute__((ext_vector_type(2)));
typedef __bf16 bf16x2_t __attribute__((ext_vector_type(2)));

constexpr int DM = 1024, NCTX = 8192, NLAT = 16384, MTOT = 24576;
constexpr int INP = 2304, INC = 2144, DFF = 2816, UPC = 5632;
constexpr int NLAYER = 4;
constexpr float EPS = 1e-6f;
constexpr size_t MiB = 1u << 20;
constexpr size_t WS_CTL = 0;
constexpr size_t WS_MOD = 1 * MiB;
constexpr size_t WS_BIN = 2 * MiB;
constexpr size_t WS_BUP = 3 * MiB;
constexpr size_t WS_SSQ = 4 * MiB;
constexpr size_t WS_WIN = 5 * MiB;
constexpr size_t WS_WUKV = WS_WIN + 4718592;
constexpr size_t WS_WOUT = 10 * MiB;
constexpr size_t WS_WUP = 12 * MiB;
constexpr size_t WS_WDN = 23 * MiB;
constexpr size_t WS_TLAT = 29 * MiB;
constexpr size_t WS_TCTX = 45 * MiB;
constexpr size_t WS_CS64 = WS_TCTX + 512 * 1024;
constexpr size_t WS_XS = 46 * MiB;
constexpr size_t WS_R = 94 * MiB;
constexpr size_t WS_P = WS_R;
constexpr size_t WS_OB = WS_P + 108 * MiB;
constexpr size_t WS_KML = WS_OB + 48 * MiB;
constexpr size_t WS_KMC = WS_KML + 23592960;
constexpr size_t WS_VML = WS_KMC + 9 * MiB;
constexpr size_t WS_VMC = WS_VML + 15 * MiB;
constexpr size_t WS_KDL = WS_VMC + 6 * MiB;
constexpr size_t WS_KDC = WS_KDL + 15 * MiB;
constexpr size_t WS_VDL = WS_KDC + 6 * MiB;
constexpr size_t WS_VDC = WS_VDL + 15 * MiB;
constexpr size_t WS_QMR = WS_VDC + 6 * MiB;
constexpr size_t WS_QDR = WS_QMR + 18 * MiB;
constexpr size_t WS_FBL = WS_QDR + 12 * MiB;
constexpr size_t WS_FBC = WS_FBL + 16 * MiB;
constexpr size_t WS_END = WS_FBC + 8 * MiB;
constexpr size_t WS_U = WS_R;
constexpr size_t WS_ACT = WS_R + 176 * MiB;
static_assert(WS_ACT + 88 * MiB <= WS_END, "overlay fits");
constexpr size_t OUT_CKV = 25165824, OUT_KROPE = OUT_CKV + 4194304, OUT_DK = OUT_KROPE + 1048576, OUT_DV = OUT_DK + 12582912;
constexpr int LDS_BYTES = 147456;
constexpr int RING_BYTES = 131072;
constexpr int LDS_MISC = RING_BYTES;

struct Args { const float* in[26]; float* out; unsigned char* ws; int ph_lo, ph_hi; };
enum { I_XP = 0, I_XS, I_C, I_CCKV, I_CKROPE, I_CDK, I_CDV, I_CCTX, I_WADA, I_BADA, I_GMIX, I_GFFN, I_WIN, I_GKV, I_WUK, I_WUV,
       I_LQ1, I_LK1, I_LQ2, I_LK2, I_GSUB, I_WOUT, I_WUP, I_WCONV, I_WDOWN, I_GFINAL };

DEV float bf2f(unsigned b) { return __uint_as_float(b << 16); }
DEV unsigned pk2(float lo, float hi) { f32x2 v = {lo, hi}; bf16x2_t b = __builtin_convertvector(v, bf16x2_t); return __builtin_bit_cast(unsigned, b); }
DEV bf16_t f2bf(float f) { return (bf16_t)(pk2(f, 0.f) & 0xffffu); }
DEV float wave_sum(float v) {
#pragma unroll
    for (int o = 1; o < 64; o <<= 1) v += __shfl_xor(v, o);
    return v;
}
DEV f32x4 mfma16(bf16x8 a, bf16x8 b, f32x4 c) { return __builtin_amdgcn_mfma_f32_16x16x32_bf16(a, b, c, 0, 0, 0); }
DEV f32x16 mfma32(bf16x8 a, bf16x8 b, f32x16 c) { return __builtin_amdgcn_mfma_f32_32x32x16_bf16(a, b, c, 0, 0, 0); }
DEV int row_b9(int row0) { return row0 < NCTX ? 0 : 1 + ((row0 - NCTX) >> 11); }

struct EpiA {
    static constexpr bool PERM = true, AFTER_DRAIN = false;
    bf16_t* O; int ldc; const float* ssq; const float* bias; int ldb; int row_off;
    DEV void operator()(const f32x4 (&acc)[2][2][4][2], const pg8::Unit& u, int wr, int wc, int fr, int fq) const {
        const int lrow0 = u.pm * 256, b9 = row_b9(row_off + lrow0);
        const int col0 = u.pn * 256 + wc * 32 + 8 * fq;
        f32x4 bv[2][2];
#pragma unroll
        for (int bj = 0; bj < 2; ++bj)
#pragma unroll
            for (int n = 0; n < 2; ++n) bv[bj][n] = *(const GAS f32x4*)(bias + (size_t)b9 * ldb + col0 + bj * 128 + 4 * n);
#pragma unroll
        for (int ai = 0; ai < 2; ++ai)
#pragma unroll
            for (int m = 0; m < 4; ++m) {
                const int lr = lrow0 + ai * 128 + wr * 64 + m * 16 + fr;
                const float rs = rsqrtf(((const GAS float*)ssq)[row_off + lr] * (1.0f / 1024.0f) + EPS);
                GAS bf16_t* rowp = (GAS bf16_t*)O + (size_t)lr * ldc + col0;
#pragma unroll
                for (int bj = 0; bj < 2; ++bj) {
                    const f32x4 v0 = acc[ai][bj][m][0] * rs + bv[bj][0], v1 = acc[ai][bj][m][1] * rs + bv[bj][1];
                    u32x4 w; w.x = pk2(v0[0], v0[1]); w.y = pk2(v0[2], v0[3]); w.z = pk2(v1[0], v1[1]); w.w = pk2(v1[2], v1[3]);
                    *(GAS u32x4*)(rowp + bj * 128) = w;
                }
            }
    }
};
struct EpiRes {
    static constexpr bool PERM = false, AFTER_DRAIN = false;
    const float* xold_c; const float* xold_l;
    float* X;
    const float* gate;
    const float* g; const float* scale;
    bf16_t* XS; float* ssq; int row_off;
    DEV void operator()(const f32x4 (&acc)[2][2][4][2], const pg8::Unit& u, int wr, int wc, int fr, int fq) const {
        const int row0 = row_off + u.pm * 256, b9 = row_b9(row0);
        const int col0 = u.pn * 256 + wc * 32 + 4 * fq;
        f32x4 gv[2][2], gs[2][2];
#pragma unroll
        for (int bj = 0; bj < 2; ++bj)
#pragma unroll
            for (int n = 0; n < 2; ++n) {
                const int c = col0 + bj * 128 + n * 16;
                gv[bj][n] = *(const GAS f32x4*)(gate + (size_t)b9 * 6144 + c);
                if (g) { const f32x4 gg = *(const GAS f32x4*)(g + c), sc = *(const GAS f32x4*)(scale + (size_t)b9 * 6144 + c); gs[bj][n] = gg * (sc + 1.0f); }
                else gs[bj][n] = (f32x4){0.f, 0.f, 0.f, 0.f};
            }
        const float* xo = (row0 < NCTX) ? xold_c : (xold_l - (size_t)NCTX * DM);
#pragma unroll
        for (int ai = 0; ai < 2; ++ai)
#pragma unroll
            for (int m = 0; m < 4; ++m) {
                const int r = row0 + ai * 128 + wr * 64 + m * 16 + fr;
                float ss = 0.f;
#pragma unroll
                for (int bj = 0; bj < 2; ++bj)
#pragma unroll
                    for (int n = 0; n < 2; ++n) {
                        const size_t off = (size_t)r * DM + col0 + bj * 128 + n * 16;
                        const f32x4 xv = *(const GAS f32x4*)(xo + off);
                        const f32x4 xn = xv + gv[bj][n] * acc[ai][bj][m][n];
                        *(GAS f32x4*)(X + off) = xn;
                        ss += (xn[0] * xn[0] + xn[1] * xn[1]) + (xn[2] * xn[2] + xn[3] * xn[3]);
                        if (g) { const f32x4 y = xn * gs[bj][n]; u32x2 w; w.x = pk2(y[0], y[1]); w.y = pk2(y[2], y[3]); *(GAS u32x2*)(XS + off) = w; }
                    }
                ss += __shfl_xor(ss, 16); ss += __shfl_xor(ss, 32);
                if (fq == 0) unsafeAtomicAdd(ssq + r, ss);
            }
    }
};
struct EpiF {
    static constexpr bool PERM = true, AFTER_DRAIN = false;
    bf16_t* OB; int rowbase; int nseq;
    DEV void operator()(const f32x4 (&acc)[2][2][4][2], const pg8::Unit& u, int wr, int wc, int fr, int fq) const {
        const int col0 = 768 + wc * 32 + 8 * fq;
#pragma unroll
        for (int ai = 0; ai < 2; ++ai)
#pragma unroll
            for (int m = 0; m < 4; ++m) {
                const int np = u.pm * 256 + ai * 128 + wr * 64 + m * 16 + fr;
                GAS bf16_t* rowp = (GAS bf16_t*)OB + (size_t)(rowbase + u.pn * nseq + np) * DM + col0;
#pragma unroll
                for (int bj = 0; bj < 2; ++bj) {
                    const f32x4 v0 = acc[ai][bj][m][0], v1 = acc[ai][bj][m][1];
                    u32x4 w; w.x = pk2(v0[0], v0[1]); w.y = pk2(v0[2], v0[3]); w.z = pk2(v1[0], v1[1]); w.w = pk2(v1[2], v1[3]);
                    *(GAS u32x4*)(rowp + bj * 128) = w;
                }
            }
    }
};


struct FfnOrder {
    pg8::StaticOrder S;
    __device__ void init(int G, int c) { S.init(104 * 256, UPC, G, c); }
    __device__ bool next(int i, pg8::Unit& u) const { return S.next(i, u); }
    DEV int arow(const pg8::Unit& u) const { if (u.pm < 32) return u.pm * 256; const int t = u.pm - 32, b = t / 9, j = t - 9 * b; return NCTX + 2048 * b + (j < 8 ? 254 * j : 1792); }
    DEV void a_ready(const pg8::Unit&) const {}
    DEV void done(const pg8::Unit&) const {}
};
DEV float dpp_ror1(float x) { const int xi = __builtin_bit_cast(int, x); return __builtin_bit_cast(float, __builtin_amdgcn_update_dpp(xi, xi, 0x121, 0xF, 0xF, false)); }
DEV float dpp_rol1(float x) { const int xi = __builtin_bit_cast(int, x); return __builtin_bit_cast(float, __builtin_amdgcn_update_dpp(xi, xi, 0x12F, 0xF, 0xF, false)); }
constexpr int LDS_HALO = LDS_MISC + 1024;
constexpr int LDS_WCV = LDS_HALO + 8192;
struct EpiFfn {
    static constexpr bool PERM = true, AFTER_DRAIN = false;
    bf16_t* ACT; const float* ssq; const float* bias; const float* wconv; LAS unsigned char* lds;
    DEV void operator()(const f32x4 (&acc)[2][2][4][2], const pg8::Unit& un, int wr, int wc, int fr_, int fq_) const {
        int tl_ = threadIdx.x; asm volatile("" : "+v"(tl_));
        const int fr = tl_ & 15, fq = (tl_ >> 4) & 3; (void)fr_; (void)fq_;
        int arow, lo, hi;
        if (un.pm < 32) { arow = un.pm * 256; lo = 0; hi = 255; }
        else { const int t = un.pm - 32, b = t / 9, j = t - 9 * b; arow = NCTX + 2048 * b + (j < 8 ? 254 * j : 1792);
               lo = (j == 0) ? 0 : (j < 8 ? 1 : 241); hi = (j < 8) ? 254 : 255; }
        const int b9 = row_b9(arow);
        const int cw = wc * 32 + 8 * fq;
        LAS unsigned char* hb = lds + LDS_HALO + wr * 2048 + cw * 4;
        LAS unsigned char* wb = lds + LDS_WCV + cw * 4;
        { const int tl = (wr * 4 + wc) * 64 + fq * 16 + fr;
          if (tl < 256) { const int tap = tl >> 6, r = tl & 63, bj = r >> 5, c4 = (r & 31) * 4;
              const GAS float* src = (tap < 3) ? ((const GAS float*)wconv + (size_t)tap * UPC) : ((const GAS float*)bias + (size_t)b9 * UPC);
              *(LAS f32x4*)(lds + LDS_WCV + tap * 1024 + bj * 512 + c4 * 4) = *(const GAS f32x4*)(src + (bj ? DFF : 0) + un.pn * 128 + c4); } }
        f32x4 u[2][2][4][2];
#pragma unroll
        for (int ai = 0; ai < 2; ++ai)
#pragma unroll
            for (int m = 0; m < 4; ++m) {
                const int R = ai * 128 + wr * 64 + m * 16 + fr;
                const float rs = __builtin_amdgcn_rsqf(((const GAS float*)ssq)[arow + R] * (1.0f / 1024.0f) + EPS);
#pragma unroll
                for (int bj = 0; bj < 2; ++bj)
#pragma unroll
                    for (int n = 0; n < 2; ++n) u[ai][bj][m][n] = acc[ai][bj][m][n] * rs;
            }
        if (fr == 0) {
#pragma unroll
            for (int ai = 0; ai < 2; ++ai)
#pragma unroll
                for (int bj = 0; bj < 2; ++bj)
#pragma unroll
                    for (int n = 0; n < 2; ++n) *(LAS f32x4*)(hb + ai * 4096 + bj * 512 + n * 16) = u[ai][bj][0][n];
        }
        if (fr == 15) {
#pragma unroll
            for (int ai = 0; ai < 2; ++ai)
#pragma unroll
                for (int bj = 0; bj < 2; ++bj)
#pragma unroll
                    for (int n = 0; n < 2; ++n) *(LAS f32x4*)(hb + ai * 4096 + 1024 + bj * 512 + n * 16) = u[ai][bj][3][n];
        }
        asm volatile("s_waitcnt lgkmcnt(0)\n\ts_barrier" ::: "memory");
        __builtin_amdgcn_sched_barrier(0);
        const bool f15 = (fr == 15), f0 = (fr == 0);
#pragma unroll
        for (int ai = 0; ai < 2; ++ai)
#pragma unroll
            for (int n = 0; n < 2; ++n) {
                const int q = 2 * ai + wr;
                f32x4 cg[4], cv[4];
#pragma unroll
                for (int bj = 0; bj < 2; ++bj) {
                    const f32x4 w0 = *(const LAS f32x4*)(wb + bj * 512 + n * 16), w1 = *(const LAS f32x4*)(wb + 1024 + bj * 512 + n * 16), w2 = *(const LAS f32x4*)(wb + 2048 + bj * 512 + n * 16);
                    const f32x4 bb = *(const LAS f32x4*)(wb + 3072 + bj * 512 + n * 16);
                    f32x4 hup = *(const LAS f32x4*)(hb + ai * 4096 + (q > 0 ? -1024 : 0) + bj * 512 + n * 16);
                    f32x4 hdn = *(const LAS f32x4*)(hb + ai * 4096 + (q < 3 ? 2048 : 0) + bj * 512 + n * 16);
                    hup = (q > 0) ? (hup + bb) : (f32x4){0.f, 0.f, 0.f, 0.f};
                    hdn = (q < 3) ? (hdn + bb) : (f32x4){0.f, 0.f, 0.f, 0.f};
                    f32x4 ub[4];
#pragma unroll
                    for (int m = 0; m < 4; ++m) ub[m] = u[ai][bj][m][n] + bb;
#pragma unroll
                    for (int m = 0; m < 4; ++m)
#pragma unroll
                        for (int e = 0; e < 4; ++e) {
                            const float cur = ub[m][e];
                            const float pu = (m == 0) ? hup[e] : ub[m == 0 ? 0 : m - 1][e];
                            const float pd = (m == 3) ? hdn[e] : ub[m == 3 ? 3 : m + 1][e];
                            const float up = dpp_ror1(f15 ? pu : cur), dn = dpp_rol1(f0 ? pd : cur);
                            const float r = w0[e] * up + w1[e] * cur + w2[e] * dn;
                            if (bj == 0) cg[m][e] = r; else cv[m][e] = r;
                        }
                }
                int tl2 = tl_; asm volatile("" : "+v"(tl2));
                GAS bf16_t* ap = (GAS bf16_t*)ACT + (size_t)(arow + wr * 64 + (tl2 & 15)) * DFF + un.pn * 128 + wc * 32 + 8 * ((tl2 >> 4) & 3);
#pragma unroll
                for (int m = 0; m < 4; ++m) {
                    const int R = ai * 128 + wr * 64 + m * 16 + fr;
                    float o[4];
#pragma unroll
                    for (int e = 0; e < 4; ++e) { const float g = cg[m][e]; o[e] = g * __builtin_amdgcn_rcpf(1.0f + __expf(-g)) * cv[m][e]; }
                    u32x2 w; w.x = pk2(o[0], o[1]); w.y = pk2(o[2], o[3]);
                    if (R >= lo && R <= hi) *(GAS u32x2*)(ap + (size_t)(ai * 128 + m * 16) * DFF + 4 * n) = w;
                }
                __builtin_amdgcn_sched_barrier(0);
            }
    }
};

DEV void transpose_item(const float* W, int K, int N, bf16_t* WT, int row_off, LAS float* scr, int item, int lane, bool perm_up = false) {
    const int nblk = N / 32, kb = item / nblk, nb = item % nblk, k0 = 64 * kb, n0 = 32 * nb;
    const int d0 = perm_up ? (((n0 % DFF) >> 7) * 256 + ((n0 >= DFF) ? 128 : 0) + ((n0 % DFF) & 127)) : (row_off + n0);
#pragma unroll 8
    for (int i = 0; i < 32; ++i) { const int kk = 2 * i + (lane >> 5); scr[kk * 33 + (lane & 31)] = W[(size_t)(k0 + kk) * N + n0 + (lane & 31)]; }
    asm volatile("s_waitcnt lgkmcnt(0)" ::: "memory");
    const int c = lane & 7;
#pragma unroll
    for (int j = 0; j < 4; ++j) { const int n = (lane >> 3) + 8 * j; const LAS float* s = scr + (8 * c) * 33 + n;
        u32x4 o; o.x = pk2(s[0 * 33], s[1 * 33]); o.y = pk2(s[2 * 33], s[3 * 33]); o.z = pk2(s[4 * 33], s[5 * 33]); o.w = pk2(s[6 * 33], s[7 * 33]);
        *(u32x4*)(WT + (size_t)(d0 + n) * K + k0 + 8 * c) = o; }
    asm volatile("s_waitcnt lgkmcnt(0)" ::: "memory");
}
DEV void convert_weights(const Args& a, LAS unsigned char* lds, int l, int mask, int gw, int NGW, int wave, int lane) {
    LAS float* scr = (LAS float*)(lds + wave * 16384);
    unsigned char* ws = a.ws;
    const int n_in = (mask & 1) ? 16 * 67 : 0, n_uk = (mask & 2) ? 2 * 12 : 0, n_out = (mask & 4) ? 16 * 32 : 0, n_up = (mask & 8) ? 16 * 176 : 0, n_dn = (mask & 16) ? 44 * 32 : 0;
    const int total = n_in + 2 * n_uk + n_out + n_up + n_dn;
    for (int it = gw; it < total; it += NGW) {
        int r = it;
        if (r < n_in) { transpose_item(a.in[I_WIN] + (size_t)l * DM * INC, DM, INC, (bf16_t*)(ws + WS_WIN), 0, scr, r, lane); continue; } r -= n_in;
        if (r < n_uk) { transpose_item(a.in[I_WUK] + (size_t)l * 128 * 384, 128, 384, (bf16_t*)(ws + WS_WUKV), 0, scr, r, lane); continue; } r -= n_uk;
        if (r < n_uk) { transpose_item(a.in[I_WUV] + (size_t)l * 128 * 384, 128, 384, (bf16_t*)(ws + WS_WUKV), 384, scr, r, lane); continue; } r -= n_uk;
        if (r < n_out) { transpose_item(a.in[I_WOUT] + (size_t)l * DM * DM, DM, DM, (bf16_t*)(ws + WS_WOUT), 0, scr, r, lane); continue; } r -= n_out;
        if (r < n_up) { transpose_item(a.in[I_WUP] + (size_t)l * DM * UPC, DM, UPC, (bf16_t*)(ws + WS_WUP), 0, scr, r, lane, true); continue; } r -= n_up;
        transpose_item(a.in[I_WDOWN] + (size_t)l * DFF * DM, DFF, DM, (bf16_t*)(ws + WS_WDN), 0, scr, r, lane);
    }
}
DEV void gemv9_item(LAS float* vec, LAS float* red, const float* W, int N, int ldw, const float* bias, float* out, int ldo, int n0, int tid) {
    const int w = tid >> 6, lane = tid & 63; const int n = n0 + lane; const bool valid = n < N;
    float acc0 = 0.f, acc1 = 0.f, acc2 = 0.f, acc3 = 0.f, acc4 = 0.f, acc5 = 0.f, acc6 = 0.f, acc7 = 0.f, acc8 = 0.f;
    const float* wp = W + (size_t)(128 * w) * ldw + (valid ? n : 0);
    const LAS float* vp = vec + 128 * w;
#pragma unroll 16
    for (int k = 0; k < 128; ++k) {
        const float wv = valid ? wp[(size_t)k * ldw] : 0.f;
        acc0 += vp[k] * wv; acc1 += vp[1024 + k] * wv; acc2 += vp[2048 + k] * wv; acc3 += vp[3072 + k] * wv; acc4 += vp[4096 + k] * wv;
        acc5 += vp[5120 + k] * wv; acc6 += vp[6144 + k] * wv; acc7 += vp[7168 + k] * wv; acc8 += vp[8192 + k] * wv;
    }
    LAS float* rp = red + (w * 9) * 64 + lane;
    rp[0] = acc0; rp[64] = acc1; rp[128] = acc2; rp[192] = acc3; rp[256] = acc4; rp[320] = acc5; rp[384] = acc6; rp[448] = acc7; rp[512] = acc8;
    __syncthreads();
    for (int idx = tid; idx < 576; idx += 512) {
        const int v = idx >> 6, ln = idx & 63; float s = 0.f;
#pragma unroll
        for (int ww = 0; ww < 8; ++ww) s += red[(ww * 9 + v) * 64 + ln];
        const int nn = n0 + ln;
        out[(size_t)v * ldo + nn] = s + ((bias && nn < N) ? bias[nn] : 0.f);
    }
    __syncthreads();
}
#define XB_TMO      128
#define XB_XCNT(j)  (256  + 64 * (j))
#define XB_XSUB(j)  (1280 + 64 * (j))
#define XB_XGEN(j)  (2304 + 64 * (j))
#define XB_TOP      3328
#define XB_TOPGEN   3392
#define XCD_BAR_WORDS 3456
#define XB_SPIN_CAP (1u << 18)

__device__ __forceinline__ unsigned xb_ld(unsigned* p)              { return __hip_atomic_load(p, __ATOMIC_RELAXED, __HIP_MEMORY_SCOPE_AGENT); }
__device__ __forceinline__ unsigned xb_add(unsigned* p, unsigned v) { return __hip_atomic_fetch_add(p, v, __ATOMIC_RELAXED, __HIP_MEMORY_SCOPE_AGENT); }
__device__ __forceinline__ unsigned xb_xcc_id() { return (unsigned)__builtin_amdgcn_s_getreg((3 << 11) | 20) & 0xFu; }
#define XB_SPIN(cond, bar) do { unsigned _sp = 0; while (cond) { __builtin_amdgcn_s_sleep(1); \
    if ((++_sp & 255u) == 0u) { if (xb_ld(&(bar)[XB_TMO])) break; if (_sp > XB_SPIN_CAP) { atomicAdd(&(bar)[XB_TMO], 1u); break; } } } } while (0)

struct XcdBarrier {
    unsigned* bar; unsigned x;
    volatile LAS unsigned* st;
};

__device__ __forceinline__ XcdBarrier xcd_barrier_post(unsigned* bar, volatile LAS unsigned* st) {
    XcdBarrier b; b.bar = bar; b.x = xb_xcc_id(); b.st = st;
    if (threadIdx.x == 0) (void)xb_add(&bar[XB_XCNT(b.x)], 1u);
    return b;
}
__device__ __forceinline__ void xcd_barrier_complete(unsigned* bar, unsigned x, unsigned& nloc, unsigned& nx) {
    const unsigned G = gridDim.x * gridDim.y * gridDim.z;
    unsigned sum, cnt, mine, sp = 0u;
    for (;;) {
        sum = 0u; cnt = 0u; mine = 0u;
#pragma unroll
        for (unsigned j = 0; j < 16; ++j) { const unsigned c = xb_ld(&bar[XB_XCNT(j)]); sum += c; cnt += (c > 0u) ? 1u : 0u; mine = (j == x) ? c : mine; }
        if (sum == G) break;
        __builtin_amdgcn_s_sleep(1);
        if ((++sp & 255u) == 0u) { if (xb_ld(&bar[XB_TMO])) break; if (sp > XB_SPIN_CAP) { atomicAdd(&bar[XB_TMO], 1u); break; } }
    }
    nloc = mine > 0u ? mine : 1u; nx = cnt > 0u ? cnt : 1u;
}

__device__ __forceinline__ void xcd_barrier(const XcdBarrier& b) {
    asm volatile("s_waitcnt vmcnt(0)" ::: "memory");
    __syncthreads();
    if (threadIdx.x == 0) {
        unsigned* bar = b.bar;
        __builtin_amdgcn_s_waitcnt(0);
        unsigned nloc = b.st[0], nx = b.st[1];
        if (nloc == 0u) { xcd_barrier_complete(bar, b.x, nloc, nx); b.st[0] = nloc; b.st[1] = nx; }
        const unsigned old = xb_add(&bar[XB_XSUB(b.x)], 1u);
        const unsigned gen = old / nloc;
        if (old + 1u == (gen + 1u) * nloc) {
            __builtin_amdgcn_fence(__ATOMIC_RELEASE, "agent");
            asm volatile("s_waitcnt vmcnt(0)" ::: "memory");
            const unsigned og = xb_add(&bar[XB_TOP], 1u);
            const unsigned tg = og / nx;
            if (og + 1u == (tg + 1u) * nx) xb_add(&bar[XB_TOPGEN], 1u);
            else XB_SPIN(xb_ld(&bar[XB_TOPGEN]) == tg, bar);
            __builtin_amdgcn_fence(__ATOMIC_ACQUIRE, "agent");
            xb_add(&bar[XB_XGEN(b.x)], 1u);
            asm volatile("s_waitcnt vmcnt(0)" ::: "memory");
        } else {
            XB_SPIN(xb_ld(&bar[XB_XGEN(b.x)]) == gen, bar);
            __builtin_amdgcn_fence(__ATOMIC_ACQUIRE, "agent");
            asm volatile("s_waitcnt vmcnt(0)" ::: "memory");
        }
    }
    __syncthreads();
}

constexpr int B_AROW = 272, B_VROW = 772, B_UROW = 528;
constexpr int B_LDS_A = 0, B_LDS_V = 64 * B_AROW, B_LDS_U = B_LDS_V + 64 * B_VROW, B_LDS_TAB = B_LDS_U + 64 * B_UROW;
static_assert(B_LDS_TAB + 4096 <= RING_BYTES, "phase B LDS");

DEV float rope1(float x, int dd, int t, const LAS f32x2* tab) {
    const float xp = __shfl_xor(x, 8);
    const int pos = (dd < 16) ? (t >> 6) : (t & 63);
    const f32x2 cs = tab[pos * 8 + (dd & 7)];
    return (dd & 8) ? (x * cs.x + xp * cs.y) : (x * cs.x - xp * cs.y);
}

DEV void phase_b(const Args& a, LAS unsigned char* lds, int l, int tid, int mode, int blk_start, int blk_stride, unsigned* qctr = nullptr) {
    unsigned char* ws = a.ws;
    const int wave = __builtin_amdgcn_readfirstlane(tid >> 6), lane = tid & 63, fr = lane & 15, fq = lane >> 4;
    const GAS bf16_t* P = (const GAS bf16_t*)(ws + WS_P);
    const GAS bf16_t* WUKV = (const GAS bf16_t*)(ws + WS_WUKV);
    const GAS bf16_t* CS64 = (const GAS bf16_t*)(ws + WS_CS64);
    GAS float* outg = (GAS float*)a.out;
    LAS f32x2* tab = (LAS f32x2*)(lds + B_LDS_TAB);
    {
        const int pos = tid >> 3, f = tid & 7;
        const float inv = __builtin_amdgcn_exp2f(-(float)f * (13.287712379549449f / 8.0f));
        const float ang = (float)pos * inv;
        tab[tid] = (f32x2){cosf(ang), sinf(ang)};
    }
    __syncthreads();
    const GAS float* gkv = (const GAS float*)a.in[I_GKV] + l * 128;
    LAS int* bslot = (LAS int*)(lds + LDS_MISC + 4);
    for (int blk = blk_start;; blk += blk_stride) {
        if (qctr) { if (tid == 0) *bslot = (int)atomicAdd(qctr, 1u); __syncthreads(); blk = *bslot; if (blk < 448) blk = (blk < 64) ? 384 + blk : blk - 64; }
        if (blk >= (mode == 0 ? 384 : 448)) break;
        int kind, r0 = 0, bidx, t0;
        if (blk < 128) { kind = 0; r0 = blk * 64; bidx = r0 >> 8; t0 = r0 & 255; }
        else if (blk < 384) { kind = 1; r0 = NCTX + (blk - 128) * 64; bidx = (r0 - NCTX) >> 11; t0 = (r0 - NCTX) & 2047; }
        else { kind = 2; const int cb = blk - 384; bidx = cb >> 3; t0 = 2048 + 64 * (cb & 7); }
        GAS bf16_t* KM; GAS bf16_t* KD; GAS bf16_t* VMt; GAS bf16_t* VDt; int vt_ld;
        if (kind == 0) { KM = (GAS bf16_t*)(ws + WS_KMC) + (size_t)(bidx * 256 + t0) * 576; KD = (GAS bf16_t*)(ws + WS_KDC) + (size_t)(bidx * 256 + t0) * 384;
                         VMt = (GAS bf16_t*)(ws + WS_VMC) + (size_t)bidx * 6 * 64 * 256 + t0; VDt = (GAS bf16_t*)(ws + WS_VDC) + (size_t)bidx * 6 * 64 * 256 + t0; vt_ld = 256; }
        else { KM = (GAS bf16_t*)(ws + WS_KML) + (size_t)(bidx * 2560 + t0) * 576; KD = (GAS bf16_t*)(ws + WS_KDL) + (size_t)(bidx * 2560 + t0) * 384;
               VMt = (GAS bf16_t*)(ws + WS_VML) + (size_t)bidx * 6 * 64 * 2560 + t0; VDt = (GAS bf16_t*)(ws + WS_VDL) + (size_t)bidx * 6 * 64 * 2560 + t0; vt_ld = 2560; }
        if (mode == 0) {
            for (int c = tid; c < 64 * 32; c += 512) { const int rr = c >> 5, e = c & 31;
                *(LAS u32x4*)(lds + B_LDS_U + rr * B_UROW + e * 16) = *(const GAS u32x4*)(P + (size_t)(r0 + rr) * INP + 1888 + 8 * e); }
            __syncthreads();
        } else {
        if (kind == 2) {
            const GAS float* cckv = (const GAS float*)a.in[I_CCKV]; const GAS float* ckr = (const GAS float*)a.in[I_CKROPE];
            const GAS float* cdk = (const GAS float*)a.in[I_CDK]; const GAS float* cdv = (const GAS float*)a.in[I_CDV];
#pragma unroll 1
            for (int i = 0; i < 8; i += 2) {
                f32x2 cv[2]; float kr[2], dk[2][6], dv[2][6];
#pragma unroll
                for (int s2 = 0; s2 < 2; ++s2) {
                    const int rr = wave * 8 + i + s2;
                    const size_t crow = ((size_t)(bidx * 4 + l)) * 512 + (t0 - 2048) + rr;
                    cv[s2] = *(const GAS f32x2*)(cckv + crow * 128 + 2 * lane);
                    kr[s2] = ckr[crow * 32 + (lane & 31)];
#pragma unroll
                    for (int q = 0; q < 6; ++q) { dk[s2][q] = cdk[crow * 384 + 64 * q + lane]; dv[s2][q] = cdv[crow * 384 + 64 * q + lane]; }
                }
#pragma unroll
                for (int s2 = 0; s2 < 2; ++s2) {
                    const int rr = wave * 8 + i + s2;
                    *(LAS unsigned*)(lds + B_LDS_A + rr * B_AROW + lane * 4) = pk2(cv[s2].x, cv[s2].y);
                    const bf16_t krb = f2bf(kr[s2]);
                    { const int hb = (lane >> 5) * 3;
#pragma unroll
                      for (int h = 0; h < 3; ++h) KM[(size_t)rr * 576 + (hb + h) * 96 + 64 + (lane & 31)] = krb; }
#pragma unroll
                    for (int q = 0; q < 6; ++q) {
                        KD[(size_t)rr * 384 + 64 * q + lane] = f2bf(dk[s2][q]);
                        *(LAS bf16_t*)(lds + B_LDS_V + rr * B_VROW + (64 * q + lane) * 2) = f2bf(dv[s2][q]);
                    }
                }
            }
        } else {
            const size_t obase = ((size_t)(bidx * 4 + l)) * 256 + t0;
#pragma unroll
            for (int it = 0; it < 2; ++it) {
                const int rr = (tid >> 4) + 32 * it, cj = tid & 15;
                const u32x4 w = *(const GAS u32x4*)(P + (size_t)(r0 + rr) * INP + 576 + 8 * cj);
                float x[8]; x[0] = bf2f(w.x & 0xffffu); x[1] = bf2f(w.x >> 16); x[2] = bf2f(w.y & 0xffffu); x[3] = bf2f(w.y >> 16);
                x[4] = bf2f(w.z & 0xffffu); x[5] = bf2f(w.z >> 16); x[6] = bf2f(w.w & 0xffffu); x[7] = bf2f(w.w >> 16);
                float ss = 0.f;
#pragma unroll
                for (int j = 0; j < 8; ++j) ss += x[j] * x[j];
                ss += __shfl_xor(ss, 1); ss += __shfl_xor(ss, 2); ss += __shfl_xor(ss, 4); ss += __shfl_xor(ss, 8);
                const float rs = rsqrtf(ss * (1.0f / 128.0f) + EPS);
                const f32x4 ga = *(const GAS f32x4*)(gkv + 8 * cj), gb = *(const GAS f32x4*)(gkv + 8 * cj + 4);
                x[0] *= rs * ga[0]; x[1] *= rs * ga[1]; x[2] *= rs * ga[2]; x[3] *= rs * ga[3]; x[4] *= rs * gb[0]; x[5] *= rs * gb[1]; x[6] *= rs * gb[2]; x[7] *= rs * gb[3];
                u32x4 o; o.x = pk2(x[0], x[1]); o.y = pk2(x[2], x[3]); o.z = pk2(x[4], x[5]); o.w = pk2(x[6], x[7]);
                *(LAS u32x4*)(lds + B_LDS_A + rr * B_AROW + cj * 16) = o;
                if (kind == 0) { GAS float* op = outg + OUT_CKV + (obase + rr) * 128 + 8 * cj; *(GAS f32x4*)op = (f32x4){x[0], x[1], x[2], x[3]}; *(GAS f32x4*)(op + 4) = (f32x4){x[4], x[5], x[6], x[7]}; }
            }
#pragma unroll 1
            for (int cb = 0; cb < 35; cb += 7) {
              u32x4 wv[7];
#pragma unroll
              for (int i = 0; i < 7; ++i) {
                const int c = tid + 512 * (cb + i); const int rr = c / 268, ch = c - rr * 268;
                const bool need = (c < 64 * 268) && (ch < 236) && !(ch >= 72 && ch < 88) && !(kind == 0 && (ch < 72 || (ch >= 92 && ch < 140)));
                wv[i] = (u32x4){0u, 0u, 0u, 0u};
                if (need) wv[i] = *(const GAS u32x4*)(P + (size_t)(r0 + rr) * INP + 8 * ch);
              }
#pragma unroll
              for (int i = 0; i < 7; ++i) {
                const int c = tid + 512 * (cb + i); const int rr = c / 268, ch = c - rr * 268;
                const bool need = (c < 64 * 268) && (ch < 236) && !(ch >= 72 && ch < 88) && !(kind == 0 && (ch < 72 || (ch >= 92 && ch < 140)));
                if (!need) continue;
                const int r = r0 + rr, t = t0 + rr;
                u32x4 w = wv[i];
                const bool ropeable = (ch < 72) ? ((ch % 12) >= 8) : (ch < 188);
                if (kind == 1 && ropeable) {
                    const int j = ch & 3;
                    const int pos = (j < 2) ? (t >> 6) : (t & 63);
                    float x[8]; x[0] = bf2f(w.x & 0xffffu); x[1] = bf2f(w.x >> 16); x[2] = bf2f(w.y & 0xffffu); x[3] = bf2f(w.y >> 16);
                    x[4] = bf2f(w.z & 0xffffu); x[5] = bf2f(w.z >> 16); x[6] = bf2f(w.w & 0xffffu); x[7] = bf2f(w.w >> 16);
                    const float sgn = (j & 1) ? 1.0f : -1.0f;
#pragma unroll
                    for (int i = 0; i < 8; ++i) {
                        const float xp = __builtin_bit_cast(float, __builtin_amdgcn_update_dpp(0, __builtin_bit_cast(int, x[i]), 0xB1, 0xF, 0xF, true));
                        const f32x2 cs = tab[pos * 8 + i];
                        x[i] = x[i] * cs.x + sgn * (xp * cs.y);
                    }
                    w.x = pk2(x[0], x[1]); w.y = pk2(x[2], x[3]); w.z = pk2(x[4], x[5]); w.w = pk2(x[6], x[7]);
                }
                if (ch < 72) { *(GAS u32x4*)((GAS bf16_t*)(ws + WS_QMR) + (size_t)(r - NCTX) * 576 + 8 * ch) = w; }
                else if (ch < 92) { const int j = ch - 88;
#pragma unroll
                    for (int h = 0; h < 6; ++h) *(GAS u32x4*)(KM + (size_t)rr * 576 + h * 96 + 64 + 8 * j) = w;
                    if (kind == 0) { GAS float* op = outg + OUT_KROPE + (obase + rr) * 32 + 8 * j;
                        *(GAS f32x4*)op = (f32x4){bf2f(w.x & 0xffffu), bf2f(w.x >> 16), bf2f(w.y & 0xffffu), bf2f(w.y >> 16)}; *(GAS f32x4*)(op + 4) = (f32x4){bf2f(w.z & 0xffffu), bf2f(w.z >> 16), bf2f(w.w & 0xffffu), bf2f(w.w >> 16)}; } }
                else if (ch < 140) { *(GAS u32x4*)((GAS bf16_t*)(ws + WS_QDR) + (size_t)(r - NCTX) * 384 + 8 * (ch - 92)) = w; }
                else if (ch < 188) { const int e = ch - 140; *(GAS u32x4*)(KD + (size_t)rr * 384 + 8 * e) = w;
                    if (kind == 0) { GAS float* op = outg + OUT_DK + (obase + rr) * 384 + 8 * e;
                        *(GAS f32x4*)op = (f32x4){bf2f(w.x & 0xffffu), bf2f(w.x >> 16), bf2f(w.y & 0xffffu), bf2f(w.y >> 16)}; *(GAS f32x4*)(op + 4) = (f32x4){bf2f(w.z & 0xffffu), bf2f(w.z >> 16), bf2f(w.w & 0xffffu), bf2f(w.w >> 16)}; } }
                else if (ch < 236) { const int e = ch - 188; LAS unsigned* vp = (LAS unsigned*)(lds + B_LDS_V + rr * B_VROW + e * 16); vp[0] = w.x; vp[1] = w.y; vp[2] = w.z; vp[3] = w.w;
                    if (kind == 0) { GAS float* op = outg + OUT_DV + (obase + rr) * 384 + 8 * e;
                        *(GAS f32x4*)op = (f32x4){bf2f(w.x & 0xffffu), bf2f(w.x >> 16), bf2f(w.y & 0xffffu), bf2f(w.y >> 16)}; *(GAS f32x4*)(op + 4) = (f32x4){bf2f(w.z & 0xffffu), bf2f(w.z >> 16), bf2f(w.w & 0xffffu), bf2f(w.w >> 16)}; } }
                else { *(LAS u32x4*)(lds + B_LDS_U + rr * B_UROW + (ch - 236) * 16) = w; }
              }
            }
        }
        bf16x8 bwa[6][4];
#pragma unroll
        for (int nt = 0; nt < 6; ++nt)
#pragma unroll
            for (int kk = 0; kk < 4; ++kk) bwa[nt][kk] = *(const GAS bf16x8*)(WUKV + (size_t)(96 * wave + 16 * nt + fr) * 128 + 32 * kk + 8 * fq);
        __syncthreads();
#pragma unroll
        for (int nt = 0; nt < 6; ++nt) {
            const int c0 = 96 * wave + 16 * nt;
            bf16x8 bw[4];
#pragma unroll
            for (int kk = 0; kk < 4; ++kk) bw[kk] = bwa[nt][kk];
#pragma unroll
            for (int mt = 0; mt < 4; ++mt) {
                f32x4 acc = {0.f, 0.f, 0.f, 0.f};
#pragma unroll
                for (int kk = 0; kk < 4; ++kk) {
                    const bf16x8 af = *(const LAS bf16x8*)(lds + B_LDS_A + (16 * mt + fr) * B_AROW + (32 * kk + 8 * fq) * 2);
                    acc = (wave < 4) ? mfma16(bw[kk], af, acc) : mfma16(af, bw[kk], acc);
                }
                u32x2 w; w.x = pk2(acc[0], acc[1]); w.y = pk2(acc[2], acc[3]);
                if (wave < 4) { const int h = c0 >> 6, d = (c0 & 63) + 4 * fq; *(GAS u32x2*)(KM + (size_t)(16 * mt + fr) * 576 + h * 96 + d) = w; }
                else { const int col = c0 - 384 + fr, h = col >> 6, dv = col & 63; *(GAS u32x2*)(VMt + (size_t)(h * 64 + dv) * vt_ld + 16 * mt + 4 * fq) = w; }
            }
        }
        }
        if (mode == 0) {
            const int g = wave >> 1, nseq = (kind == 0) ? 256 : 2048, ldk = 2 * nseq;
            GAS bf16_t* FB = (kind == 0) ? (GAS bf16_t*)(ws + WS_FBC) : (GAS bf16_t*)(ws + WS_FBL);
#pragma unroll 1
            for (int nt = 0; nt < 4; ++nt) {
                const int cc0 = 16 * ((wave & 1) * 4 + nt);
                bf16x8 bw[2];
#pragma unroll
                for (int kk = 0; kk < 2; ++kk) bw[kk] = *(const GAS bf16x8*)(CS64 + (size_t)(cc0 + fr) * 64 + 32 * kk + 8 * fq);
                const int cc = cc0 + fr, cp = cc & 63, koff = (cc >= 64) ? nseq : 0;
                GAS bf16_t* dst = FB + (size_t)(bidx * 256 + g * 64 + cp) * ldk + koff + (t0 & (nseq - 1));
#pragma unroll
                for (int mt = 0; mt < 4; ++mt) {
                    f32x4 acc = {0.f, 0.f, 0.f, 0.f};
#pragma unroll
                    for (int kk = 0; kk < 2; ++kk) {
                        const bf16x8 af = *(const LAS bf16x8*)(lds + B_LDS_U + (16 * mt + fr) * B_UROW + (64 * g + 32 * kk + 8 * fq) * 2);
                        acc = mfma16(af, bw[kk], acc);
                    }
                    u32x2 w; w.x = pk2(acc[0], acc[1]); w.y = pk2(acc[2], acc[3]);
                    *(GAS u32x2*)(dst + 16 * mt + 4 * fq) = w;
                }
            }
        }
        if (mode == 1)
#pragma unroll 4
        for (int q = 0; q < 48; ++q) {
            const int cr = 48 * wave + q;
            const bf16_t v = *(const LAS bf16_t*)(lds + B_LDS_V + lane * B_VROW + cr * 2);
            VDt[(size_t)cr * vt_ld + lane] = v;
        }
        __syncthreads();
    }
}

constexpr int AT_VROW = 136;
template <bool DIFF> struct AttnCfg {
    static constexpr int ND = DIFF ? 4 : 6;
    static constexpr int NM = DIFF ? 2 : 1;
    static constexpr int NDM = DIFF ? 2 : 6;
    static constexpr int KROW = DIFF ? 144 : 208;
    static constexpr int KT = 64 * KROW;
    static constexpr int CPR = 2 * ND;
    static constexpr int NKC = 64 * CPR;
};
constexpr int AT_LDS_K = 0, AT_LDS_V = 2 * 64 * 208, AT_LDS_SCR = AT_LDS_V + 2 * 64 * AT_VROW;
static_assert(AT_LDS_SCR + 2048 <= RING_BYTES, "attention LDS");

DEV float vmax3(float a, float b, float c) { float r; asm("v_max3_f32 %0, %1, %2, %3" : "=v"(r) : "v"(a), "v"(b), "v"(c)); return r; }
template <bool DIFF>
DEV void attn_unit(LAS unsigned char* lds, const bf16_t* Qa, int qa_ld, const bf16_t* Qb, int qb_ld, const bf16_t* Kp, int k_ld,
                   const bf16_t* Vt, int vt_ld, int nt_main, int nt_total, bf16_t* Oout, float cscale, float lam, const float* gsub, float subscale, int tid) {
    typedef AttnCfg<DIFF> C;
    const int wave = __builtin_amdgcn_readfirstlane(tid >> 6), lane = tid & 63, l31 = lane & 31, hi = lane >> 5;
    LAS float* scr = (LAS float*)(lds + AT_LDS_SCR) + wave * 64;
    const int kkey0 = tid / C::CPR, kpart0 = tid % C::CPR;
    const int kc1 = tid + 512; const bool has1 = kc1 < C::NKC; const int kkey1 = kc1 / C::CPR, kpart1 = kc1 % C::CPR;
    const int vdv = tid >> 3, vpart = tid & 7;
    const GAS bf16_t* kg0 = (const GAS bf16_t*)Kp + (size_t)kkey0 * k_ld + kpart0 * 8;
    const GAS bf16_t* kg1 = (const GAS bf16_t*)Kp + (size_t)kkey1 * k_ld + kpart1 * 8;
    const GAS bf16_t* vg = (const GAS bf16_t*)Vt + (size_t)vdv * vt_ld + vpart * 8;
    const int kl0 = kkey0 * C::KROW + kpart0 * 16, kl1 = kkey1 * C::KROW + kpart1 * 16, vl = vdv * AT_VROW + vpart * 16;
    u32x4 kr0, kr1 = {0, 0, 0, 0}, vr;
    bf16x8 qf[C::ND];
    { const GAS bf16_t* qp = (const GAS bf16_t*)Qa + (size_t)(32 * wave + l31) * qa_ld + 8 * hi;
#pragma unroll
      for (int d = 0; d < C::ND; ++d) qf[d] = *(const GAS bf16x8*)(qp + 16 * d); }
    kr0 = *(const GAS u32x4*)kg0; if (has1) kr1 = *(const GAS u32x4*)kg1; vr = *(const GAS u32x4*)vg;
    *(LAS u32x4*)(lds + AT_LDS_K + kl0) = kr0; if (has1) *(LAS u32x4*)(lds + AT_LDS_K + kl1) = kr1;
    *(LAS u32x2*)(lds + AT_LDS_V + vl) = (u32x2){vr.x, vr.y}; *(LAS u32x2*)(lds + AT_LDS_V + vl + 8) = (u32x2){vr.z, vr.w};
    __syncthreads();
    f32x16 O[C::NM][2];
    float mref[C::NM], lsum[C::NM];
#pragma unroll
    for (int mp = 0; mp < C::NM; ++mp) { mref[mp] = 0.f; lsum[mp] = 0.f;
#pragma unroll
        for (int r = 0; r < 16; ++r) { O[mp][0][r] = 0.f; O[mp][1][r] = 0.f; } }
#pragma unroll 1
    for (int t = 0; t < nt_total; ++t) {
        const int cur = t & 1;
        const bool more = (t + 1) < nt_total;
        if (more) {
            const size_t ko = (size_t)(t + 1) * 64 * k_ld;
            kr0 = *(const GAS u32x4*)(kg0 + ko); if (has1) kr1 = *(const GAS u32x4*)(kg1 + ko);
            vr = *(const GAS u32x4*)(vg + (t + 1) * 64);
        }
        if (t == nt_main) {
            const GAS bf16_t* qp = (const GAS bf16_t*)Qb + (size_t)(32 * wave + l31) * qb_ld + 8 * hi;
#pragma unroll
            for (int d = 0; d < C::ND; ++d) qf[d] = *(const GAS bf16x8*)(qp + 16 * d);
        }
        const LAS unsigned char* Kb = lds + AT_LDS_K + cur * C::KT;
        const LAS unsigned char* Vb = lds + AT_LDS_V + cur * (64 * AT_VROW);
        bf16x8 kf[2][C::NDM];
#pragma unroll
        for (int dd = 0; dd < C::NDM; ++dd) {
            kf[0][dd] = *(const LAS bf16x8*)(Kb + l31 * C::KROW + dd * 32 + hi * 16);
            kf[1][dd] = *(const LAS bf16x8*)(Kb + (32 + l31) * C::KROW + dd * 32 + hi * 16);
        }
        __builtin_amdgcn_sched_barrier(0);
        bf16x8 vf[4][2];
#pragma unroll
        for (int mp = 0; mp < C::NM; ++mp) {
            f32x16 s0, s1;
#pragma unroll
            for (int r = 0; r < 16; ++r) { s0[r] = 0.f; s1[r] = 0.f; }
#pragma unroll
            for (int dd = 0; dd < C::NDM; ++dd) {
                s0 = mfma32(kf[0][dd], qf[mp * C::NDM + dd], s0); s1 = mfma32(kf[1][dd], qf[mp * C::NDM + dd], s1);
            }
            __builtin_amdgcn_sched_barrier(0);
            if (mp == 0) {
#pragma unroll
                for (int j = 0; j < 4; ++j)
#pragma unroll
                    for (int db = 0; db < 2; ++db) {
                        const LAS unsigned char* vp = Vb + (32 * db + l31) * AT_VROW + (32 * (j >> 1) + 16 * (j & 1) + 4 * hi) * 2;
                        const s16x4 lo = *(const LAS s16x4*)vp, hh = *(const LAS s16x4*)(vp + 16);
                        vf[j][db] = (bf16x8){lo[0], lo[1], lo[2], lo[3], hh[0], hh[1], hh[2], hh[3]};
                    }
                if (C::NM > 1) {
#pragma unroll
                    for (int dd = 0; dd < C::NDM; ++dd) {
                        kf[0][dd] = *(const LAS bf16x8*)(Kb + l31 * C::KROW + (C::NDM + dd) * 32 + hi * 16);
                        kf[1][dd] = *(const LAS bf16x8*)(Kb + (32 + l31) * C::KROW + (C::NDM + dd) * 32 + hi * 16);
                    }
                }
                __builtin_amdgcn_sched_barrier(0);
            }
            float ma = vmax3(s0[0], s0[1], s1[0]), mb = vmax3(s0[2], s0[3], s1[1]); ma = vmax3(ma, s1[2], s1[3]);
#pragma unroll
            for (int r = 4; r < 16; r += 4) { ma = vmax3(ma, s0[r], s0[r + 1]); mb = vmax3(mb, s0[r + 2], s0[r + 3]); ma = vmax3(ma, s1[r], s1[r + 1]); mb = vmax3(mb, s1[r + 2], s1[r + 3]); }
            float mx = vmax3(ma, mb, mb);
            mx = vmax3(mx, __shfl_xor(mx, 32), mx);
            const float rm = mx * cscale;
            if (t == 0) mref[mp] = rm;
            else if (__any(rm > mref[mp] + 8.0f)) {
                const float mnew = vmax3(mref[mp], rm, rm);
                const float alpha = __builtin_amdgcn_exp2f(mref[mp] - mnew);
                lsum[mp] *= alpha; mref[mp] = mnew;
                if (hi == 0) scr[l31] = alpha;
                asm volatile("s_waitcnt lgkmcnt(0)" ::: "memory");
#pragma unroll
                for (int g4 = 0; g4 < 4; ++g4) { const f32x4 a4 = *(const LAS f32x4*)(scr + 8 * g4 + 4 * hi);
#pragma unroll
                    for (int j = 0; j < 4; ++j) { O[mp][0][4 * g4 + j] *= a4[j]; O[mp][1][4 * g4 + j] *= a4[j]; } }
                asm volatile("s_waitcnt lgkmcnt(0)" ::: "memory");
            }
            const float nm = -mref[mp];
            float ls = 0.f;
#pragma unroll
            for (int r = 0; r < 16; ++r) { s0[r] = __builtin_amdgcn_exp2f(fmaf(s0[r], cscale, nm)); s1[r] = __builtin_amdgcn_exp2f(fmaf(s1[r], cscale, nm)); ls += s0[r] + s1[r]; }
            lsum[mp] += ls;
            bf16x8 pa[4];
#pragma unroll
            for (int j = 0; j < 4; ++j) {
                u32x4 w;
                if (j < 2) { w.x = pk2(s0[8 * j], s0[8 * j + 1]); w.y = pk2(s0[8 * j + 2], s0[8 * j + 3]); w.z = pk2(s0[8 * j + 4], s0[8 * j + 5]); w.w = pk2(s0[8 * j + 6], s0[8 * j + 7]); }
                else { const int jj = j - 2; w.x = pk2(s1[8 * jj], s1[8 * jj + 1]); w.y = pk2(s1[8 * jj + 2], s1[8 * jj + 3]); w.z = pk2(s1[8 * jj + 4], s1[8 * jj + 5]); w.w = pk2(s1[8 * jj + 6], s1[8 * jj + 7]); }
                pa[j] = __builtin_bit_cast(bf16x8, w);
            }
#pragma unroll
            for (int j = 0; j < 4; ++j)
#pragma unroll
                for (int db = 0; db < 2; ++db) O[mp][db] = mfma32(pa[j], vf[j][db], O[mp][db]);
        }
        if (more) {
            const int nb = cur ^ 1;
            *(LAS u32x4*)(lds + AT_LDS_K + nb * C::KT + kl0) = kr0; if (has1) *(LAS u32x4*)(lds + AT_LDS_K + nb * C::KT + kl1) = kr1;
            *(LAS u32x2*)(lds + AT_LDS_V + nb * (64 * AT_VROW) + vl) = (u32x2){vr.x, vr.y}; *(LAS u32x2*)(lds + AT_LDS_V + nb * (64 * AT_VROW) + vl + 8) = (u32x2){vr.z, vr.w};
        }
        __syncthreads();
    }
    float inv[C::NM][16];
#pragma unroll
    for (int mp = 0; mp < C::NM; ++mp) {
        float lt = lsum[mp]; lt += __shfl_xor(lt, 32);
        if (hi == 0) scr[l31] = 1.0f / lt;
        asm volatile("s_waitcnt lgkmcnt(0)" ::: "memory");
#pragma unroll
        for (int g4 = 0; g4 < 4; ++g4) { const f32x4 a4 = *(const LAS f32x4*)(scr + 8 * g4 + 4 * hi);
#pragma unroll
            for (int j = 0; j < 4; ++j) inv[mp][4 * g4 + j] = a4[j]; }
        asm volatile("s_waitcnt lgkmcnt(0)" ::: "memory");
    }
    GAS bf16_t* ow = (GAS bf16_t*)Oout + (size_t)(32 * wave) * DM;
    if constexpr (!DIFF) {
#pragma unroll
        for (int r = 0; r < 16; ++r) { const int q = (r & 3) + 8 * (r >> 2) + 4 * hi;
#pragma unroll
            for (int db = 0; db < 2; ++db) ow[(size_t)q * DM + 32 * db + l31] = f2bf(O[0][db][r] * inv[0][r]); }
    } else {
        const float gs0 = ((const GAS float*)gsub)[l31] * subscale, gs1 = ((const GAS float*)gsub)[32 + l31] * subscale;
#pragma unroll
        for (int r = 0; r < 16; ++r) { const int q = (r & 3) + 8 * (r >> 2) + 4 * hi;
            const float o0 = O[0][0][r] * inv[0][r] - lam * (O[1][0][r] * inv[1][r]);
            const float o1 = O[0][1][r] * inv[0][r] - lam * (O[1][1][r] * inv[1][r]);
            float ss = o0 * o0 + o1 * o1;
#pragma unroll
            for (int o = 1; o < 32; o <<= 1) ss += __shfl_xor(ss, o);
            const float rs = rsqrtf(ss * (1.0f / 64.0f) + EPS);
            ow[(size_t)q * DM + l31] = f2bf(o0 * rs * gs0); ow[(size_t)q * DM + 32 + l31] = f2bf(o1 * rs * gs1); }
    }
}

DEV void load8(const GAS bf16_t* p, float (&v)[8]) {
    const u32x4 w = *(const GAS u32x4*)p;
    v[0] = bf2f(w.x & 0xffffu); v[1] = bf2f(w.x >> 16); v[2] = bf2f(w.y & 0xffffu); v[3] = bf2f(w.y >> 16);
    v[4] = bf2f(w.z & 0xffffu); v[5] = bf2f(w.z >> 16); v[6] = bf2f(w.w & 0xffffu); v[7] = bf2f(w.w >> 16);
}
DEV void phase_f(const Args& a, int l, int nrows, int seqlen, int tid) {
    const GAS bf16_t* U = (const GAS bf16_t*)(a.ws + WS_U);
    GAS bf16_t* ACT = (GAS bf16_t*)(a.ws + WS_ACT);
    const GAS float* wc = (const GAS float*)a.in[I_WCONV] + (size_t)l * 3 * UPC;
    const int nitems = (nrows / 8) * 352;
    for (int it = blockIdx.x * 512 + tid; it < nitems; it += gridDim.x * 512) {
        const int rb = it / 352, j8 = it - rb * 352, r0 = rb * 8, c0 = j8 * 8;
        float wg[3][8], wv[3][8];
#pragma unroll
        for (int k = 0; k < 3; ++k) {
            const f32x4 g0 = *(const GAS f32x4*)(wc + k * UPC + c0), g1 = *(const GAS f32x4*)(wc + k * UPC + c0 + 4);
            const f32x4 v0 = *(const GAS f32x4*)(wc + k * UPC + DFF + c0), v1 = *(const GAS f32x4*)(wc + k * UPC + DFF + c0 + 4);
#pragma unroll
            for (int j = 0; j < 4; ++j) { wg[k][j] = g0[j]; wg[k][4 + j] = g1[j]; wv[k][j] = v0[j]; wv[k][4 + j] = v1[j]; }
        }
        float pg[8], pv[8], cg_[8], cv[8], ng[8], nv[8];
        const bool hasp = (r0 % seqlen) != 0, hasn = ((r0 + 8) % seqlen) != 0;
        if (hasp) { load8(U + (size_t)(r0 - 1) * UPC + c0, pg); load8(U + (size_t)(r0 - 1) * UPC + DFF + c0, pv); }
        else {
#pragma unroll
            for (int j = 0; j < 8; ++j) { pg[j] = 0.f; pv[j] = 0.f; } }
        load8(U + (size_t)r0 * UPC + c0, cg_); load8(U + (size_t)r0 * UPC + DFF + c0, cv);
#pragma unroll
        for (int i = 0; i < 8; ++i) {
            const int r = r0 + i;
            if (i < 7 || hasn) { load8(U + (size_t)(r + 1) * UPC + c0, ng); load8(U + (size_t)(r + 1) * UPC + DFF + c0, nv); }
            else {
#pragma unroll
                for (int j = 0; j < 8; ++j) { ng[j] = 0.f; nv[j] = 0.f; } }
            float o[8];
#pragma unroll
            for (int j = 0; j < 8; ++j) {
                const float gt = wg[0][j] * pg[j] + wg[1][j] * cg_[j] + wg[2][j] * ng[j];
                const float vl = wv[0][j] * pv[j] + wv[1][j] * cv[j] + wv[2][j] * nv[j];
                const float sg = gt * __builtin_amdgcn_rcpf(1.0f + __expf(-gt));
                o[j] = sg * vl;
            }
            u32x4 w; w.x = pk2(o[0], o[1]); w.y = pk2(o[2], o[3]); w.z = pk2(o[4], o[5]); w.w = pk2(o[6], o[7]);
            *(GAS u32x4*)(ACT + (size_t)r * DFF + c0) = w;
#pragma unroll
            for (int j = 0; j < 8; ++j) { pg[j] = cg_[j]; pv[j] = cv[j]; cg_[j] = ng[j]; cv[j] = nv[j]; }
        }
    }
}

struct ShiftOrder {
    pg8::StaticOrder S;
    __device__ void init(int M, int N, int G, int c) { S.init(M, N, G, c); }
    __device__ bool next(int i, pg8::Unit& u) const { return S.next(i, u); }
    DEV void a_ready(const pg8::Unit&) const {}
    DEV void done(const pg8::Unit&) const {}
};

#ifndef NREP_SYNC
#define NREP_SYNC 1
#endif
#ifndef NREP_P
#define NREP_P 1
#endif
#ifndef NREP_A
#define NREP_A 1
#endif
#ifndef NREP_B1
#define NREP_B1 1
#endif
#ifndef NREP_B
#define NREP_B 1
#endif
#ifndef NREP_C
#define NREP_C 1
#endif
#ifndef NREP_E
#define NREP_E 1
#endif
#ifndef NREP_F
#define NREP_F 1
#endif
__global__ void __launch_bounds__(512, 2) mega_fwd(Args a) {
    extern __shared__ __attribute__((aligned(16))) unsigned char lds_raw[];
    LAS unsigned char* lds = (LAS unsigned char*)lds_raw;
    cg::grid_group grid = cg::this_grid();
    const int G = gridDim.x, bid = blockIdx.x;
#define PH_LOCALS \
    unsigned char* ws = a.ws; asm volatile("" : "+s"(ws)); \
    int tid = threadIdx.x; asm volatile("" : "+v"(tid)); \
    const int lane = tid & 63, wave = __builtin_amdgcn_readfirstlane(tid >> 6); \
    const int gw = bid * 8 + wave, NGW = G * 8, gt = bid * 512 + tid, NGT = G * 512; \
    float* MOD = (float*)(ws + WS_MOD); float* BIN = (float*)(ws + WS_BIN); float* BUP = (float*)(ws + WS_BUP); float* SSQ = (float*)(ws + WS_SSQ); \
    bf16_t* XS = (bf16_t*)(ws + WS_XS); bf16_t* Pb = (bf16_t*)(ws + WS_P); bf16_t* OB = (bf16_t*)(ws + WS_OB); \
    unsigned* CTL = (unsigned*)(ws + WS_CTL); \
    (void)lane; (void)wave; (void)gw; (void)NGW; (void)gt; (void)NGT; (void)MOD; (void)BIN; (void)BUP; (void)SSQ; (void)XS; (void)Pb; (void)OB; (void)CTL;
    const bool one = (a.ph_hi - a.ph_lo) > 1;
    for (int i = threadIdx.x; i < 4096; i += 512) ((LAS unsigned*)(lds + LDS_MISC))[i] = 0u;
    __syncthreads();
    XcdBarrier xbar; xbar.bar = (unsigned*)(a.ws + WS_CTL) + 16384; xbar.x = 0; xbar.st = nullptr;
    if (one) xbar = xcd_barrier_post((unsigned*)(a.ws + WS_CTL) + 16384, (volatile LAS unsigned*)(lds + LDS_MISC + 32));
    int ph = 0;
#define PH_BEGIN if (ph >= a.ph_lo && ph < a.ph_hi) { PH_LOCALS
#define PH_END   if (one && ph + 1 < a.ph_hi) { if (ph == 0) grid.sync(); else { for (int rs_ = 0; rs_ < NREP_SYNC; ++rs_) xcd_barrier(xbar); } } } ++ph;

    PH_BEGIN
#ifndef SKIP_P0
    for (int rep = 0; rep < NREP_P; ++rep) {
        LAS float* vec = (LAS float*)lds; LAS float* red = (LAS float*)(lds + 36864);
        for (int i = tid; i < 9216; i += 512) { const int v = i >> 10, k = i & 1023; const float x = (v == 0) ? a.in[I_CCTX][k] : a.in[I_C][(v - 1) * 1024 + k]; vec[i] = x / (1.0f + __expf(-x)); }
        __syncthreads();
        for (int it = bid; it < 4 * 96; it += G) { const int l = it / 96, nb = it % 96;
            gemv9_item(vec, red, a.in[I_WADA] + (size_t)l * DM * 6144, 6144, 6144, a.in[I_BADA] + l * 6144, MOD + (size_t)l * 9 * 6144, 6144, nb * 64, tid); }
        __syncthreads();
        convert_weights(a, lds, 0, 31, gw, NGW, wave, lane);
        for (int i = gt; i < 9 * MTOT; i += NGT) SSQ[i] = 0.f;
        for (int i = gt; i < 1024; i += NGT) CTL[i] = 0u;
        { unsigned* padp = (unsigned*)(ws + WS_WIN + (size_t)INC * DM * 2); for (int i = gt; i < (INP - INC) * DM / 2; i += NGT) padp[i] = 0u; }
        { bf16_t* T = (bf16_t*)(ws + WS_TLAT);
          for (int i = gt; i < 2048 * 4096; i += NGT) { const int np = i >> 12, k = i & 4095, n = k & 2047; const int m = (np * n) & 2047; const float x = (float)m * (1.0f / 1024.0f);
              const float v = (k < 2048) ? cospif(x) : -sinpif(x); T[i] = f2bf(v * 0.02209708691207961f); } }
        { bf16_t* T = (bf16_t*)(ws + WS_TCTX);
          for (int i = gt; i < 256 * 512; i += NGT) { const int np = i >> 9, k = i & 511, n = k & 255; const int m = (np * n) & 255; const float x = (float)m * (1.0f / 128.0f);
              const float v = (k < 256) ? cospif(x) : -sinpif(x); T[i] = f2bf(v * 0.0625f); } }
        { bf16_t* T = (bf16_t*)(ws + WS_CS64);
          for (int i = gt; i < 128 * 64; i += NGT) { const int cc = i >> 6, c = i & 63, cp = cc & 63; const int m = (cp * c) & 63; const float x = (float)m * (1.0f / 32.0f);
              const float v = (cc < 64) ? cospif(x) : sinpif(x); T[i] = f2bf(v * 0.125f); } }
    }
#endif
    PH_END
    PH_BEGIN
#ifndef SKIP_P1
    for (int rep = 0; rep < NREP_P; ++rep) {
        LAS float* vec = (LAS float*)lds; LAS float* red = (LAS float*)(lds + 36864);
        for (int it = bid; it < 4 * 124; it += G) { const int l = it / 124, j = it % 124; const bool up = j >= 36; const int chunk = up ? 3 : 0;
            for (int i = tid; i < 9216; i += 512) { const int v = i >> 10, k = i & 1023; vec[i] = MOD[((size_t)l * 9 + v) * 6144 + chunk * 1024 + k]; }
            __syncthreads();
            if (!up) gemv9_item(vec, red, a.in[I_WIN] + (size_t)l * DM * INC, INC, INC, nullptr, BIN + (size_t)l * 9 * INP, INP, j * 64, tid);
            else gemv9_item(vec, red, a.in[I_WUP] + (size_t)l * DM * UPC, UPC, UPC, nullptr, BUP + (size_t)l * 9 * UPC, UPC, (j - 36) * 64, tid);
        }
        for (int r = gw; r < MTOT; r += NGW) {
            const float* xr = (r < NCTX) ? a.in[I_XP] + (size_t)r * DM : a.in[I_XS] + (size_t)(r - NCTX) * DM;
            const int b9 = row_b9(r);
            const float* sc = MOD + (size_t)b9 * 6144 + 1024; const float* gm = a.in[I_GMIX];
            float ss = 0.f;
#pragma unroll
            for (int j = 0; j < 4; ++j) { const int c = 4 * lane + 256 * j; const f32x4 x = *(const f32x4*)(xr + c); const f32x4 g = *(const f32x4*)(gm + c), s = *(const f32x4*)(sc + c);
                ss += (x[0] * x[0] + x[1] * x[1]) + (x[2] * x[2] + x[3] * x[3]); const f32x4 y = x * g * (s + 1.0f);
                u32x2 w; w.x = pk2(y[0], y[1]); w.y = pk2(y[2], y[3]); *(u32x2*)(XS + (size_t)r * DM + c) = w; }
            ss = wave_sum(ss);
            if (lane == 0) SSQ[r] = ss;
        }
    }
#endif
    PH_END

#pragma unroll 1
    for (int l = 0; l < NLAYER; ++l) {
        PH_BEGIN
#ifndef SKIP_A
        {
            pg8::Gemm g{XS, (const bf16_t*)(ws + WS_WIN), MTOT, INP, DM}; pg8::StaticOrder S; S.init(MTOT, INP, G, bid);
            EpiA E{Pb, INP, SSQ + (size_t)(2 * l) * MTOT, BIN + (size_t)l * 9 * INP, INP, 0};
            for (int rep = 0; rep < NREP_A; ++rep) pg8::gemm_phase<EpiA, pg8::StaticOrder, true, true>(lds, g, S, E);
        }
#endif
        PH_END
        PH_BEGIN
#ifndef SKIP_B
        {
            for (int rep = 0; rep < NREP_B1; ++rep) phase_b(a, lds, l, tid, 0, bid, G);
        }
#endif
        PH_END
        PH_BEGIN
#ifndef SKIP_B
#pragma unroll 1
        for (int repb = 0; repb < NREP_B; ++repb) {
            if (bid < 96 && G > 128) {
#pragma unroll 1
                for (int f = 0; f < 2; ++f) {
                    pg8::Gemm g = (f == 0) ? pg8::Gemm{(const bf16_t*)(ws + WS_TLAT), (const bf16_t*)(ws + WS_FBL), 2048, 2048, 4096}
                                           : pg8::Gemm{(const bf16_t*)(ws + WS_TCTX), (const bf16_t*)(ws + WS_FBC), 256, 8192, 512};
                    pg8::StaticOrder S; S.init(g.M, g.N, G, (f == 0) ? bid : (bid + G - 64) % G);
                    EpiF E{OB, (f == 0) ? NCTX : 0, (f == 0) ? 2048 : 256};
                    pg8::gemm_phase<EpiF, pg8::StaticOrder, true, true>(lds, g, S, E);
                }
            }
            { int tidq = threadIdx.x; asm volatile("" : "+v"(tidq));
              phase_b(a, lds, l, tidq, 1, 0, 1, CTL + 64 * (16 + l + 8 * repb)); }
        }
#endif
        PH_END
        PH_BEGIN
#ifndef SKIP_C
#pragma unroll 1
        for (int rep = 0; rep < NREP_C; ++rep) {
            int tid2 = threadIdx.x; asm volatile("" : "+v"(tid2));
            unsigned char* ws2 = a.ws; asm volatile("" : "+s"(ws2));
            float lam, lam_init;
            { const float p1 = ((tid2 & 63) < 32) ? a.in[I_LQ1][l * 32 + (tid2 & 63)] * a.in[I_LK1][l * 32 + (tid2 & 63)] : 0.f, p2 = ((tid2 & 63) < 32) ? a.in[I_LQ2][l * 32 + (tid2 & 63)] * a.in[I_LK2][l * 32 + (tid2 & 63)] : 0.f;
              lam_init = 0.8f - 0.6f * expf(-0.3f * (float)l); lam = expf(wave_sum(p1)) - expf(wave_sum(p2)) + lam_init; }
            const float cm = 0.10206207261596575f * 1.4426950408889634f, cd = 0.17677669529663687f * 1.4426950408889634f;
            LAS int* qslot = (LAS int*)(lds + LDS_MISC);
            unsigned* qctr = (unsigned*)(ws2 + WS_CTL) + 64 * (1 + l + 8 * rep);
            for (;;) {
                __syncthreads();
                if (tid2 == 0) *qslot = (int)atomicAdd(qctr, 1u);
                __syncthreads();
                const int idx = *qslot;
                if (idx >= 1152) break;
                const bool lat = idx < 768;
                const bool diff = lat ? (idx < 384) : (idx < 960);
                int q0, vt_ld, nt_main, nt_total, qa_ld; size_t qa_off, k_off, vt_off; size_t qa_base, k_base, vt_base;
                int h;
                if (lat) { const int j = diff ? idx : idx - 384; const int bh = j >> 3, qb = j & 7, b = bh / 6; h = bh % 6;
                    const int lr0 = b * 2048 + qb * 256; q0 = NCTX + lr0; vt_ld = 2560; nt_main = 32; nt_total = 40;
                    qa_base = diff ? WS_QDR : WS_QMR; qa_ld = diff ? 384 : 576; qa_off = (size_t)lr0 * qa_ld + (diff ? 64 : 96) * h;
                    k_base = diff ? WS_KDL : WS_KML; k_off = (size_t)b * 2560 * (diff ? 384 : 576) + (diff ? 64 : 96) * h;
                    vt_base = diff ? WS_VDL : WS_VML; vt_off = (size_t)(b * 6 + h) * 64 * 2560; }
                else { const int j = diff ? idx - 768 : idx - 960; const int i = j / 6; h = j % 6; q0 = i * 256; vt_ld = 256; nt_main = 4; nt_total = 4;
                    qa_base = WS_P; qa_ld = INP; qa_off = (size_t)q0 * INP + (diff ? 736 + 64 * h : 96 * h);
                    k_base = diff ? WS_KDC : WS_KMC; k_off = (size_t)q0 * (diff ? 384 : 576) + (diff ? 64 : 96) * h;
                    vt_base = diff ? WS_VDC : WS_VMC; vt_off = (size_t)(i * 6 + h) * 64 * 256; }
                const bf16_t* Qa = (const bf16_t*)(ws2 + qa_base) + qa_off;
                const bf16_t* Qb = (const bf16_t*)(ws2 + WS_P) + (size_t)q0 * INP + (diff ? 736 + 64 * h : 96 * h);
                const bf16_t* Kp = (const bf16_t*)(ws2 + k_base) + k_off;
                const bf16_t* Vt = (const bf16_t*)(ws2 + vt_base) + vt_off;
                bf16_t* Oo = (bf16_t*)(ws2 + WS_OB) + (size_t)q0 * DM + (diff ? 384 : 0) + 64 * h;
                if (diff) { int tt = threadIdx.x; asm volatile("" : "+v"(tt)); attn_unit<true>(lds, Qa, qa_ld, Qb, INP, Kp, 384, Vt, vt_ld, nt_main, nt_total, Oo, cd, lam, a.in[I_GSUB] + l * 64, 1.0f - lam_init, tt); }
                else { int tt = threadIdx.x; asm volatile("" : "+v"(tt)); attn_unit<false>(lds, Qa, qa_ld, Qb, INP, Kp, 576, Vt, vt_ld, nt_main, nt_total, Oo, cm, 0.f, nullptr, 0.f, tt); }
            }
        }
#endif
        PH_END
        PH_BEGIN
#ifndef SKIP_D
        {
            if (l > 0 && bid >= 128) { convert_weights(a, lds, l, 16, gw - 128 * 8, NGW - 128 * 8, wave, lane); __syncthreads(); }
            pg8::Gemm g{OB, (const bf16_t*)(ws + WS_WOUT), MTOT, DM, DM}; pg8::StaticOrder S; S.init(MTOT, DM, G, bid);
            EpiRes E{(l == 0) ? a.in[I_XP] : a.out, (l == 0) ? a.in[I_XS] : a.out + (size_t)NCTX * DM, a.out, (MOD + (size_t)l * 9 * 6144) + 2 * 1024,
                     a.in[I_GFFN] + l * DM, (MOD + (size_t)l * 9 * 6144) + 4 * 1024, XS, SSQ + (size_t)(2 * l + 1) * MTOT, 0};
            pg8::gemm_phase<EpiRes, pg8::StaticOrder, true, true>(lds, g, S, E);
        }
#endif
        PH_END
        PH_BEGIN
#ifndef SKIP_E
        {
            pg8::Gemm g{XS, (const bf16_t*)(ws + WS_WUP), 104 * 256, UPC, DM}; FfnOrder S; S.init(G, bid);
            EpiFfn E{(bf16_t*)(ws + WS_R), SSQ + (size_t)(2 * l + 1) * MTOT, BUP + (size_t)l * 9 * UPC, a.in[I_WCONV] + (size_t)l * 3 * UPC, lds};
            for (int rep = 0; rep < NREP_E; ++rep) pg8::gemm_phase<EpiFfn, FfnOrder, true, true>(lds, g, S, E);
        }
#endif
        PH_END
        PH_BEGIN
#ifndef SKIP_G
        {
            if (l + 1 < NLAYER && bid >= 128) { convert_weights(a, lds, l + 1, 15, gw - 128 * 8, NGW - 128 * 8, wave, lane); __syncthreads(); }
            const bool nxt = (l + 1 < NLAYER);
            pg8::Gemm g{(const bf16_t*)(ws + WS_R), (const bf16_t*)(ws + WS_WDN), MTOT, DM, DFF}; pg8::StaticOrder S; S.init(MTOT, DM, G, bid);
            EpiRes E{a.out, a.out + (size_t)NCTX * DM, a.out, (MOD + (size_t)l * 9 * 6144) + 5 * 1024,
                     nxt ? a.in[I_GMIX] + (l + 1) * DM : nullptr, (MOD + (size_t)l * 9 * 6144) + 9 * 6144 + 1 * 1024, XS, SSQ + (size_t)(nxt ? 2 * l + 2 : 8) * MTOT, 0};
            pg8::gemm_phase<EpiRes, pg8::StaticOrder, true, true>(lds, g, S, E);
        }
#endif
        PH_END
    }
    PH_BEGIN
#ifndef SKIP_FIN
    {
        const float* gf = a.in[I_GFINAL];
        for (int r = gw; r < MTOT; r += NGW) {
            float* xr = a.out + (size_t)r * DM;
            f32x4 x[4]; float ss = 0.f;
#pragma unroll
            for (int j = 0; j < 4; ++j) { x[j] = *(const f32x4*)(xr + 4 * lane + 256 * j); ss += (x[j][0] * x[j][0] + x[j][1] * x[j][1]) + (x[j][2] * x[j][2] + x[j][3] * x[j][3]); }
            ss = wave_sum(ss);
            const float rs = rsqrtf(ss * (1.0f / 1024.0f) + EPS);
#pragma unroll
            for (int j = 0; j < 4; ++j) { const f32x4 g = *(const f32x4*)(gf + 4 * lane + 256 * j); *(f32x4*)(xr + 4 * lane + 256 * j) = x[j] * rs * g; }
        }
    }
#endif
    PH_END
#undef PH_BEGIN
#undef PH_END
}
constexpr int N_PHASES = 2 + NLAYER * 7 + 1;

#ifndef MK_ONE_LAUNCH
#define MK_ONE_LAUNCH 1
#endif
extern "C" void kernel_launch(void* const* d_in, const int* in_sizes, int n_in, void* d_out, int out_size, void* d_ws, size_t ws_size, hipStream_t stream) {
    static int grid = 0;
    if (grid == 0) {
        if (n_in != 26 || ws_size < WS_END) { fprintf(stderr, "kernel_launch: unexpected inputs (n_in %d, ws %zu < %zu)\n", n_in, ws_size, (size_t)WS_END); grid = -1; return; }
        int dev = 0, cus = 0, per_cu = 0;
        hipGetDevice(&dev); hipDeviceGetAttribute(&cus, hipDeviceAttributeMultiprocessorCount, dev);
        if (hipFuncSetAttribute((const void*)mega_fwd, hipFuncAttributeMaxDynamicSharedMemorySize, LDS_BYTES) != hipSuccess) { fprintf(stderr, "kernel_launch: hipFuncSetAttribute failed\n"); grid = -1; return; }
        if (hipOccupancyMaxActiveBlocksPerMultiprocessor(&per_cu, (const void*)mega_fwd, 512, LDS_BYTES) != hipSuccess || per_cu < 1) { fprintf(stderr, "kernel_launch: occupancy query gave %d\n", per_cu); per_cu = 1; }
        (void)hipGetLastError();
        grid = cus * 1;
    }
    if (grid < 0) return;
    if (hipMemsetAsync((char*)d_ws + WS_CTL, 0, 1 << 20, stream) != hipSuccess) { fprintf(stderr, "kernel_launch: memset failed\n"); return; }
    Args a{};
    for (int i = 0; i < 26; ++i) a.in[i] = (const float*)d_in[i];
    a.out = (float*)d_out; a.ws = (unsigned char*)d_ws;
#if MK_ONE_LAUNCH
    a.ph_lo = 0; a.ph_hi = N_PHASES;
    void* args[] = {&a};
    hipError_t e = hipLaunchCooperativeKernel((const void*)mega_fwd, dim3(grid), dim3(512), args, LDS_BYTES, stream);
    if (e != hipSuccess) fprintf(stderr, "cooperative launch failed: %s (grid %d)\n", hipGetErrorString(e), grid);
#else
    for (int p = 0; p < N_PHASES; ++p) { a.ph_lo = p; a.ph_hi = p + 1; hipLaunchKernelGGL(mega_fwd, dim3(grid), dim3(512), LDS_BYTES, stream, a); }
#endif
}
```
